# Optimizing an MI355X kernel written in HIP

```python
import math
import jax, jax.numpy as jnp
from jax import lax
import numpy as np

D_MODEL = 1024
BATCH = 16
SEQ = 2048
DEPTH = 4

CHUNK = 64
N_A = DEPTH // 2
N_B = DEPTH - N_A
N_DENSE = (DEPTH + 1) // 2
N_MOE = DEPTH // 2

RET_HEADS = 8
RET_DK = D_MODEL // RET_HEADS
RET_DV = 2 * D_MODEL // RET_HEADS
RET_IN = 2 * RET_HEADS * RET_DK + 2 * RET_HEADS * RET_DV
ROPE_BASE = 10000.0

SB_HEADS = 16
SB_DH = D_MODEL // SB_HEADS
Q_BLOCK = 128

FF_DENSE = 2816
N_EXPERTS = 8
TOP_K = 2
FF_EXPERT = 3584
EPS = 1e-6

kernel_name = "yoco_retention_stickbreaking_moe_adaln"


def rms_norm(x, g):
    x32 = x.astype(jnp.float32)
    y = x32 * lax.rsqrt(jnp.mean(x32 * x32, axis=-1, keepdims=True) + EPS)
    return (y * g.astype(jnp.float32)).astype(x.dtype)


def modulate(h, shift, scale):
    return h * (1.0 + scale[:, None, :]) + shift[:, None, :]


def rope(t, cos, sin):
    t1, t2 = jnp.split(t, 2, axis=-1)
    return jnp.concatenate([t1 * cos - t2 * sin, t1 * sin + t2 * cos], axis=-1)


def retention(h, positions, w_in, gn_w, w_out):
    B, S, _ = h.shape
    H, DK, DV, C = RET_HEADS, RET_DK, RET_DV, CHUNK
    nC = S // C
    proj = h @ w_in
    q, k, v, g = jnp.split(proj, [H * DK, 2 * H * DK, 2 * H * DK + H * DV], axis=-1)
    q = q.reshape(B, S, H, DK)
    k = k.reshape(B, S, H, DK)
    v = v.reshape(B, S, H, DV)
    inv_freq = jnp.power(ROPE_BASE, -jnp.arange(0, DK, 2, dtype=jnp.float32) / DK)
    ang = positions.astype(jnp.float32)[..., None] * inv_freq
    cos = jnp.cos(ang)[:, :, None, :].astype(h.dtype)
    sin = jnp.sin(ang)[:, :, None, :].astype(h.dtype)
    q = rope(q, cos, sin)
    k = rope(k, cos, sin) * (DK ** -0.5)
    log_gamma = jnp.log(1.0 - jnp.exp2(-5.0 - jnp.arange(H, dtype=jnp.float32)))
    pos = jnp.arange(C, dtype=jnp.float32)
    d_intra = jnp.exp(jnp.abs(pos[:, None] - pos[None, :])[None] * log_gamma[:, None, None]).astype(h.dtype)
    q_decay = jnp.exp((pos[:, None] + 1.0) * log_gamma[None, :]).astype(h.dtype)
    k_decay = jnp.exp((C - 1.0 - pos)[:, None] * log_gamma[None, :]).astype(h.dtype)
    chunk_decay = jnp.exp(C * log_gamma).astype(h.dtype)

    def to_chunks(t):
        return jnp.moveaxis(t.reshape(B, nC, C, H, t.shape[-1]), 1, 0)

    def step(state, qkv):
        qc, kc, vc = qkv
        scores = jnp.einsum('bchd,bshd->bhcs', qc, kc) * d_intra[None]
        intra = jnp.einsum('bhcs,bshe->bche', scores, vc)
        cross = jnp.einsum('bchd,bhde->bche', qc * q_decay[None, :, :, None], state)
        new_state = state * chunk_decay[None, :, None, None] + jnp.einsum(
            'bshd,bshe->bhde', kc * k_decay[None, :, :, None], vc)
        return new_state, intra + cross

    state0 = jnp.zeros((B, H, DK, DV), dtype=q.dtype)
    _, o = lax.scan(step, state0, (to_chunks(q), to_chunks(k), to_chunks(v)))
    o = jnp.moveaxis(o, 0, 1).reshape(B, S, H, DV)
    o32 = o.astype(jnp.float32)
    mu = jnp.mean(o32, axis=-1, keepdims=True)
    var = jnp.mean(jnp.square(o32 - mu), axis=-1, keepdims=True)
    on = ((o32 - mu) * lax.rsqrt(var + EPS)).reshape(B, S, H * DV) * gn_w.astype(jnp.float32)
    return (jax.nn.silu(g) * on.astype(h.dtype)) @ w_out


def stick_breaking(h, k_sh, v_sh, w_q, w_out):
    B, S, _ = h.shape
    q = (h @ w_q).reshape(B, S, SB_HEADS, SB_DH)
    scale = SB_DH ** -0.5
    outs = []
    for i in range(S // Q_BLOCK):
        end = (i + 1) * Q_BLOCK
        qb = q[:, i * Q_BLOCK:end]
        kb = k_sh[:, :end]
        vb = v_sh[:, :end]
        z = jnp.einsum('bqhd,bkhd->bhqk', qb, kb).astype(jnp.float32) * scale
        t_idx = i * Q_BLOCK + jnp.arange(Q_BLOCK)
        s_idx = jnp.arange(end)
        causal = s_idx[None, :] < t_idx[:, None]
        log_one_minus = jnp.where(causal, jax.nn.log_sigmoid(-z), 0.0)
        tail = lax.cumsum(log_one_minus, axis=3, reverse=True) - log_one_minus
        a = jnp.where(causal, jnp.exp(jax.nn.log_sigmoid(z) + tail), 0.0)
        outs.append(jnp.einsum('bhqk,bkhd->bqhd', a.astype(vb.dtype), vb))
    o = jnp.concatenate(outs, axis=1).reshape(B, S, SB_HEADS * SB_DH)
    return o @ w_out


def swiglu(h, w_in, w_out):
    a, b = jnp.split(h @ w_in, 2, axis=-1)
    return (jax.nn.silu(a) * b) @ w_out


def moe_swiglu(h, router, w_in, w_out):
    B, S, D = h.shape
    hf = h.reshape(B * S, D)
    logits = (hf @ router).astype(jnp.float32)
    top_v, top_i = lax.top_k(logits, TOP_K)
    top_w = jax.nn.softmax(top_v, axis=-1)
    gates = jnp.sum(jax.nn.one_hot(top_i, N_EXPERTS, dtype=jnp.float32) * top_w[..., None], axis=1)
    y = jnp.zeros_like(hf)
    for e in range(N_EXPERTS):
        y = y + gates[:, e:e + 1].astype(hf.dtype) * swiglu(hf, w_in[e], w_out[e])
    return y.reshape(B, S, D)


def setup_inputs(seed: int = 0) -> dict:
    key = jax.random.key(seed)
    ks = jax.random.split(key, 24)
    D = D_MODEL

    def nrm(k, shape, fan_in, s=1.0):
        return jax.random.normal(k, shape, jnp.float32) * (s * fan_in ** -0.5)

    def gain(k, shape):
        return 1.0 + 0.02 * jax.random.normal(k, shape, jnp.float32)

    x = jax.random.normal(ks[0], (BATCH, SEQ, D), jnp.float32)
    c = jax.random.normal(ks[1], (BATCH, D), jnp.float32)
    offset = jax.random.randint(ks[2], (BATCH, 1), 0, 4096, dtype=jnp.int32)
    positions = offset + jnp.arange(SEQ, dtype=jnp.int32)[None, :]
    return {
        "x": x,
        "c": c,
        "positions": positions,
        "ada_w": nrm(ks[3], (DEPTH, D, 6 * D), D, 0.5),
        "ada_b": 0.02 * jax.random.normal(ks[4], (DEPTH, 6 * D), jnp.float32),
        "norm_mix": gain(ks[5], (DEPTH, D)),
        "norm_ff": gain(ks[6], (DEPTH, D)),
        "ret_w_in": nrm(ks[7], (N_A, D, RET_IN), D),
        "ret_gn": gain(ks[8], (N_A, RET_HEADS * RET_DV)),
        "ret_w_out": nrm(ks[9], (N_A, RET_HEADS * RET_DV, D), RET_HEADS * RET_DV),
        "kv_ada_w": nrm(ks[10], (D, 2 * D), D, 0.5),
        "kv_ada_b": 0.02 * jax.random.normal(ks[11], (2 * D,), jnp.float32),
        "kv_norm": gain(ks[12], (D,)),
        "kv_w": nrm(ks[13], (D, 2 * SB_HEADS * SB_DH), D),
        "sb_w_q": nrm(ks[14], (N_B, D, SB_HEADS * SB_DH), D),
        "sb_w_out": nrm(ks[15], (N_B, SB_HEADS * SB_DH, D), SB_HEADS * SB_DH),
        "ff_w_in": nrm(ks[16], (N_DENSE, D, 2 * FF_DENSE), D),
        "ff_w_out": nrm(ks[17], (N_DENSE, FF_DENSE, D), FF_DENSE),
        "moe_router": nrm(ks[18], (N_MOE, D, N_EXPERTS), D),
        "moe_w_in": nrm(ks[19], (N_MOE, N_EXPERTS, D, 2 * FF_EXPERT), D),
        "moe_w_out": nrm(ks[20], (N_MOE, N_EXPERTS, FF_EXPERT, D), FF_EXPERT),
        "final_norm": gain(ks[21], (D,)),
    }


def reference(x, c, positions, ada_w, ada_b, norm_mix, norm_ff, ret_w_in, ret_gn, ret_w_out,
              kv_ada_w, kv_ada_b, kv_norm, kv_w, sb_w_q, sb_w_out, ff_w_in, ff_w_out,
              moe_router, moe_w_in, moe_w_out, final_norm):
    B, S, _ = x.shape
    cond = jax.nn.silu(c)
    k_sh = None
    v_sh = None
    for i in range(DEPTH):
        mod = cond @ ada_w[i] + ada_b[i]
        sh_m, sc_m, g_m, sh_f, sc_f, g_f = jnp.split(mod, 6, axis=-1)
        h = modulate(rms_norm(x, norm_mix[i]), sh_m, sc_m)
        if i < N_A:
            y = retention(h, positions, ret_w_in[i], ret_gn[i], ret_w_out[i])
        else:
            j = i - N_A
            y = stick_breaking(h, k_sh, v_sh, sb_w_q[j], sb_w_out[j])
        x = x + g_m[:, None, :] * y
        h = modulate(rms_norm(x, norm_ff[i]), sh_f, sc_f)
        if i % 2 == 0:
            y = swiglu(h, ff_w_in[i // 2], ff_w_out[i // 2])
        else:
            y = moe_swiglu(h, moe_router[i // 2], moe_w_in[i // 2], moe_w_out[i // 2])
        x = x + g_f[:, None, :] * y
        if i == N_A - 1:
            kv_mod = cond @ kv_ada_w + kv_ada_b
            sh_kv, sc_kv = jnp.split(kv_mod, 2, axis=-1)
            hk = modulate(rms_norm(x, kv_norm), sh_kv, sc_kv)
            kv = (hk @ kv_w).reshape(B, S, 2, SB_HEADS, SB_DH)
            k_sh = kv[:, :, 0]
            v_sh = kv[:, :, 1]
    return rms_norm(x, final_norm)
```

```cpp
#include <hip/hip_runtime.h>
#include <cstdio>
#include <cstdint>

#define LAS __attribute__((address_space(3)))
#define GAS __attribute__((address_space(1)))
typedef _Float16 f16;
typedef _Float16 f16x2 __attribute__((ext_vector_type(2)));
typedef _Float16 f16x4 __attribute__((ext_vector_type(4)));
typedef _Float16 f16x8 __attribute__((ext_vector_type(8)));
typedef float f32x2 __attribute__((ext_vector_type(2)));
typedef float f32x4 __attribute__((ext_vector_type(4)));
typedef float f32x16 __attribute__((ext_vector_type(16)));
typedef unsigned u32x2 __attribute__((ext_vector_type(2)));
typedef unsigned u32x4 __attribute__((ext_vector_type(4)));
typedef short v4i16_t __attribute__((ext_vector_type(4)));

#ifndef DIS_K0
#define DIS_K0 0
#endif
#ifndef DIS_K1
#define DIS_K1 0
#endif
#ifndef DIS_K2
#define DIS_K2 0
#endif
#ifndef DIS_K3
#define DIS_K3 0
#endif
#ifndef DIS_K4
#define DIS_K4 0
#endif
#ifndef DIS_K5
#define DIS_K5 0
#endif
#ifndef DIS_K6
#define DIS_K6 0
#endif
#ifndef DIS_K7
#define DIS_K7 0
#endif
#ifndef MK_PER_PHASE
#define MK_PER_PHASE 1
#endif

constexpr int BATCH = 16, SEQ = 2048, DM = 1024, MTOK = BATCH * SEQ;
constexpr int RH = 8, RDK = 128, RDV = 256, RIN = 6144, CHUNK = 64, NCHUNK = SEQ / CHUNK;
constexpr int SBH = 16, SDH = 64;
constexpr int FFD = 2816, NEXP = 8, FFE = 3584;
constexpr float EPS = 1e-6f;
constexpr int MOE_ROWS_MAX = 2 * MTOK + NEXP * 256;

__device__ __forceinline__ float lg2gamma(int h) {
    const float t[8] = {-4.580368961312e-02f, -2.272007650008e-02f, -1.131531322783e-02f, -5.646563141142e-03f, -2.820519062379e-03f, -1.409570254671e-03f, -7.046129765894e-04f, -3.522634716290e-04f};
    float r = t[0];
#pragma unroll
    for (int i = 1; i < 8; ++i) r = (h == i) ? t[i] : r;
    return r;
}
__device__ __forceinline__ unsigned pkh(float lo, float hi) { f32x2 v = {lo, hi}; f16x2 h = __builtin_convertvector(v, f16x2); return __builtin_bit_cast(unsigned, h); }
__device__ __forceinline__ float silu_f(float x) { return x * __builtin_amdgcn_rcpf(1.0f + __builtin_amdgcn_exp2f(-1.4426950408889634f * x)); }
__device__ __forceinline__ float ex2(float x) { return __builtin_amdgcn_exp2f(x); }

namespace pg8 {
constexpr int BM = 256, BK = 64, HALF = 128, HTB = HALF * BK * 2, STAGE_BYTES = 8 * HTB, NXCD = 8, WGM = 8;
__host__ __device__ __forceinline__ int lds_byte(int r, int c) { const int st = (r >> 4) * 2 + (c >> 5), rr = r & 15, cc = c & 31, ob = rr * 64 + cc * 2; return st * 1024 + (ob ^ (((ob >> 9) & 1) << 5)); }
__host__ __device__ __forceinline__ void stage_rc(int b, int& R, int& C) { const int st = b / 1024, sb = b % 1024, swz = sb ^ (((sb >> 9) & 1) << 5); R = (st >> 1) * 16 + swz / 64; C = (st & 1) * 32 + (swz % 64) / 2; }
__host__ __device__ __forceinline__ int perm32(int rho) { const int n = rho >> 4, i = rho & 15; return 8 * (i >> 2) + 4 * n + (i & 3); }

struct Unit { int pm, pn, be; };
struct Gemm { const f16* A; const f16* Bt; int M, N, K; size_t bstride; };

struct Order {
    int nM, nN, nwg, G, c; int tb[NEXP];
    __device__ void init(int M, int N, int G_, int c_) { nM = M / BM; nN = N / BM; nwg = nM * nN; G = G_; c = c_;
#pragma unroll
        for (int e = 0; e < NEXP; ++e) tb[e] = e ? 0x7fffffff : 0; }
    __device__ bool next(int i, Unit& u) const {
        const long L = (long)i * G + c; if (L >= nwg) return false;
        int wgid = (int)L; { const int q = nwg / NXCD, r = nwg % NXCD, xcd = wgid % NXCD, off = wgid / NXCD; wgid = (xcd < r ? xcd * (q + 1) : r * (q + 1) + (xcd - r) * q) + off; }
        const int nig = WGM * nN, gid = wgid / nig, fm = gid * WGM, gsz = (nM - fm) < WGM ? (nM - fm) : WGM;
        u.pm = fm + ((wgid % nig) % gsz); u.pn = (wgid % nig) / gsz;
        int be = 0;
#pragma unroll
        for (int e = 1; e < NEXP; ++e) be += (u.pm >= tb[e]) ? 1 : 0;
        u.be = be; return true;
    }
};


struct EpiRetIn {
    static constexpr bool PERM = true;
    f16* O; const float* rope;
    __device__ __forceinline__ void operator()(const f32x4 (&acc)[2][2][4][2], const Unit& u, int wr, int wc, int fr, int fq) const {
        const int row0 = u.pm * BM + wr * 64 + fr, cl = wc * 32 + 8 * fq;
        f16* base = O + (size_t)u.pn * BM + cl;
        if (u.pn < 8) {
            const bool isk = u.pn >= 4; const int i0 = cl >> 1;
            float lg[2]; lg[0] = lg2gamma(2 * (u.pn & 3)); lg[1] = lg2gamma(2 * (u.pn & 3) + 1);
#pragma unroll
            for (int ai = 0; ai < 2; ++ai)
#pragma unroll
                for (int m = 0; m < 4; ++m) {
                    const int row = row0 + ai * HALF + m * 16; const float pos = (float)(16 * m + fr);
                    const f32x4 cs = *(const f32x4*)(rope + (size_t)row * 128 + i0), sn = *(const f32x4*)(rope + (size_t)row * 128 + 64 + i0);
#pragma unroll
                    for (int bj = 0; bj < 2; ++bj) {
                        const float sc = isk ? ex2(-pos * lg[bj]) * 0.08838834764831845f : ex2((pos + 1.0f) * lg[bj]);
                        const f32x4 v0 = acc[ai][bj][m][0], v1 = acc[ai][bj][m][1];
                        u32x4 w;
                        w.x = pkh((v0[0] * cs[0] - v0[1] * sn[0]) * sc, (v0[0] * sn[0] + v0[1] * cs[0]) * sc);
                        w.y = pkh((v0[2] * cs[1] - v0[3] * sn[1]) * sc, (v0[2] * sn[1] + v0[3] * cs[1]) * sc);
                        w.z = pkh((v1[0] * cs[2] - v1[1] * sn[2]) * sc, (v1[0] * sn[2] + v1[1] * cs[2]) * sc);
                        w.w = pkh((v1[2] * cs[3] - v1[3] * sn[3]) * sc, (v1[2] * sn[3] + v1[3] * cs[3]) * sc);
                        *(u32x4*)(base + (size_t)row * RIN + bj * HALF) = w;
                    }
                }
        } else {
            const bool isg = u.pn >= 16;
#pragma unroll
            for (int ai = 0; ai < 2; ++ai)
#pragma unroll
                for (int m = 0; m < 4; ++m) {
                    const int row = row0 + ai * HALF + m * 16;
#pragma unroll
                    for (int bj = 0; bj < 2; ++bj) {
                        f32x4 v0 = acc[ai][bj][m][0], v1 = acc[ai][bj][m][1];
                        if (isg) {
#pragma unroll
                            for (int j = 0; j < 4; ++j) { v0[j] = silu_f(v0[j]); v1[j] = silu_f(v1[j]); } }
                        u32x4 w; w.x = pkh(v0[0], v0[1]); w.y = pkh(v0[2], v0[3]); w.z = pkh(v1[0], v1[1]); w.w = pkh(v1[2], v1[3]);
                        *(u32x4*)(base + (size_t)row * RIN + bj * HALF) = w;
                    }
                }
        }
    }
};
struct EpiRes {
    static constexpr bool PERM = false;
    const float* base; float* out; const float* gate;
    __device__ __forceinline__ void operator()(const f32x4 (&acc)[2][2][4][2], const Unit& u, int wr, int wc, int fr, int fq) const {
        const int row0 = u.pm * BM + wr * 64 + fr, col0 = u.pn * BM + wc * 32 + 4 * fq;
        const float* gp = gate + (size_t)(u.pm >> 3) * 6144 + col0;
        f32x4 gv[2][2];
#pragma unroll
        for (int bj = 0; bj < 2; ++bj)
#pragma unroll
            for (int n = 0; n < 2; ++n) gv[bj][n] = *(const f32x4*)(gp + bj * HALF + n * 16);
#pragma unroll
        for (int ai = 0; ai < 2; ++ai)
#pragma unroll
            for (int m = 0; m < 4; ++m) { const size_t off = (size_t)(row0 + ai * HALF + m * 16) * DM + col0;
#pragma unroll
                for (int bj = 0; bj < 2; ++bj)
#pragma unroll
                    for (int n = 0; n < 2; ++n) { const f32x4 b = *(const f32x4*)(base + off + bj * HALF + n * 16); *(f32x4*)(out + off + bj * HALF + n * 16) = b + gv[bj][n] * acc[ai][bj][m][n]; }
                asm volatile("" ::: "memory"); }
    }
};
struct EpiGlu {
    static constexpr bool PERM = true;
    f16* O; int ldc;
    __device__ __forceinline__ void operator()(const f32x4 (&acc)[2][2][4][2], const Unit& u, int wr, int wc, int fr, int fq) const {
        const int row0 = u.pm * BM + wr * 64 + fr, col0 = u.pn * HALF + wc * 32 + 8 * fq;
#pragma unroll
        for (int ai = 0; ai < 2; ++ai)
#pragma unroll
            for (int m = 0; m < 4; ++m) {
                const f32x4 a0 = acc[ai][0][m][0], a1 = acc[ai][0][m][1], b0 = acc[ai][1][m][0], b1 = acc[ai][1][m][1];
                u32x4 w; w.x = pkh(silu_f(a0[0]) * b0[0], silu_f(a0[1]) * b0[1]); w.y = pkh(silu_f(a0[2]) * b0[2], silu_f(a0[3]) * b0[3]);
                w.z = pkh(silu_f(a1[0]) * b1[0], silu_f(a1[1]) * b1[1]); w.w = pkh(silu_f(a1[2]) * b1[2], silu_f(a1[3]) * b1[3]);
                *(u32x4*)(O + (size_t)(row0 + ai * HALF + m * 16) * ldc + col0) = w;
            }
    }
};
struct EpiF16 {
    static constexpr bool PERM = true;
    f16* O; int ldc; int split_cols; size_t split_stride; float scale;
    __device__ __forceinline__ void operator()(const f32x4 (&acc)[2][2][4][2], const Unit& u, int wr, int wc, int fr, int fq) const {
        const int row0 = u.pm * BM + wr * 64 + fr; int colt = u.pn * BM; f16* base = O;
        if (split_cols) { const int t = colt / split_cols; base += (size_t)t * split_stride; colt -= t * split_cols; }
        const int col0 = colt + wc * 32 + 8 * fq;
#pragma unroll
        for (int ai = 0; ai < 2; ++ai)
#pragma unroll
            for (int m = 0; m < 4; ++m) { f16* rowp = base + (size_t)(row0 + ai * HALF + m * 16) * ldc + col0;
#pragma unroll
                for (int bj = 0; bj < 2; ++bj) { const f32x4 v0 = acc[ai][bj][m][0] * scale, v1 = acc[ai][bj][m][1] * scale;
                    u32x4 w; w.x = pkh(v0[0], v0[1]); w.y = pkh(v0[2], v0[3]); w.z = pkh(v1[0], v1[1]); w.w = pkh(v1[2], v1[3]);
                    *(u32x4*)(rowp + bj * HALF) = w; } }
    }
};
struct EpiMoeOut {
    static constexpr bool PERM = true;
    f16* O; const float* roww;
    __device__ __forceinline__ void operator()(const f32x4 (&acc)[2][2][4][2], const Unit& u, int wr, int wc, int fr, int fq) const {
        const int row0 = u.pm * BM + wr * 64 + fr, col0 = u.pn * BM + wc * 32 + 8 * fq;
#pragma unroll
        for (int ai = 0; ai < 2; ++ai)
#pragma unroll
            for (int m = 0; m < 4; ++m) { const int row = row0 + ai * HALF + m * 16; const float sc = roww[row]; f16* rowp = O + (size_t)row * DM + col0;
#pragma unroll
                for (int bj = 0; bj < 2; ++bj) { const f32x4 v0 = acc[ai][bj][m][0] * sc, v1 = acc[ai][bj][m][1] * sc;
                    u32x4 w; w.x = pkh(v0[0], v0[1]); w.y = pkh(v0[2], v0[3]); w.z = pkh(v1[0], v1[1]); w.w = pkh(v1[2], v1[3]);
                    *(u32x4*)(rowp + bj * HALF) = w; } }
    }
};

template <class Epi>
__device__ __forceinline__ void gemm_phase(LAS unsigned char* lds, const Gemm g, const Order& S, const Epi& E) {
    const int tid = threadIdx.x, wid = __builtin_amdgcn_readfirstlane(tid >> 6), lane = tid & 63, wr = wid >> 2, wc = wid & 3, fr = lane & 15, fq = lane >> 4;
    const int K = g.K, nt = K / BK;
    unsigned voffA[2], voffB[2];
#pragma unroll
    for (int i = 0; i < 2; ++i) { int R, C; stage_rc(tid * 16 + i * 8192, R, C); const int Rb = Epi::PERM ? ((R & ~31) + perm32(R & 31)) : R;
        voffA[i] = (unsigned)(R * K + C) * 2u; voffB[i] = (unsigned)(Rb * K + C) * 2u; }
    const size_t kstep = (size_t)(BK * 2);
    const size_t hstep = (size_t)HALF * K * 2;
    const size_t tstep = 2 * hstep;
    const unsigned ldsw = (unsigned)wid * 1024u;
    const int aoff = lds_byte(wr * 64 + fr, fq * 8), boff = lds_byte(wc * 32 + fr, fq * 8);
#define PG8_SA(b, h) (((b) * 2 + (h)) * HTB)
#define PG8_SB(b, h) ((4 + (b) * 2 + (h)) * HTB)
#define PG8_STAGE(bufoff, gbase, voff) do { _Pragma("unroll") for (int _i = 0; _i < 2; ++_i) \
        __builtin_amdgcn_global_load_lds((const unsigned*)((const char*)(gbase) + (voff)[_i]), (LAS unsigned*)(lds + (bufoff) + ldsw + _i * 8192), 16, 0, 0); } while (0)
#define PG8_LDA(dst, b, h) do { _Pragma("unroll") for (int m = 0; m < 4; ++m) _Pragma("unroll") for (int k = 0; k < 2; ++k) dst[m][k] = *(const LAS f16x8*)(lds + PG8_SA(b, h) + aoff + m * 2048 + k * 1024); } while (0)
#define PG8_LDB(dst, b, h) do { _Pragma("unroll") for (int n = 0; n < 2; ++n) _Pragma("unroll") for (int k = 0; k < 2; ++k) dst[n][k] = *(const LAS f16x8*)(lds + PG8_SB(b, h) + boff + n * 2048 + k * 1024); } while (0)
#define PG8_MMA(ai, bj, At, Bt) do { __builtin_amdgcn_s_setprio(1); _Pragma("unroll") for (int m = 0; m < 4; ++m) _Pragma("unroll") for (int n = 0; n < 2; ++n) _Pragma("unroll") for (int k = 0; k < 2; ++k) \
        acc[ai][bj][m][n] = __builtin_amdgcn_mfma_f32_16x16x32_f16(Bt[n][k], At[m][k], acc[ai][bj][m][n], 0, 0, 0); __builtin_amdgcn_s_setprio(0); } while (0)
#define PG8_WAIT_V(n) asm volatile("s_waitcnt vmcnt(" #n ")" ::: "memory")
#define PG8_WAIT_L(n) asm volatile("s_waitcnt lgkmcnt(" #n ")" ::: "memory")
#define PG8_BAR __builtin_amdgcn_s_barrier()
#define PG8_SCHED __builtin_amdgcn_sched_barrier(0)
    Unit cur, nxt; int ui = 0;
    if (!S.next(0, cur)) return;
    f32x4 acc[2][2][4][2];
#pragma unroll
    for (int a = 0; a < 2; ++a)
#pragma unroll
        for (int b = 0; b < 2; ++b)
#pragma unroll
            for (int m = 0; m < 4; ++m)
#pragma unroll
                for (int n = 0; n < 2; ++n) acc[a][b][m][n] = (f32x4){0.f, 0.f, 0.f, 0.f};
    f16x8 At[4][2], B0[2][2], B1[2][2];
    const char* cA = (const char*)g.A + (size_t)cur.pm * tstep; const char* cB = (const char*)g.Bt + (size_t)cur.be * g.bstride + (size_t)cur.pn * tstep;
    PG8_STAGE(PG8_SB(0, 0), cB, voffB); PG8_STAGE(PG8_SB(0, 1), cB + hstep, voffB); PG8_STAGE(PG8_SA(0, 0), cA, voffA); PG8_STAGE(PG8_SA(0, 1), cA + hstep, voffA);
    if (wr == 1) PG8_BAR;
    PG8_WAIT_V(2); PG8_BAR;
    PG8_STAGE(PG8_SB(1, 0), cB + kstep, voffB); PG8_STAGE(PG8_SA(1, 0), cA + kstep, voffA); PG8_STAGE(PG8_SB(1, 1), cB + hstep + kstep, voffB);
    PG8_WAIT_V(6); PG8_BAR;
    for (;;) {
        const bool has_next = S.next(ui + 1, nxt);
        const char* nA = has_next ? (const char*)g.A + (size_t)nxt.pm * tstep : cA; const char* nB = has_next ? (const char*)g.Bt + (size_t)nxt.be * g.bstride + (size_t)nxt.pn * tstep : cB;
        for (int t = 0; t < nt; t += 2) {
            const bool last = (t == nt - 2);
            const char* a1 = cA + (size_t)(t + 1) * kstep;
            const char* a2 = last ? nA : cA + (size_t)(t + 2) * kstep; const char* b2 = last ? nB : cB + (size_t)(t + 2) * kstep;
            const char* a3 = a2 + kstep; const char* b3 = b2 + kstep;
            PG8_LDB(B0, 0, 0); PG8_LDB(B1, 0, 1); PG8_SCHED; PG8_LDA(At, 0, 0); PG8_STAGE(PG8_SA(1, 1), a1 + hstep, voffA);
            PG8_WAIT_V(8); PG8_WAIT_L(0); PG8_BAR; PG8_MMA(0, 0, At, B0); PG8_MMA(0, 1, At, B1); PG8_BAR; PG8_SCHED;
            PG8_LDA(At, 0, 1); PG8_STAGE(PG8_SB(0, 0), b2, voffB); PG8_STAGE(PG8_SB(0, 1), b2 + hstep, voffB); PG8_STAGE(PG8_SA(0, 0), a2, voffA);
            PG8_WAIT_V(8); PG8_WAIT_L(0); PG8_BAR; PG8_MMA(1, 0, At, B0); PG8_MMA(1, 1, At, B1); PG8_BAR; PG8_SCHED;
            PG8_LDB(B0, 1, 0); PG8_LDB(B1, 1, 1); PG8_SCHED; PG8_LDA(At, 1, 0); PG8_STAGE(PG8_SA(0, 1), a2 + hstep, voffA);
            PG8_WAIT_V(8); PG8_WAIT_L(0); PG8_BAR; PG8_MMA(0, 0, At, B0); PG8_MMA(0, 1, At, B1); PG8_BAR; PG8_SCHED;
            PG8_LDA(At, 1, 1); PG8_STAGE(PG8_SB(1, 0), b3, voffB); PG8_STAGE(PG8_SB(1, 1), b3 + hstep, voffB); PG8_STAGE(PG8_SA(1, 0), a3, voffA);
            PG8_WAIT_V(8); PG8_WAIT_L(0); PG8_BAR; PG8_MMA(1, 0, At, B0); PG8_MMA(1, 1, At, B1); PG8_BAR; PG8_SCHED;
        }
        if (wr == 0) PG8_BAR;
        E(acc, cur, wr, wc, fr, fq);
        if (!has_next) break;
#pragma unroll
        for (int a = 0; a < 2; ++a)
#pragma unroll
            for (int b = 0; b < 2; ++b)
#pragma unroll
                for (int m = 0; m < 4; ++m)
#pragma unroll
                    for (int n = 0; n < 2; ++n) acc[a][b][m][n] = (f32x4){0.f, 0.f, 0.f, 0.f};
        cur = nxt; cA = nA; cB = nB; ++ui;
        if (wr == 1) PG8_BAR;
    }
    PG8_WAIT_V(0);
    PG8_BAR;
#undef PG8_SA
#undef PG8_SB
#undef PG8_STAGE
#undef PG8_LDA
#undef PG8_LDB
#undef PG8_MMA
#undef PG8_WAIT_V
#undef PG8_WAIT_L
#undef PG8_BAR
#undef PG8_SCHED
}
}

constexpr size_t MiB = 1u << 20;
constexpr size_t WS_CTL = 0, CTL_ZERO_BYTES = 1 * MiB;
constexpr size_t WS_MOD = 1 * MiB;
constexpr size_t WS_KVMOD = 3 * MiB;
constexpr size_t WS_TOKINFO = 4 * MiB;
constexpr size_t WS_TOKSLOT = 6 * MiB;
constexpr size_t WS_SLOTW = 7 * MiB;
constexpr size_t WS_ROPE = 8 * MiB;
constexpr size_t WS_W_RIN = 24 * MiB, WS_W_ROUT = 48 * MiB, WS_W_KV = 56 * MiB, WS_W_SQ = 60 * MiB, WS_W_SO = 64 * MiB, WS_W_FIN = 68 * MiB, WS_W_FOUT = 90 * MiB, WS_W_MIN = 101 * MiB, WS_W_MOUT = 325 * MiB;
constexpr size_t WS_X = 437 * MiB, WS_H = 565 * MiB, WS_KSH = 629 * MiB, WS_VSH = 693 * MiB, WS_BIG = 757 * MiB;
constexpr size_t WS_PROJ = WS_BIG, WS_AO = WS_BIG + 384 * MiB;
constexpr size_t WS_ACTD = WS_BIG;
constexpr size_t WS_HS = WS_BIG, WS_Y2 = WS_BIG, WS_ACTE = WS_BIG + 132 * MiB;
constexpr size_t WS_SQ = WS_BIG, WS_SO = WS_BIG + 64 * MiB, WS_HK = WS_BIG + 192 * MiB;
constexpr size_t WS_END = WS_BIG + 594 * MiB;
static_assert((size_t)MOE_ROWS_MAX * DM * 2 <= 132 * MiB && WS_ACTE + (size_t)MOE_ROWS_MAX * FFE * 2 <= WS_END && WS_AO + (size_t)MTOK * 2048 * 2 <= WS_END, "ws map");
constexpr int CW_BAR = 4096;
constexpr int CW_MOE = 16384;

constexpr int RING_BYTES = 131072;
constexpr int LDS_BYTES = 147456;
constexpr int MISC_OFF = LDS_BYTES - 256;

#define XB_TMO      128
#define XB_XCNT(j)  (256  + 64 * (j))
#define XB_XSUB(j)  (1280 + 64 * (j))
#define XB_XGEN(j)  (2304 + 64 * (j))
#define XB_TOP      3328
#define XB_TOPGEN   3392
#define XCD_BAR_WORDS 3456
#define XB_SPIN_CAP (1u << 20)
__device__ __forceinline__ unsigned xb_ld(unsigned* p)              { return __hip_atomic_load(p, __ATOMIC_RELAXED, __HIP_MEMORY_SCOPE_AGENT); }
__device__ __forceinline__ unsigned xb_add(unsigned* p, unsigned v) { return __hip_atomic_fetch_add(p, v, __ATOMIC_RELAXED, __HIP_MEMORY_SCOPE_AGENT); }
__device__ __forceinline__ unsigned xb_xcc_id() { return (unsigned)__builtin_amdgcn_s_getreg((3 << 11) | 20) & 0xFu; }
#define XB_SPIN(cond, bar) do { unsigned _sp = 0; while (cond) { __builtin_amdgcn_s_sleep(1); \
    if ((++_sp & 255u) == 0u) { if (xb_ld(&(bar)[XB_TMO])) break; if (_sp > XB_SPIN_CAP) { atomicAdd(&(bar)[XB_TMO], 1u); break; } } } } while (0)
struct XcdBarrier { unsigned* bar; unsigned x; volatile LAS unsigned* st; };
__device__ __forceinline__ XcdBarrier xcd_barrier_post(unsigned* bar, volatile LAS unsigned* st) {
    XcdBarrier b; b.bar = bar; b.x = xb_xcc_id(); b.st = st;
    if (threadIdx.x == 0) (void)xb_add(&bar[XB_XCNT(b.x)], 1u);
    return b;
}
__device__ __forceinline__ void xcd_barrier_complete(unsigned* bar, unsigned x, unsigned& nloc, unsigned& nx) {
    const unsigned G = gridDim.x * gridDim.y * gridDim.z;
    unsigned sum, cnt, mine, sp = 0u;
    for (;;) {
        sum = 0u; cnt = 0u; mine = 0u;
#pragma unroll
        for (unsigned j = 0; j < 16; ++j) { const unsigned c = xb_ld(&bar[XB_XCNT(j)]); sum += c; cnt += (c > 0u) ? 1u : 0u; mine = (j == x) ? c : mine; }
        if (sum == G) break;
        __builtin_amdgcn_s_sleep(1);
        if ((++sp & 255u) == 0u) { if (xb_ld(&bar[XB_TMO])) break; if (sp > XB_SPIN_CAP) { atomicAdd(&bar[XB_TMO], 1u); break; } }
    }
    nloc = mine > 0u ? mine : 1u; nx = cnt > 0u ? cnt : 1u;
}
__device__ __forceinline__ void xcd_barrier(const XcdBarrier& b) {
    asm volatile("s_waitcnt vmcnt(0)" ::: "memory");
    __syncthreads();
    if (threadIdx.x == 0) {
        unsigned* bar = b.bar;
        __builtin_amdgcn_s_waitcnt(0);
        unsigned nloc = b.st[0], nx = b.st[1];
        if (nloc == 0u) { xcd_barrier_complete(bar, b.x, nloc, nx); b.st[0] = nloc; b.st[1] = nx; }
        const unsigned old = xb_add(&bar[XB_XSUB(b.x)], 1u);
        const unsigned gen = old / nloc;
        if (old + 1u == (gen + 1u) * nloc) {
            __builtin_amdgcn_fence(__ATOMIC_RELEASE, "agent");
            asm volatile("s_waitcnt vmcnt(0)" ::: "memory");
            const unsigned og = xb_add(&bar[XB_TOP], 1u);
            const unsigned tg = og / nx;
            if (og + 1u == (tg + 1u) * nx) xb_add(&bar[XB_TOPGEN], 1u);
            else XB_SPIN(xb_ld(&bar[XB_TOPGEN]) == tg, bar);
            __builtin_amdgcn_fence(__ATOMIC_ACQUIRE, "agent");
            xb_add(&bar[XB_XGEN(b.x)], 1u);
            asm volatile("s_waitcnt vmcnt(0)" ::: "memory");
        } else {
            XB_SPIN(xb_ld(&bar[XB_XGEN(b.x)]) == gen, bar);
            __builtin_amdgcn_fence(__ATOMIC_ACQUIRE, "agent");
            asm volatile("s_waitcnt vmcnt(0)" ::: "memory");
        }
    }
    __syncthreads();
}

#define WG_BAR() do { asm volatile("s_waitcnt lgkmcnt(0)" ::: "memory"); __builtin_amdgcn_s_barrier(); asm volatile("" ::: "memory"); } while (0)
#define CFENCE() asm volatile("" ::: "memory")
__device__ __forceinline__ float wave_sum(float v) {
#pragma unroll
    for (int o = 1; o < 64; o <<= 1) v += __shfl_xor(v, o);
    return v;
}
__device__ __forceinline__ f16x4 tr_read(LAS const unsigned char* p) {
    return __builtin_bit_cast(f16x4, __builtin_amdgcn_ds_read_tr16_b64_v4i16((LAS v4i16_t*)p));
}
__device__ __forceinline__ f16x8 cat8(f16x4 a, f16x4 b) { return (f16x8){a[0], a[1], a[2], a[3], b[0], b[1], b[2], b[3]}; }
__device__ __forceinline__ f16x8 pack8(const f32x16& x, int s) {
    u32x4 w; w.x = pkh(x[8 * s + 0], x[8 * s + 1]); w.y = pkh(x[8 * s + 2], x[8 * s + 3]); w.z = pkh(x[8 * s + 4], x[8 * s + 5]); w.w = pkh(x[8 * s + 6], x[8 * s + 7]);
    return __builtin_bit_cast(f16x8, w);
}

struct Frame {
    LAS unsigned char* lds;
    unsigned* ctl;
    int tid, lane, wave, vcu, G;
    unsigned char* ws;
};

template <int MAP>
__device__ __forceinline__ int srccol(int n, int N) {
    if (MAP == 1) { if (n >= 2048) return n; const int p = n & 127; return (n & ~127) + (p >> 1) + 64 * (p & 1); }
    if (MAP == 2) { const int F = N >> 1, t = n >> 8, j = n & 255; return (j < 128) ? 128 * t + j : F + 128 * t + (j - 128); }
    return n;
}
template <int MAP>
__device__ __forceinline__ void p0_transpose_item(const float* W, int K, int N, f16* WT, LAS float* scr, int item, int lane) {
    const int nblk = N / 32, kb = item / nblk, nb = item % nblk, k0 = 64 * kb, n0 = 32 * nb;
    const int sc = srccol<MAP>(n0 + (lane & 31), N);
#pragma unroll 8
    for (int i = 0; i < 32; ++i) { const int kk = 2 * i + (lane >> 5); scr[kk * 33 + (lane & 31)] = W[(size_t)(k0 + kk) * N + sc]; }
    asm volatile("s_waitcnt lgkmcnt(0)" ::: "memory");
    const int c = lane & 7;
#pragma unroll
    for (int j = 0; j < 4; ++j) { const int n = (lane >> 3) + 8 * j; const LAS float* s = scr + (8 * c) * 33 + n;
        u32x4 o; o.x = pkh(s[0 * 33], s[1 * 33]); o.y = pkh(s[2 * 33], s[3 * 33]); o.z = pkh(s[4 * 33], s[5 * 33]); o.w = pkh(s[6 * 33], s[7 * 33]);
        *(u32x4*)(WT + (size_t)(n0 + n) * K + k0 + 8 * c) = o; }
    asm volatile("s_waitcnt lgkmcnt(0)" ::: "memory");
}
template <int MAP>
__device__ __forceinline__ bool p0_group(int& r, const float* W, int nb, int K, int N, f16* WT, LAS float* scr, int lane) {
    const int per = (K / 64) * (N / 32), tot = nb * per;
    if (r >= tot) { r -= tot; return false; }
    const int b = r / per, it = r % per;
    p0_transpose_item<MAP>(W + (size_t)b * K * N, K, N, WT + (size_t)b * K * N, scr, it, lane);
    return true;
}
struct P0In { const float *c, *ada_w, *ada_b, *kv_ada_w, *kv_ada_b; const int* pos; const float *ret_w_in, *ret_w_out, *kv_w, *sb_w_q, *sb_w_out, *ff_w_in, *ff_w_out, *moe_w_in, *moe_w_out; };
__device__ __forceinline__ void p0_prologue(Frame& F, const P0In& I) {
    const int gw = F.vcu * 8 + F.wave, NGW = F.G * 8;
    LAS float* condL = (LAS float*)(F.lds);
    LAS float* scr = (LAS float*)(F.lds + 65536 + F.wave * 8448);
    for (int i = F.tid; i < 16 * 1024; i += 512) { const int b = i >> 10, k = i & 1023; condL[k * 16 + b] = silu_f(I.c[i]); }
    WG_BAR();
    for (int it = gw; it < 416; it += NGW) {
        const float* W; const float* bias; float* dst; int N, col0;
        if (it < 384) { const int l = it / 96; col0 = 64 * (it % 96); N = 6144; W = I.ada_w + (size_t)l * 1024 * 6144; bias = I.ada_b + l * 6144; dst = (float*)(F.ws + WS_MOD) + (size_t)l * 16 * 6144; }
        else { col0 = 64 * (it - 384); N = 2048; W = I.kv_ada_w; bias = I.kv_ada_b; dst = (float*)(F.ws + WS_KVMOD); }
        const int cl = F.lane & 15, kg = F.lane >> 4;
        f32x4 acc[16];
#pragma unroll
        for (int b = 0; b < 16; ++b) acc[b] = (f32x4){0.f, 0.f, 0.f, 0.f};
        const float* wp = W + (size_t)kg * N + col0 + 4 * cl;
#pragma unroll 4
        for (int k4 = 0; k4 < 256; ++k4) {
            const f32x4 w = *(const f32x4*)(wp + (size_t)k4 * 4 * N);
            const LAS f32x4* cp = (const LAS f32x4*)(condL + (4 * k4 + kg) * 16);
            const f32x4 c0 = cp[0], c1 = cp[1], c2 = cp[2], c3 = cp[3];
#pragma unroll
            for (int j = 0; j < 4; ++j) { acc[j] += c0[j] * w; acc[4 + j] += c1[j] * w; acc[8 + j] += c2[j] * w; acc[12 + j] += c3[j] * w; }
        }
        const f32x4 bv = *(const f32x4*)(bias + col0 + 4 * cl);
#pragma unroll
        for (int b = 0; b < 16; ++b) {
            f32x4 v = acc[b];
#pragma unroll
            for (int j = 0; j < 4; ++j) { v[j] += __shfl_xor(v[j], 16); v[j] += __shfl_xor(v[j], 32); }
            if (kg == 0) *(f32x4*)(dst + (size_t)b * N + col0 + 4 * cl) = v + bv;
        }
    }
    {
        const double e = -(double)F.lane / 64.0;
        const double invf = exp2(e * 13.287712379549449);
        float* rope = (float*)(F.ws + WS_ROPE);
        for (int row = gw; row < MTOK; row += NGW) {
            const double rev = (double)I.pos[row] * invf * 0.15915494309189535;
            const float fr = (float)(rev - floor(rev));
            rope[(size_t)row * 128 + F.lane] = __builtin_amdgcn_cosf(fr); rope[(size_t)row * 128 + 64 + F.lane] = __builtin_amdgcn_sinf(fr);
        }
    }
    constexpr int per_rin = 16 * 192, per_rout = 32 * 32, per_kv = 16 * 64, per_sq = 16 * 32, per_fin = 16 * 176, per_fout = 44 * 32, per_min = 16 * 224, per_mout = 56 * 32;
    constexpr int NITEMS = 2 * per_rin + 2 * per_rout + per_kv + 4 * per_sq + 2 * per_fin + 2 * per_fout + 16 * per_min + 16 * per_mout;
    for (int it = gw; it < NITEMS; it += NGW) {
        int r = it;
        if (p0_group<1>(r, I.ret_w_in, 2, 1024, 6144, (f16*)(F.ws + WS_W_RIN), scr, F.lane)) continue;
        if (p0_group<0>(r, I.ret_w_out, 2, 2048, 1024, (f16*)(F.ws + WS_W_ROUT), scr, F.lane)) continue;
        if (p0_group<0>(r, I.kv_w, 1, 1024, 2048, (f16*)(F.ws + WS_W_KV), scr, F.lane)) continue;
        if (p0_group<0>(r, I.sb_w_q, 2, 1024, 1024, (f16*)(F.ws + WS_W_SQ), scr, F.lane)) continue;
        if (p0_group<0>(r, I.sb_w_out, 2, 1024, 1024, (f16*)(F.ws + WS_W_SO), scr, F.lane)) continue;
        if (p0_group<2>(r, I.ff_w_in, 2, 1024, 5632, (f16*)(F.ws + WS_W_FIN), scr, F.lane)) continue;
        if (p0_group<0>(r, I.ff_w_out, 2, 2816, 1024, (f16*)(F.ws + WS_W_FOUT), scr, F.lane)) continue;
        if (p0_group<2>(r, I.moe_w_in, 16, 1024, 7168, (f16*)(F.ws + WS_W_MIN), scr, F.lane)) continue;
        p0_group<0>(r, I.moe_w_out, 16, 3584, 1024, (f16*)(F.ws + WS_W_MOUT), scr, F.lane);
    }
}

struct NormArgs {
    const float* x; float* xw; const float* gain; const float* sh; const float* sc;
    f16* h; const float* gain2; const float* kvmod; f16* hk;
    const f16* y2; const unsigned* tokslot; const float* gatef;
    float* out;
    const float* router; unsigned* gcnt; unsigned* tokinfo;
};
template <bool COMBINE, bool KV, bool FINAL, bool ROUTER>
__device__ __forceinline__ void norm_phase(Frame& F, const NormArgs& A) {
    const int gw = F.vcu * 8 + F.wave, NGW = F.G * 8;
    LAS float* routL = (LAS float*)F.lds;
    LAS unsigned* lcnt = (LAS unsigned*)(F.lds + 32768);
    LAS unsigned* recs = (LAS unsigned*)(F.lds + 32768 + 256);
    if (ROUTER) {
        for (int i = F.tid; i < 8192; i += 512) routL[i] = A.router[i];
        if (F.tid < 16) lcnt[F.tid] = 0u;
        WG_BAR();
    }
    int nloc = 0;
    for (int row = gw; row < MTOK; row += NGW, ++nloc) {
        const int b = row >> 11;
        f32x4 v[4];
#pragma unroll
        for (int j = 0; j < 4; ++j) v[j] = *((const f32x4*)(A.x + (size_t)row * DM) + F.lane + 64 * j);
        if (COMBINE) {
            const u32x2 sl = *(const u32x2*)(A.tokslot + 2 * (size_t)row);
            const f16* ya = A.y2 + (size_t)sl.x * DM; const f16* yb = A.y2 + (size_t)sl.y * DM;
#pragma unroll
            for (int j = 0; j < 4; ++j) {
                const f16x4 a = *((const f16x4*)ya + F.lane + 64 * j), c = *((const f16x4*)yb + F.lane + 64 * j);
                const f32x4 g = *((const f32x4*)(A.gatef + (size_t)b * 6144) + F.lane + 64 * j);
#pragma unroll
                for (int t = 0; t < 4; ++t) v[j][t] += g[t] * ((float)a[t] + (float)c[t]);
                if (!FINAL) *((f32x4*)(A.xw + (size_t)row * DM) + F.lane + 64 * j) = v[j];
            }
        }
        float ss = 0.f;
#pragma unroll
        for (int j = 0; j < 4; ++j) ss += (v[j][0] * v[j][0] + v[j][1] * v[j][1]) + (v[j][2] * v[j][2] + v[j][3] * v[j][3]);
        const float rstd = 1.0f / sqrtf(wave_sum(ss) * (1.0f / DM) + EPS);
        if (FINAL) {
#pragma unroll
            for (int j = 0; j < 4; ++j) { const f32x4 g = *((const f32x4*)A.gain + F.lane + 64 * j); *((f32x4*)(A.out + (size_t)row * DM) + F.lane + 64 * j) = v[j] * rstd * g; }
        } else {
            f32x4 hv[4];
#pragma unroll
            for (int j = 0; j < 4; ++j) {
                const f32x4 g = *((const f32x4*)A.gain + F.lane + 64 * j), sh = *((const f32x4*)(A.sh + (size_t)b * 6144) + F.lane + 64 * j), sc = *((const f32x4*)(A.sc + (size_t)b * 6144) + F.lane + 64 * j);
                hv[j] = (v[j] * rstd * g) * (1.0f + sc) + sh;
                u32x2 w; w.x = pkh(hv[j][0], hv[j][1]); w.y = pkh(hv[j][2], hv[j][3]);
                *((u32x2*)(A.h + (size_t)row * DM) + F.lane + 64 * j) = w;
            }
            if (KV) {
#pragma unroll
                for (int j = 0; j < 4; ++j) {
                    const f32x4 g = *((const f32x4*)A.gain2 + F.lane + 64 * j), sh = *((const f32x4*)(A.kvmod + (size_t)b * 2048) + F.lane + 64 * j), sc = *((const f32x4*)(A.kvmod + (size_t)b * 2048 + 1024) + F.lane + 64 * j);
                    const f32x4 o = (v[j] * rstd * g) * (1.0f + sc) + sh;
                    u32x2 w; w.x = pkh(o[0], o[1]); w.y = pkh(o[2], o[3]);
                    *((u32x2*)(A.hk + (size_t)row * DM) + F.lane + 64 * j) = w;
                }
            }
            if (ROUTER) {
                float lg[8];
#pragma unroll
                for (int e = 0; e < 8; ++e) lg[e] = 0.f;
#pragma unroll
                for (int j = 0; j < 4; ++j)
#pragma unroll
                    for (int t = 0; t < 4; ++t) {
                        const LAS f32x4* rp = (const LAS f32x4*)(routL + (4 * F.lane + 256 * j + t) * 8);
                        const f32x4 r0 = rp[0], r1 = rp[1]; const float hx = hv[j][t];
                        lg[0] += hx * r0[0]; lg[1] += hx * r0[1]; lg[2] += hx * r0[2]; lg[3] += hx * r0[3]; lg[4] += hx * r1[0]; lg[5] += hx * r1[1]; lg[6] += hx * r1[2]; lg[7] += hx * r1[3];
                    }
#pragma unroll
                for (int e = 0; e < 8; ++e) lg[e] = wave_sum(lg[e]);
                int i1 = 0; float v1 = lg[0];
#pragma unroll
                for (int e = 1; e < 8; ++e) if (lg[e] > v1) { v1 = lg[e]; i1 = e; }
                int i2 = -1; float v2 = -INFINITY;
#pragma unroll
                for (int e = 0; e < 8; ++e) if (e != i1 && lg[e] > v2) { v2 = lg[e]; i2 = e; }
                const float ed = __expf(v2 - v1), w1 = 1.0f / (1.0f + ed), w2 = ed * w1;
                if (F.lane == 0) {
                    const unsigned p1 = __hip_atomic_fetch_add(&lcnt[i1], 1u, __ATOMIC_RELAXED, __HIP_MEMORY_SCOPE_WORKGROUP), p2 = __hip_atomic_fetch_add(&lcnt[i2], 1u, __ATOMIC_RELAXED, __HIP_MEMORY_SCOPE_WORKGROUP);
                    LAS unsigned* rc = recs + (F.wave * 16 + nloc) * 8;
                    rc[0] = (unsigned)i1; rc[1] = p1; rc[2] = (unsigned)i2; rc[3] = p2; rc[4] = __float_as_uint(w1); rc[5] = __float_as_uint(w2);
                }
            }
        }
    }
    if (ROUTER) {
        WG_BAR();
        if (F.tid < 8) lcnt[8 + F.tid] = __hip_atomic_fetch_add(A.gcnt + 64 * F.tid, lcnt[F.tid], __ATOMIC_RELAXED, __HIP_MEMORY_SCOPE_AGENT);
        WG_BAR();
        if (F.lane == 0) {
            int k = 0;
            for (int row = gw; row < MTOK; row += NGW, ++k) {
                const LAS unsigned* rc = recs + (F.wave * 16 + k) * 8;
                u32x4 o; o.x = rc[0]; o.y = rc[1] + lcnt[8 + rc[0]]; o.z = rc[2]; o.w = rc[3] + lcnt[8 + rc[2]];
                *(u32x4*)(A.tokinfo + 8 * (size_t)row) = o; *(u32x2*)(A.tokinfo + 8 * (size_t)row + 4) = (u32x2){rc[4], rc[5]};
            }
        }
    }
}
__device__ __forceinline__ void moe_tile_bases(const unsigned* gcnt, int (&tb)[NEXP], int& ntiles) {
    int acc = 0;
#pragma unroll
    for (int e = 0; e < NEXP; ++e) { tb[e] = acc; const unsigned c = __hip_atomic_load(gcnt + 64 * e, __ATOMIC_RELAXED, __HIP_MEMORY_SCOPE_AGENT); acc += (int)((c + 255u) >> 8); }
    ntiles = acc;
}
__device__ __forceinline__ void moe_gather(Frame& F, const unsigned* gcnt, const unsigned* tokinfo, const f16* h, f16* hs, float* slotw, unsigned* tokslot) {
    const int gw = F.vcu * 8 + F.wave, NGW = F.G * 8;
    int tb[NEXP], nt; moe_tile_bases(gcnt, tb, nt);
    for (int row = gw; row < MTOK; row += NGW) {
        const u32x4 ti = *(const u32x4*)(tokinfo + 8 * (size_t)row); const u32x2 tw = *(const u32x2*)(tokinfo + 8 * (size_t)row + 4);
        int b1 = 0, b2 = 0;
#pragma unroll
        for (int e = 0; e < NEXP; ++e) { b1 = ((int)ti.x == e) ? tb[e] : b1; b2 = ((int)ti.z == e) ? tb[e] : b2; }
        const unsigned s1 = (unsigned)b1 * 256u + ti.y, s2 = (unsigned)b2 * 256u + ti.w;
        const u32x4* src = (const u32x4*)(h + (size_t)row * DM);
        const u32x4 a = src[F.lane], c = src[F.lane + 64];
        u32x4* d1 = (u32x4*)(hs + (size_t)s1 * DM); u32x4* d2 = (u32x4*)(hs + (size_t)s2 * DM);
        d1[F.lane] = a; d1[F.lane + 64] = c; d2[F.lane] = a; d2[F.lane + 64] = c;
        if (F.lane == 0) { slotw[s1] = __uint_as_float(tw.x); slotw[s2] = __uint_as_float(tw.y); *(u32x2*)(tokslot + 2 * (size_t)row) = (u32x2){s1, s2}; }
    }
}

constexpr int SC_PQ = 272, SC_PV = 528;
constexpr int SC_QL = 0, SC_KL = 17408, SC_VL = 34816, SC_SL = 68608, SC_ST = 136192, SC_STAGE = 0;
__device__ __forceinline__ void scan_phase(Frame& F, const f16* proj, const float* gnw, f16* ao) {
    const int unit = blockIdx.x;
    if (unit >= BATCH * RH) return;
    const int b = unit >> 3, hh = unit & 7;
    LAS unsigned char* L = F.lds;
    const int tid = F.tid, lane = F.lane, wid = F.wave, rh = wid >> 2, cg = wid & 3, r = lane & 31, h = lane >> 5;
    const int gl = (lane >> 4) & 1, li = lane & 15, ta = li >> 2, tp = li & 3;
    const float lg = lg2gamma(hh);
    const float g63 = ex2(63.0f * lg), cd = ex2(64.0f * lg);
    float vm[2][4], cj[4]; const float wneg = ex2(-64.0f * lg); const int qloc = 32 * rh + r;
#pragma unroll
    for (int kt = 0; kt < 2; ++kt)
#pragma unroll
        for (int g4 = 0; g4 < 4; ++g4) vm[kt][g4] = ex2((float)(64 * kt + 16 * g4 + 8 * h - 2 * qloc - 64) * lg);
#pragma unroll
    for (int j = 0; j < 4; ++j) cj[j] = ex2((float)(2 * j) * lg);
    const size_t rowbase = (size_t)b * SEQ;
    const f16* gq = proj + rowbase * RIN + 128 * hh;
    const f16* gk = gq + 1024;
    const f16* gv = proj + rowbase * RIN + 2048 + 256 * hh;
    const f16* gg = gv + 2048;
    const int qrow = tid >> 4, qc = tid & 15;
    const int vrow = tid >> 5, vc = tid & 31;
    f32x16 SA[2][2];
#pragma unroll
    for (int et = 0; et < 2; ++et)
#pragma unroll
        for (int dd = 0; dd < 2; ++dd)
#pragma unroll
            for (int i = 0; i < 16; ++i) SA[et][dd][i] = 0.f;
    for (int i = tid; i < 128 * SC_PV / 16; i += 512) *(LAS u32x4*)(L + SC_SL + i * 16) = (u32x4){0u, 0u, 0u, 0u};
    u32x4 nq[2], nk[2], nv[4];
#pragma unroll
    for (int i = 0; i < 2; ++i) { nq[i] = *(const u32x4*)(gq + (size_t)(qrow + 32 * i) * RIN + 8 * qc); nk[i] = *(const u32x4*)(gk + (size_t)(qrow + 32 * i) * RIN + 8 * qc); }
#pragma unroll
    for (int i = 0; i < 4; ++i) nv[i] = *(const u32x4*)(gv + (size_t)(vrow + 16 * i) * RIN + 8 * vc);
#pragma unroll
    for (int i = 0; i < 2; ++i) { *(LAS u32x4*)(L + SC_QL + (qrow + 32 * i) * SC_PQ + 16 * qc) = nq[i]; *(LAS u32x4*)(L + SC_KL + (qrow + 32 * i) * SC_PQ + 16 * qc) = nk[i]; }
#pragma unroll
    for (int i = 0; i < 4; ++i) *(LAS u32x4*)(L + SC_VL + (vrow + 16 * i) * SC_PV + 16 * vc) = nv[i];
    WG_BAR();
    for (int c = 0; c < NCHUNK; ++c) {
        const size_t crow = (size_t)c * CHUNK;
        if (c + 1 < NCHUNK) {
#pragma unroll
            for (int i = 0; i < 2; ++i) { nq[i] = *(const u32x4*)(gq + (crow + 64 + qrow + 32 * i) * RIN + 8 * qc); nk[i] = *(const u32x4*)(gk + (crow + 64 + qrow + 32 * i) * RIN + 8 * qc); }
#pragma unroll
            for (int i = 0; i < 4; ++i) nv[i] = *(const u32x4*)(gv + (crow + 64 + vrow + 16 * i) * RIN + 8 * vc);
        }
        f16x8 Qf[8];
#pragma unroll
        for (int ks = 0; ks < 8; ++ks) Qf[ks] = *(const LAS f16x8*)(L + SC_QL + (32 * rh + r) * SC_PQ + (16 * ks + 8 * h) * 2);
        f16x8 Pf[2][2];
#pragma unroll
        for (int kt = 0; kt < 2; ++kt) {
            f32x16 X;
#pragma unroll
            for (int i = 0; i < 16; ++i) X[i] = 0.f;
#pragma unroll
            for (int ks = 0; ks < 8; ++ks) { const f16x8 Kf = *(const LAS f16x8*)(L + SC_KL + (32 * kt + r) * SC_PQ + (16 * ks + 8 * h) * 2); X = __builtin_amdgcn_mfma_f32_32x32x16_f16(Kf, Qf[ks], X, 0, 0, 0); }
#pragma unroll
            for (int i = 0; i < 16; ++i) { const int key = 32 * kt + (i & 3) + 8 * (i >> 2) + 4 * h; X[i] *= (key >= qloc) ? vm[kt][i >> 2] * cj[i & 3] : wneg; }
            Pf[kt][0] = pack8(X, 0); Pf[kt][1] = pack8(X, 1);
        }
        f32x16 OT[2];
#pragma unroll
        for (int et = 0; et < 2; ++et)
#pragma unroll
            for (int i = 0; i < 16; ++i) OT[et][i] = 0.f;
#pragma unroll
        for (int ks = 0; ks < 8; ++ks)
#pragma unroll
            for (int et = 0; et < 2; ++et) {
                LAS const unsigned char* sp = L + SC_SL + (16 * ks + 8 * h + ta) * SC_PV + (64 * cg + 32 * et + 16 * gl + 4 * tp) * 2;
                const f16x8 Sf = cat8(tr_read(sp), tr_read(sp + 4 * SC_PV));
                OT[et] = __builtin_amdgcn_mfma_f32_32x32x16_f16(Sf, Qf[ks], OT[et], 0, 0, 0);
            }
#pragma unroll
        for (int et = 0; et < 2; ++et)
#pragma unroll
            for (int dd = 0; dd < 2; ++dd)
#pragma unroll
                for (int i = 0; i < 16; ++i) SA[et][dd][i] *= cd;
#pragma unroll
        for (int kt = 0; kt < 2; ++kt)
#pragma unroll
            for (int s = 0; s < 2; ++s) {
                const int k0 = 32 * kt + 16 * s + 4 * h + ta;
                f16x8 Vf[2], Kt[2];
#pragma unroll
                for (int et = 0; et < 2; ++et) { LAS const unsigned char* vp = L + SC_VL + k0 * SC_PV + (64 * cg + 32 * et + 16 * gl + 4 * tp) * 2; Vf[et] = cat8(tr_read(vp), tr_read(vp + 8 * SC_PV)); }
#pragma unroll
                for (int dd = 0; dd < 2; ++dd) { LAS const unsigned char* kp = L + SC_KL + k0 * SC_PQ + (32 * (2 * rh + dd) + 16 * gl + 4 * tp) * 2; Kt[dd] = cat8(tr_read(kp), tr_read(kp + 8 * SC_PQ)); }
#pragma unroll
                for (int et = 0; et < 2; ++et) {
                    OT[et] = __builtin_amdgcn_mfma_f32_32x32x16_f16(Vf[et], Pf[kt][s], OT[et], 0, 0, 0);
#pragma unroll
                    for (int dd = 0; dd < 2; ++dd) SA[et][dd] = __builtin_amdgcn_mfma_f32_32x32x16_f16(Vf[et], Kt[dd], SA[et][dd], 0, 0, 0);
                }
            }
        float s1 = 0.f, s2 = 0.f;
#pragma unroll
        for (int et = 0; et < 2; ++et)
#pragma unroll
            for (int i = 0; i < 16; ++i) { OT[et][i] *= g63; s1 += OT[et][i]; s2 += OT[et][i] * OT[et][i]; }
        s1 += __shfl_xor(s1, 32); s2 += __shfl_xor(s2, 32);
        if (h == 0) *(LAS f32x2*)(L + SC_ST + ((rh * 4 + cg) * 32 + r) * 8) = (f32x2){s1, s2};
        WG_BAR();
        float t1 = 0.f, t2 = 0.f;
#pragma unroll
        for (int c4 = 0; c4 < 4; ++c4) { const f32x2 p = *(const LAS f32x2*)(L + SC_ST + ((rh * 4 + c4) * 32 + r) * 8); t1 += p.x; t2 += p.y; }
        const float mean = t1 * (1.0f / 256.0f), var = t2 * (1.0f / 256.0f) - mean * mean, rstd = 1.0f / sqrtf(var + EPS);
        u32x4 gc[4];
#pragma unroll
        for (int i = 0; i < 4; ++i) gc[i] = *(const u32x4*)(gg + (crow + vrow + 16 * i) * RIN + 8 * vc);
#pragma unroll
        for (int et = 0; et < 2; ++et)
#pragma unroll
            for (int dd = 0; dd < 2; ++dd)
#pragma unroll
                for (int g4 = 0; g4 < 4; ++g4) {
                    u32x2 w; w.x = pkh(SA[et][dd][4 * g4], SA[et][dd][4 * g4 + 1]); w.y = pkh(SA[et][dd][4 * g4 + 2], SA[et][dd][4 * g4 + 3]);
                    *(LAS u32x2*)(L + SC_SL + (32 * (2 * rh + dd) + r) * SC_PV + (64 * cg + 32 * et + 8 * g4 + 4 * h) * 2) = w;
                }
#pragma unroll
        for (int et = 0; et < 2; ++et)
#pragma unroll
            for (int g4 = 0; g4 < 4; ++g4) {
                u32x2 w; w.x = pkh((OT[et][4 * g4] - mean) * rstd, (OT[et][4 * g4 + 1] - mean) * rstd); w.y = pkh((OT[et][4 * g4 + 2] - mean) * rstd, (OT[et][4 * g4 + 3] - mean) * rstd);
                *(LAS u32x2*)(L + SC_STAGE + (32 * rh + r) * SC_PV + (64 * cg + 32 * et + 8 * g4 + 4 * h) * 2) = w;
            }
        WG_BAR();
        f32x4 gw0, gw1; { const float* gp = gnw + 256 * hh + 8 * vc; gw0 = *(const f32x4*)gp; gw1 = *(const f32x4*)(gp + 4); }
#pragma unroll
        for (int i = 0; i < 4; ++i) {
            const f16x8 n8 = *(const LAS f16x8*)(L + SC_STAGE + (vrow + 16 * i) * SC_PV + 16 * vc);
            const f16x8 g8 = __builtin_bit_cast(f16x8, gc[i]);
            u32x4 w;
            w.x = pkh((float)n8[0] * (float)g8[0] * gw0[0], (float)n8[1] * (float)g8[1] * gw0[1]); w.y = pkh((float)n8[2] * (float)g8[2] * gw0[2], (float)n8[3] * (float)g8[3] * gw0[3]);
            w.z = pkh((float)n8[4] * (float)g8[4] * gw1[0], (float)n8[5] * (float)g8[5] * gw1[1]); w.w = pkh((float)n8[6] * (float)g8[6] * gw1[2], (float)n8[7] * (float)g8[7] * gw1[3]);
            *(u32x4*)(ao + (rowbase + crow + vrow + 16 * i) * 2048 + 256 * hh + 8 * vc) = w;
        }
        WG_BAR();
        if (c + 1 < NCHUNK) {
#pragma unroll
            for (int i = 0; i < 2; ++i) { *(LAS u32x4*)(L + SC_QL + (qrow + 32 * i) * SC_PQ + 16 * qc) = nq[i]; *(LAS u32x4*)(L + SC_KL + (qrow + 32 * i) * SC_PQ + 16 * qc) = nk[i]; }
#pragma unroll
            for (int i = 0; i < 4; ++i) *(LAS u32x4*)(L + SC_VL + (vrow + 16 * i) * SC_PV + 16 * vc) = nv[i];
        }
        WG_BAR();
    }
}

constexpr int SBV_P = 144;
constexpr float SB_STOP = 7.8886090522101181e-31f;
__device__ __forceinline__ void sb_phase(Frame& F, const f16* Q, const f16* Kc, const f16* Vc, f16* O) {
    const int gw = F.vcu * 8 + F.wave, NGW = F.G * 8, lane = F.lane, r = lane & 31, h = lane >> 5;
    const int gl = (lane >> 4) & 1, li = lane & 15, ta = li >> 2, tp = li & 3;
    LAS unsigned char* Vw = F.lds + F.wave * (32 * SBV_P);
    const int vr = lane >> 3, vcc = lane & 7;
    for (int u = gw; u < BATCH * SBH * (SEQ / 32); u += NGW) {
        const int qblk = u & 63, bh = u >> 6, b = bh >> 4, hd = bh & 15;
        const size_t rb = (size_t)b * SEQ;
        const f16* qp = Q + (rb + 32 * qblk + r) * DM + 64 * hd + 8 * h;
        f16x8 Qf[4];
#pragma unroll
        for (int ks = 0; ks < 4; ++ks) Qf[ks] = *(const f16x8*)(qp + 16 * ks);
        f32x16 OT[2];
#pragma unroll
        for (int dt = 0; dt < 2; ++dt)
#pragma unroll
            for (int i = 0; i < 16; ++i) OT[dt][i] = 0.f;
        float carry = 1.0f;
        u32x4 kn[4], vn[4];
        { const f16* kp = Kc + (rb + 32 * qblk + r) * DM + 64 * hd + 8 * h; const f16* vp = Vc + (rb + 32 * qblk + vr) * DM + 64 * hd + 8 * vcc;
#pragma unroll
          for (int i = 0; i < 4; ++i) { kn[i] = *(const u32x4*)(kp + 16 * i); vn[i] = *(const u32x4*)(vp + (size_t)(8 * i) * DM); } }
        for (int kt = qblk; kt >= 0; --kt) {
            f16x8 Kf[4];
#pragma unroll
            for (int i = 0; i < 4; ++i) { Kf[i] = __builtin_bit_cast(f16x8, kn[i]); *(LAS u32x4*)(Vw + (vr + 8 * i) * SBV_P + 16 * vcc) = vn[i]; }
            CFENCE();
            if (kt > 0) { const f16* kp = Kc + (rb + 32 * (kt - 1) + r) * DM + 64 * hd + 8 * h; const f16* vp = Vc + (rb + 32 * (kt - 1) + vr) * DM + 64 * hd + 8 * vcc;
#pragma unroll
                for (int i = 0; i < 4; ++i) { kn[i] = *(const u32x4*)(kp + 16 * i); vn[i] = *(const u32x4*)(vp + (size_t)(8 * i) * DM); } }
            f32x16 S;
#pragma unroll
            for (int i = 0; i < 16; ++i) S[i] = 0.f;
#pragma unroll
            for (int ks = 0; ks < 4; ++ks) S = __builtin_amdgcn_mfma_f32_32x32x16_f16(Kf[ks], Qf[ks], S, 0, 0, 0);
            float om[16];
            const bool diag = (kt == qblk);
#pragma unroll
            for (int i = 0; i < 16; ++i) {
                const int kl = (i & 3) + 8 * (i >> 2) + 4 * h;
                float o = __builtin_amdgcn_rcpf(1.0f + ex2(S[i]));
                if (diag && kl >= r) o = 1.0f;
                om[i] = o;
            }
            float sfx[16], T[4];
#pragma unroll
            for (int g4 = 0; g4 < 4; ++g4) { sfx[4 * g4 + 3] = 1.0f; sfx[4 * g4 + 2] = om[4 * g4 + 3]; sfx[4 * g4 + 1] = sfx[4 * g4 + 2] * om[4 * g4 + 2]; sfx[4 * g4] = sfx[4 * g4 + 1] * om[4 * g4 + 1]; T[g4] = sfx[4 * g4] * om[4 * g4]; }
            float E[4]; float run = carry;
#pragma unroll
            for (int g4 = 3; g4 >= 0; --g4) {
                const float tl = __shfl(T[g4], r), th = __shfl(T[g4], r + 32);
                const float e_hi = run; run *= th; const float e_lo = run; run *= tl;
                E[g4] = h ? e_hi : e_lo;
            }
            carry = run;
            f32x16 Aw;
#pragma unroll
            for (int i = 0; i < 16; ++i) Aw[i] = (1.0f - om[i]) * (E[i >> 2] * sfx[i]);
            const f16x8 Af0 = pack8(Aw, 0), Af1 = pack8(Aw, 1);
            CFENCE();
#pragma unroll
            for (int dt = 0; dt < 2; ++dt) {
                LAS const unsigned char* vp = Vw + (4 * h + ta) * SBV_P + (32 * dt + 16 * gl + 4 * tp) * 2;
                const f16x8 V0 = cat8(tr_read(vp), tr_read(vp + 8 * SBV_P)), V1 = cat8(tr_read(vp + 16 * SBV_P), tr_read(vp + 24 * SBV_P));
                OT[dt] = __builtin_amdgcn_mfma_f32_32x32x16_f16(V0, Af0, OT[dt], 0, 0, 0);
                OT[dt] = __builtin_amdgcn_mfma_f32_32x32x16_f16(V1, Af1, OT[dt], 0, 0, 0);
            }
            CFENCE();
            if (__ballot(carry > SB_STOP) == 0ull) break;
        }
        f16* op = O + (rb + 32 * qblk + r) * DM + 64 * hd + 4 * h;
#pragma unroll
        for (int dt = 0; dt < 2; ++dt)
#pragma unroll
            for (int g4 = 0; g4 < 4; ++g4) { u32x2 w; w.x = pkh(OT[dt][4 * g4], OT[dt][4 * g4 + 1]); w.y = pkh(OT[dt][4 * g4 + 2], OT[dt][4 * g4 + 3]); *(u32x2*)(op + 32 * dt + 8 * g4) = w; }
    }
}

struct Args { const void* in[22]; float* out; unsigned char* ws; int ph_lo, ph_hi; };
constexpr int N_PHASES = 34;
template <int I> __device__ __forceinline__ const void* karg() {
    const auto kp = __builtin_amdgcn_kernarg_segment_ptr();
    unsigned long long v; asm volatile("s_load_dwordx2 %0, %1, %2\n\ts_waitcnt lgkmcnt(0)" : "=s"(v) : "s"(kp), "i"(I * 8) : "memory");
    return (const void*)v;
}
#define KIN(i) ((const float*)karg<(i)>())
#define IN(k) (lo <= (k) && (k) < hi)
#define SEAM(k) do { if (IN((k) + 1)) { if (!MK_PER_PHASE) xcd_barrier(bar); } } while (0)
#define WSP(T, off) ((T*)(F.ws + (off)))
template <int L> __device__ __forceinline__ void layer_phases(Frame& F, const XcdBarrier& bar, const int lo, const int hi) {
    constexpr int pb = 1 + 8 * L;
        if (IN(pb + 0) && !DIS_K0) {
            const float* modL = WSP(const float, WS_MOD) + (size_t)L * 16 * 6144;
            NormArgs A{}; A.x = (L == 0) ? KIN(0) : WSP(const float, WS_X); A.xw = WSP(float, WS_X); A.gain = KIN(5) + L * DM; A.sh = modL; A.sc = modL + 1024; A.h = WSP(f16, WS_H);
            if constexpr (L == 2) {
                A.y2 = WSP(const f16, WS_Y2); A.tokslot = WSP(const unsigned, WS_TOKSLOT); A.gatef = WSP(const float, WS_MOD) + (size_t)(L - 1) * 16 * 6144 + 5120;
                A.gain2 = KIN(12); A.kvmod = WSP(const float, WS_KVMOD); A.hk = WSP(f16, WS_HK); norm_phase<true, true, false, false>(F, A);
            } else norm_phase<false, false, false, false>(F, A);
            SEAM(pb + 0);
        }
        if (IN(pb + 1) && !DIS_K1) {
            if constexpr (L < 2) {
                pg8::Gemm g{WSP(const f16, WS_H), WSP(const f16, WS_W_RIN) + (size_t)L * RIN * DM, MTOK, RIN, DM, 0}; pg8::Order S; S.init(MTOK, RIN, F.G, (int)blockIdx.x);
                pg8::EpiRetIn E{WSP(f16, WS_PROJ), WSP(const float, WS_ROPE)};
                pg8::gemm_phase<pg8::EpiRetIn>(F.lds, g, S, E);
            } else {
                { pg8::Gemm g{WSP(const f16, WS_H), WSP(const f16, WS_W_SQ) + (size_t)(L - 2) * DM * DM, MTOK, DM, DM, 0}; pg8::Order S; S.init(MTOK, DM, F.G, (int)blockIdx.x);
                  pg8::EpiF16 E{WSP(f16, WS_SQ), DM, 0, 0, 0.125f * 1.4426950408889634f};
                  pg8::gemm_phase<pg8::EpiF16>(F.lds, g, S, E); }
                if constexpr (L == 2) { pg8::Gemm g{WSP(const f16, WS_HK), WSP(const f16, WS_W_KV), MTOK, 2048, DM, 0}; pg8::Order S; S.init(MTOK, 2048, F.G, (int)blockIdx.x);
                  pg8::EpiF16 E{WSP(f16, WS_KSH), DM, 1024, (size_t)(WS_VSH - WS_KSH) / 2, 1.0f};
                  pg8::gemm_phase<pg8::EpiF16>(F.lds, g, S, E); }
            }
            SEAM(pb + 1);
        }
        if (IN(pb + 2) && !DIS_K2) {
#ifndef NO_SCAN
            if constexpr (L < 2) scan_phase(F, WSP(const f16, WS_PROJ), KIN(8) + L * 2048, WSP(f16, WS_AO));
#endif
#ifndef NO_SB
            if constexpr (L >= 2) sb_phase(F, WSP(const f16, WS_SQ), WSP(const f16, WS_KSH), WSP(const f16, WS_VSH), WSP(f16, WS_SO));
#endif
            SEAM(pb + 2);
        }
        if (IN(pb + 3) && !DIS_K3) {
            pg8::Gemm g;
            if constexpr (L < 2) g = pg8::Gemm{WSP(const f16, WS_AO), WSP(const f16, WS_W_ROUT) + (size_t)L * DM * 2048, MTOK, DM, 2048, 0};
            else g = pg8::Gemm{WSP(const f16, WS_SO), WSP(const f16, WS_W_SO) + (size_t)(L - 2) * DM * DM, MTOK, DM, DM, 0};
            pg8::Order S; S.init(MTOK, DM, F.G, (int)blockIdx.x);
            pg8::EpiRes E{(L == 0) ? KIN(0) : WSP(const float, WS_X), WSP(float, WS_X), WSP(const float, WS_MOD) + (size_t)L * 16 * 6144 + 2048};
            pg8::gemm_phase<pg8::EpiRes>(F.lds, g, S, E);
            SEAM(pb + 3);
        }
        if (IN(pb + 4) && !DIS_K4) {
            const float* modL = WSP(const float, WS_MOD) + (size_t)L * 16 * 6144;
            NormArgs A{}; A.x = WSP(const float, WS_X); A.xw = WSP(float, WS_X); A.gain = KIN(6) + L * DM; A.sh = modL + 3072; A.sc = modL + 4096; A.h = WSP(f16, WS_H);
            if constexpr (L & 1) { A.router = KIN(18) + (size_t)(L >> 1) * DM * NEXP; A.gcnt = F.ctl + CW_MOE + (L >> 1) * 1024; A.tokinfo = WSP(unsigned, WS_TOKINFO); norm_phase<false, false, false, true>(F, A); }
            else norm_phase<false, false, false, false>(F, A);
            SEAM(pb + 4);
        }
        if (IN(pb + 5) && !DIS_K5) {
            if constexpr (L & 1) moe_gather(F, F.ctl + CW_MOE + (L >> 1) * 1024, WSP(const unsigned, WS_TOKINFO), WSP(const f16, WS_H), WSP(f16, WS_HS), WSP(float, WS_SLOTW), WSP(unsigned, WS_TOKSLOT));
            SEAM(pb + 5);
        }
        if (IN(pb + 6) && !DIS_K6) {
            const int mi = L >> 1;
            pg8::Order S;
            if constexpr (L & 1) {
                int tb[NEXP], ntl; moe_tile_bases(F.ctl + CW_MOE + mi * 1024, tb, ntl);
                S.init(ntl * 256, 2 * FFE, F.G, (int)blockIdx.x);
#pragma unroll
                for (int e = 0; e < NEXP; ++e) S.tb[e] = tb[e];
                pg8::Gemm g{WSP(const f16, WS_HS), WSP(const f16, WS_W_MIN) + (size_t)mi * NEXP * 2 * FFE * DM, ntl * 256, 2 * FFE, DM, (size_t)2 * FFE * DM * 2};
                pg8::EpiGlu E{WSP(f16, WS_ACTE), FFE};
                pg8::gemm_phase<pg8::EpiGlu>(F.lds, g, S, E);
            } else {
                S.init(MTOK, 2 * FFD, F.G, (int)blockIdx.x);
                pg8::Gemm g{WSP(const f16, WS_H), WSP(const f16, WS_W_FIN) + (size_t)mi * 2 * FFD * DM, MTOK, 2 * FFD, DM, 0};
                pg8::EpiGlu E{WSP(f16, WS_ACTD), FFD};
                pg8::gemm_phase<pg8::EpiGlu>(F.lds, g, S, E);
            }
            SEAM(pb + 6);
        }
        if (IN(pb + 7) && !DIS_K7) {
            const int mi = L >> 1;
            if constexpr (L & 1) {
                int tb[NEXP], ntl; moe_tile_bases(F.ctl + CW_MOE + mi * 1024, tb, ntl);
                pg8::Order S; S.init(ntl * 256, DM, F.G, (int)blockIdx.x);
#pragma unroll
                for (int e = 0; e < NEXP; ++e) S.tb[e] = tb[e];
                pg8::Gemm g{WSP(const f16, WS_ACTE), WSP(const f16, WS_W_MOUT) + (size_t)mi * NEXP * DM * FFE, ntl * 256, DM, FFE, (size_t)DM * FFE * 2};
                pg8::EpiMoeOut E{WSP(f16, WS_Y2), WSP(const float, WS_SLOTW)};
                pg8::gemm_phase<pg8::EpiMoeOut>(F.lds, g, S, E);
            } else {
                pg8::Order S; S.init(MTOK, DM, F.G, (int)blockIdx.x);
                pg8::Gemm g{WSP(const f16, WS_ACTD), WSP(const f16, WS_W_FOUT) + (size_t)mi * DM * FFD, MTOK, DM, FFD, 0};
                pg8::EpiRes E{WSP(const float, WS_X), WSP(float, WS_X), WSP(const float, WS_MOD) + (size_t)L * 16 * 6144 + 5120};
                pg8::gemm_phase<pg8::EpiRes>(F.lds, g, S, E);
            }
            SEAM(pb + 7);
        }
}
__global__ void __launch_bounds__(512, 2) mk_fwd(Args args) {
    extern __shared__ __attribute__((aligned(16))) unsigned char lds_raw[];
    Frame F;
    F.lds = (LAS unsigned char*)lds_raw;
    F.tid = threadIdx.x; F.lane = F.tid & 63; F.wave = __builtin_amdgcn_readfirstlane(F.tid >> 6);
    F.G = gridDim.x; { const int bx = blockIdx.x; F.vcu = (F.G % 8 == 0) ? (bx % 8) * (F.G / 8) + bx / 8 : bx; }
    F.ws = args.ws; F.ctl = (unsigned*)(args.ws + WS_CTL);
    volatile LAS unsigned* MISC = (volatile LAS unsigned*)(F.lds + MISC_OFF);
    if (F.tid < 64) ((LAS unsigned*)(F.lds + MISC_OFF))[F.tid] = 0u;
    __syncthreads();
    XcdBarrier bar; bar.bar = F.ctl + CW_BAR; bar.x = 0; bar.st = nullptr;
    if (!MK_PER_PHASE) bar = xcd_barrier_post(F.ctl + CW_BAR, MISC + 8);
    const int lo = args.ph_lo, hi = args.ph_hi;

    if (IN(0)) {
#ifndef NO_P0
        P0In I; I.c = KIN(1); I.pos = (const int*)karg<2>(); I.ada_w = KIN(3); I.ada_b = KIN(4);
        I.ret_w_in = KIN(7); I.ret_w_out = KIN(9); I.kv_ada_w = KIN(10); I.kv_ada_b = KIN(11);
        I.kv_w = KIN(13); I.sb_w_q = KIN(14); I.sb_w_out = KIN(15); I.ff_w_in = KIN(16); I.ff_w_out = KIN(17);
        I.moe_w_in = KIN(19); I.moe_w_out = KIN(20);
        p0_prologue(F, I);
#endif
        SEAM(0);
    }
    layer_phases<0>(F, bar, lo, hi); layer_phases<1>(F, bar, lo, hi); layer_phases<2>(F, bar, lo, hi); layer_phases<3>(F, bar, lo, hi);
    if (IN(33)) {
        NormArgs A{}; A.x = WSP(const float, WS_X); A.xw = WSP(float, WS_X); A.gain = KIN(21); A.out = (float*)karg<22>();
        A.y2 = WSP(const f16, WS_Y2); A.tokslot = WSP(const unsigned, WS_TOKSLOT); A.gatef = WSP(const float, WS_MOD) + (size_t)3 * 16 * 6144 + 5120;
        norm_phase<true, false, true, false>(F, A);
    }
#undef IN
#undef SEAM
#undef WSP
}

extern "C" void kernel_launch(void* const* d_in, const int* in_sizes, int n_in, void* d_out, int out_size, void* d_ws, size_t ws_size, hipStream_t stream) {
    static int grid = 0;
    if (grid == 0) {
        if (n_in != 22 || out_size != MTOK * DM || ws_size < WS_END) { fprintf(stderr, "kernel_launch: unexpected shapes (n_in %d out %d ws %zu, need %zu)\n", n_in, out_size, ws_size, (size_t)WS_END); grid = -1; return; }
        int dev = 0, cus = 0;
        if (hipGetDevice(&dev) != hipSuccess || hipDeviceGetAttribute(&cus, hipDeviceAttributeMultiprocessorCount, dev) != hipSuccess) { grid = -1; return; }
        if (hipFuncSetAttribute((const void*)mk_fwd, hipFuncAttributeMaxDynamicSharedMemorySize, LDS_BYTES) != hipSuccess) { fprintf(stderr, "kernel_launch: hipFuncSetAttribute failed\n"); grid = -1; return; }
        int per_cu = 0;
        if (hipOccupancyMaxActiveBlocksPerMultiprocessor(&per_cu, (const void*)mk_fwd, 512, LDS_BYTES) != hipSuccess || per_cu < 1) fprintf(stderr, "kernel_launch: occupancy query reports %d\n", per_cu);
        (void)hipGetLastError();
        if (cus < 256) { fprintf(stderr, "kernel_launch: needs >= 256 CUs, got %d\n", cus); grid = -1; return; }
        grid = cus;
    }
    if (grid < 0) return;
    (void)hipMemsetAsync((char*)d_ws + WS_CTL, 0, CTL_ZERO_BYTES, stream);
    Args a{};
    for (int i = 0; i < 22; ++i) a.in[i] = d_in[i];
    a.out = (float*)d_out; a.ws = (unsigned char*)d_ws;
#if MK_PER_PHASE
    for (int p = 0; p < N_PHASES; ++p) {
        if (p >= 1 && p <= 32) { const int L = (p - 1) / 8, k = (p - 1) % 8; if (k == 5 && !(L & 1)) continue; }
        a.ph_lo = p; a.ph_hi = p + 1;
        hipLaunchKernelGGL(mk_fwd, dim3(grid), dim3(512), LDS_BYTES, stream, a);
    }
#else
    a.ph_lo = 0; a.ph_hi = N_PHASES;
    hipLaunchKernelGGL(mk_fwd, dim3(grid), dim3(512), LDS_BYTES, stream, a);
#endif
}
```

```cpp
#include <hip/hip_runtime.h>
#include <cstdio>
#include <cstdint>

#define LAS __attribute__((address_space(3)))
#define GAS __attribute__((address_space(1)))
typedef _Float16 f16;
typedef _Float16 f16x2 __attribute__((ext_vector_type(2)));
typedef _Float16 f16x4 __attribute__((ext_vector_type(4)));
typedef _Float16 f16x8 __attribute__((ext_vector_type(8)));
typedef float f32x2 __attribute__((ext_vector_type(2)));
typedef float f32x4 __attribute__((ext_vector_type(4)));
typedef float f32x16 __attribute__((ext_vector_type(16)));
typedef unsigned u32x2 __attribute__((ext_vector_type(2)));
typedef unsigned u32x4 __attribute__((ext_vector_type(4)));
typedef short v4i16_t __attribute__((ext_vector_type(4)));

#ifndef DIS_K0
#define DIS_K0 0
#endif
#ifndef DIS_K1
#define DIS_K1 0
#endif
#ifndef DIS_K2
#define DIS_K2 0
#endif
#ifndef DIS_K3
#define DIS_K3 0
#endif
#ifndef DIS_K4
#define DIS_K4 0
#endif
#ifndef DIS_K5
#define DIS_K5 0
#endif
#ifndef DIS_K6
#define DIS_K6 0
#endif
#ifndef DIS_K7
#define DIS_K7 0
#endif
#ifndef MK_PER_PHASE
#define MK_PER_PHASE 0
#endif

constexpr int BATCH = 16, SEQ = 2048, DM = 1024, MTOK = BATCH * SEQ;
constexpr int RH = 8, RDK = 128, RDV = 256, RIN = 6144, CHUNK = 64, NCHUNK = SEQ / CHUNK;
constexpr int SBH = 16, SDH = 64;
constexpr int FFD = 2816, NEXP = 8, FFE = 3584;
constexpr float EPS = 1e-6f;
constexpr int MOE_ROWS_MAX = 2 * MTOK + NEXP * 256;

__device__ __forceinline__ float lg2gamma(int h) {
    const float t[8] = {-4.580368961312e-02f, -2.272007650008e-02f, -1.131531322783e-02f, -5.646563141142e-03f, -2.820519062379e-03f, -1.409570254671e-03f, -7.046129765894e-04f, -3.522634716290e-04f};
    float r = t[0];
#pragma unroll
    for (int i = 1; i < 8; ++i) r = (h == i) ? t[i] : r;
    return r;
}
__device__ __forceinline__ unsigned pkh(float lo, float hi) { f32x2 v = {lo, hi}; f16x2 h = __builtin_convertvector(v, f16x2); return __builtin_bit_cast(unsigned, h); }
__device__ __forceinline__ float silu_f(float x) { return x * __builtin_amdgcn_rcpf(1.0f + __builtin_amdgcn_exp2f(-1.4426950408889634f * x)); }
__device__ __forceinline__ float ex2(float x) { return __builtin_amdgcn_exp2f(x); }

namespace pg8 {
constexpr int BM = 256, BK = 64, HALF = 128, HTB = HALF * BK * 2, STAGE_BYTES = 8 * HTB, NXCD = 8, WGM = 8;
__host__ __device__ __forceinline__ int lds_byte(int r, int c) { const int st = (r >> 4) * 2 + (c >> 5), rr = r & 15, cc = c & 31, ob = rr * 64 + cc * 2; return st * 1024 + (ob ^ (((ob >> 9) & 1) << 5)); }
__host__ __device__ __forceinline__ void stage_rc(int b, int& R, int& C) { const int st = b / 1024, sb = b % 1024, swz = sb ^ (((sb >> 9) & 1) << 5); R = (st >> 1) * 16 + swz / 64; C = (st & 1) * 32 + (swz % 64) / 2; }
__host__ __device__ __forceinline__ int perm32(int rho) { const int n = rho >> 4, i = rho & 15; return 8 * (i >> 2) + 4 * n + (i & 3); }

struct Unit { int pm, pn, be; };
struct Gemm { const f16* A; const f16* Bt; int M, N, K; size_t bstride; };

struct Order {
    int nM, nN, nwg, G, c; int tb[NEXP];
    __device__ void init(int M, int N, int G_, int c_) { nM = M / BM; nN = N / BM; nwg = nM * nN; G = G_; c = c_;
#pragma unroll
        for (int e = 0; e < NEXP; ++e) tb[e] = e ? 0x7fffffff : 0; }
    __device__ bool next(int i, Unit& u) const {
        const long L = (long)i * G + c; if (L >= nwg) return false;
        int wgid = (int)L; { const int q = nwg / NXCD, r = nwg % NXCD, xcd = wgid % NXCD, off = wgid / NXCD; wgid = (xcd < r ? xcd * (q + 1) : r * (q + 1) + (xcd - r) * q) + off; }
        const int nig = WGM * nN, gid = wgid / nig, fm = gid * WGM, gsz = (nM - fm) < WGM ? (nM - fm) : WGM;
        u.pm = fm + ((wgid % nig) % gsz); u.pn = (wgid % nig) / gsz;
        int be = 0;
#pragma unroll
        for (int e = 1; e < NEXP; ++e) be += (u.pm >= tb[e]) ? 1 : 0;
        u.be = be; return true;
    }
};


struct EpiRetIn {
    static constexpr bool PERM = true;
    f16* O; const float* rope;
    __device__ __forceinline__ void operator()(const f32x4 (&acc)[2][2][4][2], const Unit& u, int wr, int wc, int fr, int fq) const {
        const int row0 = u.pm * BM + wr * 64 + fr, cl = wc * 32 + 8 * fq;
        f16* base = O + (size_t)u.pn * BM + cl;
        if (u.pn < 8) {
            const bool isk = u.pn >= 4; const int i0 = cl >> 1;
            float lg[2]; lg[0] = lg2gamma(2 * (u.pn & 3)); lg[1] = lg2gamma(2 * (u.pn & 3) + 1);
#pragma unroll
            for (int ai = 0; ai < 2; ++ai)
#pragma unroll
                for (int m = 0; m < 4; ++m) {
                    const int row = row0 + ai * HALF + m * 16; const float pos = (float)(16 * m + fr);
                    const f32x4 cs = *(const f32x4*)(rope + (size_t)row * 128 + i0), sn = *(const f32x4*)(rope + (size_t)row * 128 + 64 + i0);
#pragma unroll
                    for (int bj = 0; bj < 2; ++bj) {
                        const float sc = isk ? ex2(-pos * lg[bj]) * 0.08838834764831845f : ex2((pos + 1.0f) * lg[bj]);
                        const f32x4 v0 = acc[ai][bj][m][0], v1 = acc[ai][bj][m][1];
                        u32x4 w;
                        w.x = pkh((v0[0] * cs[0] - v0[1] * sn[0]) * sc, (v0[0] * sn[0] + v0[1] * cs[0]) * sc);
                        w.y = pkh((v0[2] * cs[1] - v0[3] * sn[1]) * sc, (v0[2] * sn[1] + v0[3] * cs[1]) * sc);
                        w.z = pkh((v1[0] * cs[2] - v1[1] * sn[2]) * sc, (v1[0] * sn[2] + v1[1] * cs[2]) * sc);
                        w.w = pkh((v1[2] * cs[3] - v1[3] * sn[3]) * sc, (v1[2] * sn[3] + v1[3] * cs[3]) * sc);
                        *(u32x4*)(base + (size_t)row * RIN + bj * HALF) = w;
                    }
                }
        } else {
            const bool isg = u.pn >= 16;
#pragma unroll
            for (int ai = 0; ai < 2; ++ai)
#pragma unroll
                for (int m = 0; m < 4; ++m) {
                    const int row = row0 + ai * HALF + m * 16;
#pragma unroll
                    for (int bj = 0; bj < 2; ++bj) {
                        f32x4 v0 = acc[ai][bj][m][0], v1 = acc[ai][bj][m][1];
                        if (isg) {
#pragma unroll
                            for (int j = 0; j < 4; ++j) { v0[j] = silu_f(v0[j]); v1[j] = silu_f(v1[j]); } }
                        u32x4 w; w.x = pkh(v0[0], v0[1]); w.y = pkh(v0[2], v0[3]); w.z = pkh(v1[0], v1[1]); w.w = pkh(v1[2], v1[3]);
                        *(u32x4*)(base + (size_t)row * RIN + bj * HALF) = w;
                    }
                }
        }
    }
};
struct EpiRes {
    static constexpr bool PERM = false;
    const float* base; float* out; const float* gate;
    __device__ __forceinline__ void operator()(const f32x4 (&acc)[2][2][4][2], const Unit& u, int wr, int wc, int fr, int fq) const {
        const int row0 = u.pm * BM + wr * 64 + fr, col0 = u.pn * BM + wc * 32 + 4 * fq;
        const float* gp = gate + (size_t)(u.pm >> 3) * 6144 + col0;
        f32x4 gv[2][2];
#pragma unroll
        for (int bj = 0; bj < 2; ++bj)
#pragma unroll
            for (int n = 0; n < 2; ++n) gv[bj][n] = *(const f32x4*)(gp + bj * HALF + n * 16);
#pragma unroll
        for (int ai = 0; ai < 2; ++ai)
#pragma unroll
            for (int m = 0; m < 4; ++m) { const size_t off = (size_t)(row0 + ai * HALF + m * 16) * DM + col0;
#pragma unroll
                for (int bj = 0; bj < 2; ++bj)
#pragma unroll
                    for (int n = 0; n < 2; ++n) { const f32x4 b = *(const f32x4*)(base + off + bj * HALF + n * 16); *(f32x4*)(out + off + bj * HALF + n * 16) = b + gv[bj][n] * acc[ai][bj][m][n]; }
                asm volatile("" ::: "memory"); }
    }
};
struct EpiGlu {
    static constexpr bool PERM = true;
    f16* O; int ldc;
    __device__ __forceinline__ void operator()(const f32x4 (&acc)[2][2][4][2], const Unit& u, int wr, int wc, int fr, int fq) const {
        const int row0 = u.pm * BM + wr * 64 + fr, col0 = u.pn * HALF + wc * 32 + 8 * fq;
#pragma unroll
        for (int ai = 0; ai < 2; ++ai)
#pragma unroll
            for (int m = 0; m < 4; ++m) {
                const f32x4 a0 = acc[ai][0][m][0], a1 = acc[ai][0][m][1], b0 = acc[ai][1][m][0], b1 = acc[ai][1][m][1];
                u32x4 w; w.x = pkh(silu_f(a0[0]) * b0[0], silu_f(a0[1]) * b0[1]); w.y = pkh(silu_f(a0[2]) * b0[2], silu_f(a0[3]) * b0[3]);
                w.z = pkh(silu_f(a1[0]) * b1[0], silu_f(a1[1]) * b1[1]); w.w = pkh(silu_f(a1[2]) * b1[2], silu_f(a1[3]) * b1[3]);
                *(u32x4*)(O + (size_t)(row0 + ai * HALF + m * 16) * ldc + col0) = w;
            }
    }
};
struct EpiF16 {
    static constexpr bool PERM = true;
    f16* O; int ldc; int split_cols; size_t split_stride; float scale;
    __device__ __forceinline__ void operator()(const f32x4 (&acc)[2][2][4][2], const Unit& u, int wr, int wc, int fr, int fq) const {
        const int row0 = u.pm * BM + wr * 64 + fr; int colt = u.pn * BM; f16* base = O;
        if (split_cols) { const int t = colt / split_cols; base += (size_t)t * split_stride; colt -= t * split_cols; }
        const int col0 = colt + wc * 32 + 8 * fq;
#pragma unroll
        for (int ai = 0; ai < 2; ++ai)
#pragma unroll
            for (int m = 0; m < 4; ++m) { f16* rowp = base + (size_t)(row0 + ai * HALF + m * 16) * ldc + col0;
#pragma unroll
                for (int bj = 0; bj < 2; ++bj) { const f32x4 v0 = acc[ai][bj][m][0] * scale, v1 = acc[ai][bj][m][1] * scale;
                    u32x4 w; w.x = pkh(v0[0], v0[1]); w.y = pkh(v0[2], v0[3]); w.z = pkh(v1[0], v1[1]); w.w = pkh(v1[2], v1[3]);
                    *(u32x4*)(rowp + bj * HALF) = w; } }
    }
};
struct EpiMoeOut {
    static constexpr bool PERM = true;
    f16* O; const float* roww;
    __device__ __forceinline__ void operator()(const f32x4 (&acc)[2][2][4][2], const Unit& u, int wr, int wc, int fr, int fq) const {
        const int row0 = u.pm * BM + wr * 64 + fr, col0 = u.pn * BM + wc * 32 + 8 * fq;
#pragma unroll
        for (int ai = 0; ai < 2; ++ai)
#pragma unroll
            for (int m = 0; m < 4; ++m) { const int row = row0 + ai * HALF + m * 16; const float sc = roww[row]; f16* rowp = O + (size_t)row * DM + col0;
#pragma unroll
                for (int bj = 0; bj < 2; ++bj) { const f32x4 v0 = acc[ai][bj][m][0] * sc, v1 = acc[ai][bj][m][1] * sc;
                    u32x4 w; w.x = pkh(v0[0], v0[1]); w.y = pkh(v0[2], v0[3]); w.z = pkh(v1[0], v1[1]); w.w = pkh(v1[2], v1[3]);
                    *(u32x4*)(rowp + bj * HALF) = w; } }
    }
};

template <class Epi>
__device__ __forceinline__ void gemm_phase(LAS unsigned char* lds, const Gemm g, const Order& S, const Epi& E) {
    const int tid = threadIdx.x, wid = __builtin_amdgcn_readfirstlane(tid >> 6), lane = tid & 63, wr = wid >> 2, wc = wid & 3, fr = lane & 15, fq = lane >> 4;
    const int K = g.K, nt = K / BK;
    unsigned voffA[2], voffB[2];
#pragma unroll
    for (int i = 0; i < 2; ++i) { int R, C; stage_rc(tid * 16 + i * 8192, R, C); const int Rb = Epi::PERM ? ((R & ~31) + perm32(R & 31)) : R;
        voffA[i] = (unsigned)(R * K + C) * 2u; voffB[i] = (unsigned)(Rb * K + C) * 2u; }
    const size_t kstep = (size_t)(BK * 2);
    const size_t hstep = (size_t)HALF * K * 2;
    const size_t tstep = 2 * hstep;
    const unsigned ldsw = (unsigned)wid * 1024u;
    const int aoff = lds_byte(wr * 64 + fr, fq * 8), boff = lds_byte(wc * 32 + fr, fq * 8);
#define PG8_SA(b, h) (((b) * 2 + (h)) * HTB)
#define PG8_SB(b, h) ((4 + (b) * 2 + (h)) * HTB)
#define PG8_STAGE(bufoff, gbase, voff) do { _Pragma("unroll") for (int _i = 0; _i < 2; ++_i) \
        __builtin_amdgcn_global_load_lds((const unsigned*)((const char*)(gbase) + (voff)[_i]), (LAS unsigned*)(lds + (bufoff) + ldsw + _i * 8192), 16, 0, 0); } while (0)
#define PG8_LDA(dst, b, h) do { _Pragma("unroll") for (int m = 0; m < 4; ++m) _Pragma("unroll") for (int k = 0; k < 2; ++k) dst[m][k] = *(const LAS f16x8*)(lds + PG8_SA(b, h) + aoff + m * 2048 + k * 1024); } while (0)
#define PG8_LDB(dst, b, h) do { _Pragma("unroll") for (int n = 0; n < 2; ++n) _Pragma("unroll") for (int k = 0; k < 2; ++k) dst[n][k] = *(const LAS f16x8*)(lds + PG8_SB(b, h) + boff + n * 2048 + k * 1024); } while (0)
#define PG8_MMA(ai, bj, At, Bt) do { __builtin_amdgcn_s_setprio(1); _Pragma("unroll") for (int m = 0; m < 4; ++m) _Pragma("unroll") for (int n = 0; n < 2; ++n) _Pragma("unroll") for (int k = 0; k < 2; ++k) \
        acc[ai][bj][m][n] = __builtin_amdgcn_mfma_f32_16x16x32_f16(Bt[n][k], At[m][k], acc[ai][bj][m][n], 0, 0, 0); __builtin_amdgcn_s_setprio(0); } while (0)
#define PG8_WAIT_V(n) asm volatile("s_waitcnt vmcnt(" #n ")" ::: "memory")
#define PG8_WAIT_L(n) asm volatile("s_waitcnt lgkmcnt(" #n ")" ::: "memory")
#define PG8_BAR __builtin_amdgcn_s_barrier()
#define PG8_SCHED __builtin_amdgcn_sched_barrier(0)
    Unit cur, nxt; int ui = 0;
    if (!S.next(0, cur)) return;
    f32x4 acc[2][2][4][2];
#pragma unroll
    for (int a = 0; a < 2; ++a)
#pragma unroll
        for (int b = 0; b < 2; ++b)
#pragma unroll
            for (int m = 0; m < 4; ++m)
#pragma unroll
                for (int n = 0; n < 2; ++n) acc[a][b][m][n] = (f32x4){0.f, 0.f, 0.f, 0.f};
    f16x8 At[4][2], B0[2][2], B1[2][2];
    const char* cA = (const char*)g.A + (size_t)cur.pm * tstep; const char* cB = (const char*)g.Bt + (size_t)cur.be * g.bstride + (size_t)cur.pn * tstep;
    PG8_STAGE(PG8_SB(0, 0), cB, voffB); PG8_STAGE(PG8_SB(0, 1), cB + hstep, voffB); PG8_STAGE(PG8_SA(0, 0), cA, voffA); PG8_STAGE(PG8_SA(0, 1), cA + hstep, voffA);
    if (wr == 1) PG8_BAR;
    PG8_WAIT_V(2); PG8_BAR;
    PG8_STAGE(PG8_SB(1, 0), cB + kstep, voffB); PG8_STAGE(PG8_SA(1, 0), cA + kstep, voffA); PG8_STAGE(PG8_SB(1, 1), cB + hstep + kstep, voffB);
    PG8_WAIT_V(6); PG8_BAR;
    for (;;) {
        const bool has_next = S.next(ui + 1, nxt);
        const char* nA = has_next ? (const char*)g.A + (size_t)nxt.pm * tstep : cA; const char* nB = has_next ? (const char*)g.Bt + (size_t)nxt.be * g.bstride + (size_t)nxt.pn * tstep : cB;
        for (int t = 0; t < nt; t += 2) {
            const bool last = (t == nt - 2);
            const char* a1 = cA + (size_t)(t + 1) * kstep;
            const char* a2 = last ? nA : cA + (size_t)(t + 2) * kstep; const char* b2 = last ? nB : cB + (size_t)(t + 2) * kstep;
            const char* a3 = a2 + kstep; const char* b3 = b2 + kstep;
            PG8_LDB(B0, 0, 0); PG8_LDB(B1, 0, 1); PG8_SCHED; PG8_LDA(At, 0, 0); PG8_STAGE(PG8_SA(1, 1), a1 + hstep, voffA);
            PG8_WAIT_V(8); PG8_WAIT_L(0); PG8_BAR; PG8_MMA(0, 0, At, B0); PG8_MMA(0, 1, At, B1); PG8_BAR; PG8_SCHED;
            PG8_LDA(At, 0, 1); PG8_STAGE(PG8_SB(0, 0), b2, voffB); PG8_STAGE(PG8_SB(0, 1), b2 + hstep, voffB); PG8_STAGE(PG8_SA(0, 0), a2, voffA);
            PG8_WAIT_V(8); PG8_WAIT_L(0); PG8_BAR; PG8_MMA(1, 0, At, B0); PG8_MMA(1, 1, At, B1); PG8_BAR; PG8_SCHED;
            PG8_LDB(B0, 1, 0); PG8_LDB(B1, 1, 1); PG8_SCHED; PG8_LDA(At, 1, 0); PG8_STAGE(PG8_SA(0, 1), a2 + hstep, voffA);
            PG8_WAIT_V(8); PG8_WAIT_L(0); PG8_BAR; PG8_MMA(0, 0, At, B0); PG8_MMA(0, 1, At, B1); PG8_BAR; PG8_SCHED;
            PG8_LDA(At, 1, 1); PG8_STAGE(PG8_SB(1, 0), b3, voffB); PG8_STAGE(PG8_SB(1, 1), b3 + hstep, voffB); PG8_STAGE(PG8_SA(1, 0), a3, voffA);
            PG8_WAIT_V(8); PG8_WAIT_L(0); PG8_BAR; PG8_MMA(1, 0, At, B0); PG8_MMA(1, 1, At, B1); PG8_BAR; PG8_SCHED;
        }
        if (wr == 0) PG8_BAR;
        E(acc, cur, wr, wc, fr, fq);
        if (!has_next) break;
#pragma unroll
        for (int a = 0; a < 2; ++a)
#pragma unroll
            for (int b = 0; b < 2; ++b)
#pragma unroll
                for (int m = 0; m < 4; ++m)
#pragma unroll
                    for (int n = 0; n < 2; ++n) acc[a][b][m][n] = (f32x4){0.f, 0.f, 0.f, 0.f};
        cur = nxt; cA = nA; cB = nB; ++ui;
        if (wr == 1) PG8_BAR;
    }
    PG8_WAIT_V(0);
    PG8_BAR;
#undef PG8_SA
#undef PG8_SB
#undef PG8_STAGE
#undef PG8_LDA
#undef PG8_LDB
#undef PG8_MMA
#undef PG8_WAIT_V
#undef PG8_WAIT_L
#undef PG8_BAR
#undef PG8_SCHED
}
}

constexpr size_t MiB = 1u << 20;
constexpr size_t WS_CTL = 0, CTL_ZERO_BYTES = 1 * MiB;
constexpr size_t WS_MOD = 1 * MiB;
constexpr size_t WS_KVMOD = 3 * MiB;
constexpr size_t WS_TOKINFO = 4 * MiB;
constexpr size_t WS_TOKSLOT = 6 * MiB;
constexpr size_t WS_SLOTW = 7 * MiB;
constexpr size_t WS_ROPE = 8 * MiB;
constexpr size_t WS_W_RIN = 24 * MiB, WS_W_ROUT = 48 * MiB, WS_W_KV = 56 * MiB, WS_W_SQ = 60 * MiB, WS_W_SO = 64 * MiB, WS_W_FIN = 68 * MiB, WS_W_FOUT = 90 * MiB, WS_W_MIN = 101 * MiB, WS_W_MOUT = 325 * MiB;
constexpr size_t WS_X = 437 * MiB, WS_H = 565 * MiB, WS_KSH = 629 * MiB, WS_VSH = 693 * MiB, WS_BIG = 757 * MiB;
constexpr size_t WS_PROJ = WS_BIG, WS_AO = WS_BIG + 384 * MiB;
constexpr size_t WS_ACTD = WS_BIG;
constexpr size_t WS_HS = WS_BIG, WS_Y2 = WS_BIG, WS_ACTE = WS_BIG + 132 * MiB;
constexpr size_t WS_SQ = WS_BIG, WS_SO = WS_BIG + 64 * MiB, WS_HK = WS_BIG + 192 * MiB;
constexpr size_t WS_END = WS_BIG + 594 * MiB;
static_assert((size_t)MOE_ROWS_MAX * DM * 2 <= 132 * MiB && WS_ACTE + (size_t)MOE_ROWS_MAX * FFE * 2 <= WS_END && WS_AO + (size_t)MTOK * 2048 * 2 <= WS_END, "ws map");
constexpr int CW_BAR = 4096;
constexpr int CW_MOE = 16384;

constexpr int RING_BYTES = 131072;
constexpr int LDS_BYTES = 147456;
constexpr int MISC_OFF = LDS_BYTES - 256;

#define XB_TMO      128
#define XB_XCNT(j)  (256  + 64 * (j))
#define XB_XSUB(j)  (1280 + 64 * (j))
#define XB_XGEN(j)  (2304 + 64 * (j))
#define XB_TOP      3328
#define XB_TOPGEN   3392
#define XCD_BAR_WORDS 3456
#define XB_SPIN_CAP (1u << 20)
__device__ __forceinline__ unsigned xb_ld(unsigned* p)              { return __hip_atomic_load(p, __ATOMIC_RELAXED, __HIP_MEMORY_SCOPE_AGENT); }
__device__ __forceinline__ unsigned xb_add(unsigned* p, unsigned v) { return __hip_atomic_fetch_add(p, v, __ATOMIC_RELAXED, __HIP_MEMORY_SCOPE_AGENT); }
__device__ __forceinline__ unsigned xb_xcc_id() { return (unsigned)__builtin_amdgcn_s_getreg((3 << 11) | 20) & 0xFu; }
#define XB_SPIN(cond, bar) do { unsigned _sp = 0; while (cond) { __builtin_amdgcn_s_sleep(1); \
    if ((++_sp & 255u) == 0u) { if (xb_ld(&(bar)[XB_TMO])) break; if (_sp > XB_SPIN_CAP) { atomicAdd(&(bar)[XB_TMO], 1u); break; } } } } while (0)
struct XcdBarrier { unsigned* bar; unsigned x; volatile LAS unsigned* st; };
__device__ __forceinline__ XcdBarrier xcd_barrier_post(unsigned* bar, volatile LAS unsigned* st) {
    XcdBarrier b; b.bar = bar; b.x = xb_xcc_id(); b.st = st;
    if (threadIdx.x == 0) (void)xb_add(&bar[XB_XCNT(b.x)], 1u);
    return b;
}
__device__ __forceinline__ void xcd_barrier_complete(unsigned* bar, unsigned x, unsigned& nloc, unsigned& nx) {
    const unsigned G = gridDim.x * gridDim.y * gridDim.z;
    unsigned sum, cnt, mine, sp = 0u;
    for (;;) {
        sum = 0u; cnt = 0u; mine = 0u;
#pragma unroll
        for (unsigned j = 0; j < 16; ++j) { const unsigned c = xb_ld(&bar[XB_XCNT(j)]); sum += c; cnt += (c > 0u) ? 1u : 0u; mine = (j == x) ? c : mine; }
        if (sum == G) break;
        __builtin_amdgcn_s_sleep(1);
        if ((++sp & 255u) == 0u) { if (xb_ld(&bar[XB_TMO])) break; if (sp > XB_SPIN_CAP) { atomicAdd(&bar[XB_TMO], 1u); break; } }
    }
    nloc = mine > 0u ? mine : 1u; nx = cnt > 0u ? cnt : 1u;
}
__device__ __forceinline__ void xcd_barrier(const XcdBarrier& b) {
    asm volatile("s_waitcnt vmcnt(0)" ::: "memory");
    __syncthreads();
    if (threadIdx.x == 0) {
        unsigned* bar = b.bar;
        __builtin_amdgcn_s_waitcnt(0);
        unsigned nloc = b.st[0], nx = b.st[1];
        if (nloc == 0u) { xcd_barrier_complete(bar, b.x, nloc, nx); b.st[0] = nloc; b.st[1] = nx; }
        const unsigned old = xb_add(&bar[XB_XSUB(b.x)], 1u);
        const unsigned gen = old / nloc;
        if (old + 1u == (gen + 1u) * nloc) {
            __builtin_amdgcn_fence(__ATOMIC_RELEASE, "agent");
            asm volatile("s_waitcnt vmcnt(0)" ::: "memory");
            const unsigned og = xb_add(&bar[XB_TOP], 1u);
            const unsigned tg = og / nx;
            if (og + 1u == (tg + 1u) * nx) xb_add(&bar[XB_TOPGEN], 1u);
            else XB_SPIN(xb_ld(&bar[XB_TOPGEN]) == tg, bar);
            __builtin_amdgcn_fence(__ATOMIC_ACQUIRE, "agent");
            xb_add(&bar[XB_XGEN(b.x)], 1u);
            asm volatile("s_waitcnt vmcnt(0)" ::: "memory");
        } else {
            XB_SPIN(xb_ld(&bar[XB_XGEN(b.x)]) == gen, bar);
            __builtin_amdgcn_fence(__ATOMIC_ACQUIRE, "agent");
            asm volatile("s_waitcnt vmcnt(0)" ::: "memory");
        }
    }
    __syncthreads();
}

#define WG_BAR() do { asm volatile("s_waitcnt lgkmcnt(0)" ::: "memory"); __builtin_amdgcn_s_barrier(); asm volatile("" ::: "memory"); } while (0)
#define CFENCE() asm volatile("" ::: "memory")
__device__ __forceinline__ float wave_sum(float v) {
#pragma unroll
    for (int o = 1; o < 64; o <<= 1) v += __shfl_xor(v, o);
    return v;
}
__device__ __forceinline__ f16x4 tr_read(LAS const unsigned char* p) {
    return __builtin_bit_cast(f16x4, __builtin_amdgcn_ds_read_tr16_b64_v4i16((LAS v4i16_t*)p));
}
__device__ __forceinline__ f16x8 cat8(f16x4 a, f16x4 b) { return (f16x8){a[0], a[1], a[2], a[3], b[0], b[1], b[2], b[3]}; }
__device__ __forceinline__ f16x8 pack8(const f32x16& x, int s) {
    u32x4 w; w.x = pkh(x[8 * s + 0], x[8 * s + 1]); w.y = pkh(x[8 * s + 2], x[8 * s + 3]); w.z = pkh(x[8 * s + 4], x[8 * s + 5]); w.w = pkh(x[8 * s + 6], x[8 * s + 7]);
    return __builtin_bit_cast(f16x8, w);
}

struct Frame {
    LAS unsigned char* lds;
    unsigned* ctl;
    int tid, lane, wave, vcu, G;
    unsigned char* ws;
};

template <int MAP>
__device__ __forceinline__ int srccol(int n, int N) {
    if (MAP == 1) { if (n >= 2048) return n; const int p = n & 127; return (n & ~127) + (p >> 1) + 64 * (p & 1); }
    if (MAP == 2) { const int F = N >> 1, t = n >> 8, j = n & 255; return (j < 128) ? 128 * t + j : F + 128 * t + (j - 128); }
    return n;
}
template <int MAP>
__device__ __forceinline__ void p0_transpose_item(const float* W, int K, int N, f16* WT, LAS float* scr, int item, int lane) {
    const int nblk = N / 32, kb = item / nblk, nb = item % nblk, k0 = 64 * kb, n0 = 32 * nb;
    const int sc = srccol<MAP>(n0 + (lane & 31), N);
#pragma unroll 8
    for (int i = 0; i < 32; ++i) { const int kk = 2 * i + (lane >> 5); scr[kk * 33 + (lane & 31)] = W[(size_t)(k0 + kk) * N + sc]; }
    asm volatile("s_waitcnt lgkmcnt(0)" ::: "memory");
    const int c = lane & 7;
#pragma unroll
    for (int j = 0; j < 4; ++j) { const int n = (lane >> 3) + 8 * j; const LAS float* s = scr + (8 * c) * 33 + n;
        u32x4 o; o.x = pkh(s[0 * 33], s[1 * 33]); o.y = pkh(s[2 * 33], s[3 * 33]); o.z = pkh(s[4 * 33], s[5 * 33]); o.w = pkh(s[6 * 33], s[7 * 33]);
        *(u32x4*)(WT + (size_t)(n0 + n) * K + k0 + 8 * c) = o; }
    asm volatile("s_waitcnt lgkmcnt(0)" ::: "memory");
}
template <int MAP>
__device__ __forceinline__ bool p0_group(int& r, const float* W, int nb, int K, int N, f16* WT, LAS float* scr, int lane) {
    const int per = (K / 64) * (N / 32), tot = nb * per;
    if (r >= tot) { r -= tot; return false; }
    const int b = r / per, it = r % per;
    p0_transpose_item<MAP>(W + (size_t)b * K * N, K, N, WT + (size_t)b * K * N, scr, it, lane);
    return true;
}
struct P0In { const float *c, *ada_w, *ada_b, *kv_ada_w, *kv_ada_b; const int* pos; const float *ret_w_in, *ret_w_out, *kv_w, *sb_w_q, *sb_w_out, *ff_w_in, *ff_w_out, *moe_w_in, *moe_w_out; };
__device__ __forceinline__ void p0_prologue(Frame& F, const P0In& I) {
    const int gw = F.vcu * 8 + F.wave, NGW = F.G * 8;
    LAS float* condL = (LAS float*)(F.lds);
    LAS float* scr = (LAS float*)(F.lds + 65536 + F.wave * 8448);
    for (int i = F.tid; i < 16 * 1024; i += 512) { const int b = i >> 10, k = i & 1023; condL[k * 16 + b] = silu_f(I.c[i]); }
    WG_BAR();
    for (int it = gw; it < 416; it += NGW) {
        const float* W; const float* bias; float* dst; int N, col0;
        if (it < 384) { const int l = it / 96; col0 = 64 * (it % 96); N = 6144; W = I.ada_w + (size_t)l * 1024 * 6144; bias = I.ada_b + l * 6144; dst = (float*)(F.ws + WS_MOD) + (size_t)l * 16 * 6144; }
        else { col0 = 64 * (it - 384); N = 2048; W = I.kv_ada_w; bias = I.kv_ada_b; dst = (float*)(F.ws + WS_KVMOD); }
        const int cl = F.lane & 15, kg = F.lane >> 4;
        f32x4 acc[16];
#pragma unroll
        for (int b = 0; b < 16; ++b) acc[b] = (f32x4){0.f, 0.f, 0.f, 0.f};
        const float* wp = W + (size_t)kg * N + col0 + 4 * cl;
#pragma unroll 4
        for (int k4 = 0; k4 < 256; ++k4) {
            const f32x4 w = *(const f32x4*)(wp + (size_t)k4 * 4 * N);
            const LAS f32x4* cp = (const LAS f32x4*)(condL + (4 * k4 + kg) * 16);
            const f32x4 c0 = cp[0], c1 = cp[1], c2 = cp[2], c3 = cp[3];
#pragma unroll
            for (int j = 0; j < 4; ++j) { acc[j] += c0[j] * w; acc[4 + j] += c1[j] * w; acc[8 + j] += c2[j] * w; acc[12 + j] += c3[j] * w; }
        }
        const f32x4 bv = *(const f32x4*)(bias + col0 + 4 * cl);
#pragma unroll
        for (int b = 0; b < 16; ++b) {
            f32x4 v = acc[b];
#pragma unroll
            for (int j = 0; j < 4; ++j) { v[j] += __shfl_xor(v[j], 16); v[j] += __shfl_xor(v[j], 32); }
            if (kg == 0) *(f32x4*)(dst + (size_t)b * N + col0 + 4 * cl) = v + bv;
        }
    }
    {
        const double e = -(double)F.lane / 64.0;
        const double invf = exp2(e * 13.287712379549449);
        float* rope = (float*)(F.ws + WS_ROPE);
        for (int row = gw; row < MTOK; row += NGW) {
            const double rev = (double)I.pos[row] * invf * 0.15915494309189535;
            const float fr = (float)(rev - floor(rev));
            rope[(size_t)row * 128 + F.lane] = __builtin_amdgcn_cosf(fr); rope[(size_t)row * 128 + 64 + F.lane] = __builtin_amdgcn_sinf(fr);
        }
    }
    constexpr int per_rin = 16 * 192, per_rout = 32 * 32, per_kv = 16 * 64, per_sq = 16 * 32, per_fin = 16 * 176, per_fout = 44 * 32, per_min = 16 * 224, per_mout = 56 * 32;
    constexpr int NITEMS = 2 * per_rin + 2 * per_rout + per_kv + 4 * per_sq + 2 * per_fin + 2 * per_fout + 16 * per_min + 16 * per_mout;
    for (int it = gw; it < NITEMS; it += NGW) {
        int r = it;
        if (p0_group<1>(r, I.ret_w_in, 2, 1024, 6144, (f16*)(F.ws + WS_W_RIN), scr, F.lane)) continue;
        if (p0_group<0>(r, I.ret_w_out, 2, 2048, 1024, (f16*)(F.ws + WS_W_ROUT), scr, F.lane)) continue;
        if (p0_group<0>(r, I.kv_w, 1, 1024, 2048, (f16*)(F.ws + WS_W_KV), scr, F.lane)) continue;
        if (p0_group<0>(r, I.sb_w_q, 2, 1024, 1024, (f16*)(F.ws + WS_W_SQ), scr, F.lane)) continue;
        if (p0_group<0>(r, I.sb_w_out, 2, 1024, 1024, (f16*)(F.ws + WS_W_SO), scr, F.lane)) continue;
        if (p0_group<2>(r, I.ff_w_in, 2, 1024, 5632, (f16*)(F.ws + WS_W_FIN), scr, F.lane)) continue;
        if (p0_group<0>(r, I.ff_w_out, 2, 2816, 1024, (f16*)(F.ws + WS_W_FOUT), scr, F.lane)) continue;
        if (p0_group<2>(r, I.moe_w_in, 16, 1024, 7168, (f16*)(F.ws + WS_W_MIN), scr, F.lane)) continue;
        p0_group<0>(r, I.moe_w_out, 16, 3584, 1024, (f16*)(F.ws + WS_W_MOUT), scr, F.lane);
    }
}

struct NormArgs {
    const float* x; float* xw; const float* gain; const float* sh; const float* sc;
    f16* h; const float* gain2; const float* kvmod; f16* hk;
    const f16* y2; const unsigned* tokslot; const float* gatef;
    float* out;
    const float* router; unsigned* gcnt; unsigned* tokinfo;
};
template <bool COMBINE, bool KV, bool FINAL, bool ROUTER>
__device__ __forceinline__ void norm_phase(Frame& F, const NormArgs& A) {
    const int gw = F.vcu * 8 + F.wave, NGW = F.G * 8;
    LAS float* routL = (LAS float*)F.lds;
    LAS unsigned* lcnt = (LAS unsigned*)(F.lds + 32768);
    LAS unsigned* recs = (LAS unsigned*)(F.lds + 32768 + 256);
    if (ROUTER) {
        for (int i = F.tid; i < 8192; i += 512) routL[i] = A.router[i];
        if (F.tid < 16) lcnt[F.tid] = 0u;
        WG_BAR();
    }
    int nloc = 0;
    for (int row = gw; row < MTOK; row += NGW, ++nloc) {
        const int b = row >> 11;
        f32x4 v[4];
#pragma unroll
        for (int j = 0; j < 4; ++j) v[j] = *((const f32x4*)(A.x + (size_t)row * DM) + F.lane + 64 * j);
        if (COMBINE) {
            const u32x2 sl = *(const u32x2*)(A.tokslot + 2 * (size_t)row);
            const f16* ya = A.y2 + (size_t)sl.x * DM; const f16* yb = A.y2 + (size_t)sl.y * DM;
#pragma unroll
            for (int j = 0; j < 4; ++j) {
                const f16x4 a = *((const f16x4*)ya + F.lane + 64 * j), c = *((const f16x4*)yb + F.lane + 64 * j);
                const f32x4 g = *((const f32x4*)(A.gatef + (size_t)b * 6144) + F.lane + 64 * j);
#pragma unroll
                for (int t = 0; t < 4; ++t) v[j][t] += g[t] * ((float)a[t] + (float)c[t]);
                if (!FINAL) *((f32x4*)(A.xw + (size_t)row * DM) + F.lane + 64 * j) = v[j];
            }
        }
        float ss = 0.f;
#pragma unroll
        for (int j = 0; j < 4; ++j) ss += (v[j][0] * v[j][0] + v[j][1] * v[j][1]) + (v[j][2] * v[j][2] + v[j][3] * v[j][3]);
        const float rstd = 1.0f / sqrtf(wave_sum(ss) * (1.0f / DM) + EPS);
        if (FINAL) {
#pragma unroll
            for (int j = 0; j < 4; ++j) { const f32x4 g = *((const f32x4*)A.gain + F.lane + 64 * j); *((f32x4*)(A.out + (size_t)row * DM) + F.lane + 64 * j) = v[j] * rstd * g; }
        } else {
            f32x4 hv[4];
#pragma unroll
            for (int j = 0; j < 4; ++j) {
                const f32x4 g = *((const f32x4*)A.gain + F.lane + 64 * j), sh = *((const f32x4*)(A.sh + (size_t)b * 6144) + F.lane + 64 * j), sc = *((const f32x4*)(A.sc + (size_t)b * 6144) + F.lane + 64 * j);
                hv[j] = (v[j] * rstd * g) * (1.0f + sc) + sh;
                u32x2 w; w.x = pkh(hv[j][0], hv[j][1]); w.y = pkh(hv[j][2], hv[j][3]);
                *((u32x2*)(A.h + (size_t)row * DM) + F.lane + 64 * j) = w;
            }
            if (KV) {
#pragma unroll
                for (int j = 0; j < 4; ++j) {
                    const f32x4 g = *((const f32x4*)A.gain2 + F.lane + 64 * j), sh = *((const f32x4*)(A.kvmod + (size_t)b * 2048) + F.lane + 64 * j), sc = *((const f32x4*)(A.kvmod + (size_t)b * 2048 + 1024) + F.lane + 64 * j);
                    const f32x4 o = (v[j] * rstd * g) * (1.0f + sc) + sh;
                    u32x2 w; w.x = pkh(o[0], o[1]); w.y = pkh(o[2], o[3]);
                    *((u32x2*)(A.hk + (size_t)row * DM) + F.lane + 64 * j) = w;
                }
            }
            if (ROUTER) {
                float lg[8];
#pragma unroll
                for (int e = 0; e < 8; ++e) lg[e] = 0.f;
#pragma unroll
                for (int j = 0; j < 4; ++j)
#pragma unroll
                    for (int t = 0; t < 4; ++t) {
                        const LAS f32x4* rp = (const LAS f32x4*)(routL + (4 * F.lane + 256 * j + t) * 8);
                        const f32x4 r0 = rp[0], r1 = rp[1]; const float hx = hv[j][t];
                        lg[0] += hx * r0[0]; lg[1] += hx * r0[1]; lg[2] += hx * r0[2]; lg[3] += hx * r0[3]; lg[4] += hx * r1[0]; lg[5] += hx * r1[1]; lg[6] += hx * r1[2]; lg[7] += hx * r1[3];
                    }
#pragma unroll
                for (int e = 0; e < 8; ++e) lg[e] = wave_sum(lg[e]);
                int i1 = 0; float v1 = lg[0];
#pragma unroll
                for (int e = 1; e < 8; ++e) if (lg[e] > v1) { v1 = lg[e]; i1 = e; }
                int i2 = -1; float v2 = -INFINITY;
#pragma unroll
                for (int e = 0; e < 8; ++e) if (e != i1 && lg[e] > v2) { v2 = lg[e]; i2 = e; }
                const float ed = __expf(v2 - v1), w1 = 1.0f / (1.0f + ed), w2 = ed * w1;
                if (F.lane == 0) {
                    const unsigned p1 = __hip_atomic_fetch_add(&lcnt[i1], 1u, __ATOMIC_RELAXED, __HIP_MEMORY_SCOPE_WORKGROUP), p2 = __hip_atomic_fetch_add(&lcnt[i2], 1u, __ATOMIC_RELAXED, __HIP_MEMORY_SCOPE_WORKGROUP);
                    LAS unsigned* rc = recs + (F.wave * 16 + nloc) * 8;
                    rc[0] = (unsigned)i1; rc[1] = p1; rc[2] = (unsigned)i2; rc[3] = p2; rc[4] = __float_as_uint(w1); rc[5] = __float_as_uint(w2);
                }
            }
        }
    }
    if (ROUTER) {
        WG_BAR();
        if (F.tid < 8) lcnt[8 + F.tid] = __hip_atomic_fetch_add(A.gcnt + 64 * F.tid, lcnt[F.tid], __ATOMIC_RELAXED, __HIP_MEMORY_SCOPE_AGENT);
        WG_BAR();
        if (F.lane == 0) {
            int k = 0;
            for (int row = gw; row < MTOK; row += NGW, ++k) {
                const LAS unsigned* rc = recs + (F.wave * 16 + k) * 8;
                u32x4 o; o.x = rc[0]; o.y = rc[1] + lcnt[8 + rc[0]]; o.z = rc[2]; o.w = rc[3] + lcnt[8 + rc[2]];
                *(u32x4*)(A.tokinfo + 8 * (size_t)row) = o; *(u32x2*)(A.tokinfo + 8 * (size_t)row + 4) = (u32x2){rc[4], rc[5]};
            }
        }
    }
}
__device__ __forceinline__ void moe_tile_bases(const unsigned* gcnt, int (&tb)[NEXP], int& ntiles) {
    int acc = 0;
#pragma unroll
    for (int e = 0; e < NEXP; ++e) { tb[e] = acc; const unsigned c = __hip_atomic_load(gcnt + 64 * e, __ATOMIC_RELAXED, __HIP_MEMORY_SCOPE_AGENT); acc += (int)((c + 255u) >> 8); }
    ntiles = acc;
}
__device__ __forceinline__ void moe_gather(Frame& F, const unsigned* gcnt, const unsigned* tokinfo, const f16* h, f16* hs, float* slotw, unsigned* tokslot) {
    const int gw = F.vcu * 8 + F.wave, NGW = F.G * 8;
    int tb[NEXP], nt; moe_tile_bases(gcnt, tb, nt);
    for (int row = gw; row < MTOK; row += NGW) {
        const u32x4 ti = *(const u32x4*)(tokinfo + 8 * (size_t)row); const u32x2 tw = *(const u32x2*)(tokinfo + 8 * (size_t)row + 4);
        int b1 = 0, b2 = 0;
#pragma unroll
        for (int e = 0; e < NEXP; ++e) { b1 = ((int)ti.x == e) ? tb[e] : b1; b2 = ((int)ti.z == e) ? tb[e] : b2; }
        const unsigned s1 = (unsigned)b1 * 256u + ti.y, s2 = (unsigned)b2 * 256u + ti.w;
        const u32x4* src = (const u32x4*)(h + (size_t)row * DM);
        const u32x4 a = src[F.lane], c = src[F.lane + 64];
        u32x4* d1 = (u32x4*)(hs + (size_t)s1 * DM); u32x4* d2 = (u32x4*)(hs + (size_t)s2 * DM);
        d1[F.lane] = a; d1[F.lane + 64] = c; d2[F.lane] = a; d2[F.lane + 64] = c;
        if (F.lane == 0) { slotw[s1] = __uint_as_float(tw.x); slotw[s2] = __uint_as_float(tw.y); *(u32x2*)(tokslot + 2 * (size_t)row) = (u32x2){s1, s2}; }
    }
}

constexpr int SC_PQ = 272, SC_PV = 528;
constexpr int SC_QL = 0, SC_KL = 17408, SC_VL = 34816, SC_SL = 68608, SC_ST = 136192, SC_STAGE = 0;
__device__ __forceinline__ void scan_phase(Frame& F, const f16* proj, const float* gnw, f16* ao) {
    const int unit = blockIdx.x;
    if (unit >= BATCH * RH) return;
    const int b = unit >> 3, hh = unit & 7;
    LAS unsigned char* L = F.lds;
    const int tid = F.tid, lane = F.lane, wid = F.wave, rh = wid >> 2, cg = wid & 3, r = lane & 31, h = lane >> 5;
    const int gl = (lane >> 4) & 1, li = lane & 15, ta = li >> 2, tp = li & 3;
    const float lg = lg2gamma(hh);
    const float g63 = ex2(63.0f * lg), cd = ex2(64.0f * lg);
    float vm[2][4], cj[4]; const float wneg = ex2(-64.0f * lg); const int qloc = 32 * rh + r;
#pragma unroll
    for (int kt = 0; kt < 2; ++kt)
#pragma unroll
        for (int g4 = 0; g4 < 4; ++g4) vm[kt][g4] = ex2((float)(64 * kt + 16 * g4 + 8 * h - 2 * qloc - 64) * lg);
#pragma unroll
    for (int j = 0; j < 4; ++j) cj[j] = ex2((float)(2 * j) * lg);
    const size_t rowbase = (size_t)b * SEQ;
    const f16* gq = proj + rowbase * RIN + 128 * hh;
    const f16* gk = gq + 1024;
    const f16* gv = proj + rowbase * RIN + 2048 + 256 * hh;
    const f16* gg = gv + 2048;
    const int qrow = tid >> 4, qc = tid & 15;
    const int vrow = tid >> 5, vc = tid & 31;
    f32x16 SA[2][2];
#pragma unroll
    for (int et = 0; et < 2; ++et)
#pragma unroll
        for (int dd = 0; dd < 2; ++dd)
#pragma unroll
            for (int i = 0; i < 16; ++i) SA[et][dd][i] = 0.f;
    for (int i = tid; i < 128 * SC_PV / 16; i += 512) *(LAS u32x4*)(L + SC_SL + i * 16) = (u32x4){0u, 0u, 0u, 0u};
    u32x4 nq[2], nk[2], nv[4];
#pragma unroll
    for (int i = 0; i < 2; ++i) { nq[i] = *(const u32x4*)(gq + (size_t)(qrow + 32 * i) * RIN + 8 * qc); nk[i] = *(const u32x4*)(gk + (size_t)(qrow + 32 * i) * RIN + 8 * qc); }
#pragma unroll
    for (int i = 0; i < 4; ++i) nv[i] = *(const u32x4*)(gv + (size_t)(vrow + 16 * i) * RIN + 8 * vc);
#pragma unroll
    for (int i = 0; i < 2; ++i) { *(LAS u32x4*)(L + SC_QL + (qrow + 32 * i) * SC_PQ + 16 * qc) = nq[i]; *(LAS u32x4*)(L + SC_KL + (qrow + 32 * i) * SC_PQ + 16 * qc) = nk[i]; }
#pragma unroll
    for (int i = 0; i < 4; ++i) *(LAS u32x4*)(L + SC_VL + (vrow + 16 * i) * SC_PV + 16 * vc) = nv[i];
    WG_BAR();
    for (int c = 0; c < NCHUNK; ++c) {
        const size_t crow = (size_t)c * CHUNK;
        if (c + 1 < NCHUNK) {
#pragma unroll
            for (int i = 0; i < 2; ++i) { nq[i] = *(const u32x4*)(gq + (crow + 64 + qrow + 32 * i) * RIN + 8 * qc); nk[i] = *(const u32x4*)(gk + (crow + 64 + qrow + 32 * i) * RIN + 8 * qc); }
#pragma unroll
            for (int i = 0; i < 4; ++i) nv[i] = *(const u32x4*)(gv + (crow + 64 + vrow + 16 * i) * RIN + 8 * vc);
        }
        f16x8 Qf[8];
#pragma unroll
        for (int ks = 0; ks < 8; ++ks) Qf[ks] = *(const LAS f16x8*)(L + SC_QL + (32 * rh + r) * SC_PQ + (16 * ks + 8 * h) * 2);
        f16x8 Pf[2][2];
#pragma unroll
        for (int kt = 0; kt < 2; ++kt) {
            f32x16 X;
#pragma unroll
            for (int i = 0; i < 16; ++i) X[i] = 0.f;
#pragma unroll
            for (int ks = 0; ks < 8; ++ks) { const f16x8 Kf = *(const LAS f16x8*)(L + SC_KL + (32 * kt + r) * SC_PQ + (16 * ks + 8 * h) * 2); X = __builtin_amdgcn_mfma_f32_32x32x16_f16(Kf, Qf[ks], X, 0, 0, 0); }
#pragma unroll
            for (int i = 0; i < 16; ++i) { const int key = 32 * kt + (i & 3) + 8 * (i >> 2) + 4 * h; X[i] *= (key >= qloc) ? vm[kt][i >> 2] * cj[i & 3] : wneg; }
            Pf[kt][0] = pack8(X, 0); Pf[kt][1] = pack8(X, 1);
        }
        f32x16 OT[2];
#pragma unroll
        for (int et = 0; et < 2; ++et)
#pragma unroll
            for (int i = 0; i < 16; ++i) OT[et][i] = 0.f;
#pragma unroll
        for (int ks = 0; ks < 8; ++ks)
#pragma unroll
            for (int et = 0; et < 2; ++et) {
                LAS const unsigned char* sp = L + SC_SL + (16 * ks + 8 * h + ta) * SC_PV + (64 * cg + 32 * et + 16 * gl + 4 * tp) * 2;
                const f16x8 Sf = cat8(tr_read(sp), tr_read(sp + 4 * SC_PV));
                OT[et] = __builtin_amdgcn_mfma_f32_32x32x16_f16(Sf, Qf[ks], OT[et], 0, 0, 0);
            }
#pragma unroll
        for (int et = 0; et < 2; ++et)
#pragma unroll
            for (int dd = 0; dd < 2; ++dd)
#pragma unroll
                for (int i = 0; i < 16; ++i) SA[et][dd][i] *= cd;
#pragma unroll
        for (int kt = 0; kt < 2; ++kt)
#pragma unroll
            for (int s = 0; s < 2; ++s) {
                const int k0 = 32 * kt + 16 * s + 4 * h + ta;
                f16x8 Vf[2], Kt[2];
#pragma unroll
                for (int et = 0; et < 2; ++et) { LAS const unsigned char* vp = L + SC_VL + k0 * SC_PV + (64 * cg + 32 * et + 16 * gl + 4 * tp) * 2; Vf[et] = cat8(tr_read(vp), tr_read(vp + 8 * SC_PV)); }
#pragma unroll
                for (int dd = 0; dd < 2; ++dd) { LAS const unsigned char* kp = L + SC_KL + k0 * SC_PQ + (32 * (2 * rh + dd) + 16 * gl + 4 * tp) * 2; Kt[dd] = cat8(tr_read(kp), tr_read(kp + 8 * SC_PQ)); }
#pragma unroll
                for (int et = 0; et < 2; ++et) {
                    OT[et] = __builtin_amdgcn_mfma_f32_32x32x16_f16(Vf[et], Pf[kt][s], OT[et], 0, 0, 0);
#pragma unroll
                    for (int dd = 0; dd < 2; ++dd) SA[et][dd] = __builtin_amdgcn_mfma_f32_32x32x16_f16(Vf[et], Kt[dd], SA[et][dd], 0, 0, 0);
                }
            }
        float s1 = 0.f, s2 = 0.f;
#pragma unroll
        for (int et = 0; et < 2; ++et)
#pragma unroll
            for (int i = 0; i < 16; ++i) { OT[et][i] *= g63; s1 += OT[et][i]; s2 += OT[et][i] * OT[et][i]; }
        s1 += __shfl_xor(s1, 32); s2 += __shfl_xor(s2, 32);
        if (h == 0) *(LAS f32x2*)(L + SC_ST + ((rh * 4 + cg) * 32 + r) * 8) = (f32x2){s1, s2};
        WG_BAR();
        float t1 = 0.f, t2 = 0.f;
#pragma unroll
        for (int c4 = 0; c4 < 4; ++c4) { const f32x2 p = *(const LAS f32x2*)(L + SC_ST + ((rh * 4 + c4) * 32 + r) * 8); t1 += p.x; t2 += p.y; }
        const float mean = t1 * (1.0f / 256.0f), var = t2 * (1.0f / 256.0f) - mean * mean, rstd = 1.0f / sqrtf(var + EPS);
        u32x4 gc[4];
#pragma unroll
        for (int i = 0; i < 4; ++i) gc[i] = *(const u32x4*)(gg + (crow + vrow + 16 * i) * RIN + 8 * vc);
#pragma unroll
        for (int et = 0; et < 2; ++et)
#pragma unroll
            for (int dd = 0; dd < 2; ++dd)
#pragma unroll
                for (int g4 = 0; g4 < 4; ++g4) {
                    u32x2 w; w.x = pkh(SA[et][dd][4 * g4], SA[et][dd][4 * g4 + 1]); w.y = pkh(SA[et][dd][4 * g4 + 2], SA[et][dd][4 * g4 + 3]);
                    *(LAS u32x2*)(L + SC_SL + (32 * (2 * rh + dd) + r) * SC_PV + (64 * cg + 32 * et + 8 * g4 + 4 * h) * 2) = w;
                }
#pragma unroll
        for (int et = 0; et < 2; ++et)
#pragma unroll
            for (int g4 = 0; g4 < 4; ++g4) {
                u32x2 w; w.x = pkh((OT[et][4 * g4] - mean) * rstd, (OT[et][4 * g4 + 1] - mean) * rstd); w.y = pkh((OT[et][4 * g4 + 2] - mean) * rstd, (OT[et][4 * g4 + 3] - mean) * rstd);
                *(LAS u32x2*)(L + SC_STAGE + (32 * rh + r) * SC_PV + (64 * cg + 32 * et + 8 * g4 + 4 * h) * 2) = w;
            }
        WG_BAR();
        f32x4 gw0, gw1; { const float* gp = gnw + 256 * hh + 8 * vc; gw0 = *(const f32x4*)gp; gw1 = *(const f32x4*)(gp + 4); }
#pragma unroll
        for (int i = 0; i < 4; ++i) {
            const f16x8 n8 = *(const LAS f16x8*)(L + SC_STAGE + (vrow + 16 * i) * SC_PV + 16 * vc);
            const f16x8 g8 = __builtin_bit_cast(f16x8, gc[i]);
            u32x4 w;
            w.x = pkh((float)n8[0] * (float)g8[0] * gw0[0], (float)n8[1] * (float)g8[1] * gw0[1]); w.y = pkh((float)n8[2] * (float)g8[2] * gw0[2], (float)n8[3] * (float)g8[3] * gw0[3]);
            w.z = pkh((float)n8[4] * (float)g8[4] * gw1[0], (float)n8[5] * (float)g8[5] * gw1[1]); w.w = pkh((float)n8[6] * (float)g8[6] * gw1[2], (float)n8[7] * (float)g8[7] * gw1[3]);
            *(u32x4*)(ao + (rowbase + crow + vrow + 16 * i) * 2048 + 256 * hh + 8 * vc) = w;
        }
        WG_BAR();
        if (c + 1 < NCHUNK) {
#pragma unroll
            for (int i = 0; i < 2; ++i) { *(LAS u32x4*)(L + SC_QL + (qrow + 32 * i) * SC_PQ + 16 * qc) = nq[i]; *(LAS u32x4*)(L + SC_KL + (qrow + 32 * i) * SC_PQ + 16 * qc) = nk[i]; }
#pragma unroll
            for (int i = 0; i < 4; ++i) *(LAS u32x4*)(L + SC_VL + (vrow + 16 * i) * SC_PV + 16 * vc) = nv[i];
        }
        WG_BAR();
    }
}

constexpr int SBV_P = 144;
constexpr float SB_STOP = 7.8886090522101181e-31f;
__device__ __forceinline__ void sb_phase(Frame& F, const f16* Q, const f16* Kc, const f16* Vc, f16* O) {
    const int gw = F.vcu * 8 + F.wave, NGW = F.G * 8, lane = F.lane, r = lane & 31, h = lane >> 5;
    const int gl = (lane >> 4) & 1, li = lane & 15, ta = li >> 2, tp = li & 3;
    LAS unsigned char* Vw = F.lds + F.wave * (32 * SBV_P);
    const int vr = lane >> 3, vcc = lane & 7;
    for (int u = gw; u < BATCH * SBH * (SEQ / 32); u += NGW) {
        const int qblk = u & 63, bh = u >> 6, b = bh >> 4, hd = bh & 15;
        const size_t rb = (size_t)b * SEQ;
        const f16* qp = Q + (rb + 32 * qblk + r) * DM + 64 * hd + 8 * h;
        f16x8 Qf[4];
#pragma unroll
        for (int ks = 0; ks < 4; ++ks) Qf[ks] = *(const f16x8*)(qp + 16 * ks);
        f32x16 OT[2];
#pragma unroll
        for (int dt = 0; dt < 2; ++dt)
#pragma unroll
            for (int i = 0; i < 16; ++i) OT[dt][i] = 0.f;
        float carry = 1.0f;
        u32x4 kn[4], vn[4];
        { const f16* kp = Kc + (rb + 32 * qblk + r) * DM + 64 * hd + 8 * h; const f16* vp = Vc + (rb + 32 * qblk + vr) * DM + 64 * hd + 8 * vcc;
#pragma unroll
          for (int i = 0; i < 4; ++i) { kn[i] = *(const u32x4*)(kp + 16 * i); vn[i] = *(const u32x4*)(vp + (size_t)(8 * i) * DM); } }
        for (int kt = qblk; kt >= 0; --kt) {
            f16x8 Kf[4];
#pragma unroll
            for (int i = 0; i < 4; ++i) { Kf[i] = __builtin_bit_cast(f16x8, kn[i]); *(LAS u32x4*)(Vw + (vr + 8 * i) * SBV_P + 16 * vcc) = vn[i]; }
            CFENCE();
            if (kt > 0) { const f16* kp = Kc + (rb + 32 * (kt - 1) + r) * DM + 64 * hd + 8 * h; const f16* vp = Vc + (rb + 32 * (kt - 1) + vr) * DM + 64 * hd + 8 * vcc;
#pragma unroll
                for (int i = 0; i < 4; ++i) { kn[i] = *(const u32x4*)(kp + 16 * i); vn[i] = *(const u32x4*)(vp + (size_t)(8 * i) * DM); } }
            f32x16 S;
#pragma unroll
            for (int i = 0; i < 16; ++i) S[i] = 0.f;
#pragma unroll
            for (int ks = 0; ks < 4; ++ks) S = __builtin_amdgcn_mfma_f32_32x32x16_f16(Kf[ks], Qf[ks], S, 0, 0, 0);
            float om[16];
            const bool diag = (kt == qblk);
#pragma unroll
            for (int i = 0; i < 16; ++i) {
                const int kl = (i & 3) + 8 * (i >> 2) + 4 * h;
                float o = __builtin_amdgcn_rcpf(1.0f + ex2(S[i]));
                if (diag && kl >= r) o = 1.0f;
                om[i] = o;
            }
            float sfx[16], T[4];
#pragma unroll
            for (int g4 = 0; g4 < 4; ++g4) { sfx[4 * g4 + 3] = 1.0f; sfx[4 * g4 + 2] = om[4 * g4 + 3]; sfx[4 * g4 + 1] = sfx[4 * g4 + 2] * om[4 * g4 + 2]; sfx[4 * g4] = sfx[4 * g4 + 1] * om[4 * g4 + 1]; T[g4] = sfx[4 * g4] * om[4 * g4]; }
            float E[4]; float run = carry;
#pragma unroll
            for (int g4 = 3; g4 >= 0; --g4) {
                const float tl = __shfl(T[g4], r), th = __shfl(T[g4], r + 32);
                const float e_hi = run; run *= th; const float e_lo = run; run *= tl;
                E[g4] = h ? e_hi : e_lo;
            }
            carry = run;
            f32x16 Aw;
#pragma unroll
            for (int i = 0; i < 16; ++i) Aw[i] = (1.0f - om[i]) * (E[i >> 2] * sfx[i]);
            const f16x8 Af0 = pack8(Aw, 0), Af1 = pack8(Aw, 1);
            CFENCE();
#pragma unroll
            for (int dt = 0; dt < 2; ++dt) {
                LAS const unsigned char* vp = Vw + (4 * h + ta) * SBV_P + (32 * dt + 16 * gl + 4 * tp) * 2;
                const f16x8 V0 = cat8(tr_read(vp), tr_read(vp + 8 * SBV_P)), V1 = cat8(tr_read(vp + 16 * SBV_P), tr_read(vp + 24 * SBV_P));
                OT[dt] = __builtin_amdgcn_mfma_f32_32x32x16_f16(V0, Af0, OT[dt], 0, 0, 0);
                OT[dt] = __builtin_amdgcn_mfma_f32_32x32x16_f16(V1, Af1, OT[dt], 0, 0, 0);
            }
            CFENCE();
            if (__ballot(carry > SB_STOP) == 0ull) break;
        }
        f16* op = O + (rb + 32 * qblk + r) * DM + 64 * hd + 4 * h;
#pragma unroll
        for (int dt = 0; dt < 2; ++dt)
#pragma unroll
            for (int g4 = 0; g4 < 4; ++g4) { u32x2 w; w.x = pkh(OT[dt][4 * g4], OT[dt][4 * g4 + 1]); w.y = pkh(OT[dt][4 * g4 + 2], OT[dt][4 * g4 + 3]); *(u32x2*)(op + 32 * dt + 8 * g4) = w; }
    }
}

struct Args { const void* in[22]; float* out; unsigned char* ws; int ph_lo, ph_hi; };
constexpr int N_PHASES = 34;
template <int I> __device__ __forceinline__ const void* karg() {
    const auto kp = __builtin_amdgcn_kernarg_segment_ptr();
    unsigned long long v; asm volatile("s_load_dwordx2 %0, %1, %2\n\ts_waitcnt lgkmcnt(0)" : "=s"(v) : "s"(kp), "i"(I * 8) : "memory");
    return (const void*)v;
}
#define KIN(i) ((const float*)karg<(i)>())
#define IN(k) (lo <= (k) && (k) < hi)
#define SEAM(k) do { if (IN((k) + 1)) { if (!MK_PER_PHASE) xcd_barrier(bar); } } while (0)
#define WSP(T, off) ((T*)(F.ws + (off)))
template <int L> __device__ __forceinline__ void layer_phases(Frame& F, const XcdBarrier& bar, const int lo, const int hi) {
    constexpr int pb = 1 + 8 * L;
        if (IN(pb + 0) && !DIS_K0) {
            const float* modL = WSP(const float, WS_MOD) + (size_t)L * 16 * 6144;
            NormArgs A{}; A.x = (L == 0) ? KIN(0) : WSP(const float, WS_X); A.xw = WSP(float, WS_X); A.gain = KIN(5) + L * DM; A.sh = modL; A.sc = modL + 1024; A.h = WSP(f16, WS_H);
            if constexpr (L == 2) {
                A.y2 = WSP(const f16, WS_Y2); A.tokslot = WSP(const unsigned, WS_TOKSLOT); A.gatef = WSP(const float, WS_MOD) + (size_t)(L - 1) * 16 * 6144 + 5120;
                A.gain2 = KIN(12); A.kvmod = WSP(const float, WS_KVMOD); A.hk = WSP(f16, WS_HK); norm_phase<true, true, false, false>(F, A);
            } else norm_phase<false, false, false, false>(F, A);
            SEAM(pb + 0);
        }
        if (IN(pb + 1) && !DIS_K1) {
            if constexpr (L < 2) {
                pg8::Gemm g{WSP(const f16, WS_H), WSP(const f16, WS_W_RIN) + (size_t)L * RIN * DM, MTOK, RIN, DM, 0}; pg8::Order S; S.init(MTOK, RIN, F.G, (int)blockIdx.x);
                pg8::EpiRetIn E{WSP(f16, WS_PROJ), WSP(const float, WS_ROPE)};
                pg8::gemm_phase<pg8::EpiRetIn>(F.lds, g, S, E);
            } else {
                { pg8::Gemm g{WSP(const f16, WS_H), WSP(const f16, WS_W_SQ) + (size_t)(L - 2) * DM * DM, MTOK, DM, DM, 0}; pg8::Order S; S.init(MTOK, DM, F.G, (int)blockIdx.x);
                  pg8::EpiF16 E{WSP(f16, WS_SQ), DM, 0, 0, 0.125f * 1.4426950408889634f};
                  pg8::gemm_phase<pg8::EpiF16>(F.lds, g, S, E); }
                if constexpr (L == 2) { pg8::Gemm g{WSP(const f16, WS_HK), WSP(const f16, WS_W_KV), MTOK, 2048, DM, 0}; pg8::Order S; S.init(MTOK, 2048, F.G, (int)blockIdx.x);
                  pg8::EpiF16 E{WSP(f16, WS_KSH), DM, 1024, (size_t)(WS_VSH - WS_KSH) / 2, 1.0f};
                  pg8::gemm_phase<pg8::EpiF16>(F.lds, g, S, E); }
            }
            SEAM(pb + 1);
        }
        if (IN(pb + 2) && !DIS_K2) {
#ifndef NO_SCAN
            if constexpr (L < 2) scan_phase(F, WSP(const f16, WS_PROJ), KIN(8) + L * 2048, WSP(f16, WS_AO));
#endif
#ifndef NO_SB
            if constexpr (L >= 2) sb_phase(F, WSP(const f16, WS_SQ), WSP(const f16, WS_KSH), WSP(const f16, WS_VSH), WSP(f16, WS_SO));
#endif
            SEAM(pb + 2);
        }
        if (IN(pb + 3) && !DIS_K3) {
            pg8::Gemm g;
            if constexpr (L < 2) g = pg8::Gemm{WSP(const f16, WS_AO), WSP(const f16, WS_W_ROUT) + (size_t)L * DM * 2048, MTOK, DM, 2048, 0};
            else g = pg8::Gemm{WSP(const f16, WS_SO), WSP(const f16, WS_W_SO) + (size_t)(L - 2) * DM * DM, MTOK, DM, DM, 0};
            pg8::Order S; S.init(MTOK, DM, F.G, (int)blockIdx.x);
            pg8::EpiRes E{(L == 0) ? KIN(0) : WSP(const float, WS_X), WSP(float, WS_X), WSP(const float, WS_MOD) + (size_t)L * 16 * 6144 + 2048};
            pg8::gemm_phase<pg8::EpiRes>(F.lds, g, S, E);
            SEAM(pb + 3);
        }
        if (IN(pb + 4) && !DIS_K4) {
            const float* modL = WSP(const float, WS_MOD) + (size_t)L * 16 * 6144;
            NormArgs A{}; A.x = WSP(const float, WS_X); A.xw = WSP(float, WS_X); A.gain = KIN(6) + L * DM; A.sh = modL + 3072; A.sc = modL + 4096; A.h = WSP(f16, WS_H);
            if constexpr (L & 1) { A.router = KIN(18) + (size_t)(L >> 1) * DM * NEXP; A.gcnt = F.ctl + CW_MOE + (L >> 1) * 1024; A.tokinfo = WSP(unsigned, WS_TOKINFO); norm_phase<false, false, false, true>(F, A); }
            else norm_phase<false, false, false, false>(F, A);
            SEAM(pb + 4);
        }
        if (IN(pb + 5) && !DIS_K5) {
            if constexpr (L & 1) moe_gather(F, F.ctl + CW_MOE + (L >> 1) * 1024, WSP(const unsigned, WS_TOKINFO), WSP(const f16, WS_H), WSP(f16, WS_HS), WSP(float, WS_SLOTW), WSP(unsigned, WS_TOKSLOT));
            SEAM(pb + 5);
        }
        if (IN(pb + 6) && !DIS_K6) {
            const int mi = L >> 1;
            pg8::Order S;
            if constexpr (L & 1) {
                int tb[NEXP], ntl; moe_tile_bases(F.ctl + CW_MOE + mi * 1024, tb, ntl);
                S.init(ntl * 256, 2 * FFE, F.G, (int)blockIdx.x);
#pragma unroll
                for (int e = 0; e < NEXP; ++e) S.tb[e] = tb[e];
                pg8::Gemm g{WSP(const f16, WS_HS), WSP(const f16, WS_W_MIN) + (size_t)mi * NEXP * 2 * FFE * DM, ntl * 256, 2 * FFE, DM, (size_t)2 * FFE * DM * 2};
                pg8::EpiGlu E{WSP(f16, WS_ACTE), FFE};
                pg8::gemm_phase<pg8::EpiGlu>(F.lds, g, S, E);
            } else {
                S.init(MTOK, 2 * FFD, F.G, (int)blockIdx.x);
                pg8::Gemm g{WSP(const f16, WS_H), WSP(const f16, WS_W_FIN) + (size_t)mi * 2 * FFD * DM, MTOK, 2 * FFD, DM, 0};
                pg8::EpiGlu E{WSP(f16, WS_ACTD), FFD};
                pg8::gemm_phase<pg8::EpiGlu>(F.lds, g, S, E);
            }
            SEAM(pb + 6);
        }
        if (IN(pb + 7) && !DIS_K7) {
            const int mi = L >> 1;
            if constexpr (L & 1) {
                int tb[NEXP], ntl; moe_tile_bases(F.ctl + CW_MOE + mi * 1024, tb, ntl);
                pg8::Order S; S.init(ntl * 256, DM, F.G, (int)blockIdx.x);
#pragma unroll
                for (int e = 0; e < NEXP; ++e) S.tb[e] = tb[e];
                pg8::Gemm g{WSP(const f16, WS_ACTE), WSP(const f16, WS_W_MOUT) + (size_t)mi * NEXP * DM * FFE, ntl * 256, DM, FFE, (size_t)DM * FFE * 2};
                pg8::EpiMoeOut E{WSP(f16, WS_Y2), WSP(const float, WS_SLOTW)};
                pg8::gemm_phase<pg8::EpiMoeOut>(F.lds, g, S, E);
            } else {
                pg8::Order S; S.init(MTOK, DM, F.G, (int)blockIdx.x);
                pg8::Gemm g{WSP(const f16, WS_ACTD), WSP(const f16, WS_W_FOUT) + (size_t)mi * DM * FFD, MTOK, DM, FFD, 0};
                pg8::EpiRes E{WSP(const float, WS_X), WSP(float, WS_X), WSP(const float, WS_MOD) + (size_t)L * 16 * 6144 + 5120};
                pg8::gemm_phase<pg8::EpiRes>(F.lds, g, S, E);
            }
            SEAM(pb + 7);
        }
}
__global__ void __launch_bounds__(512, 2) mk_fwd(Args args) {
    extern __shared__ __attribute__((aligned(16))) unsigned char lds_raw[];
    Frame F;
    F.lds = (LAS unsigned char*)lds_raw;
    F.tid = threadIdx.x; F.lane = F.tid & 63; F.wave = __builtin_amdgcn_readfirstlane(F.tid >> 6);
    F.G = gridDim.x; { const int bx = blockIdx.x; F.vcu = (F.G % 8 == 0) ? (bx % 8) * (F.G / 8) + bx / 8 : bx; }
    F.ws = args.ws; F.ctl = (unsigned*)(args.ws + WS_CTL);
    volatile LAS unsigned* MISC = (volatile LAS unsigned*)(F.lds + MISC_OFF);
    if (F.tid < 64) ((LAS unsigned*)(F.lds + MISC_OFF))[F.tid] = 0u;
    __syncthreads();
    XcdBarrier bar; bar.bar = F.ctl + CW_BAR; bar.x = 0; bar.st = nullptr;
    if (!MK_PER_PHASE) bar = xcd_barrier_post(F.ctl + CW_BAR, MISC + 8);
    const int lo = args.ph_lo, hi = args.ph_hi;

    if (IN(0)) {
#ifndef NO_P0
        P0In I; I.c = KIN(1); I.pos = (const int*)karg<2>(); I.ada_w = KIN(3); I.ada_b = KIN(4);
        I.ret_w_in = KIN(7); I.ret_w_out = KIN(9); I.kv_ada_w = KIN(10); I.kv_ada_b = KIN(11);
        I.kv_w = KIN(13); I.sb_w_q = KIN(14); I.sb_w_out = KIN(15); I.ff_w_in = KIN(16); I.ff_w_out = KIN(17);
        I.moe_w_in = KIN(19); I.moe_w_out = KIN(20);
        p0_prologue(F, I);
#endif
        SEAM(0);
    }
    layer_phases<0>(F, bar, lo, hi); layer_phases<1>(F, bar, lo, hi); layer_phases<2>(F, bar, lo, hi); layer_phases<3>(F, bar, lo, hi);
    if (IN(33)) {
        NormArgs A{}; A.x = WSP(const float, WS_X); A.xw = WSP(float, WS_X); A.gain = KIN(21); A.out = (float*)karg<22>();
        A.y2 = WSP(const f16, WS_Y2); A.tokslot = WSP(const unsigned, WS_TOKSLOT); A.gatef = WSP(const float, WS_MOD) + (size_t)3 * 16 * 6144 + 5120;
        norm_phase<true, false, true, false>(F, A);
    }
#undef IN
#undef SEAM
#undef WSP
}

extern "C" void kernel_launch(void* const* d_in, const int* in_sizes, int n_in, void* d_out, int out_size, void* d_ws, size_t ws_size, hipStream_t stream) {
    static int grid = 0;
    if (grid == 0) {
        if (n_in != 22 || out_size != MTOK * DM || ws_size < WS_END) { fprintf(stderr, "kernel_launch: unexpected shapes (n_in %d out %d ws %zu, need %zu)\n", n_in, out_size, ws_size, (size_t)WS_END); grid = -1; return; }
        int dev = 0, cus = 0;
        if (hipGetDevice(&dev) != hipSuccess || hipDeviceGetAttribute(&cus, hipDeviceAttributeMultiprocessorCount, dev) != hipSuccess) { grid = -1; return; }
        if (hipFuncSetAttribute((const void*)mk_fwd, hipFuncAttributeMaxDynamicSharedMemorySize, LDS_BYTES) != hipSuccess) { fprintf(stderr, "kernel_launch: hipFuncSetAttribute failed\n"); grid = -1; return; }
        int per_cu = 0;
        if (hipOccupancyMaxActiveBlocksPerMultiprocessor(&per_cu, (const void*)mk_fwd, 512, LDS_BYTES) != hipSuccess || per_cu < 1) fprintf(stderr, "kernel_launch: occupancy query reports %d\n", per_cu);
        (void)hipGetLastError();
        if (cus < 256) { fprintf(stderr, "kernel_launch: needs >= 256 CUs, got %d\n", cus); grid = -1; return; }
        grid = cus;
    }
    if (grid < 0) return;
    (void)hipMemsetAsync((char*)d_ws + WS_CTL, 0, CTL_ZERO_BYTES, stream);
    Args a{};
    for (int i = 0; i < 22; ++i) a.in[i] = d_in[i];
    a.out = (float*)d_out; a.ws = (unsigned char*)d_ws;
#if MK_PER_PHASE
    for (int p = 0; p < N_PHASES; ++p) {
        if (p >= 1 && p <= 32) { const int L = (p - 1) / 8, k = (p - 1) % 8; if (k == 5 && !(L & 1)) continue; }
        a.ph_lo = p; a.ph_hi = p + 1;
        hipLaunchKernelGGL(mk_fwd, dim3(grid), dim3(512), LDS_BYTES, stream, a);
    }
#else
    a.ph_lo = 0; a.ph_hi = N_PHASES;
    hipLaunchKernelGGL(mk_fwd, dim3(grid), dim3(512), LDS_BYTES, stream, a);
#endif
}
```

```cpp
#include <hip/hip_runtime.h>
#include <cstdio>
#include <cstdint>

#define LAS __attribute__((address_space(3)))
#define GAS __attribute__((address_space(1)))
typedef _Float16 f16;
typedef _Float16 f16x2 __attribute__((ext_vector_type(2)));
typedef _Float16 f16x4 __attribute__((ext_vector_type(4)));
typedef _Float16 f16x8 __attribute__((ext_vector_type(8)));
typedef float f32x2 __attribute__((ext_vector_type(2)));
typedef float f32x4 __attribute__((ext_vector_type(4)));
typedef float f32x16 __attribute__((ext_vector_type(16)));
typedef unsigned u32x2 __attribute__((ext_vector_type(2)));
typedef unsigned u32x4 __attribute__((ext_vector_type(4)));
typedef short v4i16_t __attribute__((ext_vector_type(4)));
typedef int i32x8 __attribute__((ext_vector_type(8)));
typedef int i32x4 __attribute__((ext_vector_type(4)));

#ifndef DIS_K0
#define DIS_K0 0
#endif
#ifndef DIS_K1
#define DIS_K1 0
#endif
#ifndef DIS_K2
#define DIS_K2 0
#endif
#ifndef DIS_K3
#define DIS_K3 0
#endif
#ifndef DIS_K4
#define DIS_K4 0
#endif
#ifndef DIS_K5
#define DIS_K5 0
#endif
#ifndef DIS_K6
#define DIS_K6 0
#endif
#ifndef DIS_K7
#define DIS_K7 0
#endif
#ifndef PROBE_DUP
#define PROBE_DUP 0
#endif
#ifndef MK_PER_PHASE
#define MK_PER_PHASE 0
#endif

constexpr int BATCH = 16, SEQ = 2048, DM = 1024, MTOK = BATCH * SEQ;
constexpr int RH = 8, RDK = 128, RDV = 256, RIN = 6144, CHUNK = 64, NCHUNK = SEQ / CHUNK;
constexpr int SBH = 16, SDH = 64;
constexpr int FFD = 2816, NEXP = 8, FFE = 3584;
constexpr float EPS = 1e-6f;
constexpr int MOE_ROWS_MAX = 2 * MTOK + NEXP * 256;

__device__ __forceinline__ float lg2gamma(int h) {
    const float t[8] = {-4.580368961312e-02f, -2.272007650008e-02f, -1.131531322783e-02f, -5.646563141142e-03f, -2.820519062379e-03f, -1.409570254671e-03f, -7.046129765894e-04f, -3.522634716290e-04f};
    float r = t[0];
#pragma unroll
    for (int i = 1; i < 8; ++i) r = (h == i) ? t[i] : r;
    return r;
}
__device__ __forceinline__ unsigned pkh(float lo, float hi) { f32x2 v = {lo, hi}; f16x2 h = __builtin_convertvector(v, f16x2); return __builtin_bit_cast(unsigned, h); }
__device__ __forceinline__ float silu_f(float x) { return x * __builtin_amdgcn_rcpf(1.0f + __builtin_amdgcn_exp2f(-1.4426950408889634f * x)); }
__device__ __forceinline__ float ex2(float x) { return __builtin_amdgcn_exp2f(x); }
__device__ __forceinline__ unsigned pk4f8(float a, float b, float c, float d) { int w = 0; w = __builtin_amdgcn_cvt_pk_fp8_f32(a, b, w, false); w = __builtin_amdgcn_cvt_pk_fp8_f32(c, d, w, true); return (unsigned)w; }
constexpr float F8_WSCALE = 64.0f;
constexpr float F8_ASCALE = 4.0f;

namespace pg8 {
constexpr int BM = 256, BK = 64, HALF = 128, HTB = HALF * BK * 2, STAGE_BYTES = 8 * HTB, NXCD = 8, WGM = 8;
__host__ __device__ __forceinline__ int lds_byte(int r, int c) { const int st = (r >> 4) * 2 + (c >> 5), rr = r & 15, cc = c & 31, ob = rr * 64 + cc * 2; return st * 1024 + (ob ^ (((ob >> 9) & 1) << 5)); }
__host__ __device__ __forceinline__ void stage_rc(int b, int& R, int& C) { const int st = b / 1024, sb = b % 1024, swz = sb ^ (((sb >> 9) & 1) << 5); R = (st >> 1) * 16 + swz / 64; C = (st & 1) * 32 + (swz % 64) / 2; }
__host__ __device__ __forceinline__ int perm32(int rho) { const int n = rho >> 4, i = rho & 15; return 8 * (i >> 2) + 4 * n + (i & 3); }

struct Unit { int pm, pn, be; };
struct Gemm { const void* A; const void* Bt; int M, N, K; size_t bstride; };

struct Order {
    int nM, nN, nwg, G, c; int tb[NEXP];
    __device__ void init(int M, int N, int G_, int c_) { nM = M / BM; nN = N / BM; nwg = nM * nN; G = G_; c = c_;
#pragma unroll
        for (int e = 0; e < NEXP; ++e) tb[e] = e ? 0x7fffffff : 0; }
    __device__ bool next(int i, Unit& u) const {
        const long L = (long)i * G + c; if (L >= nwg) return false;
        int wgid = (int)L; { const int q = nwg / NXCD, r = nwg % NXCD, xcd = wgid % NXCD, off = wgid / NXCD; wgid = (xcd < r ? xcd * (q + 1) : r * (q + 1) + (xcd - r) * q) + off; }
        const int nig = WGM * nN, gid = wgid / nig, fm = gid * WGM, gsz = (nM - fm) < WGM ? (nM - fm) : WGM;
        u.pm = fm + ((wgid % nig) % gsz); u.pn = (wgid % nig) / gsz;
        int be = 0;
#pragma unroll
        for (int e = 1; e < NEXP; ++e) be += (u.pm >= tb[e]) ? 1 : 0;
        u.be = be; return true;
    }
};


struct EpiRetIn {
    static constexpr bool PERM = true;
    f16* O; const float* rope;
    __device__ __forceinline__ void operator()(const f32x4 (&acc)[2][2][4][2], const Unit& u, int wr, int wc, int fr, int fq) const {
        const int row0 = u.pm * BM + wr * 64 + fr, cl = wc * 32 + 8 * fq;
        f16* base = O + (size_t)u.pn * BM + cl;
        if (u.pn < 8) {
            const bool isk = u.pn >= 4; const int i0 = cl >> 1;
            float lg[2]; lg[0] = lg2gamma(2 * (u.pn & 3)); lg[1] = lg2gamma(2 * (u.pn & 3) + 1);
#pragma unroll
            for (int ai = 0; ai < 2; ++ai)
#pragma unroll
                for (int m = 0; m < 4; ++m) {
                    const int row = row0 + ai * HALF + m * 16; const float pos = (float)(16 * m + fr);
                    const f32x4 cs = *(const f32x4*)(rope + (size_t)row * 128 + i0), sn = *(const f32x4*)(rope + (size_t)row * 128 + 64 + i0);
#pragma unroll
                    for (int bj = 0; bj < 2; ++bj) {
                        const float sc = isk ? ex2(-pos * lg[bj]) * 0.08838834764831845f : ex2((pos + 1.0f) * lg[bj]);
                        const f32x4 v0 = acc[ai][bj][m][0], v1 = acc[ai][bj][m][1];
                        u32x4 w;
                        w.x = pkh((v0[0] * cs[0] - v0[1] * sn[0]) * sc, (v0[0] * sn[0] + v0[1] * cs[0]) * sc);
                        w.y = pkh((v0[2] * cs[1] - v0[3] * sn[1]) * sc, (v0[2] * sn[1] + v0[3] * cs[1]) * sc);
                        w.z = pkh((v1[0] * cs[2] - v1[1] * sn[2]) * sc, (v1[0] * sn[2] + v1[1] * cs[2]) * sc);
                        w.w = pkh((v1[2] * cs[3] - v1[3] * sn[3]) * sc, (v1[2] * sn[3] + v1[3] * cs[3]) * sc);
                        *(u32x4*)(base + (size_t)row * RIN + bj * HALF) = w;
                    }
                }
        } else {
            const bool isg = u.pn >= 16;
#pragma unroll
            for (int ai = 0; ai < 2; ++ai)
#pragma unroll
                for (int m = 0; m < 4; ++m) {
                    const int row = row0 + ai * HALF + m * 16;
#pragma unroll
                    for (int bj = 0; bj < 2; ++bj) {
                        f32x4 v0 = acc[ai][bj][m][0], v1 = acc[ai][bj][m][1];
                        if (isg) {
#pragma unroll
                            for (int j = 0; j < 4; ++j) { v0[j] = silu_f(v0[j]); v1[j] = silu_f(v1[j]); } }
                        u32x4 w; w.x = pkh(v0[0], v0[1]); w.y = pkh(v0[2], v0[3]); w.z = pkh(v1[0], v1[1]); w.w = pkh(v1[2], v1[3]);
                        *(u32x4*)(base + (size_t)row * RIN + bj * HALF) = w;
                    }
                }
        }
    }
};
struct EpiRes {
    static constexpr bool PERM = false;
    const float* base; float* out; const float* gate;
    __device__ __forceinline__ void operator()(const f32x4 (&acc)[2][2][4][2], const Unit& u, int wr, int wc, int fr, int fq) const {
        const int row0 = u.pm * BM + wr * 64 + fr, col0 = u.pn * BM + wc * 32 + 4 * fq;
        const float* gp = gate + (size_t)(u.pm >> 3) * 6144 + col0;
        f32x4 gv[2][2];
#pragma unroll
        for (int bj = 0; bj < 2; ++bj)
#pragma unroll
            for (int n = 0; n < 2; ++n) gv[bj][n] = *(const f32x4*)(gp + bj * HALF + n * 16);
#pragma unroll
        for (int ai = 0; ai < 2; ++ai)
#pragma unroll
            for (int m = 0; m < 4; ++m) { const size_t off = (size_t)(row0 + ai * HALF + m * 16) * DM + col0;
#pragma unroll
                for (int bj = 0; bj < 2; ++bj)
#pragma unroll
                    for (int n = 0; n < 2; ++n) { const f32x4 b = *(const f32x4*)(base + off + bj * HALF + n * 16); *(f32x4*)(out + off + bj * HALF + n * 16) = b + gv[bj][n] * acc[ai][bj][m][n]; }
                asm volatile("" ::: "memory"); }
    }
};
template <bool F8> struct EpiGlu {
    static constexpr bool PERM = true;
    void* Ov; int ldc;
    __device__ __forceinline__ void operator()(const f32x4 (&acc)[2][2][4][2], const Unit& u, int wr, int wc, int fr, int fq) const {
        const int row0 = u.pm * BM + wr * 64 + fr, col0 = u.pn * HALF + wc * 32 + 8 * fq;
        constexpr float si = F8 ? 1.0f / F8_WSCALE : 1.0f, so = F8 ? F8_ASCALE : 1.0f;
#pragma unroll
        for (int ai = 0; ai < 2; ++ai)
#pragma unroll
            for (int m = 0; m < 4; ++m) {
                const f32x4 a0 = acc[ai][0][m][0] * si, a1 = acc[ai][0][m][1] * si, b0 = acc[ai][1][m][0] * (si * so), b1 = acc[ai][1][m][1] * (si * so);
                float r[8];
#pragma unroll
                for (int j = 0; j < 4; ++j) { r[j] = silu_f(a0[j]) * b0[j]; r[4 + j] = silu_f(a1[j]) * b1[j]; }
                if (F8) { u32x2 w; w.x = pk4f8(r[0], r[1], r[2], r[3]); w.y = pk4f8(r[4], r[5], r[6], r[7]);
                    *(u32x2*)((unsigned char*)Ov + (size_t)(row0 + ai * HALF + m * 16) * ldc + col0) = w; }
                else { u32x4 w; w.x = pkh(r[0], r[1]); w.y = pkh(r[2], r[3]); w.z = pkh(r[4], r[5]); w.w = pkh(r[6], r[7]);
                    *(u32x4*)((f16*)Ov + (size_t)(row0 + ai * HALF + m * 16) * ldc + col0) = w; }
            }
    }
};
struct EpiF16 {
    static constexpr bool PERM = true;
    f16* O; int ldc; int split_cols; size_t split_stride; float scale;
    __device__ __forceinline__ void operator()(const f32x4 (&acc)[2][2][4][2], const Unit& u, int wr, int wc, int fr, int fq) const {
        const int row0 = u.pm * BM + wr * 64 + fr; int colt = u.pn * BM; f16* base = O;
        if (split_cols) { const int t = colt / split_cols; base += (size_t)t * split_stride; colt -= t * split_cols; }
        const int col0 = colt + wc * 32 + 8 * fq;
#pragma unroll
        for (int ai = 0; ai < 2; ++ai)
#pragma unroll
            for (int m = 0; m < 4; ++m) { f16* rowp = base + (size_t)(row0 + ai * HALF + m * 16) * ldc + col0;
#pragma unroll
                for (int bj = 0; bj < 2; ++bj) { const f32x4 v0 = acc[ai][bj][m][0] * scale, v1 = acc[ai][bj][m][1] * scale;
                    u32x4 w; w.x = pkh(v0[0], v0[1]); w.y = pkh(v0[2], v0[3]); w.z = pkh(v1[0], v1[1]); w.w = pkh(v1[2], v1[3]);
                    *(u32x4*)(rowp + bj * HALF) = w; } }
    }
};
struct EpiMoeOut {
    static constexpr bool PERM = true;
    f16* O; const float* roww;
    __device__ __forceinline__ void operator()(const f32x4 (&acc)[2][2][4][2], const Unit& u, int wr, int wc, int fr, int fq) const {
        const int row0 = u.pm * BM + wr * 64 + fr, col0 = u.pn * BM + wc * 32 + 8 * fq;
#pragma unroll
        for (int ai = 0; ai < 2; ++ai)
#pragma unroll
            for (int m = 0; m < 4; ++m) { const int row = row0 + ai * HALF + m * 16; const float sc = roww[row] * (1.0f / (F8_WSCALE * F8_ASCALE)); f16* rowp = O + (size_t)row * DM + col0;
#pragma unroll
                for (int bj = 0; bj < 2; ++bj) { const f32x4 v0 = acc[ai][bj][m][0] * sc, v1 = acc[ai][bj][m][1] * sc;
                    u32x4 w; w.x = pkh(v0[0], v0[1]); w.y = pkh(v0[2], v0[3]); w.z = pkh(v1[0], v1[1]); w.w = pkh(v1[2], v1[3]);
                    *(u32x4*)(rowp + bj * HALF) = w; } }
    }
};

template <class Epi, bool F8 = false>
__device__ __forceinline__ void gemm_phase(LAS unsigned char* lds, const Gemm g, const Order& S, const Epi& E) {
    const int tid = threadIdx.x, wid = __builtin_amdgcn_readfirstlane(tid >> 6), lane = tid & 63, wr = wid >> 2, wc = wid & 3, fr = lane & 15, fq = lane >> 4;
    const int KB = g.K * (F8 ? 1 : 2), nt = KB / 128;
    unsigned voffA[2], voffB[2];
#pragma unroll
    for (int i = 0; i < 2; ++i) { int R, C; stage_rc(tid * 16 + i * 8192, R, C); const int Rb = Epi::PERM ? ((R & ~31) + perm32(R & 31)) : R;
        voffA[i] = (unsigned)(R * KB + 2 * C); voffB[i] = (unsigned)(Rb * KB + 2 * C); }
    const size_t kstep = (size_t)(BK * 2);
    const size_t hstep = (size_t)HALF * KB;
    const size_t tstep = 2 * hstep;
    const unsigned ldsw = (unsigned)wid * 1024u;
    const int aoff = lds_byte(wr * 64 + fr, fq * 8), boff = lds_byte(wc * 32 + fr, fq * 8);
#define PG8_SA(b, h) (((b) * 2 + (h)) * HTB)
#define PG8_SB(b, h) ((4 + (b) * 2 + (h)) * HTB)
#define PG8_STAGE(bufoff, gbase, voff) do { _Pragma("unroll") for (int _i = 0; _i < 2; ++_i) \
        __builtin_amdgcn_global_load_lds((const unsigned*)((const char*)(gbase) + (voff)[_i]), (LAS unsigned*)(lds + (bufoff) + ldsw + _i * 8192), 16, 0, 0); } while (0)
#define PG8_LD8(dst, addr) do { const i32x4 lo_ = *(const LAS i32x4*)(addr), hi_ = *(const LAS i32x4*)((addr) + 1024); dst = __builtin_shufflevector(lo_, hi_, 0, 1, 2, 3, 4, 5, 6, 7); } while (0)
#define PG8_LDA(dst, b, h) do { _Pragma("unroll") for (int m = 0; m < 4; ++m) { if constexpr (F8) PG8_LD8(dst##8[m], lds + PG8_SA(b, h) + aoff + m * 2048); else { _Pragma("unroll") for (int k = 0; k < 2; ++k) dst[m][k] = *(const LAS f16x8*)(lds + PG8_SA(b, h) + aoff + m * 2048 + k * 1024); } } } while (0)
#define PG8_LDB(dst, b, h) do { _Pragma("unroll") for (int n = 0; n < 2; ++n) { if constexpr (F8) PG8_LD8(dst##8[n], lds + PG8_SB(b, h) + boff + n * 2048); else { _Pragma("unroll") for (int k = 0; k < 2; ++k) dst[n][k] = *(const LAS f16x8*)(lds + PG8_SB(b, h) + boff + n * 2048 + k * 1024); } } } while (0)
#define PG8_MMA(ai, bj, At, Bt) do { __builtin_amdgcn_s_setprio(1); _Pragma("unroll") for (int m = 0; m < 4; ++m) _Pragma("unroll") for (int n = 0; n < 2; ++n) { \
        if constexpr (F8) asm volatile("v_mfma_scale_f32_16x16x128_f8f6f4 %0, %1, %2, %0, %3, %3 op_sel_hi:[0,0,0]" : "+v"(acc[ai][bj][m][n]) : "v"(Bt##8[n]), "v"(At##8[m]), "v"(f8scale)); \
        else { _Pragma("unroll") for (int k = 0; k < 2; ++k) acc[ai][bj][m][n] = __builtin_amdgcn_mfma_f32_16x16x32_f16(Bt[n][k], At[m][k], acc[ai][bj][m][n], 0, 0, 0); } } \
        __builtin_amdgcn_s_setprio(0); } while (0)
#define PG8_WAIT_V(n) asm volatile("s_waitcnt vmcnt(" #n ")" ::: "memory")
#define PG8_WAIT_L(n) asm volatile("s_waitcnt lgkmcnt(" #n ")" ::: "memory")
#define PG8_BAR __builtin_amdgcn_s_barrier()
#define PG8_SCHED __builtin_amdgcn_sched_barrier(0)
    Unit cur, nxt; int ui = 0;
    if (!S.next(0, cur)) return;
    f32x4 acc[2][2][4][2];
#pragma unroll
    for (int a = 0; a < 2; ++a)
#pragma unroll
        for (int b = 0; b < 2; ++b)
#pragma unroll
            for (int m = 0; m < 4; ++m)
#pragma unroll
                for (int n = 0; n < 2; ++n) acc[a][b][m][n] = (f32x4){0.f, 0.f, 0.f, 0.f};
    const int f8scale = 0x7f7f7f7f;
    f16x8 At[4][2], B0[2][2], B1[2][2]; i32x8 At8[4], B08[2], B18[2];
    const char* cA = (const char*)g.A + (size_t)cur.pm * tstep; const char* cB = (const char*)g.Bt + (size_t)cur.be * g.bstride + (size_t)cur.pn * tstep;
    PG8_STAGE(PG8_SB(0, 0), cB, voffB); PG8_STAGE(PG8_SB(0, 1), cB + hstep, voffB); PG8_STAGE(PG8_SA(0, 0), cA, voffA); PG8_STAGE(PG8_SA(0, 1), cA + hstep, voffA);
    if (wr == 1) PG8_BAR;
    PG8_WAIT_V(2); PG8_BAR;
    PG8_STAGE(PG8_SB(1, 0), cB + kstep, voffB); PG8_STAGE(PG8_SA(1, 0), cA + kstep, voffA); PG8_STAGE(PG8_SB(1, 1), cB + hstep + kstep, voffB);
    PG8_WAIT_V(6); PG8_BAR;
    for (;;) {
        const bool has_next = S.next(ui + 1, nxt);
        const char* nA = has_next ? (const char*)g.A + (size_t)nxt.pm * tstep : cA; const char* nB = has_next ? (const char*)g.Bt + (size_t)nxt.be * g.bstride + (size_t)nxt.pn * tstep : cB;
#pragma nounroll
        for (int t = 0; t < nt; t += 2) {
            const bool last = (t == nt - 2);
            const char* a1 = cA + (size_t)(t + 1) * kstep;
            const char* a2 = last ? nA : cA + (size_t)(t + 2) * kstep; const char* b2 = last ? nB : cB + (size_t)(t + 2) * kstep;
            const char* a3 = a2 + kstep; const char* b3 = b2 + kstep;
            PG8_LDB(B0, 0, 0); PG8_LDB(B1, 0, 1); PG8_SCHED; PG8_LDA(At, 0, 0); PG8_STAGE(PG8_SA(1, 1), a1 + hstep, voffA);
            PG8_WAIT_V(8); PG8_WAIT_L(0); PG8_BAR; PG8_MMA(0, 0, At, B0); PG8_MMA(0, 1, At, B1); PG8_BAR; PG8_SCHED;
            PG8_LDA(At, 0, 1); PG8_STAGE(PG8_SB(0, 0), b2, voffB); PG8_STAGE(PG8_SB(0, 1), b2 + hstep, voffB); PG8_STAGE(PG8_SA(0, 0), a2, voffA);
            PG8_WAIT_V(8); PG8_WAIT_L(0); PG8_BAR; PG8_MMA(1, 0, At, B0); PG8_MMA(1, 1, At, B1); PG8_BAR; PG8_SCHED;
            PG8_LDB(B0, 1, 0); PG8_LDB(B1, 1, 1); PG8_SCHED; PG8_LDA(At, 1, 0); PG8_STAGE(PG8_SA(0, 1), a2 + hstep, voffA);
            PG8_WAIT_V(8); PG8_WAIT_L(0); PG8_BAR; PG8_MMA(0, 0, At, B0); PG8_MMA(0, 1, At, B1); PG8_BAR; PG8_SCHED;
            PG8_LDA(At, 1, 1); PG8_STAGE(PG8_SB(1, 0), b3, voffB); PG8_STAGE(PG8_SB(1, 1), b3 + hstep, voffB); PG8_STAGE(PG8_SA(1, 0), a3, voffA);
            PG8_WAIT_V(8); PG8_WAIT_L(0); PG8_BAR; PG8_MMA(1, 0, At, B0); PG8_MMA(1, 1, At, B1); PG8_BAR; PG8_SCHED;
        }
        if constexpr (F8) asm volatile("s_nop 15\n\ts_nop 15" ::: "memory");
        if (wr == 0) PG8_BAR;
        E(acc, cur, wr, wc, fr, fq);
        if (!has_next) break;
#pragma unroll
        for (int a = 0; a < 2; ++a)
#pragma unroll
            for (int b = 0; b < 2; ++b)
#pragma unroll
                for (int m = 0; m < 4; ++m)
#pragma unroll
                    for (int n = 0; n < 2; ++n) acc[a][b][m][n] = (f32x4){0.f, 0.f, 0.f, 0.f};
        cur = nxt; cA = nA; cB = nB; ++ui;
        if (wr == 1) PG8_BAR;
    }
    PG8_WAIT_V(0);
    PG8_BAR;
#undef PG8_SA
#undef PG8_SB
#undef PG8_STAGE
#undef PG8_LDA
#undef PG8_LDB
#undef PG8_MMA
#undef PG8_WAIT_V
#undef PG8_WAIT_L
#undef PG8_BAR
#undef PG8_SCHED
}
}

constexpr size_t MiB = 1u << 20;
constexpr size_t WS_CTL = 0, CTL_ZERO_BYTES = 1 * MiB;
constexpr size_t WS_MOD = 1 * MiB;
constexpr size_t WS_KVMOD = 3 * MiB;
constexpr size_t WS_TOKINFO = 4 * MiB;
constexpr size_t WS_TOKSLOT = 6 * MiB;
constexpr size_t WS_SLOTW = 7 * MiB;
constexpr size_t WS_ROPE = 8 * MiB;
constexpr size_t WS_W_RIN = 24 * MiB, WS_W_ROUT = 48 * MiB, WS_W_KV = 56 * MiB, WS_W_SQ = 60 * MiB, WS_W_SO = 64 * MiB, WS_W_FIN = 68 * MiB, WS_W_FOUT = 90 * MiB, WS_W_MIN = 101 * MiB, WS_W_MOUT = 325 * MiB;
constexpr size_t WS_X = 437 * MiB, WS_H = 565 * MiB, WS_KSH = 629 * MiB, WS_VSH = 693 * MiB, WS_BIG = 757 * MiB;
constexpr size_t WS_PROJ = WS_BIG, WS_AO = WS_BIG + 384 * MiB;
constexpr size_t WS_ACTD = WS_BIG;
constexpr size_t WS_HS = WS_BIG, WS_Y2 = WS_BIG, WS_ACTE = WS_BIG + 132 * MiB;
constexpr size_t WS_SQ = WS_BIG, WS_SO = WS_BIG + 64 * MiB, WS_HK = WS_BIG + 192 * MiB;
constexpr size_t WS_END = WS_BIG + 594 * MiB;
static_assert((size_t)MOE_ROWS_MAX * DM * 2 <= 132 * MiB && WS_ACTE + (size_t)MOE_ROWS_MAX * FFE * 2 <= WS_END && WS_AO + (size_t)MTOK * 2048 * 2 <= WS_END, "ws map");
constexpr int CW_BAR = 4096;
constexpr int CW_MOE = 16384;

constexpr int RING_BYTES = 131072;
constexpr int LDS_BYTES = 147456;
constexpr int MISC_OFF = LDS_BYTES - 256;

#define XB_TMO      128
#define XB_XCNT(j)  (256  + 64 * (j))
#define XB_XSUB(j)  (1280 + 64 * (j))
#define XB_XGEN(j)  (2304 + 64 * (j))
#define XB_TOP      3328
#define XB_TOPGEN   3392
#define XCD_BAR_WORDS 3456
#define XB_SPIN_CAP (1u << 20)
__device__ __forceinline__ unsigned xb_ld(unsigned* p)              { return __hip_atomic_load(p, __ATOMIC_RELAXED, __HIP_MEMORY_SCOPE_AGENT); }
__device__ __forceinline__ unsigned xb_add(unsigned* p, unsigned v) { return __hip_atomic_fetch_add(p, v, __ATOMIC_RELAXED, __HIP_MEMORY_SCOPE_AGENT); }
__device__ __forceinline__ unsigned xb_xcc_id() { return (unsigned)__builtin_amdgcn_s_getreg((3 << 11) | 20) & 0xFu; }
#define XB_SPIN(cond, bar) do { unsigned _sp = 0; while (cond) { __builtin_amdgcn_s_sleep(1); \
    if ((++_sp & 255u) == 0u) { if (xb_ld(&(bar)[XB_TMO])) break; if (_sp > XB_SPIN_CAP) { atomicAdd(&(bar)[XB_TMO], 1u); break; } } } } while (0)
struct XcdBarrier { unsigned* bar; unsigned x; volatile LAS unsigned* st; };
__device__ __forceinline__ XcdBarrier xcd_barrier_post(unsigned* bar, volatile LAS unsigned* st) {
    XcdBarrier b; b.bar = bar; b.x = xb_xcc_id(); b.st = st;
    if (threadIdx.x == 0) (void)xb_add(&bar[XB_XCNT(b.x)], 1u);
    return b;
}
__device__ __forceinline__ void xcd_barrier_complete(unsigned* bar, unsigned x, unsigned& nloc, unsigned& nx) {
    const unsigned G = gridDim.x * gridDim.y * gridDim.z;
    unsigned sum, cnt, mine, sp = 0u;
    for (;;) {
        sum = 0u; cnt = 0u; mine = 0u;
#pragma unroll
        for (unsigned j = 0; j < 16; ++j) { const unsigned c = xb_ld(&bar[XB_XCNT(j)]); sum += c; cnt += (c > 0u) ? 1u : 0u; mine = (j == x) ? c : mine; }
        if (sum == G) break;
        __builtin_amdgcn_s_sleep(1);
        if ((++sp & 255u) == 0u) { if (xb_ld(&bar[XB_TMO])) break; if (sp > XB_SPIN_CAP) { atomicAdd(&bar[XB_TMO], 1u); break; } }
    }
    nloc = mine > 0u ? mine : 1u; nx = cnt > 0u ? cnt : 1u;
}
__device__ __forceinline__ void xcd_barrier(const XcdBarrier& b) {
    asm volatile("s_waitcnt vmcnt(0)" ::: "memory");
    __syncthreads();
    if (threadIdx.x == 0) {
        unsigned* bar = b.bar;
        __builtin_amdgcn_s_waitcnt(0);
        unsigned nloc = b.st[0], nx = b.st[1];
        if (nloc == 0u) { xcd_barrier_complete(bar, b.x, nloc, nx); b.st[0] = nloc; b.st[1] = nx; }
        const unsigned old = xb_add(&bar[XB_XSUB(b.x)], 1u);
        const unsigned gen = old / nloc;
        if (old + 1u == (gen + 1u) * nloc) {
            __builtin_amdgcn_fence(__ATOMIC_RELEASE, "agent");
            asm volatile("s_waitcnt vmcnt(0)" ::: "memory");
            const unsigned og = xb_add(&bar[XB_TOP], 1u);
            const unsigned tg = og / nx;
            if (og + 1u == (tg + 1u) * nx) xb_add(&bar[XB_TOPGEN], 1u);
            else XB_SPIN(xb_ld(&bar[XB_TOPGEN]) == tg, bar);
            __builtin_amdgcn_fence(__ATOMIC_ACQUIRE, "agent");
            xb_add(&bar[XB_XGEN(b.x)], 1u);
            asm volatile("s_waitcnt vmcnt(0)" ::: "memory");
        } else {
            XB_SPIN(xb_ld(&bar[XB_XGEN(b.x)]) == gen, bar);
            __builtin_amdgcn_fence(__ATOMIC_ACQUIRE, "agent");
            asm volatile("s_waitcnt vmcnt(0)" ::: "memory");
        }
    }
    __syncthreads();
}

#define WG_BAR() do { asm volatile("s_waitcnt lgkmcnt(0)" ::: "memory"); __builtin_amdgcn_s_barrier(); asm volatile("" ::: "memory"); } while (0)
#define CFENCE() asm volatile("" ::: "memory")
__device__ __forceinline__ float wave_sum(float v) {
#pragma unroll
    for (int o = 1; o < 64; o <<= 1) v += __shfl_xor(v, o);
    return v;
}
__device__ __forceinline__ f16x4 tr_read(LAS const unsigned char* p) {
    return __builtin_bit_cast(f16x4, __builtin_amdgcn_ds_read_tr16_b64_v4i16((LAS v4i16_t*)p));
}
__device__ __forceinline__ f16x8 cat8(f16x4 a, f16x4 b) { return (f16x8){a[0], a[1], a[2], a[3], b[0], b[1], b[2], b[3]}; }
__device__ __forceinline__ f16x8 pack8(const f32x16& x, int s) {
    u32x4 w; w.x = pkh(x[8 * s + 0], x[8 * s + 1]); w.y = pkh(x[8 * s + 2], x[8 * s + 3]); w.z = pkh(x[8 * s + 4], x[8 * s + 5]); w.w = pkh(x[8 * s + 6], x[8 * s + 7]);
    return __builtin_bit_cast(f16x8, w);
}

struct Frame {
    LAS unsigned char* lds;
    unsigned* ctl;
    int wave, vcu, G;
    unsigned char* ws;
};
__device__ __forceinline__ int lane_id() { int l; asm volatile("v_mbcnt_lo_u32_b32 %0, -1, 0\n\tv_mbcnt_hi_u32_b32 %0, -1, %0" : "=v"(l)); return l; }
#define PHASE_IDS() const int lane = lane_id(); const int tid = F.wave * 64 + lane; (void)tid

template <int I> __device__ __forceinline__ const void* karg() {
    const auto kp = __builtin_amdgcn_kernarg_segment_ptr();
    unsigned long long v; asm volatile("s_load_dwordx2 %0, %1, %2\n\ts_waitcnt lgkmcnt(0)" : "=s"(v) : "s"(kp), "i"(I * 8) : "memory");
    return (const void*)(const GAS char*)v;
}
#define KIN(i) ((const float*)karg<(i)>())
template <int MAP>
__device__ __forceinline__ int srccol(int n, int N) {
    if (MAP == 1) { if (n >= 2048) return n; const int p = n & 127; return (n & ~127) + (p >> 1) + 64 * (p & 1); }
    if (MAP == 2) { const int F = N >> 1, t = n >> 8, j = n & 255; return (j < 128) ? 128 * t + j : F + 128 * t + (j - 128); }
    return n;
}
template <int MAP, bool F8>
__device__ __forceinline__ void p0_transpose_item(const float* W, int K, int N, void* WT, LAS float* scr, int item, int lane) {
    const int nblk = N / 32, kb = item / nblk, nb = item % nblk, k0 = 64 * kb, n0 = 32 * nb;
    const int sc = srccol<MAP>(n0 + (lane & 31), N);
    const float* wp = W + (size_t)(k0 + (lane >> 5)) * N + sc;
    float v[32];
#pragma unroll
    for (int i = 0; i < 32; ++i) v[i] = wp[(size_t)(2 * i) * N];
#pragma unroll
    for (int i = 0; i < 32; ++i) scr[(2 * i + (lane >> 5)) * 33 + (lane & 31)] = F8 ? v[i] * F8_WSCALE : v[i];
    asm volatile("s_waitcnt lgkmcnt(0)" ::: "memory");
    if (F8) {
        const int c = lane & 3;
#pragma unroll
        for (int j = 0; j < 2; ++j) { const int n = (lane >> 2) + 16 * j; const LAS float* s = scr + (16 * c) * 33 + n;
            u32x4 o; o.x = pk4f8(s[0 * 33], s[1 * 33], s[2 * 33], s[3 * 33]); o.y = pk4f8(s[4 * 33], s[5 * 33], s[6 * 33], s[7 * 33]);
            o.z = pk4f8(s[8 * 33], s[9 * 33], s[10 * 33], s[11 * 33]); o.w = pk4f8(s[12 * 33], s[13 * 33], s[14 * 33], s[15 * 33]);
            *(u32x4*)((unsigned char*)WT + (size_t)(n0 + n) * K + k0 + 16 * c) = o; }
    } else {
        const int c = lane & 7;
#pragma unroll
        for (int j = 0; j < 4; ++j) { const int n = (lane >> 3) + 8 * j; const LAS float* s = scr + (8 * c) * 33 + n;
            u32x4 o; o.x = pkh(s[0 * 33], s[1 * 33]); o.y = pkh(s[2 * 33], s[3 * 33]); o.z = pkh(s[4 * 33], s[5 * 33]); o.w = pkh(s[6 * 33], s[7 * 33]);
            *(u32x4*)((f16*)WT + (size_t)(n0 + n) * K + k0 + 8 * c) = o; }
    }
    asm volatile("s_waitcnt lgkmcnt(0)" ::: "memory");
}
template <int MAP, bool F8>
__device__ __forceinline__ bool p0_group(int& r, const float* W, int nb, int K, int N, void* WT, LAS float* scr, int lane) {
    const int per = (K / 64) * (N / 32), tot = nb * per;
    if (r >= tot) { r -= tot; return false; }
    const int b = r / per, it = r % per;
    p0_transpose_item<MAP, F8>(W + (size_t)b * K * N, K, N, (unsigned char*)WT + (size_t)b * K * N * (F8 ? 1 : 2), scr, it, lane);
    return true;
}
__device__ __forceinline__ void p0_prologue(Frame& F) {
    PHASE_IDS();
    const int gw = F.vcu * 8 + F.wave, NGW = F.G * 8;
    LAS float* condL = (LAS float*)(F.lds);
    LAS float* scr = (LAS float*)(F.lds + 65536 + F.wave * 8448);
    for (int i = tid; i < 16 * 1024; i += 512) { const int b = i >> 10, k = i & 1023; condL[k * 16 + b] = silu_f(KIN(1)[i]); }
    WG_BAR();
    for (int it = gw; it < 1664; it += NGW) {
        const float* W; const float* bias; float* dst; int N, col0;
        if (it < 1536) { const int l = it / 384; col0 = 16 * (it % 384); N = 6144; W = KIN(3) + (size_t)l * 1024 * 6144; bias = KIN(4) + l * 6144; dst = (float*)(F.ws + WS_MOD) + (size_t)l * 16 * 6144; }
        else { col0 = 16 * (it - 1536); N = 2048; W = KIN(10); bias = KIN(11); dst = (float*)(F.ws + WS_KVMOD); }
        const int cl = lane & 3, kg = lane >> 2;
        f32x4 acc[16];
#pragma unroll
        for (int b = 0; b < 16; ++b) acc[b] = (f32x4){0.f, 0.f, 0.f, 0.f};
        const float* wp = W + (size_t)kg * N + col0 + 4 * cl;
#pragma unroll 4
        for (int k16 = 0; k16 < 64; ++k16) {
            const f32x4 w = *(const f32x4*)(wp + (size_t)k16 * 16 * N);
            const LAS f32x4* cp = (const LAS f32x4*)(condL + (16 * k16 + kg) * 16);
            const f32x4 c0 = cp[0], c1 = cp[1], c2 = cp[2], c3 = cp[3];
#pragma unroll
            for (int j = 0; j < 4; ++j) { acc[j] += c0[j] * w; acc[4 + j] += c1[j] * w; acc[8 + j] += c2[j] * w; acc[12 + j] += c3[j] * w; }
        }
        const f32x4 bv = *(const f32x4*)(bias + col0 + 4 * cl);
#pragma unroll
        for (int b = 0; b < 16; ++b) {
            f32x4 v = acc[b];
#pragma unroll
            for (int j = 0; j < 4; ++j) { v[j] += __shfl_xor(v[j], 4); v[j] += __shfl_xor(v[j], 8); v[j] += __shfl_xor(v[j], 16); v[j] += __shfl_xor(v[j], 32); }
            if (kg == 0) *(f32x4*)(dst + (size_t)b * N + col0 + 4 * cl) = v + bv;
        }
    }
    {
        const double e = -(double)lane / 64.0;
        const double invf = exp2(e * 13.287712379549449);
        float* rope = (float*)(F.ws + WS_ROPE); const int* posp = (const int*)karg<2>();
        for (int row = gw; row < MTOK; row += NGW) {
            const double rev = (double)posp[row] * invf * 0.15915494309189535;
            const float fr = (float)(rev - floor(rev));
            rope[(size_t)row * 128 + lane] = __builtin_amdgcn_cosf(fr); rope[(size_t)row * 128 + 64 + lane] = __builtin_amdgcn_sinf(fr);
        }
    }
    constexpr int per_rin = 16 * 192, per_rout = 32 * 32, per_kv = 16 * 64, per_sq = 16 * 32, per_fin = 16 * 176, per_fout = 44 * 32, per_min = 16 * 224, per_mout = 56 * 32;
    constexpr int NITEMS = 2 * per_rin + 2 * per_rout + per_kv + 4 * per_sq + 2 * per_fin + 2 * per_fout + 16 * per_min + 16 * per_mout;
    for (int it = gw; it < NITEMS; it += NGW) {
        int r = it;
        if (p0_group<1, false>(r, KIN(7), 2, 1024, 6144, (f16*)(F.ws + WS_W_RIN), scr, lane)) continue;
        if (p0_group<0, false>(r, KIN(9), 2, 2048, 1024, (f16*)(F.ws + WS_W_ROUT), scr, lane)) continue;
        if (p0_group<0, false>(r, KIN(13), 1, 1024, 2048, (f16*)(F.ws + WS_W_KV), scr, lane)) continue;
        if (p0_group<0, false>(r, KIN(14), 2, 1024, 1024, (f16*)(F.ws + WS_W_SQ), scr, lane)) continue;
        if (p0_group<0, false>(r, KIN(15), 2, 1024, 1024, (f16*)(F.ws + WS_W_SO), scr, lane)) continue;
        if (p0_group<2, false>(r, KIN(16), 2, 1024, 5632, (f16*)(F.ws + WS_W_FIN), scr, lane)) continue;
        if (p0_group<0, false>(r, KIN(17), 2, 2816, 1024, (f16*)(F.ws + WS_W_FOUT), scr, lane)) continue;
        if (p0_group<2, true>(r, KIN(19), 16, 1024, 7168, (f16*)(F.ws + WS_W_MIN), scr, lane)) continue;
        p0_group<0, true>(r, KIN(20), 16, 3584, 1024, (f16*)(F.ws + WS_W_MOUT), scr, lane);
    }
}

struct NormArgs {
    const float* x; float* xw; const float* gain; const float* sh; const float* sc;
    f16* h; const float* gain2; const float* kvmod; f16* hk;
    const f16* y2; const unsigned* tokslot; const float* gatef;
    float* out;
    const float* router; unsigned* gcnt; unsigned* tokinfo;
};
template <bool COMBINE, bool KV, bool FINAL, bool ROUTER>
__device__ __forceinline__ void norm_phase(Frame& F, const NormArgs& A) {
    PHASE_IDS();
    const int gw = F.vcu * 8 + F.wave, NGW = F.G * 8;
    LAS float* routL = (LAS float*)F.lds;
    LAS unsigned* lcnt = (LAS unsigned*)(F.lds + 32768);
    LAS unsigned* recs = (LAS unsigned*)(F.lds + 32768 + 256);
    if (ROUTER) {
        for (int i = tid; i < 8192; i += 512) routL[i] = A.router[i];
        if (tid < 16) lcnt[tid] = 0u;
        WG_BAR();
    }
    int nloc = 0;
    for (int row = gw; row < MTOK; row += NGW, ++nloc) {
        const int b = row >> 11;
        f32x4 v[4];
#pragma unroll
        for (int j = 0; j < 4; ++j) v[j] = *((const f32x4*)(A.x + (size_t)row * DM) + lane + 64 * j);
        if (COMBINE) {
            const u32x2 sl = *(const u32x2*)(A.tokslot + 2 * (size_t)row);
            const f16* ya = A.y2 + (size_t)sl.x * DM; const f16* yb = A.y2 + (size_t)sl.y * DM;
#pragma unroll
            for (int j = 0; j < 4; ++j) {
                const f16x4 a = *((const f16x4*)ya + lane + 64 * j), c = *((const f16x4*)yb + lane + 64 * j);
                const f32x4 g = *((const f32x4*)(A.gatef + (size_t)b * 6144) + lane + 64 * j);
#pragma unroll
                for (int t = 0; t < 4; ++t) v[j][t] += g[t] * ((float)a[t] + (float)c[t]);
                if (!FINAL) *((f32x4*)(A.xw + (size_t)row * DM) + lane + 64 * j) = v[j];
            }
        }
        float ss = 0.f;
#pragma unroll
        for (int j = 0; j < 4; ++j) ss += (v[j][0] * v[j][0] + v[j][1] * v[j][1]) + (v[j][2] * v[j][2] + v[j][3] * v[j][3]);
        const float rstd = 1.0f / sqrtf(wave_sum(ss) * (1.0f / DM) + EPS);
        if (FINAL) {
#pragma unroll
            for (int j = 0; j < 4; ++j) { const f32x4 g = *((const f32x4*)A.gain + lane + 64 * j); *((f32x4*)(A.out + (size_t)row * DM) + lane + 64 * j) = v[j] * rstd * g; }
        } else {
            f32x4 hv[4];
#pragma unroll
            for (int j = 0; j < 4; ++j) {
                const f32x4 g = *((const f32x4*)A.gain + lane + 64 * j), sh = *((const f32x4*)(A.sh + (size_t)b * 6144) + lane + 64 * j), sc = *((const f32x4*)(A.sc + (size_t)b * 6144) + lane + 64 * j);
                hv[j] = (v[j] * rstd * g) * (1.0f + sc) + sh;
                if (ROUTER) *((unsigned*)((unsigned char*)A.h + (size_t)row * DM) + lane + 64 * j) = pk4f8(hv[j][0], hv[j][1], hv[j][2], hv[j][3]);
                else { u32x2 w; w.x = pkh(hv[j][0], hv[j][1]); w.y = pkh(hv[j][2], hv[j][3]); *((u32x2*)(A.h + (size_t)row * DM) + lane + 64 * j) = w; }
            }
            if (KV) {
#pragma unroll
                for (int j = 0; j < 4; ++j) {
                    const f32x4 g = *((const f32x4*)A.gain2 + lane + 64 * j), sh = *((const f32x4*)(A.kvmod + (size_t)b * 2048) + lane + 64 * j), sc = *((const f32x4*)(A.kvmod + (size_t)b * 2048 + 1024) + lane + 64 * j);
                    const f32x4 o = (v[j] * rstd * g) * (1.0f + sc) + sh;
                    u32x2 w; w.x = pkh(o[0], o[1]); w.y = pkh(o[2], o[3]);
                    *((u32x2*)(A.hk + (size_t)row * DM) + lane + 64 * j) = w;
                }
            }
            if (ROUTER) {
                float lg[8];
#pragma unroll
                for (int e = 0; e < 8; ++e) lg[e] = 0.f;
#pragma unroll
                for (int j = 0; j < 4; ++j)
#pragma unroll
                    for (int t = 0; t < 4; ++t) {
                        const LAS f32x4* rp = (const LAS f32x4*)(routL + (4 * lane + 256 * j + t) * 8);
                        const f32x4 r0 = rp[0], r1 = rp[1]; const float hx = hv[j][t];
                        lg[0] += hx * r0[0]; lg[1] += hx * r0[1]; lg[2] += hx * r0[2]; lg[3] += hx * r0[3]; lg[4] += hx * r1[0]; lg[5] += hx * r1[1]; lg[6] += hx * r1[2]; lg[7] += hx * r1[3];
                    }
#pragma unroll
                for (int e = 0; e < 8; ++e) lg[e] = wave_sum(lg[e]);
                int i1 = 0; float v1 = lg[0];
#pragma unroll
                for (int e = 1; e < 8; ++e) if (lg[e] > v1) { v1 = lg[e]; i1 = e; }
                int i2 = -1; float v2 = -INFINITY;
#pragma unroll
                for (int e = 0; e < 8; ++e) if (e != i1 && lg[e] > v2) { v2 = lg[e]; i2 = e; }
                const float ed = __expf(v2 - v1), w1 = 1.0f / (1.0f + ed), w2 = ed * w1;
                if (lane == 0) {
                    const unsigned p1 = __hip_atomic_fetch_add(&lcnt[i1], 1u, __ATOMIC_RELAXED, __HIP_MEMORY_SCOPE_WORKGROUP), p2 = __hip_atomic_fetch_add(&lcnt[i2], 1u, __ATOMIC_RELAXED, __HIP_MEMORY_SCOPE_WORKGROUP);
                    LAS unsigned* rc = recs + (F.wave * 16 + nloc) * 8;
                    rc[0] = (unsigned)i1; rc[1] = p1; rc[2] = (unsigned)i2; rc[3] = p2; rc[4] = __float_as_uint(w1); rc[5] = __float_as_uint(w2);
                }
            }
        }
    }
    if (ROUTER) {
        WG_BAR();
        if (tid < 8) lcnt[8 + tid] = __hip_atomic_fetch_add(A.gcnt + 64 * tid, lcnt[tid], __ATOMIC_RELAXED, __HIP_MEMORY_SCOPE_AGENT);
        WG_BAR();
        if (lane == 0) {
            int k = 0;
            for (int row = gw; row < MTOK; row += NGW, ++k) {
                const LAS unsigned* rc = recs + (F.wave * 16 + k) * 8;
                u32x4 o; o.x = rc[0]; o.y = rc[1] + lcnt[8 + rc[0]]; o.z = rc[2]; o.w = rc[3] + lcnt[8 + rc[2]];
                *(u32x4*)(A.tokinfo + 8 * (size_t)row) = o; *(u32x2*)(A.tokinfo + 8 * (size_t)row + 4) = (u32x2){rc[4], rc[5]};
            }
        }
    }
}
__device__ __forceinline__ void moe_tile_bases(const unsigned* gcnt, int (&tb)[NEXP], int& ntiles) {
    int acc = 0;
#pragma unroll
    for (int e = 0; e < NEXP; ++e) { tb[e] = acc; const unsigned c = __hip_atomic_load(gcnt + 64 * e, __ATOMIC_RELAXED, __HIP_MEMORY_SCOPE_AGENT); acc += (int)((c + 255u) >> 8); }
    ntiles = acc;
}
__device__ __forceinline__ void moe_gather(Frame& F, const unsigned* gcnt, const unsigned* tokinfo, const unsigned char* h8, unsigned char* hs8, float* slotw, unsigned* tokslot) {
    PHASE_IDS();
    const int gw = F.vcu * 8 + F.wave, NGW = F.G * 8;
    int tb[NEXP], nt; moe_tile_bases(gcnt, tb, nt);
    for (int row = gw; row < MTOK; row += NGW) {
        const u32x4 ti = *(const u32x4*)(tokinfo + 8 * (size_t)row); const u32x2 tw = *(const u32x2*)(tokinfo + 8 * (size_t)row + 4);
        int b1 = 0, b2 = 0;
#pragma unroll
        for (int e = 0; e < NEXP; ++e) { b1 = ((int)ti.x == e) ? tb[e] : b1; b2 = ((int)ti.z == e) ? tb[e] : b2; }
        const unsigned s1 = (unsigned)b1 * 256u + ti.y, s2 = (unsigned)b2 * 256u + ti.w;
        const u32x4 a = *((const u32x4*)(h8 + (size_t)row * DM) + lane);
        *((u32x4*)(hs8 + (size_t)s1 * DM) + lane) = a; *((u32x4*)(hs8 + (size_t)s2 * DM) + lane) = a;
        if (lane == 0) { slotw[s1] = __uint_as_float(tw.x); slotw[s2] = __uint_as_float(tw.y); *(u32x2*)(tokslot + 2 * (size_t)row) = (u32x2){s1, s2}; }
    }
}

constexpr int SC_PQ = 272, SC_PV = 528;
constexpr int SC_QL = 0, SC_KL = 17408, SC_VL = 34816, SC_SL = 68608, SC_ST = 136192, SC_STAGE = 0;
__device__ __forceinline__ void scan_phase(Frame& F, const f16* proj, const float* gnw, f16* ao) {
    const int unit = blockIdx.x;
    if (unit >= BATCH * RH) return;
    const int b = unit >> 3, hh = unit & 7;
    LAS unsigned char* L = F.lds;
    PHASE_IDS();
    const int wid = F.wave, rh = wid >> 2, cg = wid & 3, r = lane & 31, h = lane >> 5;
    const int gl = (lane >> 4) & 1, li = lane & 15, ta = li >> 2, tp = li & 3;
    const float lg = lg2gamma(hh);
    const float g63 = ex2(63.0f * lg), cd = ex2(64.0f * lg);
    float vm[2][4], cj[4]; const float wneg = ex2(-64.0f * lg); const int qloc = 32 * rh + r;
#pragma unroll
    for (int kt = 0; kt < 2; ++kt)
#pragma unroll
        for (int g4 = 0; g4 < 4; ++g4) vm[kt][g4] = ex2((float)(64 * kt + 16 * g4 + 8 * h - 2 * qloc - 64) * lg);
#pragma unroll
    for (int j = 0; j < 4; ++j) cj[j] = ex2((float)(2 * j) * lg);
    const size_t rowbase = (size_t)b * SEQ;
    const f16* gq = proj + rowbase * RIN + 128 * hh;
    const f16* gk = gq + 1024;
    const f16* gv = proj + rowbase * RIN + 2048 + 256 * hh;
    const f16* gg = gv + 2048;
    const int qrow = tid >> 4, qc = tid & 15;
    const int vrow = tid >> 5, vc = tid & 31;
    f32x16 SA[2][2];
#pragma unroll
    for (int et = 0; et < 2; ++et)
#pragma unroll
        for (int dd = 0; dd < 2; ++dd)
#pragma unroll
            for (int i = 0; i < 16; ++i) SA[et][dd][i] = 0.f;
    for (int i = tid; i < 128 * SC_PV / 16; i += 512) *(LAS u32x4*)(L + SC_SL + i * 16) = (u32x4){0u, 0u, 0u, 0u};
    u32x4 nq[2], nk[2], nv[4];
#pragma unroll
    for (int i = 0; i < 2; ++i) { nq[i] = *(const u32x4*)(gq + (size_t)(qrow + 32 * i) * RIN + 8 * qc); nk[i] = *(const u32x4*)(gk + (size_t)(qrow + 32 * i) * RIN + 8 * qc); }
#pragma unroll
    for (int i = 0; i < 4; ++i) nv[i] = *(const u32x4*)(gv + (size_t)(vrow + 16 * i) * RIN + 8 * vc);
#pragma unroll
    for (int i = 0; i < 2; ++i) { *(LAS u32x4*)(L + SC_QL + (qrow + 32 * i) * SC_PQ + 16 * qc) = nq[i]; *(LAS u32x4*)(L + SC_KL + (qrow + 32 * i) * SC_PQ + 16 * qc) = nk[i]; }
#pragma unroll
    for (int i = 0; i < 4; ++i) *(LAS u32x4*)(L + SC_VL + (vrow + 16 * i) * SC_PV + 16 * vc) = nv[i];
    WG_BAR();
    for (int c = 0; c < NCHUNK; ++c) {
        const size_t crow = (size_t)c * CHUNK;
        if (c + 1 < NCHUNK) {
#pragma unroll
            for (int i = 0; i < 2; ++i) { nq[i] = *(const u32x4*)(gq + (crow + 64 + qrow + 32 * i) * RIN + 8 * qc); nk[i] = *(const u32x4*)(gk + (crow + 64 + qrow + 32 * i) * RIN + 8 * qc); }
#pragma unroll
            for (int i = 0; i < 4; ++i) nv[i] = *(const u32x4*)(gv + (crow + 64 + vrow + 16 * i) * RIN + 8 * vc);
        }
        f16x8 Qf[8];
#pragma unroll
        for (int ks = 0; ks < 8; ++ks) Qf[ks] = *(const LAS f16x8*)(L + SC_QL + (32 * rh + r) * SC_PQ + (16 * ks + 8 * h) * 2);
        f16x8 Pf[2][2];
#pragma unroll
        for (int kt = 0; kt < 2; ++kt) {
            f32x16 X;
#pragma unroll
            for (int i = 0; i < 16; ++i) X[i] = 0.f;
#pragma unroll
            for (int ks = 0; ks < 8; ++ks) { const f16x8 Kf = *(const LAS f16x8*)(L + SC_KL + (32 * kt + r) * SC_PQ + (16 * ks + 8 * h) * 2); X = __builtin_amdgcn_mfma_f32_32x32x16_f16(Kf, Qf[ks], X, 0, 0, 0); }
#pragma unroll
            for (int i = 0; i < 16; ++i) { const int key = 32 * kt + (i & 3) + 8 * (i >> 2) + 4 * h; X[i] *= (key >= qloc) ? vm[kt][i >> 2] * cj[i & 3] : wneg; }
            Pf[kt][0] = pack8(X, 0); Pf[kt][1] = pack8(X, 1);
        }
        f32x16 OT[2];
#pragma unroll
        for (int et = 0; et < 2; ++et)
#pragma unroll
            for (int i = 0; i < 16; ++i) OT[et][i] = 0.f;
#pragma unroll
        for (int ks = 0; ks < 8; ++ks)
#pragma unroll
            for (int et = 0; et < 2; ++et) {
                LAS const unsigned char* sp = L + SC_SL + (16 * ks + 8 * h + ta) * SC_PV + (64 * cg + 32 * et + 16 * gl + 4 * tp) * 2;
                const f16x8 Sf = cat8(tr_read(sp), tr_read(sp + 4 * SC_PV));
                OT[et] = __builtin_amdgcn_mfma_f32_32x32x16_f16(Sf, Qf[ks], OT[et], 0, 0, 0);
            }
#pragma unroll
        for (int et = 0; et < 2; ++et)
#pragma unroll
            for (int dd = 0; dd < 2; ++dd)
#pragma unroll
                for (int i = 0; i < 16; ++i) SA[et][dd][i] *= cd;
#pragma unroll
        for (int kt = 0; kt < 2; ++kt)
#pragma unroll
            for (int s = 0; s < 2; ++s) {
                const int k0 = 32 * kt + 16 * s + 4 * h + ta;
                f16x8 Vf[2], Kt[2];
#pragma unroll
                for (int et = 0; et < 2; ++et) { LAS const unsigned char* vp = L + SC_VL + k0 * SC_PV + (64 * cg + 32 * et + 16 * gl + 4 * tp) * 2; Vf[et] = cat8(tr_read(vp), tr_read(vp + 8 * SC_PV)); }
#pragma unroll
                for (int dd = 0; dd < 2; ++dd) { LAS const unsigned char* kp = L + SC_KL + k0 * SC_PQ + (32 * (2 * rh + dd) + 16 * gl + 4 * tp) * 2; Kt[dd] = cat8(tr_read(kp), tr_read(kp + 8 * SC_PQ)); }
#pragma unroll
                for (int et = 0; et < 2; ++et) {
                    OT[et] = __builtin_amdgcn_mfma_f32_32x32x16_f16(Vf[et], Pf[kt][s], OT[et], 0, 0, 0);
#pragma unroll
                    for (int dd = 0; dd < 2; ++dd) SA[et][dd] = __builtin_amdgcn_mfma_f32_32x32x16_f16(Vf[et], Kt[dd], SA[et][dd], 0, 0, 0);
                }
            }
        float s1 = 0.f, s2 = 0.f;
#pragma unroll
        for (int et = 0; et < 2; ++et)
#pragma unroll
            for (int i = 0; i < 16; ++i) { OT[et][i] *= g63; s1 += OT[et][i]; s2 += OT[et][i] * OT[et][i]; }
        s1 += __shfl_xor(s1, 32); s2 += __shfl_xor(s2, 32);
        if (h == 0) *(LAS f32x2*)(L + SC_ST + ((rh * 4 + cg) * 32 + r) * 8) = (f32x2){s1, s2};
        WG_BAR();
        float t1 = 0.f, t2 = 0.f;
#pragma unroll
        for (int c4 = 0; c4 < 4; ++c4) { const f32x2 p = *(const LAS f32x2*)(L + SC_ST + ((rh * 4 + c4) * 32 + r) * 8); t1 += p.x; t2 += p.y; }
        const float mean = t1 * (1.0f / 256.0f), var = t2 * (1.0f / 256.0f) - mean * mean, rstd = 1.0f / sqrtf(var + EPS);
        u32x4 gc[4];
#pragma unroll
        for (int i = 0; i < 4; ++i) gc[i] = *(const u32x4*)(gg + (crow + vrow + 16 * i) * RIN + 8 * vc);
#pragma unroll
        for (int et = 0; et < 2; ++et)
#pragma unroll
            for (int dd = 0; dd < 2; ++dd)
#pragma unroll
                for (int g4 = 0; g4 < 4; ++g4) {
                    u32x2 w; w.x = pkh(SA[et][dd][4 * g4], SA[et][dd][4 * g4 + 1]); w.y = pkh(SA[et][dd][4 * g4 + 2], SA[et][dd][4 * g4 + 3]);
                    *(LAS u32x2*)(L + SC_SL + (32 * (2 * rh + dd) + r) * SC_PV + (64 * cg + 32 * et + 8 * g4 + 4 * h) * 2) = w;
                }
#pragma unroll
        for (int et = 0; et < 2; ++et)
#pragma unroll
            for (int g4 = 0; g4 < 4; ++g4) {
                u32x2 w; w.x = pkh((OT[et][4 * g4] - mean) * rstd, (OT[et][4 * g4 + 1] - mean) * rstd); w.y = pkh((OT[et][4 * g4 + 2] - mean) * rstd, (OT[et][4 * g4 + 3] - mean) * rstd);
                *(LAS u32x2*)(L + SC_STAGE + (32 * rh + r) * SC_PV + (64 * cg + 32 * et + 8 * g4 + 4 * h) * 2) = w;
            }
        WG_BAR();
        f32x4 gw0, gw1; { const float* gp = gnw + 256 * hh + 8 * vc; gw0 = *(const f32x4*)gp; gw1 = *(const f32x4*)(gp + 4); }
#pragma unroll
        for (int i = 0; i < 4; ++i) {
            const f16x8 n8 = *(const LAS f16x8*)(L + SC_STAGE + (vrow + 16 * i) * SC_PV + 16 * vc);
            const f16x8 g8 = __builtin_bit_cast(f16x8, gc[i]);
            u32x4 w;
            w.x = pkh((float)n8[0] * (float)g8[0] * gw0[0], (float)n8[1] * (float)g8[1] * gw0[1]); w.y = pkh((float)n8[2] * (float)g8[2] * gw0[2], (float)n8[3] * (float)g8[3] * gw0[3]);
            w.z = pkh((float)n8[4] * (float)g8[4] * gw1[0], (float)n8[5] * (float)g8[5] * gw1[1]); w.w = pkh((float)n8[6] * (float)g8[6] * gw1[2], (float)n8[7] * (float)g8[7] * gw1[3]);
            *(u32x4*)(ao + (rowbase + crow + vrow + 16 * i) * 2048 + 256 * hh + 8 * vc) = w;
        }
        WG_BAR();
        if (c + 1 < NCHUNK) {
#pragma unroll
            for (int i = 0; i < 2; ++i) { *(LAS u32x4*)(L + SC_QL + (qrow + 32 * i) * SC_PQ + 16 * qc) = nq[i]; *(LAS u32x4*)(L + SC_KL + (qrow + 32 * i) * SC_PQ + 16 * qc) = nk[i]; }
#pragma unroll
            for (int i = 0; i < 4; ++i) *(LAS u32x4*)(L + SC_VL + (vrow + 16 * i) * SC_PV + 16 * vc) = nv[i];
        }
        WG_BAR();
    }
}

constexpr int SBV_P = 144;
constexpr float SB_STOP = 7.8886090522101181e-31f;
__device__ __forceinline__ void sb_phase(Frame& F, const f16* Q, const f16* Kc, const f16* Vc, f16* O) {
    PHASE_IDS();
    const int gw = F.vcu * 8 + F.wave, NGW = F.G * 8, r = lane & 31, h = lane >> 5;
    const int gl = (lane >> 4) & 1, li = lane & 15, ta = li >> 2, tp = li & 3;
    LAS unsigned char* Vw = F.lds + F.wave * (32 * SBV_P);
    const int vr = lane >> 3, vcc = lane & 7;
    for (int u = gw; u < BATCH * SBH * (SEQ / 32); u += NGW) {
        const int qblk = u & 63, bh = u >> 6, b = bh >> 4, hd = bh & 15;
        const size_t rb = (size_t)b * SEQ;
        const f16* qp = Q + (rb + 32 * qblk + r) * DM + 64 * hd + 8 * h;
        f16x8 Qf[4];
#pragma unroll
        for (int ks = 0; ks < 4; ++ks) Qf[ks] = *(const f16x8*)(qp + 16 * ks);
        f32x16 OT[2];
#pragma unroll
        for (int dt = 0; dt < 2; ++dt)
#pragma unroll
            for (int i = 0; i < 16; ++i) OT[dt][i] = 0.f;
        float carry = 1.0f;
        u32x4 kn[4], vn[4];
        { const f16* kp = Kc + (rb + 32 * qblk + r) * DM + 64 * hd + 8 * h; const f16* vp = Vc + (rb + 32 * qblk + vr) * DM + 64 * hd + 8 * vcc;
#pragma unroll
          for (int i = 0; i < 4; ++i) { kn[i] = *(const u32x4*)(kp + 16 * i); vn[i] = *(const u32x4*)(vp + (size_t)(8 * i) * DM); } }
        for (int kt = qblk; kt >= 0; --kt) {
            f16x8 Kf[4];
#pragma unroll
            for (int i = 0; i < 4; ++i) { Kf[i] = __builtin_bit_cast(f16x8, kn[i]); *(LAS u32x4*)(Vw + (vr + 8 * i) * SBV_P + 16 * vcc) = vn[i]; }
            CFENCE();
            if (kt > 0) { const f16* kp = Kc + (rb + 32 * (kt - 1) + r) * DM + 64 * hd + 8 * h; const f16* vp = Vc + (rb + 32 * (kt - 1) + vr) * DM + 64 * hd + 8 * vcc;
#pragma unroll
                for (int i = 0; i < 4; ++i) { kn[i] = *(const u32x4*)(kp + 16 * i); vn[i] = *(const u32x4*)(vp + (size_t)(8 * i) * DM); } }
            f32x16 S;
#pragma unroll
            for (int i = 0; i < 16; ++i) S[i] = 0.f;
#pragma unroll
            for (int ks = 0; ks < 4; ++ks) S = __builtin_amdgcn_mfma_f32_32x32x16_f16(Kf[ks], Qf[ks], S, 0, 0, 0);
            float om[16];
            const bool diag = (kt == qblk);
#pragma unroll
            for (int i = 0; i < 16; ++i) {
                const int kl = (i & 3) + 8 * (i >> 2) + 4 * h;
                float o = __builtin_amdgcn_rcpf(1.0f + ex2(S[i]));
                if (diag && kl >= r) o = 1.0f;
                om[i] = o;
            }
            float sfx[16], T[4];
#pragma unroll
            for (int g4 = 0; g4 < 4; ++g4) { sfx[4 * g4 + 3] = 1.0f; sfx[4 * g4 + 2] = om[4 * g4 + 3]; sfx[4 * g4 + 1] = sfx[4 * g4 + 2] * om[4 * g4 + 2]; sfx[4 * g4] = sfx[4 * g4 + 1] * om[4 * g4 + 1]; T[g4] = sfx[4 * g4] * om[4 * g4]; }
            float E[4]; float run = carry;
#pragma unroll
            for (int g4 = 3; g4 >= 0; --g4) {
                const float tl = __shfl(T[g4], r), th = __shfl(T[g4], r + 32);
                const float e_hi = run; run *= th; const float e_lo = run; run *= tl;
                E[g4] = h ? e_hi : e_lo;
            }
            carry = run;
            f32x16 Aw;
#pragma unroll
            for (int i = 0; i < 16; ++i) Aw[i] = (1.0f - om[i]) * (E[i >> 2] * sfx[i]);
            const f16x8 Af0 = pack8(Aw, 0), Af1 = pack8(Aw, 1);
            CFENCE();
#pragma unroll
            for (int dt = 0; dt < 2; ++dt) {
                LAS const unsigned char* vp = Vw + (4 * h + ta) * SBV_P + (32 * dt + 16 * gl + 4 * tp) * 2;
                const f16x8 V0 = cat8(tr_read(vp), tr_read(vp + 8 * SBV_P)), V1 = cat8(tr_read(vp + 16 * SBV_P), tr_read(vp + 24 * SBV_P));
                OT[dt] = __builtin_amdgcn_mfma_f32_32x32x16_f16(V0, Af0, OT[dt], 0, 0, 0);
                OT[dt] = __builtin_amdgcn_mfma_f32_32x32x16_f16(V1, Af1, OT[dt], 0, 0, 0);
            }
            CFENCE();
            if (__ballot(carry > SB_STOP) == 0ull) break;
        }
        f16* op = O + (rb + 32 * qblk + r) * DM + 64 * hd + 4 * h;
#pragma unroll
        for (int dt = 0; dt < 2; ++dt)
#pragma unroll
            for (int g4 = 0; g4 < 4; ++g4) { u32x2 w; w.x = pkh(OT[dt][4 * g4], OT[dt][4 * g4 + 1]); w.y = pkh(OT[dt][4 * g4 + 2], OT[dt][4 * g4 + 3]); *(u32x2*)(op + 32 * dt + 8 * g4) = w; }
    }
}

struct Args { const void* in[22]; float* out; unsigned char* ws; int ph_lo, ph_hi; };
constexpr int N_PHASES = 34;
#define IN(k) (lo <= (k) && (k) < hi)
#define SEAM(k) do { if (IN((k) + 1)) { if (!MK_PER_PHASE) xcd_barrier(bar); } } while (0)
#define WSP(T, off) ((T*)(F.ws + (off)))
#define REPS(cond) _Pragma("unroll") for (int rep_ = 0; rep_ < ((cond) ? 2 : 1); ++rep_)
#define REPBAR() do { if (rep_) xcd_barrier(bar); } while (0)
template <int L> __device__ __forceinline__ void layer_phases(Frame& F, const XcdBarrier& bar, const int lo, const int hi) {
    constexpr int pb = 1 + 8 * L;
        if (IN(pb + 0) && !DIS_K0) {
            const float* modL = WSP(const float, WS_MOD) + (size_t)L * 16 * 6144;
            NormArgs A{}; A.x = (L == 0) ? KIN(0) : WSP(const float, WS_X); A.xw = WSP(float, WS_X); A.gain = KIN(5) + L * DM; A.sh = modL; A.sc = modL + 1024; A.h = WSP(f16, WS_H);
            if constexpr (L == 2) {
                A.y2 = WSP(const f16, WS_Y2); A.tokslot = WSP(const unsigned, WS_TOKSLOT); A.gatef = WSP(const float, WS_MOD) + (size_t)(L - 1) * 16 * 6144 + 5120;
                A.gain2 = KIN(12); A.kvmod = WSP(const float, WS_KVMOD); A.hk = WSP(f16, WS_HK); norm_phase<true, true, false, false>(F, A);
            } else REPS(PROBE_DUP == 7 && L == 1) { REPBAR(); norm_phase<false, false, false, false>(F, A); }
            SEAM(pb + 0);
        }
        if (IN(pb + 1) && !DIS_K1) {
            if constexpr (L < 2) {
                pg8::Gemm g{WSP(const f16, WS_H), WSP(const f16, WS_W_RIN) + (size_t)L * RIN * DM, MTOK, RIN, DM, 0}; pg8::Order S; S.init(MTOK, RIN, F.G, (int)blockIdx.x);
                pg8::EpiRetIn E{WSP(f16, WS_PROJ), WSP(const float, WS_ROPE)};
                REPS(PROBE_DUP == 6 && L == 1) { REPBAR(); pg8::gemm_phase<pg8::EpiRetIn>(F.lds, g, S, E); }
            } else {
                { pg8::Gemm g{WSP(const f16, WS_H), WSP(const f16, WS_W_SQ) + (size_t)(L - 2) * DM * DM, MTOK, DM, DM, 0}; pg8::Order S; S.init(MTOK, DM, F.G, (int)blockIdx.x);
                  pg8::EpiF16 E{WSP(f16, WS_SQ), DM, 0, 0, 0.125f * 1.4426950408889634f};
                  pg8::gemm_phase<pg8::EpiF16>(F.lds, g, S, E); }
                if constexpr (L == 2) { pg8::Gemm g{WSP(const f16, WS_HK), WSP(const f16, WS_W_KV), MTOK, 2048, DM, 0}; pg8::Order S; S.init(MTOK, 2048, F.G, (int)blockIdx.x);
                  pg8::EpiF16 E{WSP(f16, WS_KSH), DM, 1024, (size_t)(WS_VSH - WS_KSH) / 2, 1.0f};
                  pg8::gemm_phase<pg8::EpiF16>(F.lds, g, S, E); }
            }
            SEAM(pb + 1);
        }
        if (IN(pb + 2) && !DIS_K2) {
#ifndef NO_SCAN
            if constexpr (L < 2) REPS(PROBE_DUP == 2 && L == 1) { REPBAR(); scan_phase(F, WSP(const f16, WS_PROJ), KIN(8) + L * 2048, WSP(f16, WS_AO)); }
#endif
#ifndef NO_SB
            if constexpr (L >= 2) REPS(PROBE_DUP == 3 && L == 3) { REPBAR(); sb_phase(F, WSP(const f16, WS_SQ), WSP(const f16, WS_KSH), WSP(const f16, WS_VSH), WSP(f16, WS_SO)); }
#endif
            SEAM(pb + 2);
        }
        if (IN(pb + 3) && !DIS_K3) {
            pg8::Gemm g;
            if constexpr (L < 2) g = pg8::Gemm{WSP(const f16, WS_AO), WSP(const f16, WS_W_ROUT) + (size_t)L * DM * 2048, MTOK, DM, 2048, 0};
            else g = pg8::Gemm{WSP(const f16, WS_SO), WSP(const f16, WS_W_SO) + (size_t)(L - 2) * DM * DM, MTOK, DM, DM, 0};
            pg8::Order S; S.init(MTOK, DM, F.G, (int)blockIdx.x);
            pg8::EpiRes E{(L == 0) ? KIN(0) : WSP(const float, WS_X), WSP(float, WS_X), WSP(const float, WS_MOD) + (size_t)L * 16 * 6144 + 2048};
            pg8::gemm_phase<pg8::EpiRes>(F.lds, g, S, E);
            SEAM(pb + 3);
        }
        if (IN(pb + 4) && !DIS_K4) {
            const float* modL = WSP(const float, WS_MOD) + (size_t)L * 16 * 6144;
            NormArgs A{}; A.x = WSP(const float, WS_X); A.xw = WSP(float, WS_X); A.gain = KIN(6) + L * DM; A.sh = modL + 3072; A.sc = modL + 4096; A.h = WSP(f16, WS_H);
            if constexpr (L & 1) { A.router = KIN(18) + (size_t)(L >> 1) * DM * NEXP; A.gcnt = F.ctl + CW_MOE + (L >> 1) * 1024; A.tokinfo = WSP(unsigned, WS_TOKINFO); norm_phase<false, false, false, true>(F, A); }
            else norm_phase<false, false, false, false>(F, A);
            SEAM(pb + 4);
        }
        if (IN(pb + 5) && !DIS_K5) {
            if constexpr (L & 1) REPS(PROBE_DUP == 8 && L == 3) { REPBAR(); moe_gather(F, F.ctl + CW_MOE + (L >> 1) * 1024, WSP(const unsigned, WS_TOKINFO), WSP(const unsigned char, WS_H), WSP(unsigned char, WS_HS), WSP(float, WS_SLOTW), WSP(unsigned, WS_TOKSLOT)); }
            SEAM(pb + 5);
        }
        if (IN(pb + 6) && !DIS_K6) {
            const int mi = L >> 1;
            pg8::Order S;
            if constexpr (L & 1) {
                int tb[NEXP], ntl; moe_tile_bases(F.ctl + CW_MOE + mi * 1024, tb, ntl);
                S.init(ntl * 256, 2 * FFE, F.G, (int)blockIdx.x);
#pragma unroll
                for (int e = 0; e < NEXP; ++e) S.tb[e] = tb[e];
                pg8::Gemm g{WSP(const unsigned char, WS_HS), WSP(const unsigned char, WS_W_MIN) + (size_t)mi * NEXP * 2 * FFE * DM, ntl * 256, 2 * FFE, DM, (size_t)2 * FFE * DM};
                pg8::EpiGlu<true> E{WSP(unsigned char, WS_ACTE), FFE};
                REPS(PROBE_DUP == 4 && L == 3) { REPBAR(); pg8::gemm_phase<pg8::EpiGlu<true>, true>(F.lds, g, S, E); }
            } else {
                S.init(MTOK, 2 * FFD, F.G, (int)blockIdx.x);
                pg8::Gemm g{WSP(const f16, WS_H), WSP(const f16, WS_W_FIN) + (size_t)mi * 2 * FFD * DM, MTOK, 2 * FFD, DM, 0};
                pg8::EpiGlu<false> E{WSP(f16, WS_ACTD), FFD};
                pg8::gemm_phase<pg8::EpiGlu<false>>(F.lds, g, S, E);
            }
            SEAM(pb + 6);
        }
        if (IN(pb + 7) && !DIS_K7) {
            const int mi = L >> 1;
            if constexpr (L & 1) {
                int tb[NEXP], ntl; moe_tile_bases(F.ctl + CW_MOE + mi * 1024, tb, ntl);
                pg8::Order S; S.init(ntl * 256, DM, F.G, (int)blockIdx.x);
#pragma unroll
                for (int e = 0; e < NEXP; ++e) S.tb[e] = tb[e];
                pg8::Gemm g{WSP(const unsigned char, WS_ACTE), WSP(const unsigned char, WS_W_MOUT) + (size_t)mi * NEXP * DM * FFE, ntl * 256, DM, FFE, (size_t)DM * FFE};
                pg8::EpiMoeOut E{WSP(f16, WS_Y2), WSP(const float, WS_SLOTW)};
                REPS(PROBE_DUP == 5 && L == 3) { REPBAR(); pg8::gemm_phase<pg8::EpiMoeOut, true>(F.lds, g, S, E); }
            } else {
                pg8::Order S; S.init(MTOK, DM, F.G, (int)blockIdx.x);
                pg8::Gemm g{WSP(const f16, WS_ACTD), WSP(const f16, WS_W_FOUT) + (size_t)mi * DM * FFD, MTOK, DM, FFD, 0};
                pg8::EpiRes E{WSP(const float, WS_X), WSP(float, WS_X), WSP(const float, WS_MOD) + (size_t)L * 16 * 6144 + 5120};
                pg8::gemm_phase<pg8::EpiRes>(F.lds, g, S, E);
            }
            SEAM(pb + 7);
        }
}
__global__ void __launch_bounds__(512, 2) mk_fwd(Args args) {
    extern __shared__ __attribute__((aligned(16))) unsigned char lds_raw[];
    Frame F;
    F.lds = (LAS unsigned char*)lds_raw;
    F.wave = __builtin_amdgcn_readfirstlane((int)threadIdx.x >> 6);
    F.G = gridDim.x; { const int bx = blockIdx.x; F.vcu = (F.G % 8 == 0) ? (bx % 8) * (F.G / 8) + bx / 8 : bx; }
    F.ws = args.ws; F.ctl = (unsigned*)(args.ws + WS_CTL);
    volatile LAS unsigned* MISC = (volatile LAS unsigned*)(F.lds + MISC_OFF);
    if (threadIdx.x < 64) ((LAS unsigned*)(F.lds + MISC_OFF))[threadIdx.x] = 0u;
    __syncthreads();
    XcdBarrier bar; bar.bar = F.ctl + CW_BAR; bar.x = 0; bar.st = nullptr;
    if (!MK_PER_PHASE) bar = xcd_barrier_post(F.ctl + CW_BAR, MISC + 8);
    const int lo = args.ph_lo, hi = args.ph_hi;

    if (IN(0)) {
#ifndef NO_P0
        REPS(PROBE_DUP == 1) { REPBAR(); p0_prologue(F); }
#endif
        SEAM(0);
    }
    layer_phases<0>(F, bar, lo, hi); layer_phases<1>(F, bar, lo, hi); layer_phases<2>(F, bar, lo, hi); layer_phases<3>(F, bar, lo, hi);
    if (IN(33)) {
        NormArgs A{}; A.x = WSP(const float, WS_X); A.xw = WSP(float, WS_X); A.gain = KIN(21); A.out = (float*)karg<22>();
        A.y2 = WSP(const f16, WS_Y2); A.tokslot = WSP(const unsigned, WS_TOKSLOT); A.gatef = WSP(const float, WS_MOD) + (size_t)3 * 16 * 6144 + 5120;
        norm_phase<true, false, true, false>(F, A);
    }
#undef IN
#undef SEAM
#undef WSP
}

extern "C" void kernel_launch(void* const* d_in, const int* in_sizes, int n_in, void* d_out, int out_size, void* d_ws, size_t ws_size, hipStream_t stream) {
    static int grid = 0;
    if (grid == 0) {
        if (n_in != 22 || out_size != MTOK * DM || ws_size < WS_END) { fprintf(stderr, "kernel_launch: unexpected shapes (n_in %d out %d ws %zu, need %zu)\n", n_in, out_size, ws_size, (size_t)WS_END); grid = -1; return; }
        int dev = 0, cus = 0;
        if (hipGetDevice(&dev) != hipSuccess || hipDeviceGetAttribute(&cus, hipDeviceAttributeMultiprocessorCount, dev) != hipSuccess) { grid = -1; return; }
        if (hipFuncSetAttribute((const void*)mk_fwd, hipFuncAttributeMaxDynamicSharedMemorySize, LDS_BYTES) != hipSuccess) { fprintf(stderr, "kernel_launch: hipFuncSetAttribute failed\n"); grid = -1; return; }
        int per_cu = 0;
        if (hipOccupancyMaxActiveBlocksPerMultiprocessor(&per_cu, (const void*)mk_fwd, 512, LDS_BYTES) != hipSuccess || per_cu < 1) fprintf(stderr, "kernel_launch: occupancy query reports %d\n", per_cu);
        (void)hipGetLastError();
        if (cus < 256) { fprintf(stderr, "kernel_launch: needs >= 256 CUs, got %d\n", cus); grid = -1; return; }
        grid = cus;
    }
    if (grid < 0) return;
    (void)hipMemsetAsync((char*)d_ws + WS_CTL, 0, CTL_ZERO_BYTES, stream);
    Args a{};
    for (int i = 0; i < 22; ++i) a.in[i] = d_in[i];
    a.out = (float*)d_out; a.ws = (unsigned char*)d_ws;
#if MK_PER_PHASE
    for (int p = 0; p < N_PHASES; ++p) {
        if (p >= 1 && p <= 32) { const int L = (p - 1) / 8, k = (p - 1) % 8; if (k == 5 && !(L & 1)) continue; }
        a.ph_lo = p; a.ph_hi = p + 1;
        hipLaunchKernelGGL(mk_fwd, dim3(grid), dim3(512), LDS_BYTES, stream, a);
    }
#else
    a.ph_lo = 0; a.ph_hi = N_PHASES;
    hipLaunchKernelGGL(mk_fwd, dim3(grid), dim3(512), LDS_BYTES, stream, a);
#endif
}
```

```cpp
#include <hip/hip_runtime.h>
#include <cstdio>
#include <cstdint>

#define LAS __attribute__((address_space(3)))
#define GAS __attribute__((address_space(1)))
typedef _Float16 f16;
typedef _Float16 f16x2 __attribute__((ext_vector_type(2)));
typedef _Float16 f16x4 __attribute__((ext_vector_type(4)));
typedef _Float16 f16x8 __attribute__((ext_vector_type(8)));
typedef float f32x2 __attribute__((ext_vector_type(2)));
typedef float f32x4 __attribute__((ext_vector_type(4)));
typedef float f32x16 __attribute__((ext_vector_type(16)));
typedef unsigned u32x2 __attribute__((ext_vector_type(2)));
typedef unsigned u32x4 __attribute__((ext_vector_type(4)));
typedef short v4i16_t __attribute__((ext_vector_type(4)));
typedef int i32x8 __attribute__((ext_vector_type(8)));
typedef int i32x4 __attribute__((ext_vector_type(4)));

#ifndef DIS_K0
#define DIS_K0 0
#endif
#ifndef DIS_K1
#define DIS_K1 0
#endif
#ifndef DIS_K2
#define DIS_K2 0
#endif
#ifndef DIS_K3
#define DIS_K3 0
#endif
#ifndef DIS_K4
#define DIS_K4 0
#endif
#ifndef DIS_K5
#define DIS_K5 0
#endif
#ifndef DIS_K6
#define DIS_K6 0
#endif
#ifndef DIS_K7
#define DIS_K7 0
#endif
#ifndef PROBE_DUP
#define PROBE_DUP 0
#endif
#ifndef DENSE_F8
#define DENSE_F8 0
#define DF8(L) (DENSE_F8 != 0 && (L) == 2)
#endif
#ifndef RETIN_F8
#define RETIN_F8 0
#endif
#ifndef MK_PER_PHASE
#define MK_PER_PHASE 0
#endif

constexpr int BATCH = 16, SEQ = 2048, DM = 1024, MTOK = BATCH * SEQ;
constexpr int RH = 8, RDK = 128, RDV = 256, RIN = 6144, CHUNK = 64, NCHUNK = SEQ / CHUNK;
constexpr int SBH = 16, SDH = 64;
constexpr int FFD = 2816, NEXP = 8, FFE = 3584;
constexpr float EPS = 1e-6f;
constexpr int MOE_ROWS_MAX = 2 * MTOK + NEXP * 256;

__device__ __forceinline__ float lg2gamma(int h) {
    const float t[8] = {-4.580368961312e-02f, -2.272007650008e-02f, -1.131531322783e-02f, -5.646563141142e-03f, -2.820519062379e-03f, -1.409570254671e-03f, -7.046129765894e-04f, -3.522634716290e-04f};
    float r = t[0];
#pragma unroll
    for (int i = 1; i < 8; ++i) r = (h == i) ? t[i] : r;
    return r;
}
__device__ __forceinline__ unsigned pkh(float lo, float hi) { f32x2 v = {lo, hi}; f16x2 h = __builtin_convertvector(v, f16x2); return __builtin_bit_cast(unsigned, h); }
__device__ __forceinline__ float silu_f(float x) { return x * __builtin_amdgcn_rcpf(1.0f + __builtin_amdgcn_exp2f(-1.4426950408889634f * x)); }
__device__ __forceinline__ float ex2(float x) { return __builtin_amdgcn_exp2f(x); }
__device__ __forceinline__ unsigned pk4f8(float a, float b, float c, float d) { int w = 0; w = __builtin_amdgcn_cvt_pk_fp8_f32(a, b, w, false); w = __builtin_amdgcn_cvt_pk_fp8_f32(c, d, w, true); return (unsigned)w; }
constexpr float F8_WSCALE = 64.0f;
constexpr float F8_ASCALE = 4.0f;

namespace pg8 {
constexpr int BM = 256, BK = 64, HALF = 128, HTB = HALF * BK * 2, STAGE_BYTES = 8 * HTB, NXCD = 8, WGM = 8;
__host__ __device__ __forceinline__ int lds_byte(int r, int c) { const int st = (r >> 4) * 2 + (c >> 5), rr = r & 15, cc = c & 31, ob = rr * 64 + cc * 2; return st * 1024 + (ob ^ (((ob >> 9) & 1) << 5)); }
__host__ __device__ __forceinline__ void stage_rc(int b, int& R, int& C) { const int st = b / 1024, sb = b % 1024, swz = sb ^ (((sb >> 9) & 1) << 5); R = (st >> 1) * 16 + swz / 64; C = (st & 1) * 32 + (swz % 64) / 2; }
__host__ __device__ __forceinline__ int perm32(int rho) { const int n = rho >> 4, i = rho & 15; return 8 * (i >> 2) + 4 * n + (i & 3); }

struct Unit { int pm, pn, be; };
struct Gemm { const void* A; const void* Bt; int M, N, K; size_t bstride; };

struct Order {
    int nM, nN, nwg, G, c; int tb[NEXP];
    __device__ void init(int M, int N, int G_, int c_) { nM = M / BM; nN = N / BM; nwg = nM * nN; G = G_; c = c_;
#pragma unroll
        for (int e = 0; e < NEXP; ++e) tb[e] = e ? 0x7fffffff : 0; }
    __device__ bool next(int i, Unit& u) const {
        const long L = (long)i * G + c; if (L >= nwg) return false;
        int wgid = (int)L; { const int q = nwg / NXCD, r = nwg % NXCD, xcd = wgid % NXCD, off = wgid / NXCD; wgid = (xcd < r ? xcd * (q + 1) : r * (q + 1) + (xcd - r) * q) + off; }
        const int nig = WGM * nN, gid = wgid / nig, fm = gid * WGM, gsz = (nM - fm) < WGM ? (nM - fm) : WGM;
        u.pm = fm + ((wgid % nig) % gsz); u.pn = (wgid % nig) / gsz;
        int be = 0;
#pragma unroll
        for (int e = 1; e < NEXP; ++e) be += (u.pm >= tb[e]) ? 1 : 0;
        u.be = be; return true;
    }
};


struct EpiRetIn {
    static constexpr bool PERM = true;
    f16* O; const float* rope; float scl;
    __device__ __forceinline__ void operator()(const f32x4 (&acc)[2][2][4][2], const Unit& u, int wr, int wc, int fr, int fq) const {
        const int row0 = u.pm * BM + wr * 64 + fr, cl = wc * 32 + 8 * fq;
        f16* base = O + (size_t)u.pn * BM + cl;
        if (u.pn < 8) {
            const bool isk = u.pn >= 4; const int i0 = cl >> 1;
            float lg[2]; lg[0] = lg2gamma(2 * (u.pn & 3)); lg[1] = lg2gamma(2 * (u.pn & 3) + 1);
#pragma unroll
            for (int ai = 0; ai < 2; ++ai)
#pragma unroll
                for (int m = 0; m < 4; ++m) {
                    const int row = row0 + ai * HALF + m * 16; const float pos = (float)(16 * m + fr);
                    const f32x4 cs = *(const f32x4*)(rope + (size_t)row * 128 + i0), sn = *(const f32x4*)(rope + (size_t)row * 128 + 64 + i0);
#pragma unroll
                    for (int bj = 0; bj < 2; ++bj) {
                        const float sc = (isk ? ex2(-pos * lg[bj]) * 0.08838834764831845f : ex2((pos + 1.0f) * lg[bj])) * scl;
                        const f32x4 v0 = acc[ai][bj][m][0], v1 = acc[ai][bj][m][1];
                        u32x4 w;
                        w.x = pkh((v0[0] * cs[0] - v0[1] * sn[0]) * sc, (v0[0] * sn[0] + v0[1] * cs[0]) * sc);
                        w.y = pkh((v0[2] * cs[1] - v0[3] * sn[1]) * sc, (v0[2] * sn[1] + v0[3] * cs[1]) * sc);
                        w.z = pkh((v1[0] * cs[2] - v1[1] * sn[2]) * sc, (v1[0] * sn[2] + v1[1] * cs[2]) * sc);
                        w.w = pkh((v1[2] * cs[3] - v1[3] * sn[3]) * sc, (v1[2] * sn[3] + v1[3] * cs[3]) * sc);
                        *(u32x4*)(base + (size_t)row * RIN + bj * HALF) = w;
                    }
                }
        } else {
            const bool isg = u.pn >= 16;
#pragma unroll
            for (int ai = 0; ai < 2; ++ai)
#pragma unroll
                for (int m = 0; m < 4; ++m) {
                    const int row = row0 + ai * HALF + m * 16;
#pragma unroll
                    for (int bj = 0; bj < 2; ++bj) {
                        f32x4 v0 = acc[ai][bj][m][0] * scl, v1 = acc[ai][bj][m][1] * scl;
                        if (isg) {
#pragma unroll
                            for (int j = 0; j < 4; ++j) { v0[j] = silu_f(v0[j]); v1[j] = silu_f(v1[j]); } }
                        u32x4 w; w.x = pkh(v0[0], v0[1]); w.y = pkh(v0[2], v0[3]); w.z = pkh(v1[0], v1[1]); w.w = pkh(v1[2], v1[3]);
                        *(u32x4*)(base + (size_t)row * RIN + bj * HALF) = w;
                    }
                }
        }
    }
};
struct EpiY {
    static constexpr bool PERM = true;
    f16* Y; const float* gate; float scl;
    __device__ __forceinline__ void operator()(const f32x4 (&acc)[2][2][4][2], const Unit& u, int wr, int wc, int fr, int fq) const {
        const int row0 = u.pm * BM + wr * 64 + fr, col0 = u.pn * BM + wc * 32 + 8 * fq;
        const float* gp = gate + (size_t)(u.pm >> 3) * 6144 + col0;
        f32x4 gv[2][2];
#pragma unroll
        for (int bj = 0; bj < 2; ++bj)
#pragma unroll
            for (int n = 0; n < 2; ++n) gv[bj][n] = *(const f32x4*)(gp + bj * HALF + 4 * n) * scl;
#pragma unroll
        for (int ai = 0; ai < 2; ++ai)
#pragma unroll
            for (int m = 0; m < 4; ++m) { f16* rowp = Y + (size_t)(row0 + ai * HALF + m * 16) * DM + col0;
#pragma unroll
                for (int bj = 0; bj < 2; ++bj) { const f32x4 v0 = acc[ai][bj][m][0] * gv[bj][0], v1 = acc[ai][bj][m][1] * gv[bj][1];
                    u32x4 w; w.x = pkh(v0[0], v0[1]); w.y = pkh(v0[2], v0[3]); w.z = pkh(v1[0], v1[1]); w.w = pkh(v1[2], v1[3]);
                    *(u32x4*)(rowp + bj * HALF) = w; } }
    }
};
template <bool F8> struct EpiGlu {
    static constexpr bool PERM = true;
    void* Ov; int ldc;
    __device__ __forceinline__ void operator()(const f32x4 (&acc)[2][2][4][2], const Unit& u, int wr, int wc, int fr, int fq) const {
        const int row0 = u.pm * BM + wr * 64 + fr, col0 = u.pn * HALF + wc * 32 + 8 * fq;
        constexpr float si = F8 ? 1.0f / F8_WSCALE : 1.0f, so = F8 ? F8_ASCALE : 1.0f;
#pragma unroll
        for (int ai = 0; ai < 2; ++ai)
#pragma unroll
            for (int m = 0; m < 4; ++m) {
                float r[8];
#pragma unroll
                for (int n = 0; n < 2; ++n)
#pragma unroll
                    for (int p = 0; p < 2; ++p) {
                        const f32x2 a = {acc[ai][0][m][n][2 * p], acc[ai][0][m][n][2 * p + 1]}, b = {acc[ai][1][m][n][2 * p], acc[ai][1][m][n][2 * p + 1]};
                        const f32x2 t = a * (-1.4426950408889634f * si); f32x2 d = {ex2(t.x), ex2(t.y)}; d = d + 1.0f;
                        const f32x2 u = {__builtin_amdgcn_rcpf(d.x), __builtin_amdgcn_rcpf(d.y)};
                        const f32x2 q = ((a * b) * u) * (si * si * so);
                        r[4 * n + 2 * p] = q.x; r[4 * n + 2 * p + 1] = q.y;
                    }
                if (F8) { u32x2 w; w.x = pk4f8(r[0], r[1], r[2], r[3]); w.y = pk4f8(r[4], r[5], r[6], r[7]);
                    *(u32x2*)((unsigned char*)Ov + (size_t)(row0 + ai * HALF + m * 16) * ldc + col0) = w; }
                else { u32x4 w; w.x = pkh(r[0], r[1]); w.y = pkh(r[2], r[3]); w.z = pkh(r[4], r[5]); w.w = pkh(r[6], r[7]);
                    *(u32x4*)((f16*)Ov + (size_t)(row0 + ai * HALF + m * 16) * ldc + col0) = w; }
            }
    }
};
struct EpiF16 {
    static constexpr bool PERM = true;
    f16* O; int ldc; int split_cols; size_t split_stride; float scale;
    __device__ __forceinline__ void operator()(const f32x4 (&acc)[2][2][4][2], const Unit& u, int wr, int wc, int fr, int fq) const {
        const int row0 = u.pm * BM + wr * 64 + fr; int colt = u.pn * BM; f16* base = O;
        if (split_cols) { const int t = colt / split_cols; base += (size_t)t * split_stride; colt -= t * split_cols; }
        const int col0 = colt + wc * 32 + 8 * fq;
#pragma unroll
        for (int ai = 0; ai < 2; ++ai)
#pragma unroll
            for (int m = 0; m < 4; ++m) { f16* rowp = base + (size_t)(row0 + ai * HALF + m * 16) * ldc + col0;
#pragma unroll
                for (int bj = 0; bj < 2; ++bj) { const f32x4 v0 = acc[ai][bj][m][0] * scale, v1 = acc[ai][bj][m][1] * scale;
                    u32x4 w; w.x = pkh(v0[0], v0[1]); w.y = pkh(v0[2], v0[3]); w.z = pkh(v1[0], v1[1]); w.w = pkh(v1[2], v1[3]);
                    *(u32x4*)(rowp + bj * HALF) = w; } }
    }
};
struct EpiMoeOut {
    static constexpr bool PERM = true;
    f16* O; const float* roww;
    __device__ __forceinline__ void operator()(const f32x4 (&acc)[2][2][4][2], const Unit& u, int wr, int wc, int fr, int fq) const {
        const int row0 = u.pm * BM + wr * 64 + fr, col0 = u.pn * BM + wc * 32 + 8 * fq;
#pragma unroll
        for (int ai = 0; ai < 2; ++ai)
#pragma unroll
            for (int m = 0; m < 4; ++m) { const int row = row0 + ai * HALF + m * 16; const float sc = roww[row] * (1.0f / (F8_WSCALE * F8_ASCALE)); f16* rowp = O + (size_t)row * DM + col0;
#pragma unroll
                for (int bj = 0; bj < 2; ++bj) { const f32x4 v0 = acc[ai][bj][m][0] * sc, v1 = acc[ai][bj][m][1] * sc;
                    u32x4 w; w.x = pkh(v0[0], v0[1]); w.y = pkh(v0[2], v0[3]); w.z = pkh(v1[0], v1[1]); w.w = pkh(v1[2], v1[3]);
                    *(u32x4*)(rowp + bj * HALF) = w; } }
    }
};

template <class Epi, bool F8 = false>
__device__ __forceinline__ void gemm_phase(LAS unsigned char* lds, const Gemm g, const Order& S, const Epi& E) {
    const int tid = threadIdx.x, wid = __builtin_amdgcn_readfirstlane(tid >> 6), lane = tid & 63, wr = wid >> 2, wc = wid & 3, fr = lane & 15, fq = lane >> 4;
    const int KB = g.K * (F8 ? 1 : 2), nt = KB / 128;
    unsigned voffA[2], voffB[2];
#pragma unroll
    for (int i = 0; i < 2; ++i) { int R, C; stage_rc(tid * 16 + i * 8192, R, C); const int Rb = Epi::PERM ? ((R & ~31) + perm32(R & 31)) : R;
        voffA[i] = (unsigned)(R * KB + 2 * C); voffB[i] = (unsigned)(Rb * KB + 2 * C); }
    const size_t kstep = (size_t)(BK * 2);
    const size_t hstep = (size_t)HALF * KB;
    const size_t tstep = 2 * hstep;
    const unsigned ldsw = (unsigned)wid * 1024u;
    const int aoff = lds_byte(wr * 64 + fr, fq * 8), boff = lds_byte(wc * 32 + fr, fq * 8);
#define PG8_SA(b, h) (((b) * 2 + (h)) * HTB)
#define PG8_SB(b, h) ((4 + (b) * 2 + (h)) * HTB)
#define PG8_STAGE(bufoff, gbase, voff) do { _Pragma("unroll") for (int _i = 0; _i < 2; ++_i) \
        __builtin_amdgcn_global_load_lds((const unsigned*)((const char*)(gbase) + (voff)[_i]), (LAS unsigned*)(lds + (bufoff) + ldsw + _i * 8192), 16, 0, 0); } while (0)
#define PG8_LD8(dst, addr) do { const i32x4 lo_ = *(const LAS i32x4*)(addr), hi_ = *(const LAS i32x4*)((addr) + 1024); dst = __builtin_shufflevector(lo_, hi_, 0, 1, 2, 3, 4, 5, 6, 7); } while (0)
#define PG8_LDA(dst, b, h) do { _Pragma("unroll") for (int m = 0; m < 4; ++m) { if constexpr (F8) PG8_LD8(dst##8[m], lds + PG8_SA(b, h) + aoff + m * 2048); else { _Pragma("unroll") for (int k = 0; k < 2; ++k) dst[m][k] = *(const LAS f16x8*)(lds + PG8_SA(b, h) + aoff + m * 2048 + k * 1024); } } } while (0)
#define PG8_LDB(dst, b, h) do { _Pragma("unroll") for (int n = 0; n < 2; ++n) { if constexpr (F8) PG8_LD8(dst##8[n], lds + PG8_SB(b, h) + boff + n * 2048); else { _Pragma("unroll") for (int k = 0; k < 2; ++k) dst[n][k] = *(const LAS f16x8*)(lds + PG8_SB(b, h) + boff + n * 2048 + k * 1024); } } } while (0)
#define PG8_MMA(ai, bj, At, Bt) do { __builtin_amdgcn_s_setprio(1); _Pragma("unroll") for (int m = 0; m < 4; ++m) _Pragma("unroll") for (int n = 0; n < 2; ++n) { \
        if constexpr (F8) asm volatile("v_mfma_scale_f32_16x16x128_f8f6f4 %0, %1, %2, %0, %3, %3 op_sel_hi:[0,0,0]" : "+v"(acc[ai][bj][m][n]) : "v"(Bt##8[n]), "v"(At##8[m]), "v"(f8scale)); \
        else { _Pragma("unroll") for (int k = 0; k < 2; ++k) acc[ai][bj][m][n] = __builtin_amdgcn_mfma_f32_16x16x32_f16(Bt[n][k], At[m][k], acc[ai][bj][m][n], 0, 0, 0); } } \
        __builtin_amdgcn_s_setprio(0); } while (0)
#define PG8_WAIT_V(n) asm volatile("s_waitcnt vmcnt(" #n ")" ::: "memory")
#define PG8_WAIT_L(n) asm volatile("s_waitcnt lgkmcnt(" #n ")" ::: "memory")
#define PG8_BAR __builtin_amdgcn_s_barrier()
#define PG8_SCHED __builtin_amdgcn_sched_barrier(0)
    Unit cur, nxt; int ui = 0;
    if (!S.next(0, cur)) return;
    f32x4 acc[2][2][4][2];
#pragma unroll
    for (int a = 0; a < 2; ++a)
#pragma unroll
        for (int b = 0; b < 2; ++b)
#pragma unroll
            for (int m = 0; m < 4; ++m)
#pragma unroll
                for (int n = 0; n < 2; ++n) acc[a][b][m][n] = (f32x4){0.f, 0.f, 0.f, 0.f};
    const int f8scale = 0x7f7f7f7f;
    f16x8 At[4][2], B0[2][2], B1[2][2]; i32x8 At8[4], B08[2], B18[2];
    const char* cA = (const char*)g.A + (size_t)cur.pm * tstep; const char* cB = (const char*)g.Bt + (size_t)cur.be * g.bstride + (size_t)cur.pn * tstep;
    PG8_STAGE(PG8_SB(0, 0), cB, voffB); PG8_STAGE(PG8_SB(0, 1), cB + hstep, voffB); PG8_STAGE(PG8_SA(0, 0), cA, voffA); PG8_STAGE(PG8_SA(0, 1), cA + hstep, voffA);
    if (wr == 1) PG8_BAR;
    PG8_WAIT_V(2); PG8_BAR;
    PG8_STAGE(PG8_SB(1, 0), cB + kstep, voffB); PG8_STAGE(PG8_SA(1, 0), cA + kstep, voffA); PG8_STAGE(PG8_SB(1, 1), cB + hstep + kstep, voffB);
    PG8_WAIT_V(6); PG8_BAR;
    for (;;) {
        const bool has_next = S.next(ui + 1, nxt);
        const char* nA = has_next ? (const char*)g.A + (size_t)nxt.pm * tstep : cA; const char* nB = has_next ? (const char*)g.Bt + (size_t)nxt.be * g.bstride + (size_t)nxt.pn * tstep : cB;
#pragma nounroll
        for (int t = 0; t < nt; t += 2) {
            const bool last = (t == nt - 2);
            const char* a1 = cA + (size_t)(t + 1) * kstep;
            const char* a2 = last ? nA : cA + (size_t)(t + 2) * kstep; const char* b2 = last ? nB : cB + (size_t)(t + 2) * kstep;
            const char* a3 = a2 + kstep; const char* b3 = b2 + kstep;
            PG8_LDB(B0, 0, 0); PG8_LDB(B1, 0, 1); PG8_SCHED; PG8_LDA(At, 0, 0); PG8_STAGE(PG8_SA(1, 1), a1 + hstep, voffA);
            PG8_WAIT_V(8); PG8_WAIT_L(0); PG8_BAR; PG8_MMA(0, 0, At, B0); PG8_MMA(0, 1, At, B1); PG8_BAR; PG8_SCHED;
            PG8_LDA(At, 0, 1); PG8_STAGE(PG8_SB(0, 0), b2, voffB); PG8_STAGE(PG8_SB(0, 1), b2 + hstep, voffB); PG8_STAGE(PG8_SA(0, 0), a2, voffA);
            PG8_WAIT_V(8); PG8_WAIT_L(0); PG8_BAR; PG8_MMA(1, 0, At, B0); PG8_MMA(1, 1, At, B1); PG8_BAR; PG8_SCHED;
            PG8_LDB(B0, 1, 0); PG8_LDB(B1, 1, 1); PG8_SCHED; PG8_LDA(At, 1, 0); PG8_STAGE(PG8_SA(0, 1), a2 + hstep, voffA);
            PG8_WAIT_V(8); PG8_WAIT_L(0); PG8_BAR; PG8_MMA(0, 0, At, B0); PG8_MMA(0, 1, At, B1); PG8_BAR; PG8_SCHED;
            PG8_LDA(At, 1, 1); PG8_STAGE(PG8_SB(1, 0), b3, voffB); PG8_STAGE(PG8_SB(1, 1), b3 + hstep, voffB); PG8_STAGE(PG8_SA(1, 0), a3, voffA);
            PG8_WAIT_V(8); PG8_WAIT_L(0); PG8_BAR; PG8_MMA(1, 0, At, B0); PG8_MMA(1, 1, At, B1); PG8_BAR; PG8_SCHED;
        }
        if constexpr (F8) asm volatile("s_nop 15\n\ts_nop 15" ::: "memory");
        if (wr == 0) PG8_BAR;
        E(acc, cur, wr, wc, fr, fq);
        if (!has_next) break;
#pragma unroll
        for (int a = 0; a < 2; ++a)
#pragma unroll
            for (int b = 0; b < 2; ++b)
#pragma unroll
                for (int m = 0; m < 4; ++m)
#pragma unroll
                    for (int n = 0; n < 2; ++n) acc[a][b][m][n] = (f32x4){0.f, 0.f, 0.f, 0.f};
        cur = nxt; cA = nA; cB = nB; ++ui;
        if (wr == 1) PG8_BAR;
    }
    PG8_WAIT_V(0);
    PG8_BAR;
#undef PG8_SA
#undef PG8_SB
#undef PG8_STAGE
#undef PG8_LDA
#undef PG8_LDB
#undef PG8_MMA
#undef PG8_WAIT_V
#undef PG8_WAIT_L
#undef PG8_BAR
#undef PG8_SCHED
}
}

constexpr size_t MiB = 1u << 20;
constexpr size_t WS_CTL = 0, CTL_ZERO_BYTES = 1 * MiB;
constexpr size_t WS_MOD = 1 * MiB;
constexpr size_t WS_KVMOD = 3 * MiB;
constexpr size_t WS_TOKINFO = 4 * MiB;
constexpr size_t WS_TOKSLOT = 6 * MiB;
constexpr size_t WS_SLOTW = 7 * MiB;
constexpr size_t WS_ROPE = 8 * MiB;
constexpr size_t WS_W_RIN = 24 * MiB, WS_W_ROUT = 48 * MiB, WS_W_KV = 56 * MiB, WS_W_SQ = 60 * MiB, WS_W_SO = 64 * MiB, WS_W_FIN = 68 * MiB, WS_W_FOUT = 90 * MiB, WS_W_MIN = 101 * MiB, WS_W_MOUT = 325 * MiB;
constexpr size_t WS_X = 437 * MiB, WS_H = 565 * MiB, WS_KSH = 629 * MiB, WS_VSH = 693 * MiB, WS_BIG = 757 * MiB;
constexpr size_t WS_PROJ = WS_BIG, WS_AO = WS_BIG + 384 * MiB;
constexpr size_t WS_ACTD = WS_BIG;
constexpr size_t WS_HS = WS_BIG, WS_Y2 = WS_BIG, WS_ACTE = WS_BIG + 132 * MiB;
constexpr size_t WS_SQ = WS_BIG, WS_SO = WS_BIG + 64 * MiB, WS_HK = WS_BIG + 192 * MiB;
constexpr size_t WS_YB = WS_BIG + 594 * MiB;
constexpr size_t WS_END = WS_YB + 64 * MiB;
static_assert((size_t)MOE_ROWS_MAX * DM * 2 <= 132 * MiB && WS_ACTE + (size_t)MOE_ROWS_MAX * FFE * 2 <= WS_YB && WS_AO + (size_t)MTOK * 2048 * 2 <= WS_YB, "ws map");
constexpr int CW_BAR = 4096;
constexpr int CW_MOE = 16384;

constexpr int RING_BYTES = 131072;
constexpr int LDS_BYTES = 147456;
constexpr int MISC_OFF = LDS_BYTES - 256;

#define XB_TMO      128
#define XB_XCNT(j)  (256  + 64 * (j))
#define XB_XSUB(j)  (1280 + 64 * (j))
#define XB_XGEN(j)  (2304 + 64 * (j))
#define XB_TOP      3328
#define XB_TOPGEN   3392
#define XCD_BAR_WORDS 3456
#define XB_SPIN_CAP (1u << 20)
__device__ __forceinline__ unsigned xb_ld(unsigned* p)              { return __hip_atomic_load(p, __ATOMIC_RELAXED, __HIP_MEMORY_SCOPE_AGENT); }
__device__ __forceinline__ unsigned xb_add(unsigned* p, unsigned v) { return __hip_atomic_fetch_add(p, v, __ATOMIC_RELAXED, __HIP_MEMORY_SCOPE_AGENT); }
__device__ __forceinline__ unsigned xb_xcc_id() { return (unsigned)__builtin_amdgcn_s_getreg((3 << 11) | 20) & 0xFu; }
#define XB_SPIN(cond, bar) do { unsigned _sp = 0; while (cond) { __builtin_amdgcn_s_sleep(1); \
    if ((++_sp & 255u) == 0u) { if (xb_ld(&(bar)[XB_TMO])) break; if (_sp > XB_SPIN_CAP) { atomicAdd(&(bar)[XB_TMO], 1u); break; } } } } while (0)
struct XcdBarrier { unsigned* bar; unsigned x; volatile LAS unsigned* st; };
__device__ __forceinline__ XcdBarrier xcd_barrier_post(unsigned* bar, volatile LAS unsigned* st) {
    XcdBarrier b; b.bar = bar; b.x = xb_xcc_id(); b.st = st;
    if (threadIdx.x == 0) (void)xb_add(&bar[XB_XCNT(b.x)], 1u);
    return b;
}
__device__ __forceinline__ void xcd_barrier_complete(unsigned* bar, unsigned x, unsigned& nloc, unsigned& nx) {
    const unsigned G = gridDim.x * gridDim.y * gridDim.z;
    unsigned sum, cnt, mine, sp = 0u;
    for (;;) {
        sum = 0u; cnt = 0u; mine = 0u;
#pragma unroll
        for (unsigned j = 0; j < 16; ++j) { const unsigned c = xb_ld(&bar[XB_XCNT(j)]); sum += c; cnt += (c > 0u) ? 1u : 0u; mine = (j == x) ? c : mine; }
        if (sum == G) break;
        __builtin_amdgcn_s_sleep(1);
        if ((++sp & 255u) == 0u) { if (xb_ld(&bar[XB_TMO])) break; if (sp > XB_SPIN_CAP) { atomicAdd(&bar[XB_TMO], 1u); break; } }
    }
    nloc = mine > 0u ? mine : 1u; nx = cnt > 0u ? cnt : 1u;
}
__device__ __forceinline__ void xcd_barrier(const XcdBarrier& b) {
    asm volatile("s_waitcnt vmcnt(0)" ::: "memory");
    __syncthreads();
    if (threadIdx.x == 0) {
        unsigned* bar = b.bar;
        __builtin_amdgcn_s_waitcnt(0);
        unsigned nloc = b.st[0], nx = b.st[1];
        if (nloc == 0u) { xcd_barrier_complete(bar, b.x, nloc, nx); b.st[0] = nloc; b.st[1] = nx; }
        const unsigned old = xb_add(&bar[XB_XSUB(b.x)], 1u);
        const unsigned gen = old / nloc;
        if (old + 1u == (gen + 1u) * nloc) {
            __builtin_amdgcn_fence(__ATOMIC_RELEASE, "agent");
            asm volatile("s_waitcnt vmcnt(0)" ::: "memory");
            const unsigned og = xb_add(&bar[XB_TOP], 1u);
            const unsigned tg = og / nx;
            if (og + 1u == (tg + 1u) * nx) xb_add(&bar[XB_TOPGEN], 1u);
            else XB_SPIN(xb_ld(&bar[XB_TOPGEN]) == tg, bar);
            __builtin_amdgcn_fence(__ATOMIC_ACQUIRE, "agent");
            xb_add(&bar[XB_XGEN(b.x)], 1u);
            asm volatile("s_waitcnt vmcnt(0)" ::: "memory");
        } else {
            XB_SPIN(xb_ld(&bar[XB_XGEN(b.x)]) == gen, bar);
            __builtin_amdgcn_fence(__ATOMIC_ACQUIRE, "agent");
            asm volatile("s_waitcnt vmcnt(0)" ::: "memory");
        }
    }
    __syncthreads();
}

#define WG_BAR() do { asm volatile("s_waitcnt lgkmcnt(0)" ::: "memory"); __builtin_amdgcn_s_barrier(); asm volatile("" ::: "memory"); } while (0)
#define CFENCE() asm volatile("" ::: "memory")
__device__ __forceinline__ float wave_sum(float v) {
#pragma unroll
    for (int o = 1; o < 64; o <<= 1) v += __shfl_xor(v, o);
    return v;
}
__device__ __forceinline__ f16x4 tr_read(LAS const unsigned char* p) {
    return __builtin_bit_cast(f16x4, __builtin_amdgcn_ds_read_tr16_b64_v4i16((LAS v4i16_t*)p));
}
__device__ __forceinline__ f16x8 cat8(f16x4 a, f16x4 b) { return (f16x8){a[0], a[1], a[2], a[3], b[0], b[1], b[2], b[3]}; }
__device__ __forceinline__ f16x8 pack8(const f32x16& x, int s) {
    u32x4 w; w.x = pkh(x[8 * s + 0], x[8 * s + 1]); w.y = pkh(x[8 * s + 2], x[8 * s + 3]); w.z = pkh(x[8 * s + 4], x[8 * s + 5]); w.w = pkh(x[8 * s + 6], x[8 * s + 7]);
    return __builtin_bit_cast(f16x8, w);
}

struct Frame {
    LAS unsigned char* lds;
    unsigned* ctl;
    int wave, vcu, G;
    unsigned char* ws;
};
__device__ __forceinline__ int lane_id() { int l; asm volatile("v_mbcnt_lo_u32_b32 %0, -1, 0\n\tv_mbcnt_hi_u32_b32 %0, -1, %0" : "=v"(l)); return l; }
#define PHASE_IDS() const int lane = lane_id(); const int tid = F.wave * 64 + lane; (void)tid

template <int I> __device__ __forceinline__ const void* karg() {
    const auto kp = __builtin_amdgcn_kernarg_segment_ptr();
    unsigned long long v; asm volatile("s_load_dwordx2 %0, %1, %2\n\ts_waitcnt lgkmcnt(0)" : "=s"(v) : "s"(kp), "i"(I * 8) : "memory");
    return (const void*)(const GAS char*)v;
}
#define KIN(i) ((const float*)karg<(i)>())
template <int MAP>
__device__ __forceinline__ int srccol(int n, int N) {
    if (MAP == 1) { if (n >= 2048) return n; const int p = n & 127; return (n & ~127) + (p >> 1) + 64 * (p & 1); }
    if (MAP == 2) { const int F = N >> 1, t = n >> 8, j = n & 255; return (j < 128) ? 128 * t + j : F + 128 * t + (j - 128); }
    return n;
}
template <int MAP, bool F8>
__device__ __forceinline__ void p0_transpose_item(const float* W, int K, int N, void* WT, LAS float* scr, int item, int lane) {
    const int nblk = N / 32, kb = item / nblk, nb = item % nblk, k0 = 64 * kb, n0 = 32 * nb;
    const int sc = srccol<MAP>(n0 + (lane & 31), N);
    const float* wp = W + (size_t)(k0 + (lane >> 5)) * N + sc;
    float v[32];
#pragma unroll
    for (int i = 0; i < 32; ++i) v[i] = wp[(size_t)(2 * i) * N];
#pragma unroll
    for (int i = 0; i < 32; ++i) scr[(2 * i + (lane >> 5)) * 33 + (lane & 31)] = F8 ? v[i] * F8_WSCALE : v[i];
    asm volatile("s_waitcnt lgkmcnt(0)" ::: "memory");
    if (F8) {
        const int c = lane & 3;
#pragma unroll
        for (int j = 0; j < 2; ++j) { const int n = (lane >> 2) + 16 * j; const LAS float* s = scr + (16 * c) * 33 + n;
            u32x4 o; o.x = pk4f8(s[0 * 33], s[1 * 33], s[2 * 33], s[3 * 33]); o.y = pk4f8(s[4 * 33], s[5 * 33], s[6 * 33], s[7 * 33]);
            o.z = pk4f8(s[8 * 33], s[9 * 33], s[10 * 33], s[11 * 33]); o.w = pk4f8(s[12 * 33], s[13 * 33], s[14 * 33], s[15 * 33]);
            *(u32x4*)((unsigned char*)WT + (size_t)(n0 + n) * K + k0 + 16 * c) = o; }
    } else {
        const int c = lane & 7;
#pragma unroll
        for (int j = 0; j < 4; ++j) { const int n = (lane >> 3) + 8 * j; const LAS float* s = scr + (8 * c) * 33 + n;
            u32x4 o; o.x = pkh(s[0 * 33], s[1 * 33]); o.y = pkh(s[2 * 33], s[3 * 33]); o.z = pkh(s[4 * 33], s[5 * 33]); o.w = pkh(s[6 * 33], s[7 * 33]);
            *(u32x4*)((f16*)WT + (size_t)(n0 + n) * K + k0 + 8 * c) = o; }
    }
    asm volatile("s_waitcnt lgkmcnt(0)" ::: "memory");
}
template <int MAP, bool F8>
__device__ __forceinline__ bool p0_group(int& r, const float* W, int nb, int K, int N, void* WT, LAS float* scr, int lane) {
    const int per = (K / 64) * (N / 32), tot = nb * per;
    if (r >= tot) { r -= tot; return false; }
    const int b = r / per, it = r % per;
    p0_transpose_item<MAP, F8>(W + (size_t)b * K * N, K, N, (unsigned char*)WT + (size_t)b * K * N * (F8 ? 1 : 2), scr, it, lane);
    return true;
}
__device__ __forceinline__ void p0_prologue(Frame& F) {
    PHASE_IDS();
    const int gw = F.vcu * 8 + F.wave, NGW = F.G * 8;
    LAS float* condL = (LAS float*)(F.lds);
    LAS float* scr = (LAS float*)(F.lds + 65536 + F.wave * 8448);
    for (int i = tid; i < 16 * 1024; i += 512) { const int b = i >> 10, k = i & 1023; condL[k * 16 + b] = silu_f(KIN(1)[i]); }
    WG_BAR();
    for (int it = gw; it < 1664; it += NGW) {
        const float* W; const float* bias; float* dst; int N, col0;
        if (it < 1536) { const int l = it / 384; col0 = 16 * (it % 384); N = 6144; W = KIN(3) + (size_t)l * 1024 * 6144; bias = KIN(4) + l * 6144; dst = (float*)(F.ws + WS_MOD) + (size_t)l * 16 * 6144; }
        else { col0 = 16 * (it - 1536); N = 2048; W = KIN(10); bias = KIN(11); dst = (float*)(F.ws + WS_KVMOD); }
        const int cl = lane & 3, kg = lane >> 2;
        f32x4 acc[16];
#pragma unroll
        for (int b = 0; b < 16; ++b) acc[b] = (f32x4){0.f, 0.f, 0.f, 0.f};
        const float* wp = W + (size_t)kg * N + col0 + 4 * cl;
#pragma unroll 4
        for (int k16 = 0; k16 < 64; ++k16) {
            const f32x4 w = *(const f32x4*)(wp + (size_t)k16 * 16 * N);
            const LAS f32x4* cp = (const LAS f32x4*)(condL + (16 * k16 + kg) * 16);
            const f32x4 c0 = cp[0], c1 = cp[1], c2 = cp[2], c3 = cp[3];
#pragma unroll
            for (int j = 0; j < 4; ++j) { acc[j] += c0[j] * w; acc[4 + j] += c1[j] * w; acc[8 + j] += c2[j] * w; acc[12 + j] += c3[j] * w; }
        }
        const f32x4 bv = *(const f32x4*)(bias + col0 + 4 * cl);
#pragma unroll
        for (int b = 0; b < 16; ++b) {
            f32x4 v = acc[b];
#pragma unroll
            for (int j = 0; j < 4; ++j) { v[j] += __shfl_xor(v[j], 4); v[j] += __shfl_xor(v[j], 8); v[j] += __shfl_xor(v[j], 16); v[j] += __shfl_xor(v[j], 32); }
            if (kg == 0) *(f32x4*)(dst + (size_t)b * N + col0 + 4 * cl) = v + bv;
        }
    }
    {
        const double e = -(double)lane / 64.0;
        const double invf = exp2(e * 13.287712379549449);
        float* rope = (float*)(F.ws + WS_ROPE); const int* posp = (const int*)karg<2>();
        for (int row = gw; row < MTOK; row += NGW) {
            const double rev = (double)posp[row] * invf * 0.15915494309189535;
            const float fr = (float)(rev - floor(rev));
            rope[(size_t)row * 128 + lane] = __builtin_amdgcn_cosf(fr); rope[(size_t)row * 128 + 64 + lane] = __builtin_amdgcn_sinf(fr);
        }
    }
    constexpr int per_rin = 16 * 192, per_rout = 32 * 32, per_kv = 16 * 64, per_sq = 16 * 32, per_fin = 16 * 176, per_fout = 44 * 32, per_min = 16 * 224, per_mout = 56 * 32;
    constexpr int NITEMS = 2 * per_rin + 2 * per_rout + per_kv + 4 * per_sq + 2 * per_fin + 2 * per_fout + 16 * per_min + 16 * per_mout;
    for (int it = gw; it < NITEMS; it += NGW) {
        int r = it;
        if (p0_group<1, RETIN_F8 != 0>(r, KIN(7), 1, 1024, 6144, (f16*)(F.ws + WS_W_RIN), scr, lane)) continue;
        if (p0_group<1, RETIN_F8 != 0>(r, KIN(7) + (size_t)1024 * 6144, 1, 1024, 6144, (f16*)(F.ws + WS_W_RIN) + (size_t)1024 * 6144, scr, lane)) continue;
        if (p0_group<0, false>(r, KIN(9), 2, 2048, 1024, (f16*)(F.ws + WS_W_ROUT), scr, lane)) continue;
        if (p0_group<0, false>(r, KIN(13), 1, 1024, 2048, (f16*)(F.ws + WS_W_KV), scr, lane)) continue;
        if (p0_group<0, false>(r, KIN(14), 2, 1024, 1024, (f16*)(F.ws + WS_W_SQ), scr, lane)) continue;
        if (p0_group<0, false>(r, KIN(15), 2, 1024, 1024, (f16*)(F.ws + WS_W_SO), scr, lane)) continue;
        if (p0_group<2, false>(r, KIN(16), 1, 1024, 5632, (f16*)(F.ws + WS_W_FIN), scr, lane)) continue;
        if (p0_group<2, DENSE_F8 != 0>(r, KIN(16) + (size_t)1024 * 5632, 1, 1024, 5632, (f16*)(F.ws + WS_W_FIN) + (size_t)1024 * 5632, scr, lane)) continue;
        if (p0_group<0, false>(r, KIN(17), 1, 2816, 1024, (f16*)(F.ws + WS_W_FOUT), scr, lane)) continue;
        if (p0_group<0, DENSE_F8 != 0>(r, KIN(17) + (size_t)2816 * 1024, 1, 2816, 1024, (f16*)(F.ws + WS_W_FOUT) + (size_t)2816 * 1024, scr, lane)) continue;
        if (p0_group<2, true>(r, KIN(19), 16, 1024, 7168, (f16*)(F.ws + WS_W_MIN), scr, lane)) continue;
        p0_group<0, true>(r, KIN(20), 16, 3584, 1024, (f16*)(F.ws + WS_W_MOUT), scr, lane);
    }
}

struct NormArgs {
    const float* x; float* xw; const float* gain; const float* sh; const float* sc;
    f16* h; const float* gain2; const float* kvmod; f16* hk;
    const f16* y2; const unsigned* tokslot; const float* gatef;
    float* out;
    const f16* yb;
    const float* router; unsigned* gcnt; unsigned* tokinfo;
};
template <bool COMBINE, bool KV, bool FINAL, bool ROUTER, bool H8 = false, bool ADDY = false>
__device__ __forceinline__ void norm_phase(Frame& F, const NormArgs& A) {
    PHASE_IDS();
    const int gw = F.vcu * 8 + F.wave, NGW = F.G * 8;
    LAS float* routL = (LAS float*)F.lds;
    LAS unsigned* lcnt = (LAS unsigned*)(F.lds + 32768);
    LAS unsigned* recs = (LAS unsigned*)(F.lds + 32768 + 256);
    if (ROUTER) {
        for (int i = tid; i < 8192; i += 512) routL[(i & 7) * 1024 + (i >> 3)] = A.router[i];
        if (tid < 16) lcnt[tid] = 0u;
        WG_BAR();
    }
    int nloc = 0;
    for (int row = gw; row < MTOK; row += NGW, ++nloc) {
        const int b = row >> 11;
        f32x4 v[4];
#pragma unroll
        for (int j = 0; j < 4; ++j) v[j] = *((const f32x4*)(A.x + (size_t)row * DM) + lane + 64 * j);
        if (ADDY) {
#pragma unroll
            for (int j = 0; j < 4; ++j) {
                const f16x4 y = *((const f16x4*)(A.yb + (size_t)row * DM) + lane + 64 * j);
#pragma unroll
                for (int t = 0; t < 4; ++t) v[j][t] += (float)y[t];
                *((f32x4*)(A.xw + (size_t)row * DM) + lane + 64 * j) = v[j];
            }
        }
        if (COMBINE) {
            const u32x2 sl = *(const u32x2*)(A.tokslot + 2 * (size_t)row);
            const f16* ya = A.y2 + (size_t)sl.x * DM; const f16* yb = A.y2 + (size_t)sl.y * DM;
#pragma unroll
            for (int j = 0; j < 4; ++j) {
                const f16x4 a = *((const f16x4*)ya + lane + 64 * j), c = *((const f16x4*)yb + lane + 64 * j);
                const f32x4 g = *((const f32x4*)(A.gatef + (size_t)b * 6144) + lane + 64 * j);
#pragma unroll
                for (int t = 0; t < 4; ++t) v[j][t] += g[t] * ((float)a[t] + (float)c[t]);
                if (!FINAL) *((f32x4*)(A.xw + (size_t)row * DM) + lane + 64 * j) = v[j];
            }
        }
        float ss = 0.f;
#pragma unroll
        for (int j = 0; j < 4; ++j) ss += (v[j][0] * v[j][0] + v[j][1] * v[j][1]) + (v[j][2] * v[j][2] + v[j][3] * v[j][3]);
        const float rstd = 1.0f / sqrtf(wave_sum(ss) * (1.0f / DM) + EPS);
        if (FINAL) {
#pragma unroll
            for (int j = 0; j < 4; ++j) { const f32x4 g = *((const f32x4*)A.gain + lane + 64 * j); *((f32x4*)(A.out + (size_t)row * DM) + lane + 64 * j) = v[j] * rstd * g; }
        } else {
            f32x4 hv[4];
#pragma unroll
            for (int j = 0; j < 4; ++j) {
                const f32x4 g = *((const f32x4*)A.gain + lane + 64 * j), sh = *((const f32x4*)(A.sh + (size_t)b * 6144) + lane + 64 * j), sc = *((const f32x4*)(A.sc + (size_t)b * 6144) + lane + 64 * j);
                hv[j] = (v[j] * rstd * g) * (1.0f + sc) + sh;
                if (H8) *((unsigned*)((unsigned char*)A.h + (size_t)row * DM) + lane + 64 * j) = pk4f8(hv[j][0], hv[j][1], hv[j][2], hv[j][3]);
                else { u32x2 w; w.x = pkh(hv[j][0], hv[j][1]); w.y = pkh(hv[j][2], hv[j][3]); *((u32x2*)(A.h + (size_t)row * DM) + lane + 64 * j) = w; }
            }
            if (KV) {
#pragma unroll
                for (int j = 0; j < 4; ++j) {
                    const f32x4 g = *((const f32x4*)A.gain2 + lane + 64 * j), sh = *((const f32x4*)(A.kvmod + (size_t)b * 2048) + lane + 64 * j), sc = *((const f32x4*)(A.kvmod + (size_t)b * 2048 + 1024) + lane + 64 * j);
                    const f32x4 o = (v[j] * rstd * g) * (1.0f + sc) + sh;
                    u32x2 w; w.x = pkh(o[0], o[1]); w.y = pkh(o[2], o[3]);
                    *((u32x2*)(A.hk + (size_t)row * DM) + lane + 64 * j) = w;
                }
            }
            if (ROUTER) {
                float lg[8];
#pragma unroll
                for (int e = 0; e < 8; ++e) lg[e] = 0.f;
#pragma unroll
                for (int j = 0; j < 4; ++j)
#pragma unroll
                    for (int e = 0; e < 8; ++e) {
                        const f32x4 rv = *((const LAS f32x4*)(routL + e * 1024) + lane + 64 * j);
                        lg[e] += (hv[j][0] * rv[0] + hv[j][1] * rv[1]) + (hv[j][2] * rv[2] + hv[j][3] * rv[3]);
                    }
#pragma unroll
                for (int e = 0; e < 8; ++e) lg[e] = wave_sum(lg[e]);
                int i1 = 0; float v1 = lg[0];
#pragma unroll
                for (int e = 1; e < 8; ++e) if (lg[e] > v1) { v1 = lg[e]; i1 = e; }
                int i2 = -1; float v2 = -INFINITY;
#pragma unroll
                for (int e = 0; e < 8; ++e) if (e != i1 && lg[e] > v2) { v2 = lg[e]; i2 = e; }
                const float ed = __expf(v2 - v1), w1 = 1.0f / (1.0f + ed), w2 = ed * w1;
                if (lane == 0) {
                    const unsigned p1 = __hip_atomic_fetch_add(&lcnt[i1], 1u, __ATOMIC_RELAXED, __HIP_MEMORY_SCOPE_WORKGROUP), p2 = __hip_atomic_fetch_add(&lcnt[i2], 1u, __ATOMIC_RELAXED, __HIP_MEMORY_SCOPE_WORKGROUP);
                    LAS unsigned* rc = recs + (F.wave * 16 + nloc) * 8;
                    rc[0] = (unsigned)i1; rc[1] = p1; rc[2] = (unsigned)i2; rc[3] = p2; rc[4] = __float_as_uint(w1); rc[5] = __float_as_uint(w2);
                }
            }
        }
    }
    if (ROUTER) {
        WG_BAR();
        if (tid < 8) lcnt[8 + tid] = __hip_atomic_fetch_add(A.gcnt + 64 * tid, lcnt[tid], __ATOMIC_RELAXED, __HIP_MEMORY_SCOPE_AGENT);
        WG_BAR();
        if (lane == 0) {
            int k = 0;
            for (int row = gw; row < MTOK; row += NGW, ++k) {
                const LAS unsigned* rc = recs + (F.wave * 16 + k) * 8;
                u32x4 o; o.x = rc[0]; o.y = rc[1] + lcnt[8 + rc[0]]; o.z = rc[2]; o.w = rc[3] + lcnt[8 + rc[2]];
                *(u32x4*)(A.tokinfo + 8 * (size_t)row) = o; *(u32x2*)(A.tokinfo + 8 * (size_t)row + 4) = (u32x2){rc[4], rc[5]};
            }
        }
    }
}
__device__ __forceinline__ void moe_tile_bases(const unsigned* gcnt, int (&tb)[NEXP], int& ntiles) {
    int acc = 0;
#pragma unroll
    for (int e = 0; e < NEXP; ++e) { tb[e] = acc; const unsigned c = __hip_atomic_load(gcnt + 64 * e, __ATOMIC_RELAXED, __HIP_MEMORY_SCOPE_AGENT); acc += (int)((c + 255u) >> 8); }
    ntiles = acc;
}
__device__ __forceinline__ void moe_gather(Frame& F, const unsigned* gcnt, const unsigned* tokinfo, const unsigned char* h8, unsigned char* hs8, float* slotw, unsigned* tokslot) {
    PHASE_IDS();
    const int gw = F.vcu * 8 + F.wave, NGW = F.G * 8;
    int tb[NEXP], nt; moe_tile_bases(gcnt, tb, nt);
    for (int row = gw; row < MTOK; row += NGW) {
        const u32x4 ti = *(const u32x4*)(tokinfo + 8 * (size_t)row); const u32x2 tw = *(const u32x2*)(tokinfo + 8 * (size_t)row + 4);
        int b1 = 0, b2 = 0;
#pragma unroll
        for (int e = 0; e < NEXP; ++e) { b1 = ((int)ti.x == e) ? tb[e] : b1; b2 = ((int)ti.z == e) ? tb[e] : b2; }
        const unsigned s1 = (unsigned)b1 * 256u + ti.y, s2 = (unsigned)b2 * 256u + ti.w;
        const u32x4 a = *((const u32x4*)(h8 + (size_t)row * DM) + lane);
        *((u32x4*)(hs8 + (size_t)s1 * DM) + lane) = a; *((u32x4*)(hs8 + (size_t)s2 * DM) + lane) = a;
        if (lane == 0) { slotw[s1] = __uint_as_float(tw.x); slotw[s2] = __uint_as_float(tw.y); *(u32x2*)(tokslot + 2 * (size_t)row) = (u32x2){s1, s2}; }
    }
}

constexpr int SC_PQ = 272, SC_PV = 528;
constexpr int SC_QL = 0, SC_KL = 17408, SC_VL = 34816, SC_SL = 68608, SC_ST = 136192, SC_STAGE = 0;
__device__ __forceinline__ void scan_phase(Frame& F, const f16* proj, const float* gnw, f16* ao) {
    const int unit = blockIdx.x;
    if (unit >= BATCH * RH) return;
    const int b = unit >> 3, hh = unit & 7;
    LAS unsigned char* L = F.lds;
    PHASE_IDS();
    const int wid = F.wave, rh = wid >> 2, cg = wid & 3, r = lane & 31, h = lane >> 5;
    const int gl = (lane >> 4) & 1, li = lane & 15, ta = li >> 2, tp = li & 3;
    const float lg = lg2gamma(hh);
    const float g63 = ex2(63.0f * lg), cd = ex2(64.0f * lg);
    float vm[2][4], cj[4]; const float wneg = ex2(-64.0f * lg); const int qloc = 32 * rh + r;
#pragma unroll
    for (int kt = 0; kt < 2; ++kt)
#pragma unroll
        for (int g4 = 0; g4 < 4; ++g4) vm[kt][g4] = ex2((float)(64 * kt + 16 * g4 + 8 * h - 2 * qloc - 64) * lg);
#pragma unroll
    for (int j = 0; j < 4; ++j) cj[j] = ex2((float)(2 * j) * lg);
    const size_t rowbase = (size_t)b * SEQ;
    const f16* gq = proj + rowbase * RIN + 128 * hh;
    const f16* gk = gq + 1024;
    const f16* gv = proj + rowbase * RIN + 2048 + 256 * hh;
    const f16* gg = gv + 2048;
    const int qrow = tid >> 4, qc = tid & 15;
    const int vrow = tid >> 5, vc = tid & 31;
    f32x16 SA[2][2];
#pragma unroll
    for (int et = 0; et < 2; ++et)
#pragma unroll
        for (int dd = 0; dd < 2; ++dd)
#pragma unroll
            for (int i = 0; i < 16; ++i) SA[et][dd][i] = 0.f;
    for (int i = tid; i < 128 * SC_PV / 16; i += 512) *(LAS u32x4*)(L + SC_SL + i * 16) = (u32x4){0u, 0u, 0u, 0u};
    u32x4 nq[2], nk[2], nv[4];
#pragma unroll
    for (int i = 0; i < 2; ++i) { nq[i] = *(const u32x4*)(gq + (size_t)(qrow + 32 * i) * RIN + 8 * qc); nk[i] = *(const u32x4*)(gk + (size_t)(qrow + 32 * i) * RIN + 8 * qc); }
#pragma unroll
    for (int i = 0; i < 4; ++i) nv[i] = *(const u32x4*)(gv + (size_t)(vrow + 16 * i) * RIN + 8 * vc);
#pragma unroll
    for (int i = 0; i < 2; ++i) { *(LAS u32x4*)(L + SC_QL + (qrow + 32 * i) * SC_PQ + 16 * qc) = nq[i]; *(LAS u32x4*)(L + SC_KL + (qrow + 32 * i) * SC_PQ + 16 * qc) = nk[i]; }
#pragma unroll
    for (int i = 0; i < 4; ++i) *(LAS u32x4*)(L + SC_VL + (vrow + 16 * i) * SC_PV + 16 * vc) = nv[i];
    WG_BAR();
    for (int c = 0; c < NCHUNK; ++c) {
        const size_t crow = (size_t)c * CHUNK;
        if (c + 1 < NCHUNK) {
#pragma unroll
            for (int i = 0; i < 2; ++i) { nq[i] = *(const u32x4*)(gq + (crow + 64 + qrow + 32 * i) * RIN + 8 * qc); nk[i] = *(const u32x4*)(gk + (crow + 64 + qrow + 32 * i) * RIN + 8 * qc); }
#pragma unroll
            for (int i = 0; i < 4; ++i) nv[i] = *(const u32x4*)(gv + (crow + 64 + vrow + 16 * i) * RIN + 8 * vc);
        }
        f16x8 Qf[8];
#pragma unroll
        for (int ks = 0; ks < 8; ++ks) Qf[ks] = *(const LAS f16x8*)(L + SC_QL + (32 * rh + r) * SC_PQ + (16 * ks + 8 * h) * 2);
        f16x8 Pf[2][2];
#pragma unroll
        for (int kt = 0; kt < 2; ++kt) {
            f32x16 X;
#pragma unroll
            for (int i = 0; i < 16; ++i) X[i] = 0.f;
#pragma unroll
            for (int ks = 0; ks < 8; ++ks) { const f16x8 Kf = *(const LAS f16x8*)(L + SC_KL + (32 * kt + r) * SC_PQ + (16 * ks + 8 * h) * 2); X = __builtin_amdgcn_mfma_f32_32x32x16_f16(Kf, Qf[ks], X, 0, 0, 0); }
#pragma unroll
            for (int i = 0; i < 16; ++i) { const int key = 32 * kt + (i & 3) + 8 * (i >> 2) + 4 * h; X[i] *= (key >= qloc) ? vm[kt][i >> 2] * cj[i & 3] : wneg; }
            Pf[kt][0] = pack8(X, 0); Pf[kt][1] = pack8(X, 1);
        }
        f32x16 OT[2];
#pragma unroll
        for (int et = 0; et < 2; ++et)
#pragma unroll
            for (int i = 0; i < 16; ++i) OT[et][i] = 0.f;
#pragma unroll
        for (int ks = 0; ks < 8; ++ks)
#pragma unroll
            for (int et = 0; et < 2; ++et) {
                LAS const unsigned char* sp = L + SC_SL + (16 * ks + 8 * h + ta) * SC_PV + (64 * cg + 32 * et + 16 * gl + 4 * tp) * 2;
                const f16x8 Sf = cat8(tr_read(sp), tr_read(sp + 4 * SC_PV));
                OT[et] = __builtin_amdgcn_mfma_f32_32x32x16_f16(Sf, Qf[ks], OT[et], 0, 0, 0);
            }
#pragma unroll
        for (int et = 0; et < 2; ++et)
#pragma unroll
            for (int dd = 0; dd < 2; ++dd)
#pragma unroll
                for (int i = 0; i < 16; ++i) SA[et][dd][i] *= cd;
#pragma unroll
        for (int kt = 0; kt < 2; ++kt)
#pragma unroll
            for (int s = 0; s < 2; ++s) {
                const int k0 = 32 * kt + 16 * s + 4 * h + ta;
                f16x8 Vf[2], Kt[2];
#pragma unroll
                for (int et = 0; et < 2; ++et) { LAS const unsigned char* vp = L + SC_VL + k0 * SC_PV + (64 * cg + 32 * et + 16 * gl + 4 * tp) * 2; Vf[et] = cat8(tr_read(vp), tr_read(vp + 8 * SC_PV)); }
#pragma unroll
                for (int dd = 0; dd < 2; ++dd) { LAS const unsigned char* kp = L + SC_KL + k0 * SC_PQ + (32 * (2 * rh + dd) + 16 * gl + 4 * tp) * 2; Kt[dd] = cat8(tr_read(kp), tr_read(kp + 8 * SC_PQ)); }
#pragma unroll
                for (int et = 0; et < 2; ++et) {
                    OT[et] = __builtin_amdgcn_mfma_f32_32x32x16_f16(Vf[et], Pf[kt][s], OT[et], 0, 0, 0);
#pragma unroll
                    for (int dd = 0; dd < 2; ++dd) SA[et][dd] = __builtin_amdgcn_mfma_f32_32x32x16_f16(Vf[et], Kt[dd], SA[et][dd], 0, 0, 0);
                }
            }
        float s1 = 0.f, s2 = 0.f;
#pragma unroll
        for (int et = 0; et < 2; ++et)
#pragma unroll
            for (int i = 0; i < 16; ++i) { OT[et][i] *= g63; s1 += OT[et][i]; s2 += OT[et][i] * OT[et][i]; }
        s1 += __shfl_xor(s1, 32); s2 += __shfl_xor(s2, 32);
        if (h == 0) *(LAS f32x2*)(L + SC_ST + ((rh * 4 + cg) * 32 + r) * 8) = (f32x2){s1, s2};
        WG_BAR();
        float t1 = 0.f, t2 = 0.f;
#pragma unroll
        for (int c4 = 0; c4 < 4; ++c4) { const f32x2 p = *(const LAS f32x2*)(L + SC_ST + ((rh * 4 + c4) * 32 + r) * 8); t1 += p.x; t2 += p.y; }
        const float mean = t1 * (1.0f / 256.0f), var = t2 * (1.0f / 256.0f) - mean * mean, rstd = 1.0f / sqrtf(var + EPS);
        u32x4 gc[4];
#pragma unroll
        for (int i = 0; i < 4; ++i) gc[i] = *(const u32x4*)(gg + (crow + vrow + 16 * i) * RIN + 8 * vc);
#pragma unroll
        for (int et = 0; et < 2; ++et)
#pragma unroll
            for (int dd = 0; dd < 2; ++dd)
#pragma unroll
                for (int g4 = 0; g4 < 4; ++g4) {
                    u32x2 w; w.x = pkh(SA[et][dd][4 * g4], SA[et][dd][4 * g4 + 1]); w.y = pkh(SA[et][dd][4 * g4 + 2], SA[et][dd][4 * g4 + 3]);
                    *(LAS u32x2*)(L + SC_SL + (32 * (2 * rh + dd) + r) * SC_PV + (64 * cg + 32 * et + 8 * g4 + 4 * h) * 2) = w;
                }
#pragma unroll
        for (int et = 0; et < 2; ++et)
#pragma unroll
            for (int g4 = 0; g4 < 4; ++g4) {
                u32x2 w; w.x = pkh((OT[et][4 * g4] - mean) * rstd, (OT[et][4 * g4 + 1] - mean) * rstd); w.y = pkh((OT[et][4 * g4 + 2] - mean) * rstd, (OT[et][4 * g4 + 3] - mean) * rstd);
                *(LAS u32x2*)(L + SC_STAGE + (32 * rh + r) * SC_PV + (64 * cg + 32 * et + 8 * g4 + 4 * h) * 2) = w;
            }
        WG_BAR();
        f32x4 gw0, gw1; { const float* gp = gnw + 256 * hh + 8 * vc; gw0 = *(const f32x4*)gp; gw1 = *(const f32x4*)(gp + 4); }
#pragma unroll
        for (int i = 0; i < 4; ++i) {
            const f16x8 n8 = *(const LAS f16x8*)(L + SC_STAGE + (vrow + 16 * i) * SC_PV + 16 * vc);
            const f16x8 g8 = __builtin_bit_cast(f16x8, gc[i]);
            u32x4 w;
            w.x = pkh((float)n8[0] * (float)g8[0] * gw0[0], (float)n8[1] * (float)g8[1] * gw0[1]); w.y = pkh((float)n8[2] * (float)g8[2] * gw0[2], (float)n8[3] * (float)g8[3] * gw0[3]);
            w.z = pkh((float)n8[4] * (float)g8[4] * gw1[0], (float)n8[5] * (float)g8[5] * gw1[1]); w.w = pkh((float)n8[6] * (float)g8[6] * gw1[2], (float)n8[7] * (float)g8[7] * gw1[3]);
            *(u32x4*)(ao + (rowbase + crow + vrow + 16 * i) * 2048 + 256 * hh + 8 * vc) = w;
        }
        WG_BAR();
        if (c + 1 < NCHUNK) {
#pragma unroll
            for (int i = 0; i < 2; ++i) { *(LAS u32x4*)(L + SC_QL + (qrow + 32 * i) * SC_PQ + 16 * qc) = nq[i]; *(LAS u32x4*)(L + SC_KL + (qrow + 32 * i) * SC_PQ + 16 * qc) = nk[i]; }
#pragma unroll
            for (int i = 0; i < 4; ++i) *(LAS u32x4*)(L + SC_VL + (vrow + 16 * i) * SC_PV + 16 * vc) = nv[i];
        }
        WG_BAR();
    }
}

constexpr int SBV_P = 144;
constexpr float SB_STOP = 7.8886090522101181e-31f;
__device__ __forceinline__ void sb_phase(Frame& F, const f16* Q, const f16* Kc, const f16* Vc, f16* O) {
    PHASE_IDS();
    const int gw = F.vcu * 8 + F.wave, NGW = F.G * 8, r = lane & 31, h = lane >> 5;
    const int gl = (lane >> 4) & 1, li = lane & 15, ta = li >> 2, tp = li & 3;
    LAS unsigned char* Vw = F.lds + F.wave * (32 * SBV_P);
    const int vr = lane >> 3, vcc = lane & 7;
    for (int u = gw; u < BATCH * SBH * (SEQ / 32); u += NGW) {
        const int qblk = u & 63, bh = u >> 6, b = bh >> 4, hd = bh & 15;
        const size_t rb = (size_t)b * SEQ;
        const f16* qp = Q + (rb + 32 * qblk + r) * DM + 64 * hd + 8 * h;
        f16x8 Qf[4];
#pragma unroll
        for (int ks = 0; ks < 4; ++ks) Qf[ks] = *(const f16x8*)(qp + 16 * ks);
        f32x16 OT[2];
#pragma unroll
        for (int dt = 0; dt < 2; ++dt)
#pragma unroll
            for (int i = 0; i < 16; ++i) OT[dt][i] = 0.f;
        float carry = 1.0f;
        u32x4 kn[4], vn[4];
        { const f16* kp = Kc + (rb + 32 * qblk + r) * DM + 64 * hd + 8 * h; const f16* vp = Vc + (rb + 32 * qblk + vr) * DM + 64 * hd + 8 * vcc;
#pragma unroll
          for (int i = 0; i < 4; ++i) { kn[i] = *(const u32x4*)(kp + 16 * i); vn[i] = *(const u32x4*)(vp + (size_t)(8 * i) * DM); } }
        for (int kt = qblk; kt >= 0; --kt) {
            f16x8 Kf[4];
#pragma unroll
            for (int i = 0; i < 4; ++i) { Kf[i] = __builtin_bit_cast(f16x8, kn[i]); *(LAS u32x4*)(Vw + (vr + 8 * i) * SBV_P + 16 * vcc) = vn[i]; }
            CFENCE();
            if (kt > 0) { const f16* kp = Kc + (rb + 32 * (kt - 1) + r) * DM + 64 * hd + 8 * h; const f16* vp = Vc + (rb + 32 * (kt - 1) + vr) * DM + 64 * hd + 8 * vcc;
#pragma unroll
                for (int i = 0; i < 4; ++i) { kn[i] = *(const u32x4*)(kp + 16 * i); vn[i] = *(const u32x4*)(vp + (size_t)(8 * i) * DM); } }
            f32x16 S;
#pragma unroll
            for (int i = 0; i < 16; ++i) S[i] = 0.f;
#pragma unroll
            for (int ks = 0; ks < 4; ++ks) S = __builtin_amdgcn_mfma_f32_32x32x16_f16(Kf[ks], Qf[ks], S, 0, 0, 0);
            float om[16];
            const bool diag = (kt == qblk);
#pragma unroll
            for (int i = 0; i < 16; ++i) {
                const int kl = (i & 3) + 8 * (i >> 2) + 4 * h;
                float o = __builtin_amdgcn_rcpf(1.0f + ex2(S[i]));
                if (diag && kl >= r) o = 1.0f;
                om[i] = o;
            }
            float sfx[16], T[4];
#pragma unroll
            for (int g4 = 0; g4 < 4; ++g4) { sfx[4 * g4 + 3] = 1.0f; sfx[4 * g4 + 2] = om[4 * g4 + 3]; sfx[4 * g4 + 1] = sfx[4 * g4 + 2] * om[4 * g4 + 2]; sfx[4 * g4] = sfx[4 * g4 + 1] * om[4 * g4 + 1]; T[g4] = sfx[4 * g4] * om[4 * g4]; }
            float E[4]; float run = carry;
#pragma unroll
            for (int g4 = 3; g4 >= 0; --g4) {
                const float tl = __shfl(T[g4], r), th = __shfl(T[g4], r + 32);
                const float e_hi = run; run *= th; const float e_lo = run; run *= tl;
                E[g4] = h ? e_hi : e_lo;
            }
            carry = run;
            f32x16 Aw;
#pragma unroll
            for (int i = 0; i < 16; ++i) Aw[i] = (1.0f - om[i]) * (E[i >> 2] * sfx[i]);
            const f16x8 Af0 = pack8(Aw, 0), Af1 = pack8(Aw, 1);
            CFENCE();
#pragma unroll
            for (int dt = 0; dt < 2; ++dt) {
                LAS const unsigned char* vp = Vw + (4 * h + ta) * SBV_P + (32 * dt + 16 * gl + 4 * tp) * 2;
                const f16x8 V0 = cat8(tr_read(vp), tr_read(vp + 8 * SBV_P)), V1 = cat8(tr_read(vp + 16 * SBV_P), tr_read(vp + 24 * SBV_P));
                OT[dt] = __builtin_amdgcn_mfma_f32_32x32x16_f16(V0, Af0, OT[dt], 0, 0, 0);
                OT[dt] = __builtin_amdgcn_mfma_f32_32x32x16_f16(V1, Af1, OT[dt], 0, 0, 0);
            }
            CFENCE();
            if (__ballot(carry > SB_STOP) == 0ull) break;
        }
        f16* op = O + (rb + 32 * qblk + r) * DM + 64 * hd + 4 * h;
#pragma unroll
        for (int dt = 0; dt < 2; ++dt)
#pragma unroll
            for (int g4 = 0; g4 < 4; ++g4) { u32x2 w; w.x = pkh(OT[dt][4 * g4], OT[dt][4 * g4 + 1]); w.y = pkh(OT[dt][4 * g4 + 2], OT[dt][4 * g4 + 3]); *(u32x2*)(op + 32 * dt + 8 * g4) = w; }
    }
}

struct Args { const void* in[22]; float* out; unsigned char* ws; int ph_lo, ph_hi; };
constexpr int N_PHASES = 34;
#define IN(k) (lo <= (k) && (k) < hi)
#define SEAM(k) do { if (IN((k) + 1)) { if (!MK_PER_PHASE) xcd_barrier(bar); } } while (0)
#define WSP(T, off) ((T*)(F.ws + (off)))
#define REPS(cond) _Pragma("unroll") for (int rep_ = 0; rep_ < ((cond) ? 2 : 1); ++rep_)
#define REPBAR() do { if (rep_) xcd_barrier(bar); } while (0)
template <int L> __device__ __forceinline__ void layer_phases(Frame& F, const XcdBarrier& bar, const int lo, const int hi) {
    constexpr int pb = 1 + 8 * L;
        if (IN(pb + 0) && !DIS_K0) {
            const float* modL = WSP(const float, WS_MOD) + (size_t)L * 16 * 6144;
            NormArgs A{}; A.x = (L == 0) ? KIN(0) : WSP(const float, WS_X); A.xw = WSP(float, WS_X); A.gain = KIN(5) + L * DM; A.sh = modL; A.sc = modL + 1024; A.h = WSP(f16, WS_H);
            if constexpr (L == 2) {
                A.y2 = WSP(const f16, WS_Y2); A.tokslot = WSP(const unsigned, WS_TOKSLOT); A.gatef = WSP(const float, WS_MOD) + (size_t)(L - 1) * 16 * 6144 + 5120;
                A.gain2 = KIN(12); A.kvmod = WSP(const float, WS_KVMOD); A.hk = WSP(f16, WS_HK); REPS(PROBE_DUP == 15) { REPBAR(); if (rep_) { A.xw = WSP(float, WS_BIG + 320 * MiB); A.h = WSP(f16, WS_BIG + 448 * MiB); A.hk = WSP(f16, WS_BIG + 512 * MiB); } norm_phase<true, true, false, false>(F, A); }
            } else REPS(PROBE_DUP == 7 && L == 1) { REPBAR(); A.yb = WSP(const f16, WS_YB); if (rep_) A.xw = WSP(float, WS_BIG + 320 * MiB); norm_phase<false, false, false, false, (RETIN_F8 != 0 && L < 2), (L == 1 || L == 3)>(F, A); }
            SEAM(pb + 0);
        }
        if (IN(pb + 1) && !DIS_K1) {
            if constexpr (L < 2) {
                pg8::Gemm g{WSP(const unsigned char, WS_H), WSP(const unsigned char, WS_W_RIN) + (size_t)L * RIN * DM * 2, MTOK, RIN, DM, 0}; pg8::Order S; S.init(MTOK, RIN, F.G, (int)blockIdx.x);
                pg8::EpiRetIn E{WSP(f16, WS_PROJ), WSP(const float, WS_ROPE), RETIN_F8 ? 1.0f / F8_WSCALE : 1.0f};
                REPS(PROBE_DUP == 6 && L == 1) { REPBAR(); pg8::gemm_phase<pg8::EpiRetIn, RETIN_F8 != 0>(F.lds, g, S, E); }
            } else REPS(PROBE_DUP == 12 && L == 2) { REPBAR();
                { pg8::Gemm g{WSP(const f16, WS_H), WSP(const f16, WS_W_SQ) + (size_t)(L - 2) * DM * DM, MTOK, DM, DM, 0}; pg8::Order S; S.init(MTOK, DM, F.G, (int)blockIdx.x);
                  pg8::EpiF16 E{WSP(f16, WS_SQ), DM, 0, 0, 0.125f * 1.4426950408889634f};
                  pg8::gemm_phase<pg8::EpiF16>(F.lds, g, S, E); }
                if constexpr (L == 2) { pg8::Gemm g{WSP(const f16, WS_HK), WSP(const f16, WS_W_KV), MTOK, 2048, DM, 0}; pg8::Order S; S.init(MTOK, 2048, F.G, (int)blockIdx.x);
                  pg8::EpiF16 E{WSP(f16, WS_KSH), DM, 1024, (size_t)(WS_VSH - WS_KSH) / 2, 1.0f};
                  pg8::gemm_phase<pg8::EpiF16>(F.lds, g, S, E); }
            }
            SEAM(pb + 1);
        }
        if (IN(pb + 2) && !DIS_K2) {
#ifndef NO_SCAN
            if constexpr (L < 2) REPS(PROBE_DUP == 2 && L == 1) { REPBAR(); scan_phase(F, WSP(const f16, WS_PROJ), KIN(8) + L * 2048, WSP(f16, WS_AO)); }
#endif
#ifndef NO_SB
            if constexpr (L >= 2) REPS(PROBE_DUP == 3 && L == 3) { REPBAR(); sb_phase(F, WSP(const f16, WS_SQ), WSP(const f16, WS_KSH), WSP(const f16, WS_VSH), WSP(f16, WS_SO)); }
#endif
            SEAM(pb + 2);
        }
        if (IN(pb + 3) && !DIS_K3) {
            pg8::Gemm g;
            if constexpr (L < 2) g = pg8::Gemm{WSP(const f16, WS_AO), WSP(const f16, WS_W_ROUT) + (size_t)L * DM * 2048, MTOK, DM, 2048, 0};
            else g = pg8::Gemm{WSP(const f16, WS_SO), WSP(const f16, WS_W_SO) + (size_t)(L - 2) * DM * DM, MTOK, DM, DM, 0};
            pg8::Order S; S.init(MTOK, DM, F.G, (int)blockIdx.x);
            pg8::EpiY E{WSP(f16, WS_YB), WSP(const float, WS_MOD) + (size_t)L * 16 * 6144 + 2048, 1.0f};
            REPS(PROBE_DUP == 9 && L == 1) { REPBAR(); pg8::gemm_phase<pg8::EpiY>(F.lds, g, S, E); }
            SEAM(pb + 3);
        }
        if (IN(pb + 4) && !DIS_K4) {
            const float* modL = WSP(const float, WS_MOD) + (size_t)L * 16 * 6144;
            NormArgs A{}; A.x = (L == 0) ? KIN(0) : WSP(const float, WS_X); A.xw = WSP(float, WS_X); A.gain = KIN(6) + L * DM; A.sh = modL + 3072; A.sc = modL + 4096; A.h = WSP(f16, WS_H); A.yb = WSP(const f16, WS_YB);
            if constexpr (L & 1) { A.router = KIN(18) + (size_t)(L >> 1) * DM * NEXP; A.gcnt = F.ctl + CW_MOE + (L >> 1) * 1024; A.tokinfo = WSP(unsigned, WS_TOKINFO); REPS(PROBE_DUP == 13 && L == 3) { REPBAR(); if (rep_) { A.gcnt = F.ctl + CW_MOE + 4096; A.tokinfo = WSP(unsigned, WS_TOKINFO + MiB); A.xw = WSP(float, WS_BIG + 320 * MiB); } norm_phase<false, false, false, true, true, true>(F, A); } }
            else norm_phase<false, false, false, false, DF8(L), true>(F, A);
            SEAM(pb + 4);
        }
        if constexpr (L & 1) if (IN(pb + 5) && !DIS_K5) {
            REPS(PROBE_DUP == 8 && L == 3) { REPBAR(); moe_gather(F, F.ctl + CW_MOE + (L >> 1) * 1024, WSP(const unsigned, WS_TOKINFO), WSP(const unsigned char, WS_H), WSP(unsigned char, WS_HS), WSP(float, WS_SLOTW), WSP(unsigned, WS_TOKSLOT)); }
            SEAM(pb + 5);
        }
        if (IN(pb + 6) && !DIS_K6) {
            const int mi = L >> 1;
            pg8::Order S;
            if constexpr (L & 1) {
                int tb[NEXP], ntl; moe_tile_bases(F.ctl + CW_MOE + mi * 1024, tb, ntl);
                S.init(ntl * 256, 2 * FFE, F.G, (int)blockIdx.x);
#pragma unroll
                for (int e = 0; e < NEXP; ++e) S.tb[e] = tb[e];
                pg8::Gemm g{WSP(const unsigned char, WS_HS), WSP(const unsigned char, WS_W_MIN) + (size_t)mi * NEXP * 2 * FFE * DM, ntl * 256, 2 * FFE, DM, (size_t)2 * FFE * DM};
                pg8::EpiGlu<true> E{WSP(unsigned char, WS_ACTE), FFE};
                REPS(PROBE_DUP == 4 && L == 3) { REPBAR(); pg8::gemm_phase<pg8::EpiGlu<true>, true>(F.lds, g, S, E); }
            } else {
                S.init(MTOK, 2 * FFD, F.G, (int)blockIdx.x);
                pg8::Gemm g{WSP(const unsigned char, WS_H), WSP(const unsigned char, WS_W_FIN) + (size_t)mi * 2 * FFD * DM * 2, MTOK, 2 * FFD, DM, 0};
                pg8::EpiGlu<DF8(L)> E{WSP(unsigned char, WS_ACTD), FFD};
                REPS(PROBE_DUP == 10 && L == 2) { REPBAR(); pg8::gemm_phase<pg8::EpiGlu<DF8(L)>, DF8(L)>(F.lds, g, S, E); }
            }
            SEAM(pb + 6);
        }
        if (IN(pb + 7) && !DIS_K7) {
            const int mi = L >> 1;
            if constexpr (L & 1) {
                int tb[NEXP], ntl; moe_tile_bases(F.ctl + CW_MOE + mi * 1024, tb, ntl);
                pg8::Order S; S.init(ntl * 256, DM, F.G, (int)blockIdx.x);
#pragma unroll
                for (int e = 0; e < NEXP; ++e) S.tb[e] = tb[e];
                pg8::Gemm g{WSP(const unsigned char, WS_ACTE), WSP(const unsigned char, WS_W_MOUT) + (size_t)mi * NEXP * DM * FFE, ntl * 256, DM, FFE, (size_t)DM * FFE};
                pg8::EpiMoeOut E{WSP(f16, WS_Y2), WSP(const float, WS_SLOTW)};
                REPS(PROBE_DUP == 5 && L == 3) { REPBAR(); pg8::gemm_phase<pg8::EpiMoeOut, true>(F.lds, g, S, E); }
            } else {
                pg8::Order S; S.init(MTOK, DM, F.G, (int)blockIdx.x);
                pg8::Gemm g{WSP(const unsigned char, WS_ACTD), WSP(const unsigned char, WS_W_FOUT) + (size_t)mi * DM * FFD * 2, MTOK, DM, FFD, 0};
                pg8::EpiY E{WSP(f16, WS_YB), WSP(const float, WS_MOD) + (size_t)L * 16 * 6144 + 5120, DF8(L) ? 1.0f / (F8_WSCALE * F8_ASCALE) : 1.0f};
                REPS(PROBE_DUP == 11 && L == 2) { REPBAR(); pg8::gemm_phase<pg8::EpiY, DF8(L)>(F.lds, g, S, E); }
            }
            SEAM(pb + 7);
        }
}
__global__ void __launch_bounds__(512, 2) mk_fwd(Args args) {
    extern __shared__ __attribute__((aligned(16))) unsigned char lds_raw[];
    Frame F;
    F.lds = (LAS unsigned char*)lds_raw;
    F.wave = __builtin_amdgcn_readfirstlane((int)threadIdx.x >> 6);
    F.G = gridDim.x; { const int bx = blockIdx.x; F.vcu = (F.G % 8 == 0) ? (bx % 8) * (F.G / 8) + bx / 8 : bx; }
    F.ws = args.ws; F.ctl = (unsigned*)(args.ws + WS_CTL);
    volatile LAS unsigned* MISC = (volatile LAS unsigned*)(F.lds + MISC_OFF);
    if (threadIdx.x < 64) ((LAS unsigned*)(F.lds + MISC_OFF))[threadIdx.x] = 0u;
    __syncthreads();
    XcdBarrier bar; bar.bar = F.ctl + CW_BAR; bar.x = 0; bar.st = nullptr;
    if (!MK_PER_PHASE) bar = xcd_barrier_post(F.ctl + CW_BAR, MISC + 8);
    const int lo = args.ph_lo, hi = args.ph_hi;

    if (IN(0)) {
#ifndef NO_P0
        REPS(PROBE_DUP == 1) { REPBAR(); p0_prologue(F); }
#endif
        SEAM(0);
    }
    layer_phases<0>(F, bar, lo, hi); layer_phases<1>(F, bar, lo, hi); layer_phases<2>(F, bar, lo, hi); layer_phases<3>(F, bar, lo, hi);
    if (IN(33)) {
        NormArgs A{}; A.x = WSP(const float, WS_X); A.xw = WSP(float, WS_X); A.gain = KIN(21); A.out = (float*)karg<22>();
        A.y2 = WSP(const f16, WS_Y2); A.tokslot = WSP(const unsigned, WS_TOKSLOT); A.gatef = WSP(const float, WS_MOD) + (size_t)3 * 16 * 6144 + 5120;
        REPS(PROBE_DUP == 14) { REPBAR(); norm_phase<true, false, true, false>(F, A); }
    }
#undef IN
#undef SEAM
#undef WSP
}

extern "C" void kernel_launch(void* const* d_in, const int* in_sizes, int n_in, void* d_out, int out_size, void* d_ws, size_t ws_size, hipStream_t stream) {
    static int grid = 0;
    if (grid == 0) {
        if (n_in != 22 || out_size != MTOK * DM || ws_size < WS_END) { fprintf(stderr, "kernel_launch: unexpected shapes (n_in %d out %d ws %zu, need %zu)\n", n_in, out_size, ws_size, (size_t)WS_END); grid = -1; return; }
        int dev = 0, cus = 0;
        if (hipGetDevice(&dev) != hipSuccess || hipDeviceGetAttribute(&cus, hipDeviceAttributeMultiprocessorCount, dev) != hipSuccess) { grid = -1; return; }
        if (hipFuncSetAttribute((const void*)mk_fwd, hipFuncAttributeMaxDynamicSharedMemorySize, LDS_BYTES) != hipSuccess) { fprintf(stderr, "kernel_launch: hipFuncSetAttribute failed\n"); grid = -1; return; }
        int per_cu = 0;
        if (hipOccupancyMaxActiveBlocksPerMultiprocessor(&per_cu, (const void*)mk_fwd, 512, LDS_BYTES) != hipSuccess || per_cu < 1) fprintf(stderr, "kernel_launch: occupancy query reports %d\n", per_cu);
        (void)hipGetLastError();
        if (cus < 256) { fprintf(stderr, "kernel_launch: needs >= 256 CUs, got %d\n", cus); grid = -1; return; }
        grid = cus;
    }
    if (grid < 0) return;
    (void)hipMemsetAsync((char*)d_ws + WS_CTL, 0, CTL_ZERO_BYTES, stream);
    Args a{};
    for (int i = 0; i < 22; ++i) a.in[i] = d_in[i];
    a.out = (float*)d_out; a.ws = (unsigned char*)d_ws;
#if MK_PER_PHASE
    for (int p = 0; p < N_PHASES; ++p) {
        if (p >= 1 && p <= 32) { const int L = (p - 1) / 8, k = (p - 1) % 8; if (k == 5 && !(L & 1)) continue; }
        a.ph_lo = p; a.ph_hi = p + 1;
        hipLaunchKernelGGL(mk_fwd, dim3(grid), dim3(512), LDS_BYTES, stream, a);
    }
#else
    a.ph_lo = 0; a.ph_hi = N_PHASES;
    hipLaunchKernelGGL(mk_fwd, dim3(grid), dim3(512), LDS_BYTES, stream, a);
#endif
}
```

```cpp
#include <hip/hip_runtime.h>
#include <cstdio>
#include <cstdint>

#define LAS __attribute__((address_space(3)))
#define GAS __attribute__((address_space(1)))
typedef _Float16 f16;
typedef _Float16 f16x2 __attribute__((ext_vector_type(2)));
typedef _Float16 f16x4 __attribute__((ext_vector_type(4)));
typedef _Float16 f16x8 __attribute__((ext_vector_type(8)));
typedef float f32x2 __attribute__((ext_vector_type(2)));
typedef float f32x4 __attribute__((ext_vector_type(4)));
typedef float f32x16 __attribute__((ext_vector_type(16)));
typedef unsigned u32x2 __attribute__((ext_vector_type(2)));
typedef unsigned u32x4 __attribute__((ext_vector_type(4)));
typedef short v4i16_t __attribute__((ext_vector_type(4)));
typedef int i32x8 __attribute__((ext_vector_type(8)));
typedef int i32x4 __attribute__((ext_vector_type(4)));

#ifndef DIS_K0
#define DIS_K0 0
#endif
#ifndef DIS_K1
#define DIS_K1 0
#endif
#ifndef DIS_K2
#define DIS_K2 0
#endif
#ifndef DIS_K3
#define DIS_K3 0
#endif
#ifndef DIS_K4
#define DIS_K4 0
#endif
#ifndef DIS_K5
#define DIS_K5 0
#endif
#ifndef DIS_K6
#define DIS_K6 0
#endif
#ifndef DIS_K7
#define DIS_K7 0
#endif
#ifndef PROBE_DUP
#define PROBE_DUP 0
#endif
#ifndef DENSE_F8
#define DENSE_F8 0
#define DF8(L) (DENSE_F8 != 0 && (L) == 2)
#endif
#ifndef RETIN_F8
#define RETIN_F8 0
#endif
#ifndef MK_PER_PHASE
#define MK_PER_PHASE 0
#endif

constexpr int BATCH = 16, SEQ = 2048, DM = 1024, MTOK = BATCH * SEQ;
constexpr int RH = 8, RDK = 128, RDV = 256, RIN = 6144, CHUNK = 64, NCHUNK = SEQ / CHUNK;
constexpr int SBH = 16, SDH = 64;
constexpr int FFD = 2816, NEXP = 8, FFE = 3584;
constexpr float EPS = 1e-6f;
constexpr int MOE_ROWS_MAX = 2 * MTOK + NEXP * 256;

__device__ __forceinline__ float lg2gamma(int h) {
    const float t[8] = {-4.580368961312e-02f, -2.272007650008e-02f, -1.131531322783e-02f, -5.646563141142e-03f, -2.820519062379e-03f, -1.409570254671e-03f, -7.046129765894e-04f, -3.522634716290e-04f};
    float r = t[0];
#pragma unroll
    for (int i = 1; i < 8; ++i) r = (h == i) ? t[i] : r;
    return r;
}
__device__ __forceinline__ unsigned pkh(float lo, float hi) { f32x2 v = {lo, hi}; f16x2 h = __builtin_convertvector(v, f16x2); return __builtin_bit_cast(unsigned, h); }
__device__ __forceinline__ float silu_f(float x) { return x * __builtin_amdgcn_rcpf(1.0f + __builtin_amdgcn_exp2f(-1.4426950408889634f * x)); }
__device__ __forceinline__ float ex2(float x) { return __builtin_amdgcn_exp2f(x); }
__device__ __forceinline__ unsigned pk4f8(float a, float b, float c, float d) { int w = 0; w = __builtin_amdgcn_cvt_pk_fp8_f32(a, b, w, false); w = __builtin_amdgcn_cvt_pk_fp8_f32(c, d, w, true); return (unsigned)w; }
constexpr float F8_WSCALE = 64.0f;
constexpr float F8_ASCALE = 4.0f;

namespace pg8 {
constexpr int BM = 256, BK = 64, HALF = 128, HTB = HALF * BK * 2, STAGE_BYTES = 8 * HTB, NXCD = 8, WGM = 8;
__host__ __device__ __forceinline__ int lds_byte(int r, int c) { const int st = (r >> 4) * 2 + (c >> 5), rr = r & 15, cc = c & 31, ob = rr * 64 + cc * 2; return st * 1024 + (ob ^ (((ob >> 9) & 1) << 5)); }
__host__ __device__ __forceinline__ void stage_rc(int b, int& R, int& C) { const int st = b / 1024, sb = b % 1024, swz = sb ^ (((sb >> 9) & 1) << 5); R = (st >> 1) * 16 + swz / 64; C = (st & 1) * 32 + (swz % 64) / 2; }
__host__ __device__ __forceinline__ int perm32(int rho) { const int n = rho >> 4, i = rho & 15; return 8 * (i >> 2) + 4 * n + (i & 3); }

struct Unit { int pm, pn, be; };
struct Gemm { const void* A; const void* Bt; int M, N, K; size_t bstride; };

struct Order {
    int nM, nN, nwg, G, c; int tb[NEXP];
    __device__ void init(int M, int N, int G_, int c_) { nM = M / BM; nN = N / BM; nwg = nM * nN; G = G_; c = c_;
#pragma unroll
        for (int e = 0; e < NEXP; ++e) tb[e] = e ? 0x7fffffff : 0; }
    __device__ bool next(int i, Unit& u) const {
        const long L = (long)i * G + c; if (L >= nwg) return false;
        int wgid = (int)L; { const int q = nwg / NXCD, r = nwg % NXCD, xcd = wgid % NXCD, off = wgid / NXCD; wgid = (xcd < r ? xcd * (q + 1) : r * (q + 1) + (xcd - r) * q) + off; }
        const int nig = WGM * nN, gid = wgid / nig, fm = gid * WGM, gsz = (nM - fm) < WGM ? (nM - fm) : WGM;
        u.pm = fm + ((wgid % nig) % gsz); u.pn = (wgid % nig) / gsz;
        int be = 0;
#pragma unroll
        for (int e = 1; e < NEXP; ++e) be += (u.pm >= tb[e]) ? 1 : 0;
        u.be = be; return true;
    }
};


struct EpiRetIn {
    static constexpr bool PERM = true;
    f16* O; const float* rope; float scl;
    __device__ __forceinline__ void operator()(const f32x4 (&acc)[2][2][4][2], const Unit& u, int wr, int wc, int fr, int fq) const {
        const int row0 = u.pm * BM + wr * 64 + fr, cl = wc * 32 + 8 * fq;
        f16* base = O + (size_t)u.pn * BM + cl;
        if (u.pn < 8) {
            const bool isk = u.pn >= 4; const int i0 = cl >> 1;
            float lg[2]; lg[0] = lg2gamma(2 * (u.pn & 3)); lg[1] = lg2gamma(2 * (u.pn & 3) + 1);
#pragma unroll
            for (int ai = 0; ai < 2; ++ai)
#pragma unroll
                for (int m = 0; m < 4; ++m) {
                    const int row = row0 + ai * HALF + m * 16; const float pos = (float)(16 * m + fr);
                    const f32x4 cs = *(const f32x4*)(rope + (size_t)row * 128 + i0), sn = *(const f32x4*)(rope + (size_t)row * 128 + 64 + i0);
#pragma unroll
                    for (int bj = 0; bj < 2; ++bj) {
                        const float sc = (isk ? ex2(-pos * lg[bj]) * 0.08838834764831845f : ex2((pos + 1.0f) * lg[bj])) * scl;
                        const f32x4 v0 = acc[ai][bj][m][0], v1 = acc[ai][bj][m][1];
                        u32x4 w;
                        w.x = pkh((v0[0] * cs[0] - v0[1] * sn[0]) * sc, (v0[0] * sn[0] + v0[1] * cs[0]) * sc);
                        w.y = pkh((v0[2] * cs[1] - v0[3] * sn[1]) * sc, (v0[2] * sn[1] + v0[3] * cs[1]) * sc);
                        w.z = pkh((v1[0] * cs[2] - v1[1] * sn[2]) * sc, (v1[0] * sn[2] + v1[1] * cs[2]) * sc);
                        w.w = pkh((v1[2] * cs[3] - v1[3] * sn[3]) * sc, (v1[2] * sn[3] + v1[3] * cs[3]) * sc);
                        *(u32x4*)(base + (size_t)row * RIN + bj * HALF) = w;
                    }
                }
        } else {
            const bool isg = u.pn >= 16;
#pragma unroll
            for (int ai = 0; ai < 2; ++ai)
#pragma unroll
                for (int m = 0; m < 4; ++m) {
                    const int row = row0 + ai * HALF + m * 16;
#pragma unroll
                    for (int bj = 0; bj < 2; ++bj) {
                        f32x4 v0 = acc[ai][bj][m][0] * scl, v1 = acc[ai][bj][m][1] * scl;
                        if (isg) {
#pragma unroll
                            for (int j = 0; j < 4; ++j) { v0[j] = silu_f(v0[j]); v1[j] = silu_f(v1[j]); } }
                        u32x4 w; w.x = pkh(v0[0], v0[1]); w.y = pkh(v0[2], v0[3]); w.z = pkh(v1[0], v1[1]); w.w = pkh(v1[2], v1[3]);
                        *(u32x4*)(base + (size_t)row * RIN + bj * HALF) = w;
                    }
                }
        }
    }
};
struct EpiY {
    static constexpr bool PERM = true;
    f16* Y; const float* gate; float scl;
    __device__ __forceinline__ void operator()(const f32x4 (&acc)[2][2][4][2], const Unit& u, int wr, int wc, int fr, int fq) const {
        const int row0 = u.pm * BM + wr * 64 + fr, col0 = u.pn * BM + wc * 32 + 8 * fq;
        const float* gp = gate + (size_t)(u.pm >> 3) * 6144 + col0;
        f32x4 gv[2][2];
#pragma unroll
        for (int bj = 0; bj < 2; ++bj)
#pragma unroll
            for (int n = 0; n < 2; ++n) gv[bj][n] = *(const f32x4*)(gp + bj * HALF + 4 * n) * scl;
#pragma unroll
        for (int ai = 0; ai < 2; ++ai)
#pragma unroll
            for (int m = 0; m < 4; ++m) { f16* rowp = Y + (size_t)(row0 + ai * HALF + m * 16) * DM + col0;
#pragma unroll
                for (int bj = 0; bj < 2; ++bj) { const f32x4 v0 = acc[ai][bj][m][0] * gv[bj][0], v1 = acc[ai][bj][m][1] * gv[bj][1];
                    u32x4 w; w.x = pkh(v0[0], v0[1]); w.y = pkh(v0[2], v0[3]); w.z = pkh(v1[0], v1[1]); w.w = pkh(v1[2], v1[3]);
                    *(u32x4*)(rowp + bj * HALF) = w; } }
    }
};
template <bool F8> struct EpiGlu {
    static constexpr bool PERM = true;
    void* Ov; int ldc;
    __device__ __forceinline__ void operator()(const f32x4 (&acc)[2][2][4][2], const Unit& u, int wr, int wc, int fr, int fq) const {
        const int row0 = u.pm * BM + wr * 64 + fr, col0 = u.pn * HALF + wc * 32 + 8 * fq;
        constexpr float si = F8 ? 1.0f / F8_WSCALE : 1.0f, so = F8 ? F8_ASCALE : 1.0f;
#pragma unroll
        for (int ai = 0; ai < 2; ++ai)
#pragma unroll
            for (int m = 0; m < 4; ++m) {
                float r[8];
#pragma unroll
                for (int n = 0; n < 2; ++n)
#pragma unroll
                    for (int p = 0; p < 2; ++p) {
                        const f32x2 a = {acc[ai][0][m][n][2 * p], acc[ai][0][m][n][2 * p + 1]}, b = {acc[ai][1][m][n][2 * p], acc[ai][1][m][n][2 * p + 1]};
                        const f32x2 t = a * (-1.4426950408889634f * si); f32x2 d = {ex2(t.x), ex2(t.y)}; d = d + 1.0f;
                        const f32x2 u = {__builtin_amdgcn_rcpf(d.x), __builtin_amdgcn_rcpf(d.y)};
                        const f32x2 q = ((a * b) * u) * (si * si * so);
                        r[4 * n + 2 * p] = q.x; r[4 * n + 2 * p + 1] = q.y;
                    }
                if (F8) { u32x2 w; w.x = pk4f8(r[0], r[1], r[2], r[3]); w.y = pk4f8(r[4], r[5], r[6], r[7]);
                    *(u32x2*)((unsigned char*)Ov + (size_t)(row0 + ai * HALF + m * 16) * ldc + col0) = w; }
                else { u32x4 w; w.x = pkh(r[0], r[1]); w.y = pkh(r[2], r[3]); w.z = pkh(r[4], r[5]); w.w = pkh(r[6], r[7]);
                    *(u32x4*)((f16*)Ov + (size_t)(row0 + ai * HALF + m * 16) * ldc + col0) = w; }
            }
    }
};
struct EpiF16 {
    static constexpr bool PERM = true;
    f16* O; int ldc; int split_cols; size_t split_stride; float scale;
    __device__ __forceinline__ void operator()(const f32x4 (&acc)[2][2][4][2], const Unit& u, int wr, int wc, int fr, int fq) const {
        const int row0 = u.pm * BM + wr * 64 + fr; int colt = u.pn * BM; f16* base = O;
        if (split_cols) { const int t = colt / split_cols; base += (size_t)t * split_stride; colt -= t * split_cols; }
        const int col0 = colt + wc * 32 + 8 * fq;
#pragma unroll
        for (int ai = 0; ai < 2; ++ai)
#pragma unroll
            for (int m = 0; m < 4; ++m) { f16* rowp = base + (size_t)(row0 + ai * HALF + m * 16) * ldc + col0;
#pragma unroll
                for (int bj = 0; bj < 2; ++bj) { const f32x4 v0 = acc[ai][bj][m][0] * scale, v1 = acc[ai][bj][m][1] * scale;
                    u32x4 w; w.x = pkh(v0[0], v0[1]); w.y = pkh(v0[2], v0[3]); w.z = pkh(v1[0], v1[1]); w.w = pkh(v1[2], v1[3]);
                    *(u32x4*)(rowp + bj * HALF) = w; } }
    }
};
struct EpiMoeOut {
    static constexpr bool PERM = true;
    f16* O; const float* roww;
    __device__ __forceinline__ void operator()(const f32x4 (&acc)[2][2][4][2], const Unit& u, int wr, int wc, int fr, int fq) const {
        const int row0 = u.pm * BM + wr * 64 + fr, col0 = u.pn * BM + wc * 32 + 8 * fq;
#pragma unroll
        for (int ai = 0; ai < 2; ++ai)
#pragma unroll
            for (int m = 0; m < 4; ++m) { const int row = row0 + ai * HALF + m * 16; const float sc = roww[row] * (1.0f / (F8_WSCALE * F8_ASCALE)); f16* rowp = O + (size_t)row * DM + col0;
#pragma unroll
                for (int bj = 0; bj < 2; ++bj) { const f32x4 v0 = acc[ai][bj][m][0] * sc, v1 = acc[ai][bj][m][1] * sc;
                    u32x4 w; w.x = pkh(v0[0], v0[1]); w.y = pkh(v0[2], v0[3]); w.z = pkh(v1[0], v1[1]); w.w = pkh(v1[2], v1[3]);
                    *(u32x4*)(rowp + bj * HALF) = w; } }
    }
};

template <class Epi, bool F8 = false>
__device__ __forceinline__ void gemm_phase(LAS unsigned char* lds, const Gemm g, const Order& S, const Epi& E) {
    const int tid = threadIdx.x, wid = __builtin_amdgcn_readfirstlane(tid >> 6), lane = tid & 63, wr = wid >> 2, wc = wid & 3, fr = lane & 15, fq = lane >> 4;
    const int KB = g.K * (F8 ? 1 : 2), nt = KB / 128;
    unsigned voffA[2], voffB[2];
#pragma unroll
    for (int i = 0; i < 2; ++i) { int R, C; stage_rc(tid * 16 + i * 8192, R, C); const int Rb = Epi::PERM ? ((R & ~31) + perm32(R & 31)) : R;
        voffA[i] = (unsigned)(R * KB + 2 * C); voffB[i] = (unsigned)(Rb * KB + 2 * C); }
    const size_t kstep = (size_t)(BK * 2);
    const size_t hstep = (size_t)HALF * KB;
    const size_t tstep = 2 * hstep;
    const unsigned ldsw = (unsigned)wid * 1024u;
    const int aoff = lds_byte(wr * 64 + fr, fq * 8), boff = lds_byte(wc * 32 + fr, fq * 8);
#define PG8_SA(b, h) (((b) * 2 + (h)) * HTB)
#define PG8_SB(b, h) ((4 + (b) * 2 + (h)) * HTB)
#define PG8_STAGE(bufoff, gbase, voff) do { _Pragma("unroll") for (int _i = 0; _i < 2; ++_i) \
        __builtin_amdgcn_global_load_lds((const unsigned*)((const char*)(gbase) + (voff)[_i]), (LAS unsigned*)(lds + (bufoff) + ldsw + _i * 8192), 16, 0, 0); } while (0)
#define PG8_LD8(dst, addr) do { const i32x4 lo_ = *(const LAS i32x4*)(addr), hi_ = *(const LAS i32x4*)((addr) + 1024); dst = __builtin_shufflevector(lo_, hi_, 0, 1, 2, 3, 4, 5, 6, 7); } while (0)
#define PG8_LDA(dst, b, h) do { _Pragma("unroll") for (int m = 0; m < 4; ++m) { if constexpr (F8) PG8_LD8(dst##8[m], lds + PG8_SA(b, h) + aoff + m * 2048); else { _Pragma("unroll") for (int k = 0; k < 2; ++k) dst[m][k] = *(const LAS f16x8*)(lds + PG8_SA(b, h) + aoff + m * 2048 + k * 1024); } } } while (0)
#define PG8_LDB(dst, b, h) do { _Pragma("unroll") for (int n = 0; n < 2; ++n) { if constexpr (F8) PG8_LD8(dst##8[n], lds + PG8_SB(b, h) + boff + n * 2048); else { _Pragma("unroll") for (int k = 0; k < 2; ++k) dst[n][k] = *(const LAS f16x8*)(lds + PG8_SB(b, h) + boff + n * 2048 + k * 1024); } } } while (0)
#define PG8_MMA(ai, bj, At, Bt) do { __builtin_amdgcn_s_setprio(1); _Pragma("unroll") for (int m = 0; m < 4; ++m) _Pragma("unroll") for (int n = 0; n < 2; ++n) { \
        if constexpr (F8) asm volatile("v_mfma_scale_f32_16x16x128_f8f6f4 %0, %1, %2, %0, %3, %3 op_sel_hi:[0,0,0]" : "+v"(acc[ai][bj][m][n]) : "v"(Bt##8[n]), "v"(At##8[m]), "v"(f8scale)); \
        else { _Pragma("unroll") for (int k = 0; k < 2; ++k) acc[ai][bj][m][n] = __builtin_amdgcn_mfma_f32_16x16x32_f16(Bt[n][k], At[m][k], acc[ai][bj][m][n], 0, 0, 0); } } \
        __builtin_amdgcn_s_setprio(0); } while (0)
#define PG8_WAIT_V(n) asm volatile("s_waitcnt vmcnt(" #n ")" ::: "memory")
#define PG8_WAIT_L(n) asm volatile("s_waitcnt lgkmcnt(" #n ")" ::: "memory")
#define PG8_BAR __builtin_amdgcn_s_barrier()
#define PG8_SCHED __builtin_amdgcn_sched_barrier(0)
    Unit cur, nxt; int ui = 0;
    if (!S.next(0, cur)) return;
    f32x4 acc[2][2][4][2];
#pragma unroll
    for (int a = 0; a < 2; ++a)
#pragma unroll
        for (int b = 0; b < 2; ++b)
#pragma unroll
            for (int m = 0; m < 4; ++m)
#pragma unroll
                for (int n = 0; n < 2; ++n) acc[a][b][m][n] = (f32x4){0.f, 0.f, 0.f, 0.f};
    const int f8scale = 0x7f7f7f7f;
    f16x8 At[4][2], B0[2][2], B1[2][2]; i32x8 At8[4], B08[2], B18[2];
    const char* cA = (const char*)g.A + (size_t)cur.pm * tstep; const char* cB = (const char*)g.Bt + (size_t)cur.be * g.bstride + (size_t)cur.pn * tstep;
    PG8_STAGE(PG8_SB(0, 0), cB, voffB); PG8_STAGE(PG8_SB(0, 1), cB + hstep, voffB); PG8_STAGE(PG8_SA(0, 0), cA, voffA); PG8_STAGE(PG8_SA(0, 1), cA + hstep, voffA);
    if (wr == 1) PG8_BAR;
    PG8_WAIT_V(2); PG8_BAR;
    PG8_STAGE(PG8_SB(1, 0), cB + kstep, voffB); PG8_STAGE(PG8_SA(1, 0), cA + kstep, voffA); PG8_STAGE(PG8_SB(1, 1), cB + hstep + kstep, voffB);
    PG8_WAIT_V(6); PG8_BAR;
    for (;;) {
        const bool has_next = S.next(ui + 1, nxt);
        const char* nA = has_next ? (const char*)g.A + (size_t)nxt.pm * tstep : cA; const char* nB = has_next ? (const char*)g.Bt + (size_t)nxt.be * g.bstride + (size_t)nxt.pn * tstep : cB;
#pragma nounroll
        for (int t = 0; t < nt; t += 2) {
            const bool last = (t == nt - 2);
            const char* a1 = cA + (size_t)(t + 1) * kstep;
            const char* a2 = last ? nA : cA + (size_t)(t + 2) * kstep; const char* b2 = last ? nB : cB + (size_t)(t + 2) * kstep;
            const char* a3 = a2 + kstep; const char* b3 = b2 + kstep;
            PG8_LDB(B0, 0, 0); PG8_LDB(B1, 0, 1); PG8_SCHED; PG8_LDA(At, 0, 0); PG8_STAGE(PG8_SA(1, 1), a1 + hstep, voffA);
            PG8_WAIT_V(8); PG8_WAIT_L(0); PG8_BAR; PG8_MMA(0, 0, At, B0); PG8_MMA(0, 1, At, B1); PG8_BAR; PG8_SCHED;
            PG8_LDA(At, 0, 1); PG8_STAGE(PG8_SB(0, 0), b2, voffB); PG8_STAGE(PG8_SB(0, 1), b2 + hstep, voffB); PG8_STAGE(PG8_SA(0, 0), a2, voffA);
            PG8_WAIT_V(8); PG8_WAIT_L(0); PG8_BAR; PG8_MMA(1, 0, At, B0); PG8_MMA(1, 1, At, B1); PG8_BAR; PG8_SCHED;
            PG8_LDB(B0, 1, 0); PG8_LDB(B1, 1, 1); PG8_SCHED; PG8_LDA(At, 1, 0); PG8_STAGE(PG8_SA(0, 1), a2 + hstep, voffA);
            PG8_WAIT_V(8); PG8_WAIT_L(0); PG8_BAR; PG8_MMA(0, 0, At, B0); PG8_MMA(0, 1, At, B1); PG8_BAR; PG8_SCHED;
            PG8_LDA(At, 1, 1); PG8_STAGE(PG8_SB(1, 0), b3, voffB); PG8_STAGE(PG8_SB(1, 1), b3 + hstep, voffB); PG8_STAGE(PG8_SA(1, 0), a3, voffA);
            PG8_WAIT_V(8); PG8_WAIT_L(0); PG8_BAR; PG8_MMA(1, 0, At, B0); PG8_MMA(1, 1, At, B1); PG8_BAR; PG8_SCHED;
        }
        if constexpr (F8) asm volatile("s_nop 15\n\ts_nop 15" ::: "memory");
        if (wr == 0) PG8_BAR;
        E(acc, cur, wr, wc, fr, fq);
        if (!has_next) break;
#pragma unroll
        for (int a = 0; a < 2; ++a)
#pragma unroll
            for (int b = 0; b < 2; ++b)
#pragma unroll
                for (int m = 0; m < 4; ++m)
#pragma unroll
                    for (int n = 0; n < 2; ++n) acc[a][b][m][n] = (f32x4){0.f, 0.f, 0.f, 0.f};
        cur = nxt; cA = nA; cB = nB; ++ui;
        if (wr == 1) PG8_BAR;
    }
    PG8_WAIT_V(0);
    PG8_BAR;
#undef PG8_SA
#undef PG8_SB
#undef PG8_STAGE
#undef PG8_LDA
#undef PG8_LDB
#undef PG8_MMA
#undef PG8_WAIT_V
#undef PG8_WAIT_L
#undef PG8_BAR
#undef PG8_SCHED
}
}

constexpr size_t MiB = 1u << 20;
constexpr size_t WS_CTL = 0, CTL_ZERO_BYTES = 1 * MiB;
constexpr size_t WS_MOD = 1 * MiB;
constexpr size_t WS_KVMOD = 3 * MiB;
constexpr size_t WS_TOKINFO = 4 * MiB;
constexpr size_t WS_TOKSLOT = 6 * MiB;
constexpr size_t WS_SLOTW = 7 * MiB;
constexpr size_t WS_ROPE = 8 * MiB;
constexpr size_t WS_W_RIN = 24 * MiB, WS_W_ROUT = 48 * MiB, WS_W_KV = 56 * MiB, WS_W_SQ = 60 * MiB, WS_W_SO = 64 * MiB, WS_W_FIN = 68 * MiB, WS_W_FOUT = 90 * MiB, WS_W_MIN = 101 * MiB, WS_W_MOUT = 325 * MiB;
constexpr size_t WS_X = 437 * MiB, WS_H = 565 * MiB, WS_KSH = 629 * MiB, WS_VSH = 693 * MiB, WS_BIG = 757 * MiB;
constexpr size_t WS_PROJ = WS_BIG, WS_AO = WS_BIG + 384 * MiB;
constexpr size_t WS_ACTD = WS_BIG;
constexpr size_t WS_HS = WS_BIG, WS_Y2 = WS_BIG, WS_ACTE = WS_BIG + 132 * MiB;
constexpr size_t WS_SQ = WS_BIG, WS_SO = WS_BIG + 64 * MiB, WS_HK = WS_BIG + 192 * MiB;
constexpr size_t WS_YB = WS_BIG + 594 * MiB;
constexpr size_t WS_END = WS_YB + 64 * MiB;
static_assert((size_t)MOE_ROWS_MAX * DM * 2 <= 132 * MiB && WS_ACTE + (size_t)MOE_ROWS_MAX * FFE * 2 <= WS_YB && WS_AO + (size_t)MTOK * 2048 * 2 <= WS_YB, "ws map");
constexpr int CW_BAR = 4096;
constexpr int CW_MOE = 16384;

constexpr int RING_BYTES = 131072;
constexpr int LDS_BYTES = 147456;
constexpr int MISC_OFF = LDS_BYTES - 256;

#define XB_TMO      128
#define XB_XCNT(j)  (256  + 64 * (j))
#define XB_XSUB(j)  (1280 + 64 * (j))
#define XB_XGEN(j)  (2304 + 64 * (j))
#define XB_TOP      3328
#define XB_TOPGEN   3392
#define XCD_BAR_WORDS 3456
#define XB_SPIN_CAP (1u << 20)
__device__ __forceinline__ unsigned xb_ld(unsigned* p)              { return __hip_atomic_load(p, __ATOMIC_RELAXED, __HIP_MEMORY_SCOPE_AGENT); }
__device__ __forceinline__ unsigned xb_add(unsigned* p, unsigned v) { return __hip_atomic_fetch_add(p, v, __ATOMIC_RELAXED, __HIP_MEMORY_SCOPE_AGENT); }
__device__ __forceinline__ unsigned xb_xcc_id() { return (unsigned)__builtin_amdgcn_s_getreg((3 << 11) | 20) & 0xFu; }
#define XB_SPIN(cond, bar) do { unsigned _sp = 0; while (cond) { __builtin_amdgcn_s_sleep(1); \
    if ((++_sp & 255u) == 0u) { if (xb_ld(&(bar)[XB_TMO])) break; if (_sp > XB_SPIN_CAP) { atomicAdd(&(bar)[XB_TMO], 1u); break; } } } } while (0)
struct XcdBarrier { unsigned* bar; unsigned x; volatile LAS unsigned* st; };
__device__ __forceinline__ XcdBarrier xcd_barrier_post(unsigned* bar, volatile LAS unsigned* st) {
    XcdBarrier b; b.bar = bar; b.x = xb_xcc_id(); b.st = st;
    if (threadIdx.x == 0) (void)xb_add(&bar[XB_XCNT(b.x)], 1u);
    return b;
}
__device__ __forceinline__ void xcd_barrier_complete(unsigned* bar, unsigned x, unsigned& nloc, unsigned& nx) {
    const unsigned G = gridDim.x * gridDim.y * gridDim.z;
    unsigned sum, cnt, mine, sp = 0u;
    for (;;) {
        sum = 0u; cnt = 0u; mine = 0u;
#pragma unroll
        for (unsigned j = 0; j < 16; ++j) { const unsigned c = xb_ld(&bar[XB_XCNT(j)]); sum += c; cnt += (c > 0u) ? 1u : 0u; mine = (j == x) ? c : mine; }
        if (sum == G) break;
        __builtin_amdgcn_s_sleep(1);
        if ((++sp & 255u) == 0u) { if (xb_ld(&bar[XB_TMO])) break; if (sp > XB_SPIN_CAP) { atomicAdd(&bar[XB_TMO], 1u); break; } }
    }
    nloc = mine > 0u ? mine : 1u; nx = cnt > 0u ? cnt : 1u;
}
__device__ __forceinline__ void xcd_barrier(const XcdBarrier& b) {
    asm volatile("s_waitcnt vmcnt(0)" ::: "memory");
    __syncthreads();
    if (threadIdx.x == 0) {
        unsigned* bar = b.bar;
        __builtin_amdgcn_s_waitcnt(0);
        unsigned nloc = b.st[0], nx = b.st[1];
        if (nloc == 0u) { xcd_barrier_complete(bar, b.x, nloc, nx); b.st[0] = nloc; b.st[1] = nx; }
        const unsigned old = xb_add(&bar[XB_XSUB(b.x)], 1u);
        const unsigned gen = old / nloc;
        if (old + 1u == (gen + 1u) * nloc) {
            __builtin_amdgcn_fence(__ATOMIC_RELEASE, "agent");
            asm volatile("s_waitcnt vmcnt(0)" ::: "memory");
            const unsigned og = xb_add(&bar[XB_TOP], 1u);
            const unsigned tg = og / nx;
            if (og + 1u == (tg + 1u) * nx) xb_add(&bar[XB_TOPGEN], 1u);
            else XB_SPIN(xb_ld(&bar[XB_TOPGEN]) == tg, bar);
            __builtin_amdgcn_fence(__ATOMIC_ACQUIRE, "agent");
            xb_add(&bar[XB_XGEN(b.x)], 1u);
            asm volatile("s_waitcnt vmcnt(0)" ::: "memory");
        } else {
            XB_SPIN(xb_ld(&bar[XB_XGEN(b.x)]) == gen, bar);
            __builtin_amdgcn_fence(__ATOMIC_ACQUIRE, "agent");
            asm volatile("s_waitcnt vmcnt(0)" ::: "memory");
        }
    }
    __syncthreads();
}

#define WG_BAR() do { asm volatile("s_waitcnt lgkmcnt(0)" ::: "memory"); __builtin_amdgcn_s_barrier(); asm volatile("" ::: "memory"); } while (0)
#define CFENCE() asm volatile("" ::: "memory")
__device__ __forceinline__ float wave_sum(float v) {
#pragma unroll
    for (int o = 1; o < 64; o <<= 1) v += __shfl_xor(v, o);
    return v;
}
__device__ __forceinline__ f16x4 tr_read(LAS const unsigned char* p) {
    return __builtin_bit_cast(f16x4, __builtin_amdgcn_ds_read_tr16_b64_v4i16((LAS v4i16_t*)p));
}
__device__ __forceinline__ f16x8 cat8(f16x4 a, f16x4 b) { return (f16x8){a[0], a[1], a[2], a[3], b[0], b[1], b[2], b[3]}; }
__device__ __forceinline__ f16x8 pack8(const f32x16& x, int s) {
    u32x4 w; w.x = pkh(x[8 * s + 0], x[8 * s + 1]); w.y = pkh(x[8 * s + 2], x[8 * s + 3]); w.z = pkh(x[8 * s + 4], x[8 * s + 5]); w.w = pkh(x[8 * s + 6], x[8 * s + 7]);
    return __builtin_bit_cast(f16x8, w);
}

struct Frame {
    LAS unsigned char* lds;
    unsigned* ctl;
    int wave, vcu, G;
    unsigned char* ws;
};
__device__ __forceinline__ int lane_id() { int l; asm volatile("v_mbcnt_lo_u32_b32 %0, -1, 0\n\tv_mbcnt_hi_u32_b32 %0, -1, %0" : "=v"(l)); return l; }
#define PHASE_IDS() const int lane = lane_id(); const int tid = F.wave * 64 + lane; (void)tid

template <int I> __device__ __forceinline__ const void* karg() {
    const auto kp = __builtin_amdgcn_kernarg_segment_ptr();
    unsigned long long v; asm volatile("s_load_dwordx2 %0, %1, %2\n\ts_waitcnt lgkmcnt(0)" : "=s"(v) : "s"(kp), "i"(I * 8) : "memory");
    return (const void*)(const GAS char*)v;
}
#define KIN(i) ((const float*)karg<(i)>())
template <int MAP>
__device__ __forceinline__ int srccol(int n, int N) {
    if (MAP == 1) { if (n >= 2048) return n; const int p = n & 127; return (n & ~127) + (p >> 1) + 64 * (p & 1); }
    if (MAP == 2) { const int F = N >> 1, t = n >> 8, j = n & 255; return (j < 128) ? 128 * t + j : F + 128 * t + (j - 128); }
    return n;
}
template <int MAP, bool F8>
__device__ __forceinline__ void p0_transpose_item(const float* W, int K, int N, void* WT, LAS float* scr, int item, int lane) {
    const int nblk = N / 32, kb = item / nblk, nb = item % nblk, k0 = 64 * kb, n0 = 32 * nb;
    const int sc = srccol<MAP>(n0 + (lane & 31), N);
    const float* wp = W + (size_t)(k0 + (lane >> 5)) * N + sc;
    float v[32];
#pragma unroll
    for (int i = 0; i < 32; ++i) v[i] = wp[(size_t)(2 * i) * N];
#pragma unroll
    for (int i = 0; i < 32; ++i) scr[(2 * i + (lane >> 5)) * 33 + (lane & 31)] = F8 ? v[i] * F8_WSCALE : v[i];
    asm volatile("s_waitcnt lgkmcnt(0)" ::: "memory");
    if (F8) {
        const int c = lane & 3;
#pragma unroll
        for (int j = 0; j < 2; ++j) { const int n = (lane >> 2) + 16 * j; const LAS float* s = scr + (16 * c) * 33 + n;
            u32x4 o; o.x = pk4f8(s[0 * 33], s[1 * 33], s[2 * 33], s[3 * 33]); o.y = pk4f8(s[4 * 33], s[5 * 33], s[6 * 33], s[7 * 33]);
            o.z = pk4f8(s[8 * 33], s[9 * 33], s[10 * 33], s[11 * 33]); o.w = pk4f8(s[12 * 33], s[13 * 33], s[14 * 33], s[15 * 33]);
            *(u32x4*)((unsigned char*)WT + (size_t)(n0 + n) * K + k0 + 16 * c) = o; }
    } else {
        const int c = lane & 7;
#pragma unroll
        for (int j = 0; j < 4; ++j) { const int n = (lane >> 3) + 8 * j; const LAS float* s = scr + (8 * c) * 33 + n;
            u32x4 o; o.x = pkh(s[0 * 33], s[1 * 33]); o.y = pkh(s[2 * 33], s[3 * 33]); o.z = pkh(s[4 * 33], s[5 * 33]); o.w = pkh(s[6 * 33], s[7 * 33]);
            *(u32x4*)((f16*)WT + (size_t)(n0 + n) * K + k0 + 8 * c) = o; }
    }
    asm volatile("s_waitcnt lgkmcnt(0)" ::: "memory");
}
template <int MAP, bool F8>
__device__ __forceinline__ bool p0_group(int& r, const float* W, int nb, int K, int N, void* WT, LAS float* scr, int lane) {
    const int per = (K / 64) * (N / 32), tot = nb * per;
    if (r >= tot) { r -= tot; return false; }
    const int b = r / per, it = r % per;
    p0_transpose_item<MAP, F8>(W + (size_t)b * K * N, K, N, (unsigned char*)WT + (size_t)b * K * N * (F8 ? 1 : 2), scr, it, lane);
    return true;
}
__device__ __forceinline__ void p0_prologue(Frame& F) {
    PHASE_IDS();
    const int gw = F.vcu * 8 + F.wave, NGW = F.G * 8;
    LAS float* condL = (LAS float*)(F.lds);
    LAS float* scr = (LAS float*)(F.lds + 65536 + F.wave * 8448);
    for (int i = tid; i < 16 * 1024; i += 512) { const int b = i >> 10, k = i & 1023; condL[k * 16 + b] = silu_f(KIN(1)[i]); }
    WG_BAR();
    for (int it = gw; it < 1664; it += NGW) {
        const float* W; const float* bias; float* dst; int N, col0;
        if (it < 1536) { const int l = it / 384; col0 = 16 * (it % 384); N = 6144; W = KIN(3) + (size_t)l * 1024 * 6144; bias = KIN(4) + l * 6144; dst = (float*)(F.ws + WS_MOD) + (size_t)l * 16 * 6144; }
        else { col0 = 16 * (it - 1536); N = 2048; W = KIN(10); bias = KIN(11); dst = (float*)(F.ws + WS_KVMOD); }
        const int cl = lane & 3, kg = lane >> 2;
        f32x4 acc[16];
#pragma unroll
        for (int b = 0; b < 16; ++b) acc[b] = (f32x4){0.f, 0.f, 0.f, 0.f};
        const float* wp = W + (size_t)kg * N + col0 + 4 * cl;
#pragma unroll 4
        for (int k16 = 0; k16 < 64; ++k16) {
            const f32x4 w = *(const f32x4*)(wp + (size_t)k16 * 16 * N);
            const LAS f32x4* cp = (const LAS f32x4*)(condL + (16 * k16 + kg) * 16);
            const f32x4 c0 = cp[0], c1 = cp[1], c2 = cp[2], c3 = cp[3];
#pragma unroll
            for (int j = 0; j < 4; ++j) { acc[j] += c0[j] * w; acc[4 + j] += c1[j] * w; acc[8 + j] += c2[j] * w; acc[12 + j] += c3[j] * w; }
        }
        const f32x4 bv = *(const f32x4*)(bias + col0 + 4 * cl);
#pragma unroll
        for (int b = 0; b < 16; ++b) {
            f32x4 v = acc[b];
#pragma unroll
            for (int j = 0; j < 4; ++j) { v[j] += __shfl_xor(v[j], 4); v[j] += __shfl_xor(v[j], 8); v[j] += __shfl_xor(v[j], 16); v[j] += __shfl_xor(v[j], 32); }
            if (kg == 0) *(f32x4*)(dst + (size_t)b * N + col0 + 4 * cl) = v + bv;
        }
    }
    {
        const double e = -(double)lane / 64.0;
        const double invf = exp2(e * 13.287712379549449);
        float* rope = (float*)(F.ws + WS_ROPE); const int* posp = (const int*)karg<2>();
        for (int row = gw; row < MTOK; row += NGW) {
            const double rev = (double)posp[row] * invf * 0.15915494309189535;
            const float fr = (float)(rev - floor(rev));
            rope[(size_t)row * 128 + lane] = __builtin_amdgcn_cosf(fr); rope[(size_t)row * 128 + 64 + lane] = __builtin_amdgcn_sinf(fr);
        }
    }
    constexpr int per_rin = 16 * 192, per_rout = 32 * 32, per_kv = 16 * 64, per_sq = 16 * 32, per_fin = 16 * 176, per_fout = 44 * 32, per_min = 16 * 224, per_mout = 56 * 32;
    constexpr int NITEMS = 2 * per_rin + 2 * per_rout + per_kv + 4 * per_sq + 2 * per_fin + 2 * per_fout + 16 * per_min + 16 * per_mout;
    for (int it = gw; it < NITEMS; it += NGW) {
        int r = it;
        if (p0_group<1, RETIN_F8 != 0>(r, KIN(7), 1, 1024, 6144, (f16*)(F.ws + WS_W_RIN), scr, lane)) continue;
        if (p0_group<1, RETIN_F8 != 0>(r, KIN(7) + (size_t)1024 * 6144, 1, 1024, 6144, (f16*)(F.ws + WS_W_RIN) + (size_t)1024 * 6144, scr, lane)) continue;
        if (p0_group<0, false>(r, KIN(9), 2, 2048, 1024, (f16*)(F.ws + WS_W_ROUT), scr, lane)) continue;
        if (p0_group<0, false>(r, KIN(13), 1, 1024, 2048, (f16*)(F.ws + WS_W_KV), scr, lane)) continue;
        if (p0_group<0, false>(r, KIN(14), 2, 1024, 1024, (f16*)(F.ws + WS_W_SQ), scr, lane)) continue;
        if (p0_group<0, false>(r, KIN(15), 2, 1024, 1024, (f16*)(F.ws + WS_W_SO), scr, lane)) continue;
        if (p0_group<2, false>(r, KIN(16), 1, 1024, 5632, (f16*)(F.ws + WS_W_FIN), scr, lane)) continue;
        if (p0_group<2, DENSE_F8 != 0>(r, KIN(16) + (size_t)1024 * 5632, 1, 1024, 5632, (f16*)(F.ws + WS_W_FIN) + (size_t)1024 * 5632, scr, lane)) continue;
        if (p0_group<0, false>(r, KIN(17), 1, 2816, 1024, (f16*)(F.ws + WS_W_FOUT), scr, lane)) continue;
        if (p0_group<0, DENSE_F8 != 0>(r, KIN(17) + (size_t)2816 * 1024, 1, 2816, 1024, (f16*)(F.ws + WS_W_FOUT) + (size_t)2816 * 1024, scr, lane)) continue;
        if (p0_group<2, true>(r, KIN(19), 16, 1024, 7168, (f16*)(F.ws + WS_W_MIN), scr, lane)) continue;
        p0_group<0, true>(r, KIN(20), 16, 3584, 1024, (f16*)(F.ws + WS_W_MOUT), scr, lane);
    }
}

struct NormArgs {
    const float* x; float* xw; const float* gain; const float* sh; const float* sc;
    f16* h; const float* gain2; const float* kvmod; f16* hk;
    const f16* y2; const unsigned* tokslot; const float* gatef;
    float* out;
    const f16* yb;
    const float* router; unsigned* gcnt; unsigned* tokinfo;
};
template <bool COMBINE, bool KV, bool FINAL, bool ROUTER, bool H8 = false, bool ADDY = false>
__device__ __forceinline__ void norm_phase(Frame& F, const NormArgs& A) {
    PHASE_IDS();
    const int gw = F.vcu * 8 + F.wave, NGW = F.G * 8;
    LAS float* routL = (LAS float*)F.lds;
    LAS unsigned* lcnt = (LAS unsigned*)(F.lds + 32768);
    LAS unsigned* recs = (LAS unsigned*)(F.lds + 32768 + 256);
    if (ROUTER) {
        for (int i = tid; i < 8192; i += 512) routL[(i & 7) * 1024 + (i >> 3)] = A.router[i];
        if (tid < 16) lcnt[tid] = 0u;
        WG_BAR();
    }
    int nloc = 0;
    for (int row = gw; row < MTOK; row += NGW, ++nloc) {
        const int b = row >> 11;
        f32x4 v[4];
#pragma unroll
        for (int j = 0; j < 4; ++j) v[j] = *((const f32x4*)(A.x + (size_t)row * DM) + lane + 64 * j);
        if (ADDY) {
#pragma unroll
            for (int j = 0; j < 4; ++j) {
                const f16x4 y = *((const f16x4*)(A.yb + (size_t)row * DM) + lane + 64 * j);
#pragma unroll
                for (int t = 0; t < 4; ++t) v[j][t] += (float)y[t];
                *((f32x4*)(A.xw + (size_t)row * DM) + lane + 64 * j) = v[j];
            }
        }
        if (COMBINE) {
            const u32x2 sl = *(const u32x2*)(A.tokslot + 2 * (size_t)row);
            const f16* ya = A.y2 + (size_t)sl.x * DM; const f16* yb = A.y2 + (size_t)sl.y * DM;
#pragma unroll
            for (int j = 0; j < 4; ++j) {
                const f16x4 a = *((const f16x4*)ya + lane + 64 * j), c = *((const f16x4*)yb + lane + 64 * j);
                const f32x4 g = *((const f32x4*)(A.gatef + (size_t)b * 6144) + lane + 64 * j);
#pragma unroll
                for (int t = 0; t < 4; ++t) v[j][t] += g[t] * ((float)a[t] + (float)c[t]);
                if (!FINAL) *((f32x4*)(A.xw + (size_t)row * DM) + lane + 64 * j) = v[j];
            }
        }
        float ss = 0.f;
#pragma unroll
        for (int j = 0; j < 4; ++j) ss += (v[j][0] * v[j][0] + v[j][1] * v[j][1]) + (v[j][2] * v[j][2] + v[j][3] * v[j][3]);
        const float rstd = 1.0f / sqrtf(wave_sum(ss) * (1.0f / DM) + EPS);
        if (FINAL) {
#pragma unroll
            for (int j = 0; j < 4; ++j) { const f32x4 g = *((const f32x4*)A.gain + lane + 64 * j); *((f32x4*)(A.out + (size_t)row * DM) + lane + 64 * j) = v[j] * rstd * g; }
        } else {
            f32x4 hv[4];
#pragma unroll
            for (int j = 0; j < 4; ++j) {
                const f32x4 g = *((const f32x4*)A.gain + lane + 64 * j), sh = *((const f32x4*)(A.sh + (size_t)b * 6144) + lane + 64 * j), sc = *((const f32x4*)(A.sc + (size_t)b * 6144) + lane + 64 * j);
                hv[j] = (v[j] * rstd * g) * (1.0f + sc) + sh;
                if (H8) *((unsigned*)((unsigned char*)A.h + (size_t)row * DM) + lane + 64 * j) = pk4f8(hv[j][0], hv[j][1], hv[j][2], hv[j][3]);
                else { u32x2 w; w.x = pkh(hv[j][0], hv[j][1]); w.y = pkh(hv[j][2], hv[j][3]); *((u32x2*)(A.h + (size_t)row * DM) + lane + 64 * j) = w; }
            }
            if (KV) {
#pragma unroll
                for (int j = 0; j < 4; ++j) {
                    const f32x4 g = *((const f32x4*)A.gain2 + lane + 64 * j), sh = *((const f32x4*)(A.kvmod + (size_t)b * 2048) + lane + 64 * j), sc = *((const f32x4*)(A.kvmod + (size_t)b * 2048 + 1024) + lane + 64 * j);
                    const f32x4 o = (v[j] * rstd * g) * (1.0f + sc) + sh;
                    u32x2 w; w.x = pkh(o[0], o[1]); w.y = pkh(o[2], o[3]);
                    *((u32x2*)(A.hk + (size_t)row * DM) + lane + 64 * j) = w;
                }
            }
            if (ROUTER) {
                float lg[8];
#pragma unroll
                for (int e = 0; e < 8; ++e) lg[e] = 0.f;
#pragma unroll
                for (int j = 0; j < 4; ++j)
#pragma unroll
                    for (int e = 0; e < 8; ++e) {
                        const f32x4 rv = *((const LAS f32x4*)(routL + e * 1024) + lane + 64 * j);
                        lg[e] += (hv[j][0] * rv[0] + hv[j][1] * rv[1]) + (hv[j][2] * rv[2] + hv[j][3] * rv[3]);
                    }
#pragma unroll
                for (int e = 0; e < 8; ++e) lg[e] = wave_sum(lg[e]);
                int i1 = 0; float v1 = lg[0];
#pragma unroll
                for (int e = 1; e < 8; ++e) if (lg[e] > v1) { v1 = lg[e]; i1 = e; }
                int i2 = -1; float v2 = -INFINITY;
#pragma unroll
                for (int e = 0; e < 8; ++e) if (e != i1 && lg[e] > v2) { v2 = lg[e]; i2 = e; }
                const float ed = __expf(v2 - v1), w1 = 1.0f / (1.0f + ed), w2 = ed * w1;
                if (lane == 0) {
                    const unsigned p1 = __hip_atomic_fetch_add(&lcnt[i1], 1u, __ATOMIC_RELAXED, __HIP_MEMORY_SCOPE_WORKGROUP), p2 = __hip_atomic_fetch_add(&lcnt[i2], 1u, __ATOMIC_RELAXED, __HIP_MEMORY_SCOPE_WORKGROUP);
                    LAS unsigned* rc = recs + (F.wave * 16 + nloc) * 8;
                    rc[0] = (unsigned)i1; rc[1] = p1; rc[2] = (unsigned)i2; rc[3] = p2; rc[4] = __float_as_uint(w1); rc[5] = __float_as_uint(w2);
                }
            }
        }
    }
    if (ROUTER) {
        WG_BAR();
        if (tid < 8) lcnt[8 + tid] = __hip_atomic_fetch_add(A.gcnt + 64 * tid, lcnt[tid], __ATOMIC_RELAXED, __HIP_MEMORY_SCOPE_AGENT);
        WG_BAR();
        if (lane == 0) {
            int k = 0;
            for (int row = gw; row < MTOK; row += NGW, ++k) {
                const LAS unsigned* rc = recs + (F.wave * 16 + k) * 8;
                u32x4 o; o.x = rc[0]; o.y = rc[1] + lcnt[8 + rc[0]]; o.z = rc[2]; o.w = rc[3] + lcnt[8 + rc[2]];
                *(u32x4*)(A.tokinfo + 8 * (size_t)row) = o; *(u32x2*)(A.tokinfo + 8 * (size_t)row + 4) = (u32x2){rc[4], rc[5]};
            }
        }
    }
}
__device__ __forceinline__ void moe_tile_bases(const unsigned* gcnt, int (&tb)[NEXP], int& ntiles) {
    int acc = 0;
#pragma unroll
    for (int e = 0; e < NEXP; ++e) { tb[e] = acc; const unsigned c = __hip_atomic_load(gcnt + 64 * e, __ATOMIC_RELAXED, __HIP_MEMORY_SCOPE_AGENT); acc += (int)((c + 255u) >> 8); }
    ntiles = acc;
}
__device__ __forceinline__ void moe_gather(Frame& F, const unsigned* gcnt, const unsigned* tokinfo, const unsigned char* h8, unsigned char* hs8, float* slotw, unsigned* tokslot) {
    PHASE_IDS();
    const int gw = F.vcu * 8 + F.wave, NGW = F.G * 8;
    int tb[NEXP], nt; moe_tile_bases(gcnt, tb, nt);
    for (int row = gw; row < MTOK; row += NGW) {
        const u32x4 ti = *(const u32x4*)(tokinfo + 8 * (size_t)row); const u32x2 tw = *(const u32x2*)(tokinfo + 8 * (size_t)row + 4);
        int b1 = 0, b2 = 0;
#pragma unroll
        for (int e = 0; e < NEXP; ++e) { b1 = ((int)ti.x == e) ? tb[e] : b1; b2 = ((int)ti.z == e) ? tb[e] : b2; }
        const unsigned s1 = (unsigned)b1 * 256u + ti.y, s2 = (unsigned)b2 * 256u + ti.w;
        const u32x4 a = *((const u32x4*)(h8 + (size_t)row * DM) + lane);
        *((u32x4*)(hs8 + (size_t)s1 * DM) + lane) = a; *((u32x4*)(hs8 + (size_t)s2 * DM) + lane) = a;
        if (lane == 0) { slotw[s1] = __uint_as_float(tw.x); slotw[s2] = __uint_as_float(tw.y); *(u32x2*)(tokslot + 2 * (size_t)row) = (u32x2){s1, s2}; }
    }
}

constexpr int SC_PV = 576;
constexpr int SC_QL = 0, SC_KL = 16384, SC_VL = 32768, SC_SL = 69632, SC_ST = 135168, SC_STAGE = 0;
__device__ __forceinline__ int sc_off(int row, int ch) { return 256 * row + 16 * (ch ^ (((row & 3) << 2) | ((row >> 2) & 3))); }
__device__ __forceinline__ void scan_phase(Frame& F, const f16* proj, const float* gnw, f16* ao) {
    if (blockIdx.x >= 2 * BATCH * RH) return;
    const int unit = blockIdx.x >> 1, half = blockIdx.x & 1;
    const int b = unit >> 3, hh = unit & 7;
    const int c_first_full = half ? NCHUNK / 2 : 0, c_end = half ? NCHUNK : NCHUNK / 2;
    LAS unsigned char* L = F.lds;
    PHASE_IDS();
    const int wid = F.wave, rh = wid >> 2, cg = wid & 3, r = lane & 31, h = lane >> 5;
    const int gl = (lane >> 4) & 1, li = lane & 15, ta = li >> 2, tp = li & 3;
    const float lg = lg2gamma(hh);
    const float g63 = ex2(63.0f * lg), cd = __int_as_float(__builtin_amdgcn_readfirstlane(__float_as_int(ex2(64.0f * lg))));
    float vm[4], cj[4]; const int qloc = 32 * rh + r;
    const float wneg = __int_as_float(__builtin_amdgcn_readfirstlane(__float_as_int(ex2(-64.0f * lg))));
#pragma unroll
    for (int g4 = 0; g4 < 4; ++g4) vm[g4] = ex2((float)(16 * g4 + 8 * h - 2 * qloc - 64) * lg);
#pragma unroll
    for (int j = 0; j < 4; ++j) cj[j] = __int_as_float(__builtin_amdgcn_readfirstlane(__float_as_int(ex2((float)(2 * j) * lg))));
    const size_t rowbase = (size_t)b * SEQ;
    const f16* gq = proj + rowbase * RIN + 128 * hh;
    const f16* gk = gq + 1024;
    const f16* gv = proj + rowbase * RIN + 2048 + 256 * hh;
    const f16* gg = gv + 2048;
    const int qrow = tid >> 4, qc = tid & 15;
    const int vrow = tid >> 5, vc = tid & 31;
    int qoffL[2];
#pragma unroll
    for (int i = 0; i < 2; ++i) qoffL[i] = sc_off(qrow + 32 * i, qc);
    f32x16 SA[2][2];
#pragma unroll
    for (int dd = 0; dd < 2; ++dd)
#pragma unroll
        for (int et = 0; et < 2; ++et)
#pragma unroll
            for (int i = 0; i < 16; ++i) SA[dd][et][i] = 0.f;
    for (int i = tid; i < 65536 / 16; i += 512) *(LAS u32x4*)(L + SC_SL + i * 16) = (u32x4){0u, 0u, 0u, 0u};
    u32x4 nq[2], nk[2], nv[4];
#pragma unroll
    for (int i = 0; i < 2; ++i) { nq[i] = *(const u32x4*)(gq + (size_t)(qrow + 32 * i) * RIN + 8 * qc); nk[i] = *(const u32x4*)(gk + (size_t)(qrow + 32 * i) * RIN + 8 * qc); }
#pragma unroll
    for (int i = 0; i < 4; ++i) nv[i] = *(const u32x4*)(gv + (size_t)(vrow + 16 * i) * RIN + 8 * vc);
#pragma unroll
    for (int i = 0; i < 2; ++i) { *(LAS u32x4*)(L + SC_QL + qoffL[i]) = nq[i]; *(LAS u32x4*)(L + SC_KL + qoffL[i]) = nk[i]; }
#pragma unroll
    for (int i = 0; i < 4; ++i) *(LAS u32x4*)(L + SC_VL + (vrow + 16 * i) * SC_PV + 16 * vc) = nv[i];
    WG_BAR();
    for (int c = 0; c < c_first_full; ++c) {
        const size_t crow = (size_t)c * CHUNK;
#pragma unroll
        for (int i = 0; i < 2; ++i) { nq[i] = *(const u32x4*)(gq + (crow + 64 + qrow + 32 * i) * RIN + 8 * qc); nk[i] = *(const u32x4*)(gk + (crow + 64 + qrow + 32 * i) * RIN + 8 * qc); }
#pragma unroll
        for (int i = 0; i < 4; ++i) nv[i] = *(const u32x4*)(gv + (crow + 64 + vrow + 16 * i) * RIN + 8 * vc);
        int ro = r, ho = h, tao = ta, tpo = tp, glo = gl, vro = vrow, vco = vc;
        asm volatile("" : "+v"(ro), "+v"(ho), "+v"(tao), "+v"(tpo), "+v"(glo), "+v"(vro), "+v"(vco));
#pragma unroll
        for (int dd = 0; dd < 2; ++dd)
#pragma unroll
            for (int et = 0; et < 2; ++et)
#pragma unroll
                for (int i = 0; i < 16; ++i) SA[dd][et][i] *= cd;
#pragma unroll
        for (int kt = 0; kt < 2; ++kt)
#pragma unroll
            for (int s = 0; s < 2; ++s) {
                const int k0 = 32 * kt + 16 * s + 4 * ho + tao;
                f16x8 Vf[2], Kt[2];
#pragma unroll
                for (int et = 0; et < 2; ++et) { LAS const unsigned char* vp = L + SC_VL + k0 * SC_PV + (64 * cg + 32 * et + 16 * glo + 4 * tpo) * 2; Vf[et] = cat8(tr_read(vp), tr_read(vp + 8 * SC_PV)); }
#pragma unroll
                for (int dd = 0; dd < 2; ++dd) { const int ch = 4 * (2 * rh + dd) + 2 * glo + (tpo >> 1);
                    Kt[dd] = cat8(tr_read(L + SC_KL + sc_off(k0, ch) + 8 * (tpo & 1)), tr_read(L + SC_KL + sc_off(k0 + 8, ch) + 8 * (tpo & 1))); }
#pragma unroll
                for (int et = 0; et < 2; ++et)
#pragma unroll
                    for (int dd = 0; dd < 2; ++dd) SA[dd][et] = __builtin_amdgcn_mfma_f32_32x32x16_f16(Kt[dd], Vf[et], SA[dd][et], 0, 0, 0);
            }
        WG_BAR();
        if (c + 1 == c_first_full) {
#pragma unroll
            for (int dd = 0; dd < 2; ++dd)
#pragma unroll
                for (int et = 0; et < 2; ++et)
#pragma unroll
                    for (int g4 = 0; g4 < 4; ++g4) {
                        u32x2 w; w.x = pkh(SA[dd][et][4 * g4], SA[dd][et][4 * g4 + 1]); w.y = pkh(SA[dd][et][4 * g4 + 2], SA[dd][et][4 * g4 + 3]);
                        *(LAS u32x2*)(L + SC_SL + sc_off(64 * cg + 32 * et + ro, 4 * (2 * rh + dd) + g4) + 8 * ho) = w;
                    }
        }
#pragma unroll
        for (int i = 0; i < 2; ++i) { const int qo = sc_off((vro * 2 + (vco >> 4)) + 32 * i, vco & 15); *(LAS u32x4*)(L + SC_QL + qo) = nq[i]; *(LAS u32x4*)(L + SC_KL + qo) = nk[i]; }
#pragma unroll
        for (int i = 0; i < 4; ++i) *(LAS u32x4*)(L + SC_VL + (vrow + 16 * i) * SC_PV + 16 * vc) = nv[i];
        WG_BAR();
    }
    for (int c = c_first_full; c < c_end; ++c) {
        const size_t crow = (size_t)c * CHUNK;
        if (c + 1 < c_end) {
#pragma unroll
            for (int i = 0; i < 2; ++i) { nq[i] = *(const u32x4*)(gq + (crow + 64 + qrow + 32 * i) * RIN + 8 * qc); nk[i] = *(const u32x4*)(gk + (crow + 64 + qrow + 32 * i) * RIN + 8 * qc); }
#pragma unroll
            for (int i = 0; i < 4; ++i) nv[i] = *(const u32x4*)(gv + (crow + 64 + vrow + 16 * i) * RIN + 8 * vc);
        }
        int ro = r, ho = h, tao = ta, tpo = tp, glo = gl, vro = vrow, vco = vc;
        asm volatile("" : "+v"(ro), "+v"(ho), "+v"(tao), "+v"(tpo), "+v"(glo), "+v"(vro), "+v"(vco));
        f16x8 Pf[2][2]; f32x16 OT[2];
        {
        f16x8 Qf[8];
#pragma unroll
        for (int ks = 0; ks < 8; ++ks) Qf[ks] = *(const LAS f16x8*)(L + SC_QL + sc_off(32 * rh + ro, 2 * ks + ho));
#pragma unroll
        for (int kt = 0; kt < 2; ++kt) {
            f32x16 X;
#pragma unroll
            for (int i = 0; i < 16; ++i) X[i] = 0.f;
#pragma unroll
            for (int ks = 0; ks < 8; ++ks) { const f16x8 Kf = *(const LAS f16x8*)(L + SC_KL + sc_off(32 * kt + ro, 2 * ks + ho)); X = __builtin_amdgcn_mfma_f32_32x32x16_f16(Kf, Qf[ks], X, 0, 0, 0); }
#pragma unroll
            for (int i = 0; i < 16; ++i) { const int key = 32 * kt + (i & 3) + 8 * (i >> 2) + 4 * h; X[i] *= (key >= qloc) ? vm[i >> 2] * (kt ? cd * cj[i & 3] : cj[i & 3]) : wneg; }
            Pf[kt][0] = pack8(X, 0); Pf[kt][1] = pack8(X, 1);
        }
#pragma unroll
        for (int et = 0; et < 2; ++et)
#pragma unroll
            for (int i = 0; i < 16; ++i) OT[et][i] = 0.f;
#pragma unroll
        for (int ks = 0; ks < 8; ++ks)
#pragma unroll
            for (int et = 0; et < 2; ++et) {
                const f16x8 Sf = *(const LAS f16x8*)(L + SC_SL + sc_off(64 * cg + 32 * et + ro, 2 * ks + ho));
                OT[et] = __builtin_amdgcn_mfma_f32_32x32x16_f16(Sf, Qf[ks], OT[et], 0, 0, 0);
            }
        }
#pragma unroll
        for (int dd = 0; dd < 2; ++dd)
#pragma unroll
            for (int et = 0; et < 2; ++et)
#pragma unroll
                for (int i = 0; i < 16; ++i) SA[dd][et][i] *= cd;
#pragma unroll
        for (int kt = 0; kt < 2; ++kt)
#pragma unroll
            for (int s = 0; s < 2; ++s) {
                const int k0 = 32 * kt + 16 * s + 4 * ho + tao;
                f16x8 Vf[2], Kt[2];
#pragma unroll
                for (int et = 0; et < 2; ++et) { LAS const unsigned char* vp = L + SC_VL + k0 * SC_PV + (64 * cg + 32 * et + 16 * glo + 4 * tpo) * 2; Vf[et] = cat8(tr_read(vp), tr_read(vp + 8 * SC_PV)); }
#pragma unroll
                for (int dd = 0; dd < 2; ++dd) { const int ch = 4 * (2 * rh + dd) + 2 * glo + (tpo >> 1);
                    Kt[dd] = cat8(tr_read(L + SC_KL + sc_off(k0, ch) + 8 * (tpo & 1)), tr_read(L + SC_KL + sc_off(k0 + 8, ch) + 8 * (tpo & 1))); }
#pragma unroll
                for (int et = 0; et < 2; ++et) {
                    OT[et] = __builtin_amdgcn_mfma_f32_32x32x16_f16(Vf[et], Pf[kt][s], OT[et], 0, 0, 0);
#pragma unroll
                    for (int dd = 0; dd < 2; ++dd) SA[dd][et] = __builtin_amdgcn_mfma_f32_32x32x16_f16(Kt[dd], Vf[et], SA[dd][et], 0, 0, 0);
                }
            }
        float mean = 0.f, rstd = 0.f;
        {
        float s1 = 0.f, s2 = 0.f;
#pragma unroll
        for (int et = 0; et < 2; ++et)
#pragma unroll
            for (int i = 0; i < 16; ++i) { OT[et][i] *= g63; s1 += OT[et][i]; s2 += OT[et][i] * OT[et][i]; }
        s1 += __shfl_xor(s1, 32); s2 += __shfl_xor(s2, 32);
        if (h == 0) *(LAS f32x2*)(L + SC_ST + ((rh * 4 + cg) * 32 + r) * 8) = (f32x2){s1, s2};
        }
        WG_BAR();
        u32x4 gc[4];
        {
        float t1 = 0.f, t2 = 0.f;
#pragma unroll
        for (int c4 = 0; c4 < 4; ++c4) { const f32x2 p = *(const LAS f32x2*)(L + SC_ST + ((rh * 4 + c4) * 32 + r) * 8); t1 += p.x; t2 += p.y; }
        mean = t1 * (1.0f / 256.0f); const float var = t2 * (1.0f / 256.0f) - mean * mean; rstd = 1.0f / sqrtf(var + EPS);
#pragma unroll
        for (int i = 0; i < 4; ++i) gc[i] = *(const u32x4*)(gg + (crow + vrow + 16 * i) * RIN + 8 * vc);
        }
        {
#pragma unroll
        for (int dd = 0; dd < 2; ++dd)
#pragma unroll
            for (int et = 0; et < 2; ++et)
#pragma unroll
                for (int g4 = 0; g4 < 4; ++g4) {
                    u32x2 w; w.x = pkh(SA[dd][et][4 * g4], SA[dd][et][4 * g4 + 1]); w.y = pkh(SA[dd][et][4 * g4 + 2], SA[dd][et][4 * g4 + 3]);
                    *(LAS u32x2*)(L + SC_SL + sc_off(64 * cg + 32 * et + ro, 4 * (2 * rh + dd) + g4) + 8 * ho) = w;
                }
        }
        {
#pragma unroll
        for (int et = 0; et < 2; ++et)
#pragma unroll
            for (int g4 = 0; g4 < 4; ++g4) {
                u32x2 w; w.x = pkh((OT[et][4 * g4] - mean) * rstd, (OT[et][4 * g4 + 1] - mean) * rstd); w.y = pkh((OT[et][4 * g4 + 2] - mean) * rstd, (OT[et][4 * g4 + 3] - mean) * rstd);
                *(LAS u32x2*)(L + SC_STAGE + 16384 * (cg >> 1) + sc_off(32 * rh + ro, 8 * (cg & 1) + 4 * et + g4) + 8 * ho) = w;
            }
        }
        WG_BAR();
        {
        f32x4 gw0, gw1; { const float* gp = gnw + 256 * hh + 8 * vc; gw0 = *(const f32x4*)gp; gw1 = *(const f32x4*)(gp + 4); }
#pragma unroll
        for (int i = 0; i < 4; ++i) {
            const f16x8 n8 = *(const LAS f16x8*)(L + SC_STAGE + 16384 * (vco >> 4) + sc_off(vro + 16 * i, vco & 15));
            const f16x8 g8 = __builtin_bit_cast(f16x8, gc[i]);
            u32x4 w;
            w.x = pkh((float)n8[0] * (float)g8[0] * gw0[0], (float)n8[1] * (float)g8[1] * gw0[1]); w.y = pkh((float)n8[2] * (float)g8[2] * gw0[2], (float)n8[3] * (float)g8[3] * gw0[3]);
            w.z = pkh((float)n8[4] * (float)g8[4] * gw1[0], (float)n8[5] * (float)g8[5] * gw1[1]); w.w = pkh((float)n8[6] * (float)g8[6] * gw1[2], (float)n8[7] * (float)g8[7] * gw1[3]);
            *(u32x4*)(ao + (rowbase + crow + vrow + 16 * i) * 2048 + 256 * hh + 8 * vc) = w;
        }
        }
        WG_BAR();
        if (c + 1 < c_end) {
#pragma unroll
            for (int i = 0; i < 2; ++i) { const int qo = sc_off((vro * 2 + (vco >> 4)) + 32 * i, vco & 15); *(LAS u32x4*)(L + SC_QL + qo) = nq[i]; *(LAS u32x4*)(L + SC_KL + qo) = nk[i]; }
#pragma unroll
            for (int i = 0; i < 4; ++i) *(LAS u32x4*)(L + SC_VL + (vrow + 16 * i) * SC_PV + 16 * vc) = nv[i];
        }
        WG_BAR();
    }
}

constexpr int SBV_P = 144;
constexpr float SB_STOP = 7.8886090522101181e-31f;
__device__ __forceinline__ void sb_phase(Frame& F, const f16* Q, const f16* Kc, const f16* Vc, f16* O) {
    PHASE_IDS();
    const int gw = F.vcu * 8 + F.wave, NGW = F.G * 8, r = lane & 31, h = lane >> 5;
    const int gl = (lane >> 4) & 1, li = lane & 15, ta = li >> 2, tp = li & 3;
    LAS unsigned char* Vw = F.lds + F.wave * (32 * SBV_P);
    const int vr = lane >> 3, vcc = lane & 7;
    for (int u = gw; u < BATCH * SBH * (SEQ / 32); u += NGW) {
        const int qblk = u & 63, bh = u >> 6, b = bh >> 4, hd = bh & 15;
        const size_t rb = (size_t)b * SEQ;
        const f16* qp = Q + (rb + 32 * qblk + r) * DM + 64 * hd + 8 * h;
        f16x8 Qf[4];
#pragma unroll
        for (int ks = 0; ks < 4; ++ks) Qf[ks] = *(const f16x8*)(qp + 16 * ks);
        f32x16 OT[2];
#pragma unroll
        for (int dt = 0; dt < 2; ++dt)
#pragma unroll
            for (int i = 0; i < 16; ++i) OT[dt][i] = 0.f;
        float carry = 1.0f;
        u32x4 kn[4], vn[4];
        { const f16* kp = Kc + (rb + 32 * qblk + r) * DM + 64 * hd + 8 * h; const f16* vp = Vc + (rb + 32 * qblk + vr) * DM + 64 * hd + 8 * vcc;
#pragma unroll
          for (int i = 0; i < 4; ++i) { kn[i] = *(const u32x4*)(kp + 16 * i); vn[i] = *(const u32x4*)(vp + (size_t)(8 * i) * DM); } }
        for (int kt = qblk; kt >= 0; --kt) {
            f16x8 Kf[4];
#pragma unroll
            for (int i = 0; i < 4; ++i) { Kf[i] = __builtin_bit_cast(f16x8, kn[i]); *(LAS u32x4*)(Vw + (vr + 8 * i) * SBV_P + 16 * vcc) = vn[i]; }
            CFENCE();
            if (kt > 0) { const f16* kp = Kc + (rb + 32 * (kt - 1) + r) * DM + 64 * hd + 8 * h; const f16* vp = Vc + (rb + 32 * (kt - 1) + vr) * DM + 64 * hd + 8 * vcc;
#pragma unroll
                for (int i = 0; i < 4; ++i) { kn[i] = *(const u32x4*)(kp + 16 * i); vn[i] = *(const u32x4*)(vp + (size_t)(8 * i) * DM); } }
            f32x16 S;
#pragma unroll
            for (int i = 0; i < 16; ++i) S[i] = 0.f;
#pragma unroll
            for (int ks = 0; ks < 4; ++ks) S = __builtin_amdgcn_mfma_f32_32x32x16_f16(Kf[ks], Qf[ks], S, 0, 0, 0);
            float om[16];
            const bool diag = (kt == qblk);
#pragma unroll
            for (int i = 0; i < 16; ++i) {
                const int kl = (i & 3) + 8 * (i >> 2) + 4 * h;
                float o = __builtin_amdgcn_rcpf(1.0f + ex2(S[i]));
                if (diag && kl >= r) o = 1.0f;
                om[i] = o;
            }
            float sfx[16], T[4];
#pragma unroll
            for (int g4 = 0; g4 < 4; ++g4) { sfx[4 * g4 + 3] = 1.0f; sfx[4 * g4 + 2] = om[4 * g4 + 3]; sfx[4 * g4 + 1] = sfx[4 * g4 + 2] * om[4 * g4 + 2]; sfx[4 * g4] = sfx[4 * g4 + 1] * om[4 * g4 + 1]; T[g4] = sfx[4 * g4] * om[4 * g4]; }
            float E[4]; float run = carry;
#pragma unroll
            for (int g4 = 3; g4 >= 0; --g4) {
                const float tl = __shfl(T[g4], r), th = __shfl(T[g4], r + 32);
                const float e_hi = run; run *= th; const float e_lo = run; run *= tl;
                E[g4] = h ? e_hi : e_lo;
            }
            carry = run;
            f32x16 Aw;
#pragma unroll
            for (int i = 0; i < 16; ++i) Aw[i] = (1.0f - om[i]) * (E[i >> 2] * sfx[i]);
            const f16x8 Af0 = pack8(Aw, 0), Af1 = pack8(Aw, 1);
            CFENCE();
#pragma unroll
            for (int dt = 0; dt < 2; ++dt) {
                LAS const unsigned char* vp = Vw + (4 * h + ta) * SBV_P + (32 * dt + 16 * gl + 4 * tp) * 2;
                const f16x8 V0 = cat8(tr_read(vp), tr_read(vp + 8 * SBV_P)), V1 = cat8(tr_read(vp + 16 * SBV_P), tr_read(vp + 24 * SBV_P));
                OT[dt] = __builtin_amdgcn_mfma_f32_32x32x16_f16(V0, Af0, OT[dt], 0, 0, 0);
                OT[dt] = __builtin_amdgcn_mfma_f32_32x32x16_f16(V1, Af1, OT[dt], 0, 0, 0);
            }
            CFENCE();
            if (__ballot(carry > SB_STOP) == 0ull) break;
        }
        f16* op = O + (rb + 32 * qblk + r) * DM + 64 * hd + 4 * h;
#pragma unroll
        for (int dt = 0; dt < 2; ++dt)
#pragma unroll
            for (int g4 = 0; g4 < 4; ++g4) { u32x2 w; w.x = pkh(OT[dt][4 * g4], OT[dt][4 * g4 + 1]); w.y = pkh(OT[dt][4 * g4 + 2], OT[dt][4 * g4 + 3]); *(u32x2*)(op + 32 * dt + 8 * g4) = w; }
    }
}

struct Args { const void* in[22]; float* out; unsigned char* ws; int ph_lo, ph_hi; };
constexpr int N_PHASES = 34;
#define IN(k) (lo <= (k) && (k) < hi)
#define SEAM(k) do { if (IN((k) + 1)) { if (!MK_PER_PHASE) xcd_barrier(bar); } } while (0)
#define WSP(T, off) ((T*)(F.ws + (off)))
#define REPS(cond) _Pragma("unroll") for (int rep_ = 0; rep_ < ((cond) ? 2 : 1); ++rep_)
#define REPBAR() do { if (rep_) xcd_barrier(bar); } while (0)
template <int L> __device__ __forceinline__ void layer_phases(Frame& F, const XcdBarrier& bar, const int lo, const int hi) {
    constexpr int pb = 1 + 8 * L;
        if (IN(pb + 0) && !DIS_K0) {
            const float* modL = WSP(const float, WS_MOD) + (size_t)L * 16 * 6144;
            NormArgs A{}; A.x = (L == 0) ? KIN(0) : WSP(const float, WS_X); A.xw = WSP(float, WS_X); A.gain = KIN(5) + L * DM; A.sh = modL; A.sc = modL + 1024; A.h = WSP(f16, WS_H);
            if constexpr (L == 2) {
                A.y2 = WSP(const f16, WS_Y2); A.tokslot = WSP(const unsigned, WS_TOKSLOT); A.gatef = WSP(const float, WS_MOD) + (size_t)(L - 1) * 16 * 6144 + 5120;
                A.gain2 = KIN(12); A.kvmod = WSP(const float, WS_KVMOD); A.hk = WSP(f16, WS_HK); REPS(PROBE_DUP == 15) { REPBAR(); if (rep_) { A.xw = WSP(float, WS_BIG + 320 * MiB); A.h = WSP(f16, WS_BIG + 448 * MiB); A.hk = WSP(f16, WS_BIG + 512 * MiB); } norm_phase<true, true, false, false>(F, A); }
            } else REPS(PROBE_DUP == 7 && L == 1) { REPBAR(); A.yb = WSP(const f16, WS_YB); if (rep_) A.xw = WSP(float, WS_BIG + 320 * MiB); norm_phase<false, false, false, false, (RETIN_F8 != 0 && L < 2), (L == 1 || L == 3)>(F, A); }
            SEAM(pb + 0);
        }
        if (IN(pb + 1) && !DIS_K1) {
            if constexpr (L < 2) {
                pg8::Gemm g{WSP(const unsigned char, WS_H), WSP(const unsigned char, WS_W_RIN) + (size_t)L * RIN * DM * 2, MTOK, RIN, DM, 0}; pg8::Order S; S.init(MTOK, RIN, F.G, (int)blockIdx.x);
                pg8::EpiRetIn E{WSP(f16, WS_PROJ), WSP(const float, WS_ROPE), RETIN_F8 ? 1.0f / F8_WSCALE : 1.0f};
                REPS(PROBE_DUP == 6 && L == 1) { REPBAR(); pg8::gemm_phase<pg8::EpiRetIn, RETIN_F8 != 0>(F.lds, g, S, E); }
            } else REPS(PROBE_DUP == 12 && L == 2) { REPBAR();
                { pg8::Gemm g{WSP(const f16, WS_H), WSP(const f16, WS_W_SQ) + (size_t)(L - 2) * DM * DM, MTOK, DM, DM, 0}; pg8::Order S; S.init(MTOK, DM, F.G, (int)blockIdx.x);
                  pg8::EpiF16 E{WSP(f16, WS_SQ), DM, 0, 0, 0.125f * 1.4426950408889634f};
                  pg8::gemm_phase<pg8::EpiF16>(F.lds, g, S, E); }
                if constexpr (L == 2) { pg8::Gemm g{WSP(const f16, WS_HK), WSP(const f16, WS_W_KV), MTOK, 2048, DM, 0}; pg8::Order S; S.init(MTOK, 2048, F.G, (int)blockIdx.x);
                  pg8::EpiF16 E{WSP(f16, WS_KSH), DM, 1024, (size_t)(WS_VSH - WS_KSH) / 2, 1.0f};
                  pg8::gemm_phase<pg8::EpiF16>(F.lds, g, S, E); }
            }
            SEAM(pb + 1);
        }
        if (IN(pb + 2) && !DIS_K2) {
#ifndef NO_SCAN
            if constexpr (L < 2) REPS(PROBE_DUP == 2 && L == 1) { REPBAR(); scan_phase(F, WSP(const f16, WS_PROJ), KIN(8) + L * 2048, WSP(f16, WS_AO)); }
#endif
#ifndef NO_SB
            if constexpr (L >= 2) REPS(PROBE_DUP == 3 && L == 3) { REPBAR(); sb_phase(F, WSP(const f16, WS_SQ), WSP(const f16, WS_KSH), WSP(const f16, WS_VSH), WSP(f16, WS_SO)); }
#endif
            SEAM(pb + 2);
        }
        if (IN(pb + 3) && !DIS_K3) {
            pg8::Gemm g;
            if constexpr (L < 2) g = pg8::Gemm{WSP(const f16, WS_AO), WSP(const f16, WS_W_ROUT) + (size_t)L * DM * 2048, MTOK, DM, 2048, 0};
            else g = pg8::Gemm{WSP(const f16, WS_SO), WSP(const f16, WS_W_SO) + (size_t)(L - 2) * DM * DM, MTOK, DM, DM, 0};
            pg8::Order S; S.init(MTOK, DM, F.G, (int)blockIdx.x);
            pg8::EpiY E{WSP(f16, WS_YB), WSP(const float, WS_MOD) + (size_t)L * 16 * 6144 + 2048, 1.0f};
            REPS(PROBE_DUP == 9 && L == 1) { REPBAR(); pg8::gemm_phase<pg8::EpiY>(F.lds, g, S, E); }
            SEAM(pb + 3);
        }
        if (IN(pb + 4) && !DIS_K4) {
            const float* modL = WSP(const float, WS_MOD) + (size_t)L * 16 * 6144;
            NormArgs A{}; A.x = (L == 0) ? KIN(0) : WSP(const float, WS_X); A.xw = WSP(float, WS_X); A.gain = KIN(6) + L * DM; A.sh = modL + 3072; A.sc = modL + 4096; A.h = WSP(f16, WS_H); A.yb = WSP(const f16, WS_YB);
            if constexpr (L & 1) { A.router = KIN(18) + (size_t)(L >> 1) * DM * NEXP; A.gcnt = F.ctl + CW_MOE + (L >> 1) * 1024; A.tokinfo = WSP(unsigned, WS_TOKINFO); REPS(PROBE_DUP == 13 && L == 3) { REPBAR(); if (rep_) { A.gcnt = F.ctl + CW_MOE + 4096; A.tokinfo = WSP(unsigned, WS_TOKINFO + MiB); A.xw = WSP(float, WS_BIG + 320 * MiB); } norm_phase<false, false, false, true, true, true>(F, A); } }
            else norm_phase<false, false, false, false, DF8(L), true>(F, A);
            SEAM(pb + 4);
        }
        if constexpr (L & 1) if (IN(pb + 5) && !DIS_K5) {
            REPS(PROBE_DUP == 8 && L == 3) { REPBAR(); moe_gather(F, F.ctl + CW_MOE + (L >> 1) * 1024, WSP(const unsigned, WS_TOKINFO), WSP(const unsigned char, WS_H), WSP(unsigned char, WS_HS), WSP(float, WS_SLOTW), WSP(unsigned, WS_TOKSLOT)); }
            SEAM(pb + 5);
        }
        if (IN(pb + 6) && !DIS_K6) {
            const int mi = L >> 1;
            pg8::Order S;
            if constexpr (L & 1) {
                int tb[NEXP], ntl; moe_tile_bases(F.ctl + CW_MOE + mi * 1024, tb, ntl);
                S.init(ntl * 256, 2 * FFE, F.G, (int)blockIdx.x);
#pragma unroll
                for (int e = 0; e < NEXP; ++e) S.tb[e] = tb[e];
                pg8::Gemm g{WSP(const unsigned char, WS_HS), WSP(const unsigned char, WS_W_MIN) + (size_t)mi * NEXP * 2 * FFE * DM, ntl * 256, 2 * FFE, DM, (size_t)2 * FFE * DM};
                pg8::EpiGlu<true> E{WSP(unsigned char, WS_ACTE), FFE};
                REPS(PROBE_DUP == 4 && L == 3) { REPBAR(); pg8::gemm_phase<pg8::EpiGlu<true>, true>(F.lds, g, S, E); }
            } else {
                S.init(MTOK, 2 * FFD, F.G, (int)blockIdx.x);
                pg8::Gemm g{WSP(const unsigned char, WS_H), WSP(const unsigned char, WS_W_FIN) + (size_t)mi * 2 * FFD * DM * 2, MTOK, 2 * FFD, DM, 0};
                pg8::EpiGlu<DF8(L)> E{WSP(unsigned char, WS_ACTD), FFD};
                REPS(PROBE_DUP == 10 && L == 2) { REPBAR(); pg8::gemm_phase<pg8::EpiGlu<DF8(L)>, DF8(L)>(F.lds, g, S, E); }
            }
            SEAM(pb + 6);
        }
        if (IN(pb + 7) && !DIS_K7) {
            const int mi = L >> 1;
            if constexpr (L & 1) {
                int tb[NEXP], ntl; moe_tile_bases(F.ctl + CW_MOE + mi * 1024, tb, ntl);
                pg8::Order S; S.init(ntl * 256, DM, F.G, (int)blockIdx.x);
#pragma unroll
                for (int e = 0; e < NEXP; ++e) S.tb[e] = tb[e];
                pg8::Gemm g{WSP(const unsigned char, WS_ACTE), WSP(const unsigned char, WS_W_MOUT) + (size_t)mi * NEXP * DM * FFE, ntl * 256, DM, FFE, (size_t)DM * FFE};
                pg8::EpiMoeOut E{WSP(f16, WS_Y2), WSP(const float, WS_SLOTW)};
                REPS(PROBE_DUP == 5 && L == 3) { REPBAR(); pg8::gemm_phase<pg8::EpiMoeOut, true>(F.lds, g, S, E); }
            } else {
                pg8::Order S; S.init(MTOK, DM, F.G, (int)blockIdx.x);
                pg8::Gemm g{WSP(const unsigned char, WS_ACTD), WSP(const unsigned char, WS_W_FOUT) + (size_t)mi * DM * FFD * 2, MTOK, DM, FFD, 0};
                pg8::EpiY E{WSP(f16, WS_YB), WSP(const float, WS_MOD) + (size_t)L * 16 * 6144 + 5120, DF8(L) ? 1.0f / (F8_WSCALE * F8_ASCALE) : 1.0f};
                REPS(PROBE_DUP == 11 && L == 2) { REPBAR(); pg8::gemm_phase<pg8::EpiY, DF8(L)>(F.lds, g, S, E); }
            }
            SEAM(pb + 7);
        }
}
__global__ void __launch_bounds__(512, 2) mk_fwd(Args args) {
    extern __shared__ __attribute__((aligned(16))) unsigned char lds_raw[];
    Frame F;
    F.lds = (LAS unsigned char*)lds_raw;
    F.wave = __builtin_amdgcn_readfirstlane((int)threadIdx.x >> 6);
    F.G = gridDim.x; { const int bx = blockIdx.x; F.vcu = (F.G % 8 == 0) ? (bx % 8) * (F.G / 8) + bx / 8 : bx; }
    F.ws = args.ws; F.ctl = (unsigned*)(args.ws + WS_CTL);
    volatile LAS unsigned* MISC = (volatile LAS unsigned*)(F.lds + MISC_OFF);
    if (threadIdx.x < 64) ((LAS unsigned*)(F.lds + MISC_OFF))[threadIdx.x] = 0u;
    __syncthreads();
    XcdBarrier bar; bar.bar = F.ctl + CW_BAR; bar.x = 0; bar.st = nullptr;
    if (!MK_PER_PHASE) bar = xcd_barrier_post(F.ctl + CW_BAR, MISC + 8);
    const int lo = args.ph_lo, hi = args.ph_hi;

    if (IN(0)) {
#ifndef NO_P0
        REPS(PROBE_DUP == 1) { REPBAR(); p0_prologue(F); }
#endif
        SEAM(0);
    }
    layer_phases<0>(F, bar, lo, hi); layer_phases<1>(F, bar, lo, hi); layer_phases<2>(F, bar, lo, hi); layer_phases<3>(F, bar, lo, hi);
    if (IN(33)) {
        NormArgs A{}; A.x = WSP(const float, WS_X); A.xw = WSP(float, WS_X); A.gain = KIN(21); A.out = (float*)karg<22>();
        A.y2 = WSP(const f16, WS_Y2); A.tokslot = WSP(const unsigned, WS_TOKSLOT); A.gatef = WSP(const float, WS_MOD) + (size_t)3 * 16 * 6144 + 5120;
        REPS(PROBE_DUP == 14) { REPBAR(); norm_phase<true, false, true, false>(F, A); }
    }
#undef IN
#undef SEAM
#undef WSP
}

extern "C" void kernel_launch(void* const* d_in, const int* in_sizes, int n_in, void* d_out, int out_size, void* d_ws, size_t ws_size, hipStream_t stream) {
    static int grid = 0;
    if (grid == 0) {
        if (n_in != 22 || out_size != MTOK * DM || ws_size < WS_END) { fprintf(stderr, "kernel_launch: unexpected shapes (n_in %d out %d ws %zu, need %zu)\n", n_in, out_size, ws_size, (size_t)WS_END); grid = -1; return; }
        int dev = 0, cus = 0;
        if (hipGetDevice(&dev) != hipSuccess || hipDeviceGetAttribute(&cus, hipDeviceAttributeMultiprocessorCount, dev) != hipSuccess) { grid = -1; return; }
        if (hipFuncSetAttribute((const void*)mk_fwd, hipFuncAttributeMaxDynamicSharedMemorySize, LDS_BYTES) != hipSuccess) { fprintf(stderr, "kernel_launch: hipFuncSetAttribute failed\n"); grid = -1; return; }
        int per_cu = 0;
        if (hipOccupancyMaxActiveBlocksPerMultiprocessor(&per_cu, (const void*)mk_fwd, 512, LDS_BYTES) != hipSuccess || per_cu < 1) fprintf(stderr, "kernel_launch: occupancy query reports %d\n", per_cu);
        (void)hipGetLastError();
        if (cus < 256) { fprintf(stderr, "kernel_launch: needs >= 256 CUs, got %d\n", cus); grid = -1; return; }
        grid = cus;
    }
    if (grid < 0) return;
    (void)hipMemsetAsync((char*)d_ws + WS_CTL, 0, CTL_ZERO_BYTES, stream);
    Args a{};
    for (int i = 0; i < 22; ++i) a.in[i] = d_in[i];
    a.out = (float*)d_out; a.ws = (unsigned char*)d_ws;
#if MK_PER_PHASE
    for (int p = 0; p < N_PHASES; ++p) {
        if (p >= 1 && p <= 32) { const int L = (p - 1) / 8, k = (p - 1) % 8; if (k == 5 && !(L & 1)) continue; }
        a.ph_lo = p; a.ph_hi = p + 1;
        hipLaunchKernelGGL(mk_fwd, dim3(grid), dim3(512), LDS_BYTES, stream, a);
    }
#else
    a.ph_lo = 0; a.ph_hi = N_PHASES;
    hipLaunchKernelGGL(mk_fwd, dim3(grid), dim3(512), LDS_BYTES, stream, a);
#endif
}
```

```cpp
#include <hip/hip_runtime.h>
#include <cstdio>
#include <cstdint>

#define LAS __attribute__((address_space(3)))
#define GAS __attribute__((address_space(1)))
typedef _Float16 f16;
typedef _Float16 f16x2 __attribute__((ext_vector_type(2)));
typedef _Float16 f16x4 __attribute__((ext_vector_type(4)));
typedef _Float16 f16x8 __attribute__((ext_vector_type(8)));
typedef float f32x2 __attribute__((ext_vector_type(2)));
typedef float f32x4 __attribute__((ext_vector_type(4)));
typedef float f32x16 __attribute__((ext_vector_type(16)));
typedef unsigned u32x2 __attribute__((ext_vector_type(2)));
typedef unsigned u32x4 __attribute__((ext_vector_type(4)));
typedef short v4i16_t __attribute__((ext_vector_type(4)));
typedef int i32x8 __attribute__((ext_vector_type(8)));
typedef int i32x4 __attribute__((ext_vector_type(4)));

#ifndef DIS_K0
#define DIS_K0 0
#endif
#ifndef DIS_K1
#define DIS_K1 0
#endif
#ifndef DIS_K2
#define DIS_K2 0
#endif
#ifndef DIS_K3
#define DIS_K3 0
#endif
#ifndef DIS_K4
#define DIS_K4 0
#endif
#ifndef DIS_K5
#define DIS_K5 0
#endif
#ifndef DIS_K6
#define DIS_K6 0
#endif
#ifndef DIS_K7
#define DIS_K7 0
#endif
#ifndef PROBE_DUP
#define PROBE_DUP 0
#endif
#ifndef DENSE_F8
#define DENSE_F8 1
#define DF8(L) (DENSE_F8 != 0 && (L) == 2)
#ifndef DENSE_F8_OUT
#define DENSE_F8_OUT 0
#endif
#define DF8O(L) (DF8(L) && DENSE_F8_OUT != 0)
#endif
#ifndef RETIN_F8
#define RETIN_F8 0
#endif
#ifndef STAG_MOE
#define STAG_MOE 0
#endif
#ifndef STAG_RET
#define STAG_RET 0
#endif
#ifndef CONV_IN_SCAN
#define CONV_IN_SCAN 1
#endif
#ifndef MK_PER_PHASE
#define MK_PER_PHASE 0
#endif

constexpr int BATCH = 16, SEQ = 2048, DM = 1024, MTOK = BATCH * SEQ;
constexpr int RH = 8, RDK = 128, RDV = 256, RIN = 6144, CHUNK = 64, NCHUNK = SEQ / CHUNK;
constexpr int SBH = 16, SDH = 64;
constexpr int FFD = 2816, NEXP = 8, FFE = 3584;
constexpr float EPS = 1e-6f;
constexpr int MOE_ROWS_MAX = 2 * MTOK + NEXP * 256;

__device__ __forceinline__ float lg2gamma(int h) {
    const float t[8] = {-4.580368961312e-02f, -2.272007650008e-02f, -1.131531322783e-02f, -5.646563141142e-03f, -2.820519062379e-03f, -1.409570254671e-03f, -7.046129765894e-04f, -3.522634716290e-04f};
    float r = t[0];
#pragma unroll
    for (int i = 1; i < 8; ++i) r = (h == i) ? t[i] : r;
    return r;
}
__device__ __forceinline__ unsigned pkh(float lo, float hi) { f32x2 v = {lo, hi}; f16x2 h = __builtin_convertvector(v, f16x2); return __builtin_bit_cast(unsigned, h); }
__device__ __forceinline__ float silu_f(float x) { return x * __builtin_amdgcn_rcpf(1.0f + __builtin_amdgcn_exp2f(-1.4426950408889634f * x)); }
__device__ __forceinline__ float ex2(float x) { return __builtin_amdgcn_exp2f(x); }
__device__ __forceinline__ unsigned pk4f8(float a, float b, float c, float d) { int w = 0; w = __builtin_amdgcn_cvt_pk_fp8_f32(a, b, w, false); w = __builtin_amdgcn_cvt_pk_fp8_f32(c, d, w, true); return (unsigned)w; }
constexpr float F8_WSCALE = 64.0f;
constexpr float F8_ASCALE = 4.0f;

namespace pg8 {
constexpr int BM = 256, BK = 64, HALF = 128, HTB = HALF * BK * 2, STAGE_BYTES = 8 * HTB, NXCD = 8, WGM = 8;
__host__ __device__ __forceinline__ int lds_byte(int r, int c) { const int st = (r >> 4) * 2 + (c >> 5), rr = r & 15, cc = c & 31, ob = rr * 64 + cc * 2; return st * 1024 + (ob ^ (((ob >> 9) & 1) << 5)); }
__host__ __device__ __forceinline__ void stage_rc(int b, int& R, int& C) { const int st = b / 1024, sb = b % 1024, swz = sb ^ (((sb >> 9) & 1) << 5); R = (st >> 1) * 16 + swz / 64; C = (st & 1) * 32 + (swz % 64) / 2; }
__host__ __device__ __forceinline__ int perm32(int rho) { const int n = rho >> 4, i = rho & 15; return 8 * (i >> 2) + 4 * n + (i & 3); }

struct Unit { int pm, pn, be, arow, vrow; };
struct Gemm { const void* A; const void* Bt; int M, N, K; size_t bstride; int stagger = 0; };

struct Order {
    int nM, nN, nwg, G, c; int tb[NEXP]; int cap, avirt;
    __device__ void init(int M, int N, int G_, int c_) { nM = M / BM; nN = N / BM; nwg = nM * nN; G = G_; c = c_; cap = 0; avirt = 0;
#pragma unroll
        for (int e = 0; e < NEXP; ++e) tb[e] = e ? 0x7fffffff : 0; }
    __device__ bool next(int i, Unit& u) const {
        const long L = (long)i * G + c; if (L >= nwg) return false;
        int wgid = (int)L; { const int q = nwg / NXCD, r = nwg % NXCD, xcd = wgid % NXCD, off = wgid / NXCD; wgid = (xcd < r ? xcd * (q + 1) : r * (q + 1) + (xcd - r) * q) + off; }
        const int nig = WGM * nN, gid = wgid / nig, fm = gid * WGM, gsz = (nM - fm) < WGM ? (nM - fm) : WGM;
        u.pm = fm + ((wgid % nig) % gsz); u.pn = (wgid % nig) / gsz;
        int be = 0;
#pragma unroll
        for (int e = 1; e < NEXP; ++e) be += (u.pm >= tb[e]) ? 1 : 0;
        u.be = be;
        int tbe = 0;
#pragma unroll
        for (int e = 1; e < NEXP; ++e) tbe = (be == e) ? tb[e] : tbe;
        u.vrow = cap ? be * cap + (u.pm - tbe) * BM : u.pm * BM; u.arow = avirt ? u.vrow : u.pm * BM;
        return true;
    }
};


struct EpiRetIn {
    static constexpr bool PERM = true;
    f16* O; const float* rope; float scl;
    __device__ __forceinline__ void operator()(const f32x4 (&acc)[2][2][4][2], const Unit& u, int wr, int wc, int fr, int fq) const {
        const int row0 = u.pm * BM + wr * 64 + fr, cl = wc * 32 + 8 * fq;
        f16* base = O + (size_t)u.pn * BM + cl;
        if (u.pn < 8) {
            const bool isk = u.pn >= 4; const int i0 = cl >> 1;
            float lg[2]; lg[0] = lg2gamma(2 * (u.pn & 3)); lg[1] = lg2gamma(2 * (u.pn & 3) + 1);
#pragma unroll
            for (int ai = 0; ai < 2; ++ai)
#pragma unroll
                for (int m = 0; m < 4; ++m) {
                    const int row = row0 + ai * HALF + m * 16; const float pos = (float)(16 * m + fr);
                    const f32x4 cs = *(const f32x4*)(rope + (size_t)row * 128 + i0), sn = *(const f32x4*)(rope + (size_t)row * 128 + 64 + i0);
#pragma unroll
                    for (int bj = 0; bj < 2; ++bj) {
                        const float sc = (isk ? ex2(-pos * lg[bj]) * 0.08838834764831845f : ex2((pos + 1.0f) * lg[bj])) * scl;
                        const f32x4 v0 = acc[ai][bj][m][0], v1 = acc[ai][bj][m][1];
                        u32x4 w;
                        w.x = pkh((v0[0] * cs[0] - v0[1] * sn[0]) * sc, (v0[0] * sn[0] + v0[1] * cs[0]) * sc);
                        w.y = pkh((v0[2] * cs[1] - v0[3] * sn[1]) * sc, (v0[2] * sn[1] + v0[3] * cs[1]) * sc);
                        w.z = pkh((v1[0] * cs[2] - v1[1] * sn[2]) * sc, (v1[0] * sn[2] + v1[1] * cs[2]) * sc);
                        w.w = pkh((v1[2] * cs[3] - v1[3] * sn[3]) * sc, (v1[2] * sn[3] + v1[3] * cs[3]) * sc);
                        *(u32x4*)(base + (size_t)row * RIN + bj * HALF) = w;
                    }
                }
        } else {
            const bool isg = u.pn >= 16;
#pragma unroll
            for (int ai = 0; ai < 2; ++ai)
#pragma unroll
                for (int m = 0; m < 4; ++m) {
                    const int row = row0 + ai * HALF + m * 16;
#pragma unroll
                    for (int bj = 0; bj < 2; ++bj) {
                        f32x4 v0 = acc[ai][bj][m][0] * scl, v1 = acc[ai][bj][m][1] * scl;
                        if (isg) {
#pragma unroll
                            for (int j = 0; j < 4; ++j) { v0[j] = silu_f(v0[j]); v1[j] = silu_f(v1[j]); } }
                        u32x4 w; w.x = pkh(v0[0], v0[1]); w.y = pkh(v0[2], v0[3]); w.z = pkh(v1[0], v1[1]); w.w = pkh(v1[2], v1[3]);
                        *(u32x4*)(base + (size_t)row * RIN + bj * HALF) = w;
                    }
                }
        }
    }
};
struct EpiY {
    static constexpr bool PERM = true;
    f16* Y; const float* gate; float scl;
    __device__ __forceinline__ void operator()(const f32x4 (&acc)[2][2][4][2], const Unit& u, int wr, int wc, int fr, int fq) const {
        const int row0 = u.pm * BM + wr * 64 + fr, col0 = u.pn * BM + wc * 32 + 8 * fq;
        const float* gp = gate + (size_t)(u.pm >> 3) * 6144 + col0;
        f32x4 gv[2][2];
#pragma unroll
        for (int bj = 0; bj < 2; ++bj)
#pragma unroll
            for (int n = 0; n < 2; ++n) gv[bj][n] = *(const f32x4*)(gp + bj * HALF + 4 * n) * scl;
#pragma unroll
        for (int ai = 0; ai < 2; ++ai)
#pragma unroll
            for (int m = 0; m < 4; ++m) { f16* rowp = Y + (size_t)(row0 + ai * HALF + m * 16) * DM + col0;
#pragma unroll
                for (int bj = 0; bj < 2; ++bj) { const f32x4 v0 = acc[ai][bj][m][0] * gv[bj][0], v1 = acc[ai][bj][m][1] * gv[bj][1];
                    u32x4 w; w.x = pkh(v0[0], v0[1]); w.y = pkh(v0[2], v0[3]); w.z = pkh(v1[0], v1[1]); w.w = pkh(v1[2], v1[3]);
                    *(u32x4*)(rowp + bj * HALF) = w; } }
    }
};
template <bool F8IN, bool F8 = F8IN> struct EpiGlu {
    static constexpr bool PERM = true;
    void* Ov; int ldc;
    __device__ __forceinline__ void operator()(const f32x4 (&acc)[2][2][4][2], const Unit& u, int wr, int wc, int fr, int fq) const {
        const int row0 = u.pm * BM + wr * 64 + fr, col0 = u.pn * HALF + wc * 32 + 8 * fq;
        constexpr float si = F8IN ? 1.0f / F8_WSCALE : 1.0f, so = F8 ? F8_ASCALE : 1.0f;
#pragma unroll
        for (int ai = 0; ai < 2; ++ai)
#pragma unroll
            for (int m = 0; m < 4; ++m) {
                float r[8];
#pragma unroll
                for (int n = 0; n < 2; ++n)
#pragma unroll
                    for (int p = 0; p < 2; ++p) {
                        const f32x2 a = {acc[ai][0][m][n][2 * p], acc[ai][0][m][n][2 * p + 1]}, b = {acc[ai][1][m][n][2 * p], acc[ai][1][m][n][2 * p + 1]};
                        const f32x2 t = a * (-1.4426950408889634f * si); f32x2 d = {ex2(t.x), ex2(t.y)}; d = d + 1.0f;
                        const f32x2 u = {__builtin_amdgcn_rcpf(d.x), __builtin_amdgcn_rcpf(d.y)};
                        const f32x2 q = ((a * b) * u) * (si * si * so);
                        r[4 * n + 2 * p] = q.x; r[4 * n + 2 * p + 1] = q.y;
                    }
                if (F8) { u32x2 w; w.x = pk4f8(r[0], r[1], r[2], r[3]); w.y = pk4f8(r[4], r[5], r[6], r[7]);
                    *(u32x2*)((unsigned char*)Ov + (size_t)(row0 + ai * HALF + m * 16) * ldc + col0) = w; }
                else { u32x4 w; w.x = pkh(r[0], r[1]); w.y = pkh(r[2], r[3]); w.z = pkh(r[4], r[5]); w.w = pkh(r[6], r[7]);
                    *(u32x4*)((f16*)Ov + (size_t)(row0 + ai * HALF + m * 16) * ldc + col0) = w; }
            }
    }
};
struct EpiF16 {
    static constexpr bool PERM = true;
    f16* O; int ldc; int split_cols; size_t split_stride; float scale;
    __device__ __forceinline__ void operator()(const f32x4 (&acc)[2][2][4][2], const Unit& u, int wr, int wc, int fr, int fq) const {
        const int row0 = u.pm * BM + wr * 64 + fr; int colt = u.pn * BM; f16* base = O;
        if (split_cols) { const int t = colt / split_cols; base += (size_t)t * split_stride; colt -= t * split_cols; }
        const int col0 = colt + wc * 32 + 8 * fq;
#pragma unroll
        for (int ai = 0; ai < 2; ++ai)
#pragma unroll
            for (int m = 0; m < 4; ++m) { f16* rowp = base + (size_t)(row0 + ai * HALF + m * 16) * ldc + col0;
#pragma unroll
                for (int bj = 0; bj < 2; ++bj) { const f32x4 v0 = acc[ai][bj][m][0] * scale, v1 = acc[ai][bj][m][1] * scale;
                    u32x4 w; w.x = pkh(v0[0], v0[1]); w.y = pkh(v0[2], v0[3]); w.z = pkh(v1[0], v1[1]); w.w = pkh(v1[2], v1[3]);
                    *(u32x4*)(rowp + bj * HALF) = w; } }
    }
};
struct EpiMoeOut {
    static constexpr bool PERM = true;
    f16* O; const float* roww;
    __device__ __forceinline__ void operator()(const f32x4 (&acc)[2][2][4][2], const Unit& u, int wr, int wc, int fr, int fq) const {
        const int row0 = u.pm * BM + wr * 64 + fr, col0 = u.pn * BM + wc * 32 + 8 * fq;
#pragma unroll
        for (int ai = 0; ai < 2; ++ai)
#pragma unroll
            for (int m = 0; m < 4; ++m) { const int rl = wr * 64 + fr + ai * HALF + m * 16, row = u.pm * BM + rl; const float sc = roww[u.vrow + rl] * (1.0f / (F8_WSCALE * F8_ASCALE)); f16* rowp = O + (size_t)row * DM + col0;
#pragma unroll
                for (int bj = 0; bj < 2; ++bj) { const f32x4 v0 = acc[ai][bj][m][0] * sc, v1 = acc[ai][bj][m][1] * sc;
                    u32x4 w; w.x = pkh(v0[0], v0[1]); w.y = pkh(v0[2], v0[3]); w.z = pkh(v1[0], v1[1]); w.w = pkh(v1[2], v1[3]);
                    *(u32x4*)(rowp + bj * HALF) = w; } }
    }
};

template <bool P> struct EpiNull {
    static constexpr bool PERM = P;
    float* sink;
    __device__ __forceinline__ void operator()(const f32x4 (&acc)[2][2][4][2], const Unit& u, int wr, int wc, int fr, int fq) const {
        float s = 0.f;
#pragma unroll
        for (int ai = 0; ai < 2; ++ai)
#pragma unroll
            for (int bj = 0; bj < 2; ++bj)
#pragma unroll
                for (int m = 0; m < 4; ++m)
#pragma unroll
                    for (int n = 0; n < 2; ++n) s += acc[ai][bj][m][n][0] + acc[ai][bj][m][n][1] + acc[ai][bj][m][n][2] + acc[ai][bj][m][n][3];
        if (s == 1.2345e37f) sink[0] = s;
    }
};
template <class Epi, bool F8 = false>
__device__ __forceinline__ void gemm_phase(LAS unsigned char* lds, const Gemm g, const Order& S, const Epi& E) {
    const int tid = threadIdx.x, wid = __builtin_amdgcn_readfirstlane(tid >> 6), lane = tid & 63, wr = wid >> 2, wc = wid & 3, fr = lane & 15, fq = lane >> 4;
    const int KB = g.K * (F8 ? 1 : 2), nt = KB / 128;
    unsigned voffA[2], voffB[2];
#pragma unroll
    for (int i = 0; i < 2; ++i) { int R, C; stage_rc(tid * 16 + i * 8192, R, C); const int Rb = Epi::PERM ? ((R & ~31) + perm32(R & 31)) : R;
        voffA[i] = (unsigned)(R * KB + 2 * C); voffB[i] = (unsigned)(Rb * KB + 2 * C); }
    const size_t kstep = (size_t)(BK * 2);
    const size_t hstep = (size_t)HALF * KB;
    const size_t tstep = 2 * hstep;
    const unsigned ldsw = (unsigned)wid * 1024u;
    const int aoff = lds_byte(wr * 64 + fr, fq * 8), boff = lds_byte(wc * 32 + fr, fq * 8);
#define PG8_SA(b, h) (((b) * 2 + (h)) * HTB)
#define PG8_SB(b, h) ((4 + (b) * 2 + (h)) * HTB)
#define PG8_STAGE(bufoff, gbase, voff) do { _Pragma("unroll") for (int _i = 0; _i < 2; ++_i) \
        __builtin_amdgcn_global_load_lds((const unsigned*)((const char*)(gbase) + (voff)[_i]), (LAS unsigned*)(lds + (bufoff) + ldsw + _i * 8192), 16, 0, 0); } while (0)
#define PG8_LD8(dst, addr) do { const i32x4 lo_ = *(const LAS i32x4*)(addr), hi_ = *(const LAS i32x4*)((addr) + 1024); dst = __builtin_shufflevector(lo_, hi_, 0, 1, 2, 3, 4, 5, 6, 7); } while (0)
#define PG8_LDA(dst, b, h) do { _Pragma("unroll") for (int m = 0; m < 4; ++m) { if constexpr (F8) PG8_LD8(dst##8[m], lds + PG8_SA(b, h) + aoff + m * 2048); else { _Pragma("unroll") for (int k = 0; k < 2; ++k) dst[m][k] = *(const LAS f16x8*)(lds + PG8_SA(b, h) + aoff + m * 2048 + k * 1024); } } } while (0)
#define PG8_LDB(dst, b, h) do { _Pragma("unroll") for (int n = 0; n < 2; ++n) { if constexpr (F8) PG8_LD8(dst##8[n], lds + PG8_SB(b, h) + boff + n * 2048); else { _Pragma("unroll") for (int k = 0; k < 2; ++k) dst[n][k] = *(const LAS f16x8*)(lds + PG8_SB(b, h) + boff + n * 2048 + k * 1024); } } } while (0)
#define PG8_MMA(ai, bj, At, Bt) do { __builtin_amdgcn_s_setprio(1); _Pragma("unroll") for (int m = 0; m < 4; ++m) _Pragma("unroll") for (int n = 0; n < 2; ++n) { \
        if constexpr (F8) asm volatile("v_mfma_scale_f32_16x16x128_f8f6f4 %0, %1, %2, %0, %3, %3 op_sel_hi:[0,0,0]" : "+v"(acc[ai][bj][m][n]) : "v"(Bt##8[n]), "v"(At##8[m]), "v"(f8scale)); \
        else { _Pragma("unroll") for (int k = 0; k < 2; ++k) acc[ai][bj][m][n] = __builtin_amdgcn_mfma_f32_16x16x32_f16(Bt[n][k], At[m][k], acc[ai][bj][m][n], 0, 0, 0); } } \
        __builtin_amdgcn_s_setprio(0); } while (0)
#define PG8_WAIT_V(n) asm volatile("s_waitcnt vmcnt(" #n ")" ::: "memory")
#define PG8_WAIT_L(n) asm volatile("s_waitcnt lgkmcnt(" #n ")" ::: "memory")
#define PG8_BAR __builtin_amdgcn_s_barrier()
#define PG8_SCHED __builtin_amdgcn_sched_barrier(0)
    Unit cur, nxt; int ui = 0;
    if (!S.next(0, cur)) return;
    if (g.stagger) {
        const unsigned grp = (blockIdx.x >> 3) & 3u;
        if (grp) { const unsigned long long t0 = __builtin_amdgcn_s_memrealtime(); while (__builtin_amdgcn_s_memrealtime() - t0 < (unsigned long long)(grp * (unsigned)g.stagger)) __builtin_amdgcn_s_sleep(16); }
    }
    f32x4 acc[2][2][4][2];
#pragma unroll
    for (int a = 0; a < 2; ++a)
#pragma unroll
        for (int b = 0; b < 2; ++b)
#pragma unroll
            for (int m = 0; m < 4; ++m)
#pragma unroll
                for (int n = 0; n < 2; ++n) acc[a][b][m][n] = (f32x4){0.f, 0.f, 0.f, 0.f};
    const int f8scale = 0x7f7f7f7f;
    f16x8 At[4][2], B0[2][2], B1[2][2]; i32x8 At8[4], B08[2], B18[2];
    const char* cA = (const char*)g.A + (size_t)cur.arow * KB; const char* cB = (const char*)g.Bt + (size_t)cur.be * g.bstride + (size_t)cur.pn * tstep;
    PG8_STAGE(PG8_SB(0, 0), cB, voffB); PG8_STAGE(PG8_SB(0, 1), cB + hstep, voffB); PG8_STAGE(PG8_SA(0, 0), cA, voffA); PG8_STAGE(PG8_SA(0, 1), cA + hstep, voffA);
    if (wr == 1) PG8_BAR;
    PG8_WAIT_V(2); PG8_BAR;
    PG8_STAGE(PG8_SB(1, 0), cB + kstep, voffB); PG8_STAGE(PG8_SA(1, 0), cA + kstep, voffA); PG8_STAGE(PG8_SB(1, 1), cB + hstep + kstep, voffB);
    PG8_WAIT_V(6); PG8_BAR;
    for (;;) {
        const bool has_next = S.next(ui + 1, nxt);
        const char* nA = has_next ? (const char*)g.A + (size_t)nxt.arow * KB : cA; const char* nB = has_next ? (const char*)g.Bt + (size_t)nxt.be * g.bstride + (size_t)nxt.pn * tstep : cB;
#pragma nounroll
        for (int t = 0; t < nt; t += 2) {
            const bool last = (t == nt - 2);
            const char* a1 = cA + (size_t)(t + 1) * kstep;
            const char* a2 = last ? nA : cA + (size_t)(t + 2) * kstep; const char* b2 = last ? nB : cB + (size_t)(t + 2) * kstep;
            const char* a3 = a2 + kstep; const char* b3 = b2 + kstep;
            PG8_LDB(B0, 0, 0); PG8_LDB(B1, 0, 1); PG8_SCHED; PG8_LDA(At, 0, 0); PG8_STAGE(PG8_SA(1, 1), a1 + hstep, voffA);
            PG8_WAIT_V(8); PG8_WAIT_L(0); PG8_BAR; PG8_MMA(0, 0, At, B0); PG8_MMA(0, 1, At, B1); PG8_BAR; PG8_SCHED;
            PG8_LDA(At, 0, 1); PG8_STAGE(PG8_SB(0, 0), b2, voffB); PG8_STAGE(PG8_SB(0, 1), b2 + hstep, voffB); PG8_STAGE(PG8_SA(0, 0), a2, voffA);
            PG8_WAIT_V(8); PG8_WAIT_L(0); PG8_BAR; PG8_MMA(1, 0, At, B0); PG8_MMA(1, 1, At, B1); PG8_BAR; PG8_SCHED;
            PG8_LDB(B0, 1, 0); PG8_LDB(B1, 1, 1); PG8_SCHED; PG8_LDA(At, 1, 0); PG8_STAGE(PG8_SA(0, 1), a2 + hstep, voffA);
            PG8_WAIT_V(8); PG8_WAIT_L(0); PG8_BAR; PG8_MMA(0, 0, At, B0); PG8_MMA(0, 1, At, B1); PG8_BAR; PG8_SCHED;
            PG8_LDA(At, 1, 1); PG8_STAGE(PG8_SB(1, 0), b3, voffB); PG8_STAGE(PG8_SB(1, 1), b3 + hstep, voffB); PG8_STAGE(PG8_SA(1, 0), a3, voffA);
            PG8_WAIT_V(8); PG8_WAIT_L(0); PG8_BAR; PG8_MMA(1, 0, At, B0); PG8_MMA(1, 1, At, B1); PG8_BAR; PG8_SCHED;
        }
        if constexpr (F8) asm volatile("s_nop 15\n\ts_nop 15" ::: "memory");
        if (wr == 0) PG8_BAR;
        E(acc, cur, wr, wc, fr, fq);
        if (!has_next) break;
#pragma unroll
        for (int a = 0; a < 2; ++a)
#pragma unroll
            for (int b = 0; b < 2; ++b)
#pragma unroll
                for (int m = 0; m < 4; ++m)
#pragma unroll
                    for (int n = 0; n < 2; ++n) acc[a][b][m][n] = (f32x4){0.f, 0.f, 0.f, 0.f};
        cur = nxt; cA = nA; cB = nB; ++ui;
        if (wr == 1) PG8_BAR;
    }
    PG8_WAIT_V(0);
    PG8_BAR;
#undef PG8_SA
#undef PG8_SB
#undef PG8_STAGE
#undef PG8_LDA
#undef PG8_LDB
#undef PG8_MMA
#undef PG8_WAIT_V
#undef PG8_WAIT_L
#undef PG8_BAR
#undef PG8_SCHED
}
}

constexpr size_t MiB = 1u << 20;
constexpr size_t WS_CTL = 0, CTL_ZERO_BYTES = 1 * MiB;
constexpr size_t WS_MOD = 1 * MiB;
constexpr size_t WS_KVMOD = 3 * MiB;
constexpr size_t WS_TOKINFO = 4 * MiB;
constexpr size_t WS_TOKSLOT = 6 * MiB;
constexpr size_t WS_SLOTW = 7 * MiB;
constexpr size_t WS_ROPE = 8 * MiB;
constexpr size_t WS_W_RIN = 24 * MiB, WS_W_ROUT = 48 * MiB, WS_W_KV = 56 * MiB, WS_W_SQ = 60 * MiB, WS_W_SO = 64 * MiB, WS_W_FIN = 68 * MiB, WS_W_FOUT = 90 * MiB, WS_W_MIN = 101 * MiB, WS_W_MOUT = 325 * MiB;
constexpr size_t WS_X = 437 * MiB, WS_H = 565 * MiB, WS_KSH = 629 * MiB, WS_VSH = 693 * MiB, WS_BIG = 757 * MiB;
constexpr size_t WS_PROJ = WS_BIG, WS_AO = WS_BIG + 384 * MiB;
constexpr size_t WS_ACTD = WS_BIG;
constexpr int MOE_CAP = MTOK;
constexpr size_t WS_HS = WS_BIG, WS_Y2 = WS_BIG, WS_ACTE = WS_BIG + 256 * MiB;
constexpr size_t WS_SQ = WS_BIG, WS_SO = WS_BIG + 64 * MiB, WS_HK = WS_BIG + 192 * MiB;
constexpr size_t WS_YB = WS_BIG + 594 * MiB;
constexpr size_t WS_END = WS_YB + 64 * MiB;
static_assert((size_t)MOE_ROWS_MAX * DM * 2 <= 256 * MiB && (size_t)NEXP * MOE_CAP * DM <= 256 * MiB && WS_ACTE + (size_t)MOE_ROWS_MAX * FFE <= WS_YB && WS_AO + (size_t)MTOK * 2048 * 2 <= WS_YB, "ws map");
constexpr int CW_BAR = 4096;
constexpr int CW_MOE = 16384;

constexpr int RING_BYTES = 131072;
constexpr int LDS_BYTES = 147456;
constexpr int MISC_OFF = LDS_BYTES - 256;

#define XB_TMO      128
#define XB_XCNT(j)  (256  + 64 * (j))
#define XB_XSUB(j)  (1280 + 64 * (j))
#define XB_XGEN(j)  (2304 + 64 * (j))
#define XB_TOP      3328
#define XB_TOPGEN   3392
#define XCD_BAR_WORDS 3456
#define XB_SPIN_CAP (1u << 20)
__device__ __forceinline__ unsigned xb_ld(unsigned* p)              { return __hip_atomic_load(p, __ATOMIC_RELAXED, __HIP_MEMORY_SCOPE_AGENT); }
__device__ __forceinline__ unsigned xb_add(unsigned* p, unsigned v) { return __hip_atomic_fetch_add(p, v, __ATOMIC_RELAXED, __HIP_MEMORY_SCOPE_AGENT); }
__device__ __forceinline__ unsigned xb_xcc_id() { return (unsigned)__builtin_amdgcn_s_getreg((3 << 11) | 20) & 0xFu; }
#define XB_SPIN(cond, bar) do { unsigned _sp = 0; while (cond) { __builtin_amdgcn_s_sleep(1); \
    if ((++_sp & 255u) == 0u) { if (xb_ld(&(bar)[XB_TMO])) break; if (_sp > XB_SPIN_CAP) { atomicAdd(&(bar)[XB_TMO], 1u); break; } } } } while (0)
struct XcdBarrier { unsigned* bar; unsigned x; volatile LAS unsigned* st; };
__device__ __forceinline__ XcdBarrier xcd_barrier_post(unsigned* bar, volatile LAS unsigned* st) {
    XcdBarrier b; b.bar = bar; b.x = xb_xcc_id(); b.st = st;
    if (threadIdx.x == 0) (void)xb_add(&bar[XB_XCNT(b.x)], 1u);
    return b;
}
__device__ __forceinline__ void xcd_barrier_complete(unsigned* bar, unsigned x, unsigned& nloc, unsigned& nx) {
    const unsigned G = gridDim.x * gridDim.y * gridDim.z;
    unsigned sum, cnt, mine, sp = 0u;
    for (;;) {
        sum = 0u; cnt = 0u; mine = 0u;
#pragma unroll
        for (unsigned j = 0; j < 16; ++j) { const unsigned c = xb_ld(&bar[XB_XCNT(j)]); sum += c; cnt += (c > 0u) ? 1u : 0u; mine = (j == x) ? c : mine; }
        if (sum == G) break;
        __builtin_amdgcn_s_sleep(1);
        if ((++sp & 255u) == 0u) { if (xb_ld(&bar[XB_TMO])) break; if (sp > XB_SPIN_CAP) { atomicAdd(&bar[XB_TMO], 1u); break; } }
    }
    nloc = mine > 0u ? mine : 1u; nx = cnt > 0u ? cnt : 1u;
}
__device__ __forceinline__ void xcd_barrier(const XcdBarrier& b) {
    asm volatile("s_waitcnt vmcnt(0)" ::: "memory");
    __syncthreads();
    if (threadIdx.x == 0) {
        unsigned* bar = b.bar;
        __builtin_amdgcn_s_waitcnt(0);
        unsigned nloc = b.st[0], nx = b.st[1];
        if (nloc == 0u) { xcd_barrier_complete(bar, b.x, nloc, nx); b.st[0] = nloc; b.st[1] = nx; }
        const unsigned old = xb_add(&bar[XB_XSUB(b.x)], 1u);
        const unsigned gen = old / nloc;
        if (old + 1u == (gen + 1u) * nloc) {
            __builtin_amdgcn_fence(__ATOMIC_RELEASE, "agent");
            asm volatile("s_waitcnt vmcnt(0)" ::: "memory");
            const unsigned og = xb_add(&bar[XB_TOP], 1u);
            const unsigned tg = og / nx;
            if (og + 1u == (tg + 1u) * nx) xb_add(&bar[XB_TOPGEN], 1u);
            else XB_SPIN(xb_ld(&bar[XB_TOPGEN]) == tg, bar);
            __builtin_amdgcn_fence(__ATOMIC_ACQUIRE, "agent");
            xb_add(&bar[XB_XGEN(b.x)], 1u);
            asm volatile("s_waitcnt vmcnt(0)" ::: "memory");
        } else {
            XB_SPIN(xb_ld(&bar[XB_XGEN(b.x)]) == gen, bar);
            __builtin_amdgcn_fence(__ATOMIC_ACQUIRE, "agent");
            asm volatile("s_waitcnt vmcnt(0)" ::: "memory");
        }
    }
    __syncthreads();
}

#define WG_BAR() do { asm volatile("s_waitcnt lgkmcnt(0)" ::: "memory"); __builtin_amdgcn_s_barrier(); asm volatile("" ::: "memory"); } while (0)
#define CFENCE() asm volatile("" ::: "memory")
__device__ __forceinline__ float wave_sum(float v) {
#pragma unroll
    for (int o = 1; o < 64; o <<= 1) v += __shfl_xor(v, o);
    return v;
}
__device__ __forceinline__ f16x4 tr_read(LAS const unsigned char* p) {
    return __builtin_bit_cast(f16x4, __builtin_amdgcn_ds_read_tr16_b64_v4i16((LAS v4i16_t*)p));
}
__device__ __forceinline__ f16x8 cat8(f16x4 a, f16x4 b) { return (f16x8){a[0], a[1], a[2], a[3], b[0], b[1], b[2], b[3]}; }
__device__ __forceinline__ f16x8 pack8(const f32x16& x, int s) {
    u32x4 w; w.x = pkh(x[8 * s + 0], x[8 * s + 1]); w.y = pkh(x[8 * s + 2], x[8 * s + 3]); w.z = pkh(x[8 * s + 4], x[8 * s + 5]); w.w = pkh(x[8 * s + 6], x[8 * s + 7]);
    return __builtin_bit_cast(f16x8, w);
}

struct Frame {
    LAS unsigned char* lds;
    unsigned* ctl;
    int wave, vcu, G;
    unsigned char* ws;
};
__device__ __forceinline__ int lane_id() { int l; asm volatile("v_mbcnt_lo_u32_b32 %0, -1, 0\n\tv_mbcnt_hi_u32_b32 %0, -1, %0" : "=v"(l)); return l; }
#define PHASE_IDS() const int lane = lane_id(); const int tid = F.wave * 64 + lane; (void)tid

template <int I> __device__ __forceinline__ const void* karg() {
    const auto kp = __builtin_amdgcn_kernarg_segment_ptr();
    unsigned long long v; asm volatile("s_load_dwordx2 %0, %1, %2\n\ts_waitcnt lgkmcnt(0)" : "=s"(v) : "s"(kp), "i"(I * 8) : "memory");
    return (const void*)(const GAS char*)v;
}
#define KIN(i) ((const float*)karg<(i)>())
template <int MAP>
__device__ __forceinline__ int srccol(int n, int N) {
    if (MAP == 1) { if (n >= 2048) return n; const int p = n & 127; return (n & ~127) + (p >> 1) + 64 * (p & 1); }
    if (MAP == 2) { const int F = N >> 1, t = n >> 8, j = n & 255; return (j < 128) ? 128 * t + j : F + 128 * t + (j - 128); }
    return n;
}
template <int MAP, bool F8>
__device__ __forceinline__ void p0_transpose_item(const float* W, int K, int N, void* WT, LAS float* scr, int item, int lane) {
    const int nblk = N / 32, kb = item / nblk, nb = item % nblk, k0 = 64 * kb, n0 = 32 * nb;
    const int sc = srccol<MAP>(n0 + (lane & 31), N);
    const float* wp = W + (size_t)(k0 + (lane >> 5)) * N + sc;
    float v[32];
#pragma unroll
    for (int i = 0; i < 32; ++i) v[i] = __builtin_nontemporal_load(wp + (size_t)(2 * i) * N);
#pragma unroll
    for (int i = 0; i < 32; ++i) scr[(2 * i + (lane >> 5)) * 33 + (lane & 31)] = F8 ? v[i] * F8_WSCALE : v[i];
    asm volatile("s_waitcnt lgkmcnt(0)" ::: "memory");
    if (F8) {
        const int c = lane & 3;
#pragma unroll
        for (int j = 0; j < 2; ++j) { const int n = (lane >> 2) + 16 * j; const LAS float* s = scr + (16 * c) * 33 + n;
            u32x4 o; o.x = pk4f8(s[0 * 33], s[1 * 33], s[2 * 33], s[3 * 33]); o.y = pk4f8(s[4 * 33], s[5 * 33], s[6 * 33], s[7 * 33]);
            o.z = pk4f8(s[8 * 33], s[9 * 33], s[10 * 33], s[11 * 33]); o.w = pk4f8(s[12 * 33], s[13 * 33], s[14 * 33], s[15 * 33]);
            *(u32x4*)((unsigned char*)WT + (size_t)(n0 + n) * K + k0 + 16 * c) = o; }
    } else {
        const int c = lane & 7;
#pragma unroll
        for (int j = 0; j < 4; ++j) { const int n = (lane >> 3) + 8 * j; const LAS float* s = scr + (8 * c) * 33 + n;
            u32x4 o; o.x = pkh(s[0 * 33], s[1 * 33]); o.y = pkh(s[2 * 33], s[3 * 33]); o.z = pkh(s[4 * 33], s[5 * 33]); o.w = pkh(s[6 * 33], s[7 * 33]);
            *(u32x4*)((f16*)WT + (size_t)(n0 + n) * K + k0 + 8 * c) = o; }
    }
    asm volatile("s_waitcnt lgkmcnt(0)" ::: "memory");
}
template <int MAP, bool F8>
__device__ __forceinline__ bool p0_group(int& r, const float* W, int nb, int K, int N, void* WT, LAS float* scr, int lane) {
    const int per = (K / 64) * (N / 32), tot = nb * per;
    if (r >= tot) { r -= tot; return false; }
    const int b = r / per, it = r % per;
    p0_transpose_item<MAP, F8>(W + (size_t)b * K * N, K, N, (unsigned char*)WT + (size_t)b * K * N * (F8 ? 1 : 2), scr, it, lane);
    return true;
}
constexpr int CONV_ITEMS_0 = 8 * (16 * 224 + 56 * 32) + 16 * 192 + 32 * 32;
constexpr int CONV_ITEMS_1 = 8 * (16 * 224 + 56 * 32) + 16 * 64 + 4 * 16 * 32 + 16 * 176 + 44 * 32;
__device__ __forceinline__ void conv_rest(int r, int which, unsigned char* ws, LAS float* scr, int lane) {
    if (which != 1) {
        if (p0_group<2, true>(r, KIN(19), NEXP, 1024, 7168, ws + WS_W_MIN, scr, lane)) return;
        if (p0_group<0, true>(r, KIN(20), NEXP, 3584, 1024, ws + WS_W_MOUT, scr, lane)) return;
        if (p0_group<1, RETIN_F8 != 0>(r, KIN(7) + (size_t)1024 * 6144, 1, 1024, 6144, (f16*)(ws + WS_W_RIN) + (size_t)1024 * 6144, scr, lane)) return;
        if (p0_group<0, false>(r, KIN(9) + (size_t)2048 * 1024, 1, 2048, 1024, (f16*)(ws + WS_W_ROUT) + (size_t)2048 * 1024, scr, lane)) return;
    }
    if (which != 0) {
        if (p0_group<2, true>(r, KIN(19) + (size_t)NEXP * 1024 * 7168, NEXP, 1024, 7168, ws + WS_W_MIN + (size_t)NEXP * 1024 * 7168, scr, lane)) return;
        if (p0_group<0, true>(r, KIN(20) + (size_t)NEXP * 3584 * 1024, NEXP, 3584, 1024, ws + WS_W_MOUT + (size_t)NEXP * 3584 * 1024, scr, lane)) return;
        if (p0_group<0, false>(r, KIN(13), 1, 1024, 2048, (f16*)(ws + WS_W_KV), scr, lane)) return;
        if (p0_group<0, false>(r, KIN(14), 2, 1024, 1024, (f16*)(ws + WS_W_SQ), scr, lane)) return;
        if (p0_group<0, false>(r, KIN(15), 2, 1024, 1024, (f16*)(ws + WS_W_SO), scr, lane)) return;
        if (p0_group<2, DENSE_F8 != 0>(r, KIN(16) + (size_t)1024 * 5632, 1, 1024, 5632, (f16*)(ws + WS_W_FIN) + (size_t)1024 * 5632, scr, lane)) return;
        p0_group<0, (DENSE_F8 != 0 && DENSE_F8_OUT != 0)>(r, KIN(17) + (size_t)2816 * 1024, 1, 2816, 1024, (f16*)(ws + WS_W_FOUT) + (size_t)2816 * 1024, scr, lane);
    }
}
__device__ __forceinline__ void p0_prologue(Frame& F) {
    PHASE_IDS();
    const int gw = F.vcu * 8 + F.wave, NGW = F.G * 8;
    LAS float* condL = (LAS float*)(F.lds);
    LAS float* scr = (LAS float*)(F.lds + 65536 + F.wave * 8448);
    for (int i = tid; i < 16 * 1024; i += 512) { const int b = i >> 10, k = i & 1023; condL[k * 16 + b] = silu_f(KIN(1)[i]); }
    WG_BAR();
    for (int it = gw; it < 1664; it += NGW) {
        const float* W; const float* bias; float* dst; int N, col0;
        if (it < 1536) { const int l = it / 384; col0 = 16 * (it % 384); N = 6144; W = KIN(3) + (size_t)l * 1024 * 6144; bias = KIN(4) + l * 6144; dst = (float*)(F.ws + WS_MOD) + (size_t)l * 16 * 6144; }
        else { col0 = 16 * (it - 1536); N = 2048; W = KIN(10); bias = KIN(11); dst = (float*)(F.ws + WS_KVMOD); }
        const int cl = lane & 3, kg = lane >> 2;
        f32x4 acc[16];
#pragma unroll
        for (int b = 0; b < 16; ++b) acc[b] = (f32x4){0.f, 0.f, 0.f, 0.f};
        const float* wp = W + (size_t)kg * N + col0 + 4 * cl;
#pragma unroll 4
        for (int k16 = 0; k16 < 64; ++k16) {
            const f32x4 w = *(const f32x4*)(wp + (size_t)k16 * 16 * N);
            const LAS f32x4* cp = (const LAS f32x4*)(condL + (16 * k16 + kg) * 16);
            const f32x4 c0 = cp[0], c1 = cp[1], c2 = cp[2], c3 = cp[3];
#pragma unroll
            for (int j = 0; j < 4; ++j) { acc[j] += c0[j] * w; acc[4 + j] += c1[j] * w; acc[8 + j] += c2[j] * w; acc[12 + j] += c3[j] * w; }
        }
        const f32x4 bv = *(const f32x4*)(bias + col0 + 4 * cl);
#pragma unroll
        for (int b = 0; b < 16; ++b) {
            f32x4 v = acc[b];
#pragma unroll
            for (int j = 0; j < 4; ++j) { v[j] += __shfl_xor(v[j], 4); v[j] += __shfl_xor(v[j], 8); v[j] += __shfl_xor(v[j], 16); v[j] += __shfl_xor(v[j], 32); }
            if (kg == 0) *(f32x4*)(dst + (size_t)b * N + col0 + 4 * cl) = v + bv;
        }
    }
    {
        const double e = -(double)lane / 64.0;
        const double invf = exp2(e * 13.287712379549449);
        float* rope = (float*)(F.ws + WS_ROPE); const int* posp = (const int*)karg<2>();
        for (int row = gw; row < MTOK; row += NGW) {
            const double rev = (double)posp[row] * invf * 0.15915494309189535;
            const float fr = (float)(rev - floor(rev));
            rope[(size_t)row * 128 + lane] = __builtin_amdgcn_cosf(fr); rope[(size_t)row * 128 + 64 + lane] = __builtin_amdgcn_sinf(fr);
        }
    }
    constexpr int per_rin = 16 * 192, per_rout = 32 * 32, per_kv = 16 * 64, per_sq = 16 * 32, per_fin = 16 * 176, per_fout = 44 * 32, per_min = 16 * 224, per_mout = 56 * 32;
    constexpr int NITEMS = CONV_IN_SCAN ? (per_rin + per_rout + per_fin + per_fout) : (2 * per_rin + 2 * per_rout + per_kv + 4 * per_sq + 2 * per_fin + 2 * per_fout + 16 * per_min + 16 * per_mout);
    for (int it = gw; it < NITEMS; it += NGW) {
        int r = it;
        if (p0_group<1, RETIN_F8 != 0>(r, KIN(7), 1, 1024, 6144, (f16*)(F.ws + WS_W_RIN), scr, lane)) continue;
        if (p0_group<0, false>(r, KIN(9), 1, 2048, 1024, (f16*)(F.ws + WS_W_ROUT), scr, lane)) continue;
        if (p0_group<2, false>(r, KIN(16), 1, 1024, 5632, (f16*)(F.ws + WS_W_FIN), scr, lane)) continue;
        if (p0_group<0, false>(r, KIN(17), 1, 2816, 1024, (f16*)(F.ws + WS_W_FOUT), scr, lane)) continue;
        if (!CONV_IN_SCAN) conv_rest(r, 2, F.ws, scr, lane);
    }
}

__device__ __forceinline__ void moe_tile_bases(const unsigned* gcnt, int (&tb)[NEXP], int& ntiles) {
    int acc = 0;
#pragma unroll
    for (int e = 0; e < NEXP; ++e) { tb[e] = acc; const unsigned c = __hip_atomic_load(gcnt + 64 * e, __ATOMIC_RELAXED, __HIP_MEMORY_SCOPE_AGENT); acc += (int)((c + 255u) >> 8); }
    ntiles = acc;
}
struct NormArgs {
    const void* x; f16* xw; const float* gain; const float* sh; const float* sc;
    f16* h; const float* gain2; const float* kvmod; f16* hk;
    const f16* y2; const float* gatef;
    float* out;
    const f16* yb;
    const float* router; unsigned* gcnt; unsigned* tokinfo; unsigned char* hs8; float* wof;
};
template <bool COMBINE, bool KV, bool FINAL, bool ROUTER, bool H8 = false, bool ADDY = false, bool XF32 = false>
__device__ __forceinline__ void norm_phase(Frame& F, const NormArgs& A) {
    PHASE_IDS();
    const int gw = F.vcu * 8 + F.wave, NGW = F.G * 8;
    LAS float* routL = (LAS float*)F.lds;
    LAS unsigned* lcnt = (LAS unsigned*)(F.lds + 32768);
    LAS unsigned* recs = (LAS unsigned*)(F.lds + 32768 + 256);
    if (ROUTER) {
        for (int i = tid; i < 8192; i += 512) routL[(i & 7) * 1024 + (i >> 3)] = A.router[i];
        if (tid < 16) lcnt[tid] = 0u;
        WG_BAR();
    }
    int ctb[NEXP]; int cnt_ = 0; (void)cnt_;
    if (COMBINE) moe_tile_bases(A.gcnt, ctb, cnt_);
    f32x4 cxf[4], nxf[4]; f16x4 cxh[4], nxh[4], cya[4], nya[4], cyb[4], nyb[4]; u32x4 ti_n = {0u, 0u, 0u, 0u};
#define NP_ISSUE(row_, ti_, xf_, xh_, ya_, yb_) do { \
        _Pragma("unroll") for (int j = 0; j < 4; ++j) { if (XF32) xf_[j] = *((const f32x4*)((const float*)A.x + (size_t)(row_) * DM) + lane + 64 * j); else xh_[j] = *((const f16x4*)((const f16*)A.x + (size_t)(row_) * DM) + lane + 64 * j); } \
        if (ADDY) { _Pragma("unroll") for (int j = 0; j < 4; ++j) ya_[j] = *((const f16x4*)(A.yb + (size_t)(row_) * DM) + lane + 64 * j); } \
        if (COMBINE) { int b1_ = 0, b2_ = 0; \
            _Pragma("unroll") for (int e = 0; e < NEXP; ++e) { b1_ = ((int)(ti_).x == e) ? ctb[e] : b1_; b2_ = ((int)(ti_).z == e) ? ctb[e] : b2_; } \
            const f16* pa_ = A.y2 + ((size_t)b1_ * 256 + (ti_).y) * DM; const f16* pb_ = A.y2 + ((size_t)b2_ * 256 + (ti_).w) * DM; \
            _Pragma("unroll") for (int j = 0; j < 4; ++j) { ya_[j] = *((const f16x4*)pa_ + lane + 64 * j); yb_[j] = *((const f16x4*)pb_ + lane + 64 * j); } } } while (0)
    if (gw < MTOK) {
        u32x4 ti0 = {0u, 0u, 0u, 0u};
        if (COMBINE) ti0 = *(const u32x4*)(A.tokinfo + 8 * (size_t)gw);
        NP_ISSUE(gw, ti0, cxf, cxh, cya, cyb);
        if (COMBINE && gw + NGW < MTOK) ti_n = *(const u32x4*)(A.tokinfo + 8 * (size_t)(gw + NGW));
    }
    int nloc = 0;
    for (int row = gw; row < MTOK; row += NGW, ++nloc) {
        const int b = row >> 11;
        if (row + NGW < MTOK) {
            NP_ISSUE(row + NGW, ti_n, nxf, nxh, nya, nyb);
            if (COMBINE && row + 2 * NGW < MTOK) ti_n = *(const u32x4*)(A.tokinfo + 8 * (size_t)(row + 2 * NGW));
        }
        f32x4 v[4];
#pragma unroll
        for (int j = 0; j < 4; ++j) { if (XF32) v[j] = cxf[j]; else v[j] = (f32x4){(float)cxh[j][0], (float)cxh[j][1], (float)cxh[j][2], (float)cxh[j][3]}; }
        if (ADDY) {
#pragma unroll
            for (int j = 0; j < 4; ++j) {
#pragma unroll
                for (int t = 0; t < 4; ++t) v[j][t] += (float)cya[j][t];
                { u32x2 w; w.x = pkh(v[j][0], v[j][1]); w.y = pkh(v[j][2], v[j][3]); *((u32x2*)(A.xw + (size_t)row * DM) + lane + 64 * j) = w; }
            }
        }
        if (COMBINE) {
#pragma unroll
            for (int j = 0; j < 4; ++j) {
                const f32x4 g = *((const f32x4*)(A.gatef + (size_t)b * 6144) + lane + 64 * j);
#pragma unroll
                for (int t = 0; t < 4; ++t) v[j][t] += g[t] * ((float)cya[j][t] + (float)cyb[j][t]);
                if (!FINAL) { u32x2 w; w.x = pkh(v[j][0], v[j][1]); w.y = pkh(v[j][2], v[j][3]); *((u32x2*)(A.xw + (size_t)row * DM) + lane + 64 * j) = w; }
            }
        }
        float ss = 0.f;
#pragma unroll
        for (int j = 0; j < 4; ++j) ss += (v[j][0] * v[j][0] + v[j][1] * v[j][1]) + (v[j][2] * v[j][2] + v[j][3] * v[j][3]);
        const float rstd = 1.0f / sqrtf(wave_sum(ss) * (1.0f / DM) + EPS);
        if (FINAL) {
#pragma unroll
            for (int j = 0; j < 4; ++j) { const f32x4 g = *((const f32x4*)A.gain + lane + 64 * j); *((f32x4*)(A.out + (size_t)row * DM) + lane + 64 * j) = v[j] * rstd * g; }
        } else {
            f32x4 hv[4];
#pragma unroll
            for (int j = 0; j < 4; ++j) {
                const f32x4 g = *((const f32x4*)A.gain + lane + 64 * j), sh = *((const f32x4*)(A.sh + (size_t)b * 6144) + lane + 64 * j), sc = *((const f32x4*)(A.sc + (size_t)b * 6144) + lane + 64 * j);
                hv[j] = (v[j] * rstd * g) * (1.0f + sc) + sh;
                if (H8) *((unsigned*)((unsigned char*)A.h + (size_t)row * DM) + lane + 64 * j) = pk4f8(hv[j][0], hv[j][1], hv[j][2], hv[j][3]);
                else { u32x2 w; w.x = pkh(hv[j][0], hv[j][1]); w.y = pkh(hv[j][2], hv[j][3]); *((u32x2*)(A.h + (size_t)row * DM) + lane + 64 * j) = w; }
            }
            if (KV) {
#pragma unroll
                for (int j = 0; j < 4; ++j) {
                    const f32x4 g = *((const f32x4*)A.gain2 + lane + 64 * j), sh = *((const f32x4*)(A.kvmod + (size_t)b * 2048) + lane + 64 * j), sc = *((const f32x4*)(A.kvmod + (size_t)b * 2048 + 1024) + lane + 64 * j);
                    const f32x4 o = (v[j] * rstd * g) * (1.0f + sc) + sh;
                    u32x2 w; w.x = pkh(o[0], o[1]); w.y = pkh(o[2], o[3]);
                    *((u32x2*)(A.hk + (size_t)row * DM) + lane + 64 * j) = w;
                }
            }
            if (ROUTER) {
                float lg[8];
#pragma unroll
                for (int e = 0; e < 8; ++e) lg[e] = 0.f;
#pragma unroll
                for (int j = 0; j < 4; ++j)
#pragma unroll
                    for (int e = 0; e < 8; ++e) {
                        const f32x4 rv = *((const LAS f32x4*)(routL + e * 1024) + lane + 64 * j);
                        lg[e] += (hv[j][0] * rv[0] + hv[j][1] * rv[1]) + (hv[j][2] * rv[2] + hv[j][3] * rv[3]);
                    }
                {
                    float r4[4], r2[2], r1;
                    const bool b0 = lane & 1, b1 = lane & 2, b2 = lane & 4;
#pragma unroll
                    for (int k = 0; k < 4; ++k) { const float keep = b0 ? lg[k + 4] : lg[k], send = b0 ? lg[k] : lg[k + 4]; r4[k] = keep + __shfl_xor(send, 1); }
#pragma unroll
                    for (int k = 0; k < 2; ++k) { const float keep = b1 ? r4[k + 2] : r4[k], send = b1 ? r4[k] : r4[k + 2]; r2[k] = keep + __shfl_xor(send, 2); }
                    { const float keep = b2 ? r2[1] : r2[0], send = b2 ? r2[0] : r2[1]; r1 = keep + __shfl_xor(send, 4); }
                    r1 += __shfl_xor(r1, 8); r1 += __shfl_xor(r1, 16); r1 += __shfl_xor(r1, 32);
#pragma unroll
                    for (int e = 0; e < 8; ++e) lg[e] = __int_as_float(__builtin_amdgcn_readlane(__float_as_int(r1), ((e >> 2) & 1) | (((e >> 1) & 1) << 1) | ((e & 1) << 2)));
                }
                int i1 = 0; float v1 = lg[0];
#pragma unroll
                for (int e = 1; e < 8; ++e) if (lg[e] > v1) { v1 = lg[e]; i1 = e; }
                int i2 = (i1 == 0) ? 1 : 0; float v2 = lg[i2];
#pragma unroll
                for (int e = 0; e < 8; ++e) if (e != i1 && lg[e] > v2) { v2 = lg[e]; i2 = e; }
                const float ed = __expf(v2 - v1), w1 = 1.0f / (1.0f + ed), w2 = ed * w1;
                if (lane == 0) {
                    const unsigned p1 = __hip_atomic_fetch_add(&lcnt[i1], 1u, __ATOMIC_RELAXED, __HIP_MEMORY_SCOPE_WORKGROUP), p2 = __hip_atomic_fetch_add(&lcnt[i2], 1u, __ATOMIC_RELAXED, __HIP_MEMORY_SCOPE_WORKGROUP);
                    LAS unsigned* rc = recs + (F.wave * 16 + nloc) * 8;
                    rc[0] = (unsigned)i1; rc[1] = p1; rc[2] = (unsigned)i2; rc[3] = p2; rc[4] = __float_as_uint(w1); rc[5] = __float_as_uint(w2);
                }
            }
        }
#pragma unroll
        for (int j = 0; j < 4; ++j) { cxf[j] = nxf[j]; cxh[j] = nxh[j]; cya[j] = nya[j]; cyb[j] = nyb[j]; }
    }
    if (ROUTER) {
        WG_BAR();
        if (tid < 8) lcnt[8 + tid] = __hip_atomic_fetch_add(A.gcnt + 64 * tid, lcnt[tid], __ATOMIC_RELAXED, __HIP_MEMORY_SCOPE_AGENT);
        WG_BAR();
        asm volatile("s_waitcnt vmcnt(0)" ::: "memory");
        for (int k0 = 0, row0 = gw; row0 < MTOK; row0 += 4 * NGW, k0 += 4) {
            u32x4 a[4];
#pragma unroll
            for (int q = 0; q < 4; ++q) { const int row = row0 + q * NGW; if (row < MTOK) a[q] = *((const u32x4*)((const unsigned char*)A.h + (size_t)row * DM) + lane); }
#pragma unroll
            for (int q = 0; q < 4; ++q) { const int row = row0 + q * NGW; if (row < MTOK) {
                const LAS unsigned* rc = recs + (F.wave * 16 + k0 + q) * 8;
                const unsigned e1 = rc[0], p1 = rc[1] + lcnt[8 + rc[0]], e2 = rc[2], p2 = rc[3] + lcnt[8 + rc[2]];
                const size_t v1 = (size_t)e1 * MOE_CAP + p1, v2 = (size_t)e2 * MOE_CAP + p2;
                *((u32x4*)(A.hs8 + v1 * DM) + lane) = a[q]; *((u32x4*)(A.hs8 + v2 * DM) + lane) = a[q];
                if (lane == 0) { *(u32x4*)(A.tokinfo + 8 * (size_t)row) = (u32x4){e1, p1, e2, p2}; A.wof[v1] = __uint_as_float(rc[4]); A.wof[v2] = __uint_as_float(rc[5]); } } }
        }
    }
}
constexpr int SC_PV = 576;
constexpr int SC_QL = 0, SC_KL = 16384, SC_VL = 32768, SC_SL = 69632, SC_ST = 135168, SC_STAGE = 0;
__device__ __forceinline__ int sc_off(int row, int ch) { return 256 * row + 16 * (ch ^ (((row & 3) << 2) | ((row >> 2) & 3))); }
__device__ __forceinline__ void scan_phase(Frame& F, const f16* proj, const float* gnw, f16* ao, int mi) {
    if (CONV_IN_SCAN) {
        if (blockIdx.x >= BATCH * RH) {
            PHASE_IDS();
            LAS float* scr = (LAS float*)(F.lds + F.wave * 8448);
            const int cw = ((int)blockIdx.x - BATCH * RH) * 8 + F.wave, NCW = ((int)gridDim.x - BATCH * RH) * 8;
            const int nit = mi ? CONV_ITEMS_1 : CONV_ITEMS_0;
            for (int it = cw; it < nit; it += NCW) conv_rest(it, mi, F.ws, scr, lane);
            return;
        }
    } else if (blockIdx.x >= 2 * BATCH * RH) return;
    const int unit = CONV_IN_SCAN ? (int)blockIdx.x : (int)(blockIdx.x >> 1), half = CONV_IN_SCAN ? 0 : (int)(blockIdx.x & 1);
    const int b = unit >> 3, hh = unit & 7;
    const int c_first_full = half ? NCHUNK / 2 : 0, c_end = CONV_IN_SCAN ? NCHUNK : (half ? NCHUNK : NCHUNK / 2);
    LAS unsigned char* L = F.lds;
    PHASE_IDS();
    const int wid = F.wave, rh = wid >> 2, cg = wid & 3, r = lane & 31, h = lane >> 5;
    const int gl = (lane >> 4) & 1, li = lane & 15, ta = li >> 2, tp = li & 3;
    const float lg = lg2gamma(hh);
    const float g63 = ex2(63.0f * lg), cd = __int_as_float(__builtin_amdgcn_readfirstlane(__float_as_int(ex2(64.0f * lg))));
    float vm[4], cj[4]; const int qloc = 32 * rh + r;
    const float wneg = __int_as_float(__builtin_amdgcn_readfirstlane(__float_as_int(ex2(-64.0f * lg))));
#pragma unroll
    for (int g4 = 0; g4 < 4; ++g4) vm[g4] = ex2((float)(16 * g4 + 8 * h - 2 * qloc - 64) * lg);
#pragma unroll
    for (int j = 0; j < 4; ++j) cj[j] = __int_as_float(__builtin_amdgcn_readfirstlane(__float_as_int(ex2((float)(2 * j) * lg))));
    const size_t rowbase = (size_t)b * SEQ;
    const f16* gq = proj + rowbase * RIN + 128 * hh;
    const f16* gk = gq + 1024;
    const f16* gv = proj + rowbase * RIN + 2048 + 256 * hh;
    const f16* gg = gv + 2048;
    const int qrow = tid >> 4, qc = tid & 15;
    const int vrow = tid >> 5, vc = tid & 31;
    int qoffL[2];
#pragma unroll
    for (int i = 0; i < 2; ++i) qoffL[i] = sc_off(qrow + 32 * i, qc);
    f32x16 SA[2][2];
#pragma unroll
    for (int dd = 0; dd < 2; ++dd)
#pragma unroll
        for (int et = 0; et < 2; ++et)
#pragma unroll
            for (int i = 0; i < 16; ++i) SA[dd][et][i] = 0.f;
    for (int i = tid; i < 65536 / 16; i += 512) *(LAS u32x4*)(L + SC_SL + i * 16) = (u32x4){0u, 0u, 0u, 0u};
    u32x4 nq[2], nk[2], nv[4];
#pragma unroll
    for (int i = 0; i < 2; ++i) { nq[i] = *(const u32x4*)(gq + (size_t)(qrow + 32 * i) * RIN + 8 * qc); nk[i] = *(const u32x4*)(gk + (size_t)(qrow + 32 * i) * RIN + 8 * qc); }
#pragma unroll
    for (int i = 0; i < 4; ++i) nv[i] = *(const u32x4*)(gv + (size_t)(vrow + 16 * i) * RIN + 8 * vc);
#pragma unroll
    for (int i = 0; i < 2; ++i) { *(LAS u32x4*)(L + SC_QL + qoffL[i]) = nq[i]; *(LAS u32x4*)(L + SC_KL + qoffL[i]) = nk[i]; }
#pragma unroll
    for (int i = 0; i < 4; ++i) *(LAS u32x4*)(L + SC_VL + (vrow + 16 * i) * SC_PV + 16 * vc) = nv[i];
    WG_BAR();
    for (int c = 0; c < c_first_full; ++c) {
        const size_t crow = (size_t)c * CHUNK;
#pragma unroll
        for (int i = 0; i < 2; ++i) { nq[i] = *(const u32x4*)(gq + (crow + 64 + qrow + 32 * i) * RIN + 8 * qc); nk[i] = *(const u32x4*)(gk + (crow + 64 + qrow + 32 * i) * RIN + 8 * qc); }
#pragma unroll
        for (int i = 0; i < 4; ++i) nv[i] = *(const u32x4*)(gv + (crow + 64 + vrow + 16 * i) * RIN + 8 * vc);
        int ro = r, ho = h, tao = ta, tpo = tp, glo = gl, vro = vrow, vco = vc;
        asm volatile("" : "+v"(ro), "+v"(ho), "+v"(tao), "+v"(tpo), "+v"(glo), "+v"(vro), "+v"(vco));
#pragma unroll
        for (int dd = 0; dd < 2; ++dd)
#pragma unroll
            for (int et = 0; et < 2; ++et)
#pragma unroll
                for (int i = 0; i < 16; ++i) SA[dd][et][i] *= cd;
#pragma unroll
        for (int kt = 0; kt < 2; ++kt)
#pragma unroll
            for (int s = 0; s < 2; ++s) {
                const int k0 = 32 * kt + 16 * s + 4 * ho + tao;
                f16x8 Vf[2], Kt[2];
#pragma unroll
                for (int et = 0; et < 2; ++et) { LAS const unsigned char* vp = L + SC_VL + k0 * SC_PV + (64 * cg + 32 * et + 16 * glo + 4 * tpo) * 2; Vf[et] = cat8(tr_read(vp), tr_read(vp + 8 * SC_PV)); }
#pragma unroll
                for (int dd = 0; dd < 2; ++dd) { const int ch = 4 * (2 * rh + dd) + 2 * glo + (tpo >> 1);
                    Kt[dd] = cat8(tr_read(L + SC_KL + sc_off(k0, ch) + 8 * (tpo & 1)), tr_read(L + SC_KL + sc_off(k0 + 8, ch) + 8 * (tpo & 1))); }
#pragma unroll
                for (int et = 0; et < 2; ++et)
#pragma unroll
                    for (int dd = 0; dd < 2; ++dd) SA[dd][et] = __builtin_amdgcn_mfma_f32_32x32x16_f16(Kt[dd], Vf[et], SA[dd][et], 0, 0, 0);
            }
        WG_BAR();
        if (c + 1 == c_first_full) {
#pragma unroll
            for (int dd = 0; dd < 2; ++dd)
#pragma unroll
                for (int et = 0; et < 2; ++et)
#pragma unroll
                    for (int g4 = 0; g4 < 4; ++g4) {
                        u32x2 w; w.x = pkh(SA[dd][et][4 * g4], SA[dd][et][4 * g4 + 1]); w.y = pkh(SA[dd][et][4 * g4 + 2], SA[dd][et][4 * g4 + 3]);
                        *(LAS u32x2*)(L + SC_SL + sc_off(64 * cg + 32 * et + ro, 4 * (2 * rh + dd) + g4) + 8 * ho) = w;
                    }
        }
#pragma unroll
        for (int i = 0; i < 2; ++i) { const int qo = sc_off((vro * 2 + (vco >> 4)) + 32 * i, vco & 15); *(LAS u32x4*)(L + SC_QL + qo) = nq[i]; *(LAS u32x4*)(L + SC_KL + qo) = nk[i]; }
#pragma unroll
        for (int i = 0; i < 4; ++i) *(LAS u32x4*)(L + SC_VL + (vrow + 16 * i) * SC_PV + 16 * vc) = nv[i];
        WG_BAR();
    }
    for (int c = c_first_full; c < c_end; ++c) {
        const size_t crow = (size_t)c * CHUNK;
        if (c + 1 < c_end) {
#pragma unroll
            for (int i = 0; i < 2; ++i) { nq[i] = *(const u32x4*)(gq + (crow + 64 + qrow + 32 * i) * RIN + 8 * qc); nk[i] = *(const u32x4*)(gk + (crow + 64 + qrow + 32 * i) * RIN + 8 * qc); }
#pragma unroll
            for (int i = 0; i < 4; ++i) nv[i] = *(const u32x4*)(gv + (crow + 64 + vrow + 16 * i) * RIN + 8 * vc);
        }
        int ro = r, ho = h, tao = ta, tpo = tp, glo = gl, vro = vrow, vco = vc;
        asm volatile("" : "+v"(ro), "+v"(ho), "+v"(tao), "+v"(tpo), "+v"(glo), "+v"(vro), "+v"(vco));
        f16x8 Pf[2][2]; f32x16 OT[2];
        {
        f16x8 Qf[8];
#pragma unroll
        for (int ks = 0; ks < 8; ++ks) Qf[ks] = *(const LAS f16x8*)(L + SC_QL + sc_off(32 * rh + ro, 2 * ks + ho));
#pragma unroll
        for (int kt = 0; kt < 2; ++kt) {
            f32x16 X;
#pragma unroll
            for (int i = 0; i < 16; ++i) X[i] = 0.f;
#pragma unroll
            for (int ks = 0; ks < 8; ++ks) { const f16x8 Kf = *(const LAS f16x8*)(L + SC_KL + sc_off(32 * kt + ro, 2 * ks + ho)); X = __builtin_amdgcn_mfma_f32_32x32x16_f16(Kf, Qf[ks], X, 0, 0, 0); }
#pragma unroll
            for (int i = 0; i < 16; ++i) { const int key = 32 * kt + (i & 3) + 8 * (i >> 2) + 4 * h; X[i] *= (key >= qloc) ? vm[i >> 2] * (kt ? cd * cj[i & 3] : cj[i & 3]) : wneg; }
            Pf[kt][0] = pack8(X, 0); Pf[kt][1] = pack8(X, 1);
        }
#pragma unroll
        for (int et = 0; et < 2; ++et)
#pragma unroll
            for (int i = 0; i < 16; ++i) OT[et][i] = 0.f;
#pragma unroll
        for (int ks = 0; ks < 8; ++ks)
#pragma unroll
            for (int et = 0; et < 2; ++et) {
                const f16x8 Sf = *(const LAS f16x8*)(L + SC_SL + sc_off(64 * cg + 32 * et + ro, 2 * ks + ho));
                OT[et] = __builtin_amdgcn_mfma_f32_32x32x16_f16(Sf, Qf[ks], OT[et], 0, 0, 0);
            }
        }
#pragma unroll
        for (int dd = 0; dd < 2; ++dd)
#pragma unroll
            for (int et = 0; et < 2; ++et)
#pragma unroll
                for (int i = 0; i < 16; ++i) SA[dd][et][i] *= cd;
#pragma unroll
        for (int kt = 0; kt < 2; ++kt)
#pragma unroll
            for (int s = 0; s < 2; ++s) {
                const int k0 = 32 * kt + 16 * s + 4 * ho + tao;
                f16x8 Vf[2], Kt[2];
#pragma unroll
                for (int et = 0; et < 2; ++et) { LAS const unsigned char* vp = L + SC_VL + k0 * SC_PV + (64 * cg + 32 * et + 16 * glo + 4 * tpo) * 2; Vf[et] = cat8(tr_read(vp), tr_read(vp + 8 * SC_PV)); }
#pragma unroll
                for (int dd = 0; dd < 2; ++dd) { const int ch = 4 * (2 * rh + dd) + 2 * glo + (tpo >> 1);
                    Kt[dd] = cat8(tr_read(L + SC_KL + sc_off(k0, ch) + 8 * (tpo & 1)), tr_read(L + SC_KL + sc_off(k0 + 8, ch) + 8 * (tpo & 1))); }
#pragma unroll
                for (int et = 0; et < 2; ++et) {
                    OT[et] = __builtin_amdgcn_mfma_f32_32x32x16_f16(Vf[et], Pf[kt][s], OT[et], 0, 0, 0);
#pragma unroll
                    for (int dd = 0; dd < 2; ++dd) SA[dd][et] = __builtin_amdgcn_mfma_f32_32x32x16_f16(Kt[dd], Vf[et], SA[dd][et], 0, 0, 0);
                }
            }
        float mean = 0.f, rstd = 0.f;
        {
        float s1 = 0.f, s2 = 0.f;
#pragma unroll
        for (int et = 0; et < 2; ++et)
#pragma unroll
            for (int i = 0; i < 16; ++i) { OT[et][i] *= g63; s1 += OT[et][i]; s2 += OT[et][i] * OT[et][i]; }
        s1 += __shfl_xor(s1, 32); s2 += __shfl_xor(s2, 32);
        if (h == 0) *(LAS f32x2*)(L + SC_ST + ((rh * 4 + cg) * 32 + r) * 8) = (f32x2){s1, s2};
        }
        WG_BAR();
        u32x4 gc[4];
        {
        float t1 = 0.f, t2 = 0.f;
#pragma unroll
        for (int c4 = 0; c4 < 4; ++c4) { const f32x2 p = *(const LAS f32x2*)(L + SC_ST + ((rh * 4 + c4) * 32 + r) * 8); t1 += p.x; t2 += p.y; }
        mean = t1 * (1.0f / 256.0f); const float var = t2 * (1.0f / 256.0f) - mean * mean; rstd = 1.0f / sqrtf(var + EPS);
#pragma unroll
        for (int i = 0; i < 4; ++i) gc[i] = *(const u32x4*)(gg + (crow + vrow + 16 * i) * RIN + 8 * vc);
        }
        {
#pragma unroll
        for (int dd = 0; dd < 2; ++dd)
#pragma unroll
            for (int et = 0; et < 2; ++et)
#pragma unroll
                for (int g4 = 0; g4 < 4; ++g4) {
                    u32x2 w; w.x = pkh(SA[dd][et][4 * g4], SA[dd][et][4 * g4 + 1]); w.y = pkh(SA[dd][et][4 * g4 + 2], SA[dd][et][4 * g4 + 3]);
                    *(LAS u32x2*)(L + SC_SL + sc_off(64 * cg + 32 * et + ro, 4 * (2 * rh + dd) + g4) + 8 * ho) = w;
                }
        }
        {
#pragma unroll
        for (int et = 0; et < 2; ++et)
#pragma unroll
            for (int g4 = 0; g4 < 4; ++g4) {
                u32x2 w; w.x = pkh((OT[et][4 * g4] - mean) * rstd, (OT[et][4 * g4 + 1] - mean) * rstd); w.y = pkh((OT[et][4 * g4 + 2] - mean) * rstd, (OT[et][4 * g4 + 3] - mean) * rstd);
                *(LAS u32x2*)(L + SC_STAGE + 16384 * (cg >> 1) + sc_off(32 * rh + ro, 8 * (cg & 1) + 4 * et + g4) + 8 * ho) = w;
            }
        }
        WG_BAR();
        {
        f32x4 gw0, gw1; { const float* gp = gnw + 256 * hh + 8 * vc; gw0 = *(const f32x4*)gp; gw1 = *(const f32x4*)(gp + 4); }
#pragma unroll
        for (int i = 0; i < 4; ++i) {
            const f16x8 n8 = *(const LAS f16x8*)(L + SC_STAGE + 16384 * (vco >> 4) + sc_off(vro + 16 * i, vco & 15));
            const f16x8 g8 = __builtin_bit_cast(f16x8, gc[i]);
            u32x4 w;
            w.x = pkh((float)n8[0] * (float)g8[0] * gw0[0], (float)n8[1] * (float)g8[1] * gw0[1]); w.y = pkh((float)n8[2] * (float)g8[2] * gw0[2], (float)n8[3] * (float)g8[3] * gw0[3]);
            w.z = pkh((float)n8[4] * (float)g8[4] * gw1[0], (float)n8[5] * (float)g8[5] * gw1[1]); w.w = pkh((float)n8[6] * (float)g8[6] * gw1[2], (float)n8[7] * (float)g8[7] * gw1[3]);
            *(u32x4*)(ao + (rowbase + crow + vrow + 16 * i) * 2048 + 256 * hh + 8 * vc) = w;
        }
        }
        WG_BAR();
        if (c + 1 < c_end) {
#pragma unroll
            for (int i = 0; i < 2; ++i) { const int qo = sc_off((vro * 2 + (vco >> 4)) + 32 * i, vco & 15); *(LAS u32x4*)(L + SC_QL + qo) = nq[i]; *(LAS u32x4*)(L + SC_KL + qo) = nk[i]; }
#pragma unroll
            for (int i = 0; i < 4; ++i) *(LAS u32x4*)(L + SC_VL + (vrow + 16 * i) * SC_PV + 16 * vc) = nv[i];
        }
        WG_BAR();
    }
}

constexpr int SBV_P = 144;
constexpr float SB_STOP = 5.421010862427522e-20f;
__device__ __forceinline__ void sb_phase(Frame& F, const f16* Q, const f16* Kc, const f16* Vc, f16* O, const float stop = SB_STOP) {
    PHASE_IDS();
    const int gw = F.vcu * 8 + F.wave, NGW = F.G * 8, r = lane & 31, h = lane >> 5;
    const int gl = (lane >> 4) & 1, li = lane & 15, ta = li >> 2, tp = li & 3;
    LAS unsigned char* Kw = F.lds + F.wave * (96 * SBV_P);
    LAS unsigned char* Vw = Kw + 32 * SBV_P; LAS unsigned char* Qw = Kw + 64 * SBV_P;
    const int vr = lane >> 3, vcc = lane & 7;
    constexpr int NU = BATCH * SBH * (SEQ / 32);
    u32x4 qn2[4], kn2[4], vn2[4];
    if (gw < NU) { const int qblk = gw & 63, bh = gw >> 6, b = bh >> 4, hd = bh & 15; const size_t rb = (size_t)b * SEQ;
        const f16* qp = Q + (rb + 32 * qblk + vr) * DM + 64 * hd + 8 * vcc; const f16* kp = Kc + (rb + 32 * qblk + vr) * DM + 64 * hd + 8 * vcc; const f16* vp = Vc + (rb + 32 * qblk + vr) * DM + 64 * hd + 8 * vcc;
#pragma unroll
        for (int i = 0; i < 4; ++i) { qn2[i] = *(const u32x4*)(qp + (size_t)(8 * i) * DM); kn2[i] = *(const u32x4*)(kp + (size_t)(8 * i) * DM); vn2[i] = *(const u32x4*)(vp + (size_t)(8 * i) * DM); } }
    for (int u = gw; u < NU; u += NGW) {
        const int qblk = u & 63, bh = u >> 6, b = bh >> 4, hd = bh & 15;
        const size_t rb = (size_t)b * SEQ;
        f16x8 Qf[4];
#pragma unroll
        for (int i = 0; i < 4; ++i) *(LAS u32x4*)(Qw + (vr + 8 * i) * SBV_P + 16 * vcc) = qn2[i];
        CFENCE();
#pragma unroll
        for (int ks = 0; ks < 4; ++ks) Qf[ks] = *(const LAS f16x8*)(Qw + r * SBV_P + (16 * ks + 8 * h) * 2);
        CFENCE();
        f32x16 OT[2];
#pragma unroll
        for (int dt = 0; dt < 2; ++dt)
#pragma unroll
            for (int i = 0; i < 16; ++i) OT[dt][i] = 0.f;
        float carry = 1.0f;
        u32x4 kn[4], vn[4];
#pragma unroll
        for (int i = 0; i < 4; ++i) { kn[i] = kn2[i]; vn[i] = vn2[i]; }
        if (u + NGW < NU) { const int un = u + NGW, qb2 = un & 63, bh2 = un >> 6, b2 = bh2 >> 4, hd2 = bh2 & 15; const size_t rb2 = (size_t)b2 * SEQ;
            const f16* qp = Q + (rb2 + 32 * qb2 + vr) * DM + 64 * hd2 + 8 * vcc; const f16* kp = Kc + (rb2 + 32 * qb2 + vr) * DM + 64 * hd2 + 8 * vcc; const f16* vp = Vc + (rb2 + 32 * qb2 + vr) * DM + 64 * hd2 + 8 * vcc;
#pragma unroll
            for (int i = 0; i < 4; ++i) { qn2[i] = *(const u32x4*)(qp + (size_t)(8 * i) * DM); kn2[i] = *(const u32x4*)(kp + (size_t)(8 * i) * DM); vn2[i] = *(const u32x4*)(vp + (size_t)(8 * i) * DM); } }
        for (int kt = qblk; kt >= 0; --kt) {
#pragma unroll
            for (int i = 0; i < 4; ++i) { *(LAS u32x4*)(Kw + (vr + 8 * i) * SBV_P + 16 * vcc) = kn[i]; *(LAS u32x4*)(Vw + (vr + 8 * i) * SBV_P + 16 * vcc) = vn[i]; }
            CFENCE();
            f16x8 Kf[4];
#pragma unroll
            for (int ks = 0; ks < 4; ++ks) Kf[ks] = *(const LAS f16x8*)(Kw + r * SBV_P + (16 * ks + 8 * h) * 2);
            CFENCE();
            if (kt > 0) { const f16* kp = Kc + (rb + 32 * (kt - 1) + vr) * DM + 64 * hd + 8 * vcc; const f16* vp = Vc + (rb + 32 * (kt - 1) + vr) * DM + 64 * hd + 8 * vcc;
#pragma unroll
                for (int i = 0; i < 4; ++i) { kn[i] = *(const u32x4*)(kp + (size_t)(8 * i) * DM); vn[i] = *(const u32x4*)(vp + (size_t)(8 * i) * DM); } }
            f32x16 S;
#pragma unroll
            for (int i = 0; i < 16; ++i) S[i] = 0.f;
#pragma unroll
            for (int ks = 0; ks < 4; ++ks) S = __builtin_amdgcn_mfma_f32_32x32x16_f16(Kf[ks], Qf[ks], S, 0, 0, 0);
            float om[16];
            const bool diag = (kt == qblk);
#pragma unroll
            for (int i = 0; i < 16; ++i) {
                const int kl = (i & 3) + 8 * (i >> 2) + 4 * h;
                float o = __builtin_amdgcn_rcpf(1.0f + ex2(S[i]));
                if (diag && kl >= r) o = 1.0f;
                om[i] = o;
            }
            float sfx[16], T[4];
#pragma unroll
            for (int g4 = 0; g4 < 4; ++g4) { sfx[4 * g4 + 3] = 1.0f; sfx[4 * g4 + 2] = om[4 * g4 + 3]; sfx[4 * g4 + 1] = sfx[4 * g4 + 2] * om[4 * g4 + 2]; sfx[4 * g4] = sfx[4 * g4 + 1] * om[4 * g4 + 1]; T[g4] = sfx[4 * g4] * om[4 * g4]; }
            float E[4]; float run = carry;
#pragma unroll
            for (int g4 = 3; g4 >= 0; --g4) {
                const auto sw = __builtin_amdgcn_permlane32_swap(__float_as_uint(T[g4]), __float_as_uint(T[g4]), false, false);
                const float tl = __uint_as_float(sw[0]), th = __uint_as_float(sw[1]);
                const float e_hi = run; run *= th; const float e_lo = run; run *= tl;
                E[g4] = h ? e_hi : e_lo;
            }
            carry = run;
            f32x16 Aw;
#pragma unroll
            for (int i = 0; i < 16; ++i) Aw[i] = (1.0f - om[i]) * (E[i >> 2] * sfx[i]);
            const f16x8 Af0 = pack8(Aw, 0), Af1 = pack8(Aw, 1);
            CFENCE();
#pragma unroll
            for (int dt = 0; dt < 2; ++dt) {
                LAS const unsigned char* vp = Vw + (4 * h + ta) * SBV_P + (32 * dt + 16 * gl + 4 * tp) * 2;
                const f16x8 V0 = cat8(tr_read(vp), tr_read(vp + 8 * SBV_P)), V1 = cat8(tr_read(vp + 16 * SBV_P), tr_read(vp + 24 * SBV_P));
                OT[dt] = __builtin_amdgcn_mfma_f32_32x32x16_f16(V0, Af0, OT[dt], 0, 0, 0);
                OT[dt] = __builtin_amdgcn_mfma_f32_32x32x16_f16(V1, Af1, OT[dt], 0, 0, 0);
            }
            CFENCE();
            if (__ballot(carry > stop) == 0ull) break;
        }
        CFENCE();
#pragma unroll
        for (int dt = 0; dt < 2; ++dt)
#pragma unroll
            for (int g4 = 0; g4 < 4; ++g4) { u32x2 w; w.x = pkh(OT[dt][4 * g4], OT[dt][4 * g4 + 1]); w.y = pkh(OT[dt][4 * g4 + 2], OT[dt][4 * g4 + 3]); *(LAS u32x2*)(Qw + r * SBV_P + (32 * dt + 8 * g4 + 4 * h) * 2) = w; }
        CFENCE();
        f16* op = O + (rb + 32 * qblk + vr) * DM + 64 * hd + 8 * vcc;
#pragma unroll
        for (int i = 0; i < 4; ++i) *(u32x4*)(op + (size_t)(8 * i) * DM) = *(const LAS u32x4*)(Qw + (vr + 8 * i) * SBV_P + 16 * vcc);
        CFENCE();
    }
}

struct Args { const void* in[22]; float* out; unsigned char* ws; int ph_lo, ph_hi; };
constexpr int N_PHASES = 34;
#define IN(k) (lo <= (k) && (k) < hi)
#define SEAM(k) do { if (IN((k) + 1)) { if (!MK_PER_PHASE) xcd_barrier(bar); } } while (0)
#define WSP(T, off) ((T*)(F.ws + (off)))
#define REPS(cond) _Pragma("unroll") for (int rep_ = 0; rep_ < ((cond) ? 2 : 1); ++rep_)
#define REPBAR() do { if (rep_) xcd_barrier(bar); } while (0)
#define REPSN(cond, n) _Pragma("unroll") for (int rep_ = 0; rep_ < ((cond) ? (n) : 1); ++rep_)
template <int L> __device__ __forceinline__ void layer_phases(Frame& F, const XcdBarrier& bar, const int lo, const int hi) {
    constexpr int pb = 1 + 8 * L;
        if (IN(pb + 0) && !DIS_K0) {
            const float* modL = WSP(const float, WS_MOD) + (size_t)L * 16 * 6144;
            NormArgs A{}; A.x = (L == 0) ? (const void*)KIN(0) : (const void*)WSP(const f16, WS_X); A.xw = WSP(f16, WS_X); A.gain = KIN(5) + L * DM; A.sh = modL; A.sc = modL + 1024; A.h = WSP(f16, WS_H);
            if constexpr (L == 2) {
                A.y2 = WSP(const f16, WS_Y2); A.gcnt = F.ctl + CW_MOE; A.tokinfo = WSP(unsigned, WS_TOKINFO); A.gatef = WSP(const float, WS_MOD) + (size_t)(L - 1) * 16 * 6144 + 5120;
                A.gain2 = KIN(12); A.kvmod = WSP(const float, WS_KVMOD); A.hk = WSP(f16, WS_HK); REPSN(PROBE_DUP == 15, 5) { REPBAR(); if (rep_) { A.xw = WSP(f16, WS_BIG + 320 * MiB); A.h = WSP(f16, WS_BIG + 448 * MiB); A.hk = WSP(f16, WS_BIG + 512 * MiB); } norm_phase<true, true, false, false>(F, A); }
            } else REPSN(PROBE_DUP == 7 && L == 1, 5) { REPBAR(); A.yb = WSP(const f16, WS_YB); if (rep_) { A.xw = WSP(f16, WS_BIG + 320 * MiB); A.h = WSP(f16, WS_BIG + 448 * MiB); } norm_phase<false, false, false, false, (RETIN_F8 != 0 && L < 2), (L == 1 || L == 3), (L == 0)>(F, A); }
            SEAM(pb + 0);
        }
        if (IN(pb + 1) && !DIS_K1) {
            if constexpr (L < 2) {
                pg8::Gemm g{WSP(const unsigned char, WS_H), WSP(const unsigned char, WS_W_RIN) + (size_t)L * RIN * DM * 2, MTOK, RIN, DM, 0, STAG_RET}; pg8::Order S; S.init(MTOK, RIN, F.G, (int)blockIdx.x);
                pg8::EpiRetIn E{WSP(f16, WS_PROJ), WSP(const float, WS_ROPE), RETIN_F8 ? 1.0f / F8_WSCALE : 1.0f};
                REPS(PROBE_DUP == 6 && L == 1) { REPBAR(); pg8::gemm_phase<pg8::EpiRetIn, RETIN_F8 != 0>(F.lds, g, S, E); }
                if constexpr (PROBE_DUP == 17 && L == 1) { xcd_barrier(bar); pg8::EpiNull<true> EN{WSP(float, WS_SLOTW)}; pg8::gemm_phase<pg8::EpiNull<true>, false>(F.lds, g, S, EN); }
            } else REPS(PROBE_DUP == 12 && L == 2) { REPBAR();
                { pg8::Gemm g{WSP(const f16, WS_H), WSP(const f16, WS_W_SQ) + (size_t)(L - 2) * DM * DM, MTOK, DM, DM, 0}; pg8::Order S; S.init(MTOK, DM, F.G, (int)blockIdx.x);
                  pg8::EpiF16 E{WSP(f16, WS_SQ), DM, 0, 0, 0.125f * 1.4426950408889634f};
                  pg8::gemm_phase<pg8::EpiF16>(F.lds, g, S, E); }
                if constexpr (L == 2) { pg8::Gemm g{WSP(const f16, WS_HK), WSP(const f16, WS_W_KV), MTOK, 2048, DM, 0}; pg8::Order S; S.init(MTOK, 2048, F.G, (int)blockIdx.x);
                  pg8::EpiF16 E{WSP(f16, WS_KSH), DM, 1024, (size_t)(WS_VSH - WS_KSH) / 2, 1.0f};
                  pg8::gemm_phase<pg8::EpiF16>(F.lds, g, S, E); }
            }
            SEAM(pb + 1);
        }
        if (IN(pb + 2) && !DIS_K2) {
#ifndef NO_SCAN
            if constexpr (L < 2) REPS(PROBE_DUP == 2 && L == 1) { REPBAR(); scan_phase(F, WSP(const f16, WS_PROJ), KIN(8) + L * 2048, WSP(f16, WS_AO), L); }
#endif
#ifndef NO_SB
            if constexpr (L >= 2) REPSN((PROBE_DUP == 3 || PROBE_DUP == 22 || PROBE_DUP == 23) && L == 3, 5) { REPBAR(); sb_phase(F, WSP(const f16, WS_SQ), WSP(const f16, WS_KSH), WSP(const f16, WS_VSH), rep_ ? WSP(f16, WS_BIG + 320 * MiB) : WSP(f16, WS_SO), (rep_ && PROBE_DUP == 22) ? 2.0f : (rep_ && PROBE_DUP == 23) ? 1e-6f : SB_STOP); }
#endif
            SEAM(pb + 2);
        }
        if (IN(pb + 3) && !DIS_K3) {
            pg8::Gemm g;
            if constexpr (L < 2) g = pg8::Gemm{WSP(const f16, WS_AO), WSP(const f16, WS_W_ROUT) + (size_t)L * DM * 2048, MTOK, DM, 2048, 0};
            else g = pg8::Gemm{WSP(const f16, WS_SO), WSP(const f16, WS_W_SO) + (size_t)(L - 2) * DM * DM, MTOK, DM, DM, 0};
            pg8::Order S; S.init(MTOK, DM, F.G, (int)blockIdx.x);
            pg8::EpiY E{WSP(f16, WS_YB), WSP(const float, WS_MOD) + (size_t)L * 16 * 6144 + 2048, 1.0f};
            REPS(PROBE_DUP == 9 && L == 1) { REPBAR(); pg8::gemm_phase<pg8::EpiY>(F.lds, g, S, E); }
            SEAM(pb + 3);
        }
        if (IN(pb + 4) && !DIS_K4) {
            const float* modL = WSP(const float, WS_MOD) + (size_t)L * 16 * 6144;
            NormArgs A{}; A.x = (L == 0) ? (const void*)KIN(0) : (const void*)WSP(const f16, WS_X); A.xw = WSP(f16, WS_X); A.gain = KIN(6) + L * DM; A.sh = modL + 3072; A.sc = modL + 4096; A.h = WSP(f16, WS_H); A.yb = WSP(const f16, WS_YB);
            if constexpr (L & 1) { A.router = KIN(18) + (size_t)(L >> 1) * DM * NEXP; A.gcnt = F.ctl + CW_MOE + (L >> 1) * 1024; A.tokinfo = WSP(unsigned, WS_TOKINFO); A.hs8 = WSP(unsigned char, WS_HS); A.wof = WSP(float, WS_SLOTW); REPSN(PROBE_DUP == 13 && L == 3, 5) { REPBAR(); if (rep_) { A.gcnt = F.ctl + CW_MOE + 4096; A.tokinfo = WSP(unsigned, WS_TOKINFO + MiB); A.xw = WSP(f16, WS_BIG + 320 * MiB); A.h = WSP(f16, WS_BIG + 448 * MiB); A.hs8 = WSP(unsigned char, WS_END); A.wof = WSP(float, WS_BIG + 512 * MiB); } norm_phase<false, false, false, true, true, true>(F, A); } }
            else norm_phase<false, false, false, false, DF8(L), true, (L == 0)>(F, A);
            SEAM(pb + 4);
        }
        if (IN(pb + 6) && !DIS_K6) {
            const int mi = L >> 1;
            pg8::Order S;
            if constexpr (L & 1) {
                int tb[NEXP], ntl; moe_tile_bases(F.ctl + CW_MOE + mi * 1024, tb, ntl);
                S.init(ntl * 256, 2 * FFE, F.G, (int)blockIdx.x); S.cap = MOE_CAP; S.avirt = 1;
#pragma unroll
                for (int e = 0; e < NEXP; ++e) S.tb[e] = tb[e];
                pg8::Gemm g{WSP(const unsigned char, WS_HS), WSP(const unsigned char, WS_W_MIN) + (size_t)mi * NEXP * 2 * FFE * DM, ntl * 256, 2 * FFE, DM, (size_t)2 * FFE * DM, STAG_MOE};
                pg8::EpiGlu<true> E{WSP(unsigned char, WS_ACTE), FFE};
                REPS(PROBE_DUP == 4 && L == 3) { REPBAR(); pg8::gemm_phase<pg8::EpiGlu<true>, true>(F.lds, g, S, E); }
                if constexpr (PROBE_DUP == 16 && L == 3) { xcd_barrier(bar); pg8::EpiNull<true> EN{WSP(float, WS_SLOTW)}; pg8::gemm_phase<pg8::EpiNull<true>, true>(F.lds, g, S, EN); }
            } else {
                S.init(MTOK, 2 * FFD, F.G, (int)blockIdx.x);
                pg8::Gemm g{WSP(const unsigned char, WS_H), WSP(const unsigned char, WS_W_FIN) + (size_t)mi * 2 * FFD * DM * 2, MTOK, 2 * FFD, DM, 0};
                pg8::EpiGlu<DF8(L), DF8O(L)> E{WSP(unsigned char, WS_ACTD), FFD};
                REPS(PROBE_DUP == 10 && L == 2) { REPBAR(); pg8::gemm_phase<pg8::EpiGlu<DF8(L), DF8O(L)>, DF8(L)>(F.lds, g, S, E); }
            }
            SEAM(pb + 6);
        }
        if (IN(pb + 7) && !DIS_K7) {
            const int mi = L >> 1;
            if constexpr (L & 1) {
                int tb[NEXP], ntl; moe_tile_bases(F.ctl + CW_MOE + mi * 1024, tb, ntl);
                pg8::Order S; S.init(ntl * 256, DM, F.G, (int)blockIdx.x); S.cap = MOE_CAP;
#pragma unroll
                for (int e = 0; e < NEXP; ++e) S.tb[e] = tb[e];
                pg8::Gemm g{WSP(const unsigned char, WS_ACTE), WSP(const unsigned char, WS_W_MOUT) + (size_t)mi * NEXP * DM * FFE, ntl * 256, DM, FFE, (size_t)DM * FFE};
                pg8::EpiMoeOut E{WSP(f16, WS_Y2), WSP(const float, WS_SLOTW)};
                REPS(PROBE_DUP == 5 && L == 3) { REPBAR(); pg8::gemm_phase<pg8::EpiMoeOut, true>(F.lds, g, S, E); }
            } else {
                pg8::Order S; S.init(MTOK, DM, F.G, (int)blockIdx.x);
                pg8::Gemm g{WSP(const unsigned char, WS_ACTD), WSP(const unsigned char, WS_W_FOUT) + (size_t)mi * DM * FFD * 2, MTOK, DM, FFD, 0};
                pg8::EpiY E{WSP(f16, WS_YB), WSP(const float, WS_MOD) + (size_t)L * 16 * 6144 + 5120, DF8O(L) ? 1.0f / (F8_WSCALE * F8_ASCALE) : 1.0f};
                REPS(PROBE_DUP == 11 && L == 2) { REPBAR(); pg8::gemm_phase<pg8::EpiY, DF8O(L)>(F.lds, g, S, E); }
            }
            SEAM(pb + 7);
        }
}
__global__ void __launch_bounds__(512, 2) mk_fwd(Args args) {
    extern __shared__ __attribute__((aligned(16))) unsigned char lds_raw[];
    Frame F;
    F.lds = (LAS unsigned char*)lds_raw;
    F.wave = __builtin_amdgcn_readfirstlane((int)threadIdx.x >> 6);
    F.G = gridDim.x; { const int bx = blockIdx.x; F.vcu = (F.G % 8 == 0) ? (bx % 8) * (F.G / 8) + bx / 8 : bx; }
    F.ws = args.ws; F.ctl = (unsigned*)(args.ws + WS_CTL);
    volatile LAS unsigned* MISC = (volatile LAS unsigned*)(F.lds + MISC_OFF);
    if (threadIdx.x < 64) ((LAS unsigned*)(F.lds + MISC_OFF))[threadIdx.x] = 0u;
    __syncthreads();
    XcdBarrier bar; bar.bar = F.ctl + CW_BAR; bar.x = 0; bar.st = nullptr;
    if (!MK_PER_PHASE) bar = xcd_barrier_post(F.ctl + CW_BAR, MISC + 8);
    const int lo = args.ph_lo, hi = args.ph_hi;

    if (IN(0)) {
#ifndef NO_P0
        REPS(PROBE_DUP == 1) { REPBAR(); p0_prologue(F); }
#endif
        SEAM(0);
    }
    layer_phases<0>(F, bar, lo, hi); layer_phases<1>(F, bar, lo, hi); layer_phases<2>(F, bar, lo, hi); layer_phases<3>(F, bar, lo, hi);
    if (IN(33)) {
        NormArgs A{}; A.x = WSP(const f16, WS_X); A.xw = WSP(f16, WS_X); A.gain = KIN(21); A.out = (float*)karg<22>();
        A.y2 = WSP(const f16, WS_Y2); A.gcnt = F.ctl + CW_MOE + 1024; A.tokinfo = WSP(unsigned, WS_TOKINFO); A.gatef = WSP(const float, WS_MOD) + (size_t)3 * 16 * 6144 + 5120;
        REPSN(PROBE_DUP == 14, 5) { REPBAR(); norm_phase<true, false, true, false>(F, A); }
        if constexpr (PROBE_DUP == 24) { _Pragma("unroll 1") for (int i = 0; i < 40; ++i) xcd_barrier(bar); }
        if constexpr (PROBE_DUP == 20 || PROBE_DUP == 21) {
            xcd_barrier(bar);
            f16x8 a = {(f16)1.f, (f16)0.5f, (f16)0.25f, (f16)1.f, (f16)1.f, (f16)0.5f, (f16)0.25f, (f16)1.f}, b = a;
            f32x16 acc[4];
#pragma unroll
            for (int i = 0; i < 4; ++i)
#pragma unroll
                for (int j = 0; j < 16; ++j) acc[i][j] = 0.f;
            f32x4 acc16[8];
#pragma unroll
            for (int i = 0; i < 8; ++i) acc16[i] = (f32x4){0.f, 0.f, 0.f, 0.f};
            for (int it = 0; it < (PROBE_DUP == 20 ? 16384 : 8192); ++it) {
                if constexpr (PROBE_DUP == 20) {
#pragma unroll
                    for (int i = 0; i < 4; ++i) acc[i] = __builtin_amdgcn_mfma_f32_32x32x16_f16(a, b, acc[i], 0, 0, 0);
                } else {
#pragma unroll
                    for (int i = 0; i < 8; ++i) acc16[i] = __builtin_amdgcn_mfma_f32_16x16x32_f16(a, b, acc16[i], 0, 0, 0);
                }
            }
            float sacc = 0.f;
#pragma unroll
            for (int i = 0; i < 4; ++i) sacc += acc[i][0] + acc16[i][0] + acc16[4 + i][1];
            if (sacc == 1.2345e37f) WSP(float, WS_SLOTW)[0] = sacc;
        }
    }
#undef IN
#undef SEAM
#undef WSP
}

extern "C" void kernel_launch(void* const* d_in, const int* in_sizes, int n_in, void* d_out, int out_size, void* d_ws, size_t ws_size, hipStream_t stream) {
    static int grid = 0;
    if (grid == 0) {
        if (n_in != 22 || out_size != MTOK * DM || ws_size < WS_END) { fprintf(stderr, "kernel_launch: unexpected shapes (n_in %d out %d ws %zu, need %zu)\n", n_in, out_size, ws_size, (size_t)WS_END); grid = -1; return; }
        int dev = 0, cus = 0;
        if (hipGetDevice(&dev) != hipSuccess || hipDeviceGetAttribute(&cus, hipDeviceAttributeMultiprocessorCount, dev) != hipSuccess) { grid = -1; return; }
        if (hipFuncSetAttribute((const void*)mk_fwd, hipFuncAttributeMaxDynamicSharedMemorySize, LDS_BYTES) != hipSuccess) { fprintf(stderr, "kernel_launch: hipFuncSetAttribute failed\n"); grid = -1; return; }
        int per_cu = 0;
        if (hipOccupancyMaxActiveBlocksPerMultiprocessor(&per_cu, (const void*)mk_fwd, 512, LDS_BYTES) != hipSuccess || per_cu < 1) fprintf(stderr, "kernel_launch: occupancy query reports %d\n", per_cu);
        (void)hipGetLastError();
        if (cus < 256) { fprintf(stderr, "kernel_launch: needs >= 256 CUs, got %d\n", cus); grid = -1; return; }
        grid = cus;
    }
    if (grid < 0) return;
    (void)hipMemsetAsync((char*)d_ws + WS_CTL, 0, CTL_ZERO_BYTES, stream);
    Args a{};
    for (int i = 0; i < 22; ++i) a.in[i] = d_in[i];
    a.out = (float*)d_out; a.ws = (unsigned char*)d_ws;
#if MK_PER_PHASE
    for (int p = 0; p < N_PHASES; ++p) {
        if (p >= 1 && p <= 32) { const int L = (p - 1) / 8, k = (p - 1) % 8; if (k == 5) continue; (void)L; }
        a.ph_lo = p; a.ph_hi = p + 1;
        hipLaunchKernelGGL(mk_fwd, dim3(grid), dim3(512), LDS_BYTES, stream, a);
    }
#else
    a.ph_lo = 0; a.ph_hi = N_PHASES;
    hipLaunchKernelGGL(mk_fwd, dim3(grid), dim3(512), LDS_BYTES, stream, a);
#endif
}
```

```cpp
#include <hip/hip_runtime.h>
#include <cstdio>
#include <cstdint>

#define LAS __attribute__((address_space(3)))
#define GAS __attribute__((address_space(1)))
typedef _Float16 f16;
typedef _Float16 f16x2 __attribute__((ext_vector_type(2)));
typedef _Float16 f16x4 __attribute__((ext_vector_type(4)));
typedef _Float16 f16x8 __attribute__((ext_vector_type(8)));
typedef float f32x2 __attribute__((ext_vector_type(2)));
typedef float f32x4 __attribute__((ext_vector_type(4)));
typedef float f32x16 __attribute__((ext_vector_type(16)));
typedef unsigned u32x2 __attribute__((ext_vector_type(2)));
typedef unsigned u32x4 __attribute__((ext_vector_type(4)));
typedef short v4i16_t __attribute__((ext_vector_type(4)));
typedef int i32x8 __attribute__((ext_vector_type(8)));
typedef int i32x4 __attribute__((ext_vector_type(4)));

#ifndef DIS_K0
#define DIS_K0 0
#endif
#ifndef DIS_K1
#define DIS_K1 0
#endif
#ifndef DIS_K2
#define DIS_K2 0
#endif
#ifndef DIS_K3
#define DIS_K3 0
#endif
#ifndef DIS_K4
#define DIS_K4 0
#endif
#ifndef DIS_K5
#define DIS_K5 0
#endif
#ifndef DIS_K6
#define DIS_K6 0
#endif
#ifndef DIS_K7
#define DIS_K7 0
#endif
#ifndef PROBE_DUP
#define PROBE_DUP 0
#endif
#ifndef DENSE_F8
#define DENSE_F8 1
#define DF8(L) (DENSE_F8 != 0 && (L) == 2)
#ifndef DENSE_F8_OUT
#define DENSE_F8_OUT 0
#endif
#define DF8O(L) (DF8(L) && DENSE_F8_OUT != 0)
#endif
#ifndef RETIN_F8
#define RETIN_F8 0
#endif
#ifndef STAG_MOE
#define STAG_MOE 0
#endif
#ifndef STAG_RET
#define STAG_RET 0
#endif
#ifndef CONV_IN_SCAN
#define CONV_IN_SCAN 1
#endif
#ifndef MK_PER_PHASE
#define MK_PER_PHASE 0
#endif

constexpr int BATCH = 16, SEQ = 2048, DM = 1024, MTOK = BATCH * SEQ;
constexpr int RH = 8, RDK = 128, RDV = 256, RIN = 6144, CHUNK = 64, NCHUNK = SEQ / CHUNK;
constexpr int SBH = 16, SDH = 64;
constexpr int FFD = 2816, NEXP = 8, FFE = 3584;
constexpr float EPS = 1e-6f;
constexpr int MOE_ROWS_MAX = 2 * MTOK + NEXP * 256;

__device__ __forceinline__ float lg2gamma(int h) {
    const float t[8] = {-4.580368961312e-02f, -2.272007650008e-02f, -1.131531322783e-02f, -5.646563141142e-03f, -2.820519062379e-03f, -1.409570254671e-03f, -7.046129765894e-04f, -3.522634716290e-04f};
    float r = t[0];
#pragma unroll
    for (int i = 1; i < 8; ++i) r = (h == i) ? t[i] : r;
    return r;
}
__device__ __forceinline__ unsigned pkh(float lo, float hi) { f32x2 v = {lo, hi}; f16x2 h = __builtin_convertvector(v, f16x2); return __builtin_bit_cast(unsigned, h); }
__device__ __forceinline__ float silu_f(float x) { return x * __builtin_amdgcn_rcpf(1.0f + __builtin_amdgcn_exp2f(-1.4426950408889634f * x)); }
__device__ __forceinline__ float ex2(float x) { return __builtin_amdgcn_exp2f(x); }
__device__ __forceinline__ unsigned pk4f8(float a, float b, float c, float d) { int w = 0; w = __builtin_amdgcn_cvt_pk_fp8_f32(a, b, w, false); w = __builtin_amdgcn_cvt_pk_fp8_f32(c, d, w, true); return (unsigned)w; }
constexpr float F8_WSCALE = 64.0f;
constexpr float F8_ASCALE = 4.0f;

namespace pg8 {
constexpr int BM = 256, BK = 64, HALF = 128, HTB = HALF * BK * 2, STAGE_BYTES = 8 * HTB, NXCD = 8, WGM = 8;
__host__ __device__ __forceinline__ int lds_byte(int r, int c) { const int st = (r >> 4) * 2 + (c >> 5), rr = r & 15, cc = c & 31, ob = rr * 64 + cc * 2; return st * 1024 + (ob ^ (((ob >> 9) & 1) << 5)); }
__host__ __device__ __forceinline__ void stage_rc(int b, int& R, int& C) { const int st = b / 1024, sb = b % 1024, swz = sb ^ (((sb >> 9) & 1) << 5); R = (st >> 1) * 16 + swz / 64; C = (st & 1) * 32 + (swz % 64) / 2; }
__host__ __device__ __forceinline__ int perm32(int rho) { const int n = rho >> 4, i = rho & 15; return 8 * (i >> 2) + 4 * n + (i & 3); }

struct Unit { int pm, pn, be, arow, vrow; };
struct Gemm { const void* A; const void* Bt; int M, N, K; size_t bstride; int stagger = 0; };

struct Order {
    int nM, nN, nwg, G, c; int tb[NEXP]; int cap, avirt;
    __device__ void init(int M, int N, int G_, int c_) { nM = M / BM; nN = N / BM; nwg = nM * nN; G = G_; c = c_; cap = 0; avirt = 0;
#pragma unroll
        for (int e = 0; e < NEXP; ++e) tb[e] = e ? 0x7fffffff : 0; }
    __device__ bool next(int i, Unit& u) const {
        const long L = (long)i * G + c; if (L >= nwg) return false;
        int wgid = (int)L; { const int q = nwg / NXCD, r = nwg % NXCD, xcd = wgid % NXCD, off = wgid / NXCD; wgid = (xcd < r ? xcd * (q + 1) : r * (q + 1) + (xcd - r) * q) + off; }
        const int nig = WGM * nN, gid = wgid / nig, fm = gid * WGM, gsz = (nM - fm) < WGM ? (nM - fm) : WGM;
        u.pm = fm + ((wgid % nig) % gsz); u.pn = (wgid % nig) / gsz;
        int be = 0;
#pragma unroll
        for (int e = 1; e < NEXP; ++e) be += (u.pm >= tb[e]) ? 1 : 0;
        u.be = be;
        int tbe = 0;
#pragma unroll
        for (int e = 1; e < NEXP; ++e) tbe = (be == e) ? tb[e] : tbe;
        u.vrow = cap ? be * cap + (u.pm - tbe) * BM : u.pm * BM; u.arow = avirt ? u.vrow : u.pm * BM;
        return true;
    }
};


struct EpiRetIn {
    static constexpr bool PERM = true; static constexpr int NST = 16;
    f16* O; const float* rope; float scl;
    __device__ __forceinline__ void operator()(const f32x4 (&acc)[2][2][4][2], const Unit& u, int wr, int wc, int fr, int fq) const {
        const int row0 = u.pm * BM + wr * 64 + fr, cl = wc * 32 + 8 * fq;
        f16* base = O + (size_t)u.pn * BM + cl;
        if (u.pn < 8) {
            const bool isk = u.pn >= 4; const int i0 = cl >> 1;
            float lg[2]; lg[0] = lg2gamma(2 * (u.pn & 3)); lg[1] = lg2gamma(2 * (u.pn & 3) + 1);
#pragma unroll
            for (int ai = 0; ai < 2; ++ai)
#pragma unroll
                for (int m = 0; m < 4; ++m) {
                    const int row = row0 + ai * HALF + m * 16; const float pos = (float)(16 * m + fr);
                    const f32x4 cs = *(const f32x4*)(rope + (size_t)row * 128 + i0), sn = *(const f32x4*)(rope + (size_t)row * 128 + 64 + i0);
#pragma unroll
                    for (int bj = 0; bj < 2; ++bj) {
                        const float sc = (isk ? ex2(-pos * lg[bj]) * 0.08838834764831845f : ex2((pos + 1.0f) * lg[bj])) * scl;
                        const f32x4 v0 = acc[ai][bj][m][0], v1 = acc[ai][bj][m][1];
                        u32x4 w;
                        w.x = pkh((v0[0] * cs[0] - v0[1] * sn[0]) * sc, (v0[0] * sn[0] + v0[1] * cs[0]) * sc);
                        w.y = pkh((v0[2] * cs[1] - v0[3] * sn[1]) * sc, (v0[2] * sn[1] + v0[3] * cs[1]) * sc);
                        w.z = pkh((v1[0] * cs[2] - v1[1] * sn[2]) * sc, (v1[0] * sn[2] + v1[1] * cs[2]) * sc);
                        w.w = pkh((v1[2] * cs[3] - v1[3] * sn[3]) * sc, (v1[2] * sn[3] + v1[3] * cs[3]) * sc);
                        *(u32x4*)(base + (size_t)row * RIN + bj * HALF) = w;
                    }
                }
        } else {
            const bool isg = u.pn >= 16;
#pragma unroll
            for (int ai = 0; ai < 2; ++ai)
#pragma unroll
                for (int m = 0; m < 4; ++m) {
                    const int row = row0 + ai * HALF + m * 16;
#pragma unroll
                    for (int bj = 0; bj < 2; ++bj) {
                        f32x4 v0 = acc[ai][bj][m][0] * scl, v1 = acc[ai][bj][m][1] * scl;
                        if (isg) {
#pragma unroll
                            for (int j = 0; j < 4; ++j) { v0[j] = silu_f(v0[j]); v1[j] = silu_f(v1[j]); } }
                        u32x4 w; w.x = pkh(v0[0], v0[1]); w.y = pkh(v0[2], v0[3]); w.z = pkh(v1[0], v1[1]); w.w = pkh(v1[2], v1[3]);
                        *(u32x4*)(base + (size_t)row * RIN + bj * HALF) = w;
                    }
                }
        }
    }
};
struct EpiY {
    static constexpr bool PERM = true; static constexpr int NST = 16;
    f16* Y; const float* gate; float scl;
    __device__ __forceinline__ void operator()(const f32x4 (&acc)[2][2][4][2], const Unit& u, int wr, int wc, int fr, int fq) const {
        const int row0 = u.pm * BM + wr * 64 + fr, col0 = u.pn * BM + wc * 32 + 8 * fq;
        const float* gp = gate + (size_t)(u.pm >> 3) * 6144 + col0;
        f32x4 gv[2][2];
#pragma unroll
        for (int bj = 0; bj < 2; ++bj)
#pragma unroll
            for (int n = 0; n < 2; ++n) gv[bj][n] = *(const f32x4*)(gp + bj * HALF + 4 * n) * scl;
#pragma unroll
        for (int ai = 0; ai < 2; ++ai)
#pragma unroll
            for (int m = 0; m < 4; ++m) { f16* rowp = Y + (size_t)(row0 + ai * HALF + m * 16) * DM + col0;
#pragma unroll
                for (int bj = 0; bj < 2; ++bj) { const f32x4 v0 = acc[ai][bj][m][0] * gv[bj][0], v1 = acc[ai][bj][m][1] * gv[bj][1];
                    u32x4 w; w.x = pkh(v0[0], v0[1]); w.y = pkh(v0[2], v0[3]); w.z = pkh(v1[0], v1[1]); w.w = pkh(v1[2], v1[3]);
                    *(u32x4*)(rowp + bj * HALF) = w; } }
    }
};
template <bool F8IN, bool F8 = F8IN> struct EpiGlu {
    static constexpr bool PERM = true; static constexpr int NST = 8;
    void* Ov; int ldc;
    __device__ __forceinline__ void operator()(const f32x4 (&acc)[2][2][4][2], const Unit& u, int wr, int wc, int fr, int fq) const {
        const int row0 = u.pm * BM + wr * 64 + fr, col0 = u.pn * HALF + wc * 32 + 8 * fq;
        constexpr float si = F8IN ? 1.0f / F8_WSCALE : 1.0f, so = F8 ? F8_ASCALE : 1.0f;
#pragma unroll
        for (int ai = 0; ai < 2; ++ai)
#pragma unroll
            for (int m = 0; m < 4; ++m) {
                float r[8];
#pragma unroll
                for (int n = 0; n < 2; ++n)
#pragma unroll
                    for (int p = 0; p < 2; ++p) {
                        const f32x2 a = {acc[ai][0][m][n][2 * p], acc[ai][0][m][n][2 * p + 1]}, b = {acc[ai][1][m][n][2 * p], acc[ai][1][m][n][2 * p + 1]};
                        const f32x2 t = a * (-1.4426950408889634f * si); f32x2 d = {ex2(t.x), ex2(t.y)}; d = d + 1.0f;
                        const f32x2 u = {__builtin_amdgcn_rcpf(d.x), __builtin_amdgcn_rcpf(d.y)};
                        const f32x2 q = ((a * b) * u) * (si * si * so);
                        r[4 * n + 2 * p] = q.x; r[4 * n + 2 * p + 1] = q.y;
                    }
                if (F8) { u32x2 w; w.x = pk4f8(r[0], r[1], r[2], r[3]); w.y = pk4f8(r[4], r[5], r[6], r[7]);
                    *(u32x2*)((unsigned char*)Ov + (size_t)(row0 + ai * HALF + m * 16) * ldc + col0) = w; }
                else { u32x4 w; w.x = pkh(r[0], r[1]); w.y = pkh(r[2], r[3]); w.z = pkh(r[4], r[5]); w.w = pkh(r[6], r[7]);
                    *(u32x4*)((f16*)Ov + (size_t)(row0 + ai * HALF + m * 16) * ldc + col0) = w; }
            }
    }
};
struct EpiF16 {
    static constexpr bool PERM = true; static constexpr int NST = 16;
    f16* O; int ldc; int split_cols; size_t split_stride; float scale;
    __device__ __forceinline__ void operator()(const f32x4 (&acc)[2][2][4][2], const Unit& u, int wr, int wc, int fr, int fq) const {
        const int row0 = u.pm * BM + wr * 64 + fr; int colt = u.pn * BM; f16* base = O;
        if (split_cols) { const int t = colt / split_cols; base += (size_t)t * split_stride; colt -= t * split_cols; }
        const int col0 = colt + wc * 32 + 8 * fq;
#pragma unroll
        for (int ai = 0; ai < 2; ++ai)
#pragma unroll
            for (int m = 0; m < 4; ++m) { f16* rowp = base + (size_t)(row0 + ai * HALF + m * 16) * ldc + col0;
#pragma unroll
                for (int bj = 0; bj < 2; ++bj) { const f32x4 v0 = acc[ai][bj][m][0] * scale, v1 = acc[ai][bj][m][1] * scale;
                    u32x4 w; w.x = pkh(v0[0], v0[1]); w.y = pkh(v0[2], v0[3]); w.z = pkh(v1[0], v1[1]); w.w = pkh(v1[2], v1[3]);
                    *(u32x4*)(rowp + bj * HALF) = w; } }
    }
};
struct EpiMoeOut {
    static constexpr bool PERM = true; static constexpr int NST = 16;
    f16* O; const float* roww;
    __device__ __forceinline__ void operator()(const f32x4 (&acc)[2][2][4][2], const Unit& u, int wr, int wc, int fr, int fq) const {
        const int row0 = u.pm * BM + wr * 64 + fr, col0 = u.pn * BM + wc * 32 + 8 * fq;
#pragma unroll
        for (int ai = 0; ai < 2; ++ai)
#pragma unroll
            for (int m = 0; m < 4; ++m) { const int rl = wr * 64 + fr + ai * HALF + m * 16, row = u.pm * BM + rl; const float sc = roww[u.vrow + rl] * (1.0f / (F8_WSCALE * F8_ASCALE)); f16* rowp = O + (size_t)row * DM + col0;
#pragma unroll
                for (int bj = 0; bj < 2; ++bj) { const f32x4 v0 = acc[ai][bj][m][0] * sc, v1 = acc[ai][bj][m][1] * sc;
                    u32x4 w; w.x = pkh(v0[0], v0[1]); w.y = pkh(v0[2], v0[3]); w.z = pkh(v1[0], v1[1]); w.w = pkh(v1[2], v1[3]);
                    *(u32x4*)(rowp + bj * HALF) = w; } }
    }
};

template <bool P> struct EpiNull {
    static constexpr bool PERM = P; static constexpr int NST = 0;
    float* sink;
    __device__ __forceinline__ void operator()(const f32x4 (&acc)[2][2][4][2], const Unit& u, int wr, int wc, int fr, int fq) const {
        float s = 0.f;
#pragma unroll
        for (int ai = 0; ai < 2; ++ai)
#pragma unroll
            for (int bj = 0; bj < 2; ++bj)
#pragma unroll
                for (int m = 0; m < 4; ++m)
#pragma unroll
                    for (int n = 0; n < 2; ++n) s += acc[ai][bj][m][n][0] + acc[ai][bj][m][n][1] + acc[ai][bj][m][n][2] + acc[ai][bj][m][n][3];
        if (s == 1.2345e37f) sink[0] = s;
    }
};
template <class Epi, bool F8 = false>
__device__ __forceinline__ void gemm_phase(LAS unsigned char* lds, const Gemm g, const Order& S, const Epi& E) {
    const int tid = threadIdx.x, wid = __builtin_amdgcn_readfirstlane(tid >> 6), lane = tid & 63, wr = wid >> 2, wc = wid & 3, fr = lane & 15, fq = lane >> 4;
    const int KB = g.K * (F8 ? 1 : 2), nt = KB / 128;
    unsigned voffA[2], voffB[2];
#pragma unroll
    for (int i = 0; i < 2; ++i) { int R, C; stage_rc(tid * 16 + i * 8192, R, C); const int Rb = Epi::PERM ? ((R & ~31) + perm32(R & 31)) : R;
        voffA[i] = (unsigned)(R * KB + 2 * C); voffB[i] = (unsigned)(Rb * KB + 2 * C); }
    const size_t kstep = (size_t)(BK * 2);
    const size_t hstep = (size_t)HALF * KB;
    const size_t tstep = 2 * hstep;
    const unsigned ldsw = (unsigned)wid * 1024u;
    const int aoff = lds_byte(wr * 64 + fr, fq * 8), boff = lds_byte(wc * 32 + fr, fq * 8);
#define PG8_SA(b, h) (((b) * 2 + (h)) * HTB)
#define PG8_SB(b, h) ((4 + (b) * 2 + (h)) * HTB)
#define PG8_STAGE(bufoff, gbase, voff) do { _Pragma("unroll") for (int _i = 0; _i < 2; ++_i) \
        __builtin_amdgcn_global_load_lds((const unsigned*)((const char*)(gbase) + (voff)[_i]), (LAS unsigned*)(lds + (bufoff) + ldsw + _i * 8192), 16, 0, 0); } while (0)
#define PG8_LD8(dst, addr) do { const i32x4 lo_ = *(const LAS i32x4*)(addr), hi_ = *(const LAS i32x4*)((addr) + 1024); dst = __builtin_shufflevector(lo_, hi_, 0, 1, 2, 3, 4, 5, 6, 7); } while (0)
#define PG8_LDA(dst, b, h) do { _Pragma("unroll") for (int m = 0; m < 4; ++m) { if constexpr (F8) PG8_LD8(dst##8[m], lds + PG8_SA(b, h) + aoff + m * 2048); else { _Pragma("unroll") for (int k = 0; k < 2; ++k) dst[m][k] = *(const LAS f16x8*)(lds + PG8_SA(b, h) + aoff + m * 2048 + k * 1024); } } } while (0)
#define PG8_LDB(dst, b, h) do { _Pragma("unroll") for (int n = 0; n < 2; ++n) { if constexpr (F8) PG8_LD8(dst##8[n], lds + PG8_SB(b, h) + boff + n * 2048); else { _Pragma("unroll") for (int k = 0; k < 2; ++k) dst[n][k] = *(const LAS f16x8*)(lds + PG8_SB(b, h) + boff + n * 2048 + k * 1024); } } } while (0)
#define PG8_MMA(ai, bj, At, Bt) do { __builtin_amdgcn_s_setprio(1); _Pragma("unroll") for (int m = 0; m < 4; ++m) _Pragma("unroll") for (int n = 0; n < 2; ++n) { \
        if constexpr (F8) asm volatile("v_mfma_scale_f32_16x16x128_f8f6f4 %0, %1, %2, %0, %3, %3 op_sel_hi:[0,0,0]" : "+v"(acc[ai][bj][m][n]) : "v"(Bt##8[n]), "v"(At##8[m]), "v"(f8scale)); \
        else { _Pragma("unroll") for (int k = 0; k < 2; ++k) acc[ai][bj][m][n] = __builtin_amdgcn_mfma_f32_16x16x32_f16(Bt[n][k], At[m][k], acc[ai][bj][m][n], 0, 0, 0); } } \
        __builtin_amdgcn_s_setprio(0); } while (0)
#define PG8_WAIT_V(n) asm volatile("s_waitcnt vmcnt(" #n ")" ::: "memory")
#define PG8_WAIT_VR() asm volatile("s_waitcnt vmcnt(%0)" :: "n"(8 + Epi::NST) : "memory")
#define PG8_WAIT_L(n) asm volatile("s_waitcnt lgkmcnt(" #n ")" ::: "memory")
#define PG8_BAR __builtin_amdgcn_s_barrier()
#define PG8_SCHED __builtin_amdgcn_sched_barrier(0)
    Unit cur, nxt; int ui = 0; bool relax = false;
    if (!S.next(0, cur)) return;
    if (g.stagger) {
        const unsigned grp = (blockIdx.x >> 3) & 3u;
        if (grp) { const unsigned long long t0 = __builtin_amdgcn_s_memrealtime(); while (__builtin_amdgcn_s_memrealtime() - t0 < (unsigned long long)(grp * (unsigned)g.stagger)) __builtin_amdgcn_s_sleep(16); }
    }
    f32x4 acc[2][2][4][2];
#pragma unroll
    for (int a = 0; a < 2; ++a)
#pragma unroll
        for (int b = 0; b < 2; ++b)
#pragma unroll
            for (int m = 0; m < 4; ++m)
#pragma unroll
                for (int n = 0; n < 2; ++n) acc[a][b][m][n] = (f32x4){0.f, 0.f, 0.f, 0.f};
    const int f8scale = 0x7f7f7f7f;
    f16x8 At[4][2], B0[2][2], B1[2][2]; i32x8 At8[4], B08[2], B18[2];
    const char* cA = (const char*)g.A + (size_t)cur.arow * KB; const char* cB = (const char*)g.Bt + (size_t)cur.be * g.bstride + (size_t)cur.pn * tstep;
    PG8_STAGE(PG8_SB(0, 0), cB, voffB); PG8_STAGE(PG8_SB(0, 1), cB + hstep, voffB); PG8_STAGE(PG8_SA(0, 0), cA, voffA); PG8_STAGE(PG8_SA(0, 1), cA + hstep, voffA);
    if (wr == 1) PG8_BAR;
    PG8_WAIT_V(2); PG8_BAR;
    PG8_STAGE(PG8_SB(1, 0), cB + kstep, voffB); PG8_STAGE(PG8_SA(1, 0), cA + kstep, voffA); PG8_STAGE(PG8_SB(1, 1), cB + hstep + kstep, voffB);
    PG8_WAIT_V(6); PG8_BAR;
    for (;;) {
        const bool has_next = S.next(ui + 1, nxt);
        const char* nA = has_next ? (const char*)g.A + (size_t)nxt.arow * KB : cA; const char* nB = has_next ? (const char*)g.Bt + (size_t)nxt.be * g.bstride + (size_t)nxt.pn * tstep : cB;
#pragma nounroll
        for (int t = 0; t < nt; t += 2) {
            const bool last = (t == nt - 2);
            const char* a1 = cA + (size_t)(t + 1) * kstep;
            const char* a2 = last ? nA : cA + (size_t)(t + 2) * kstep; const char* b2 = last ? nB : cB + (size_t)(t + 2) * kstep;
            const char* a3 = a2 + kstep; const char* b3 = b2 + kstep;
            PG8_LDB(B0, 0, 0); PG8_LDB(B1, 0, 1); PG8_SCHED; PG8_LDA(At, 0, 0); PG8_STAGE(PG8_SA(1, 1), a1 + hstep, voffA);
            if (relax) PG8_WAIT_VR(); else PG8_WAIT_V(8);
            PG8_WAIT_L(0); PG8_BAR; PG8_MMA(0, 0, At, B0); PG8_MMA(0, 1, At, B1); PG8_BAR; PG8_SCHED;
            PG8_LDA(At, 0, 1); PG8_STAGE(PG8_SB(0, 0), b2, voffB); PG8_STAGE(PG8_SB(0, 1), b2 + hstep, voffB); PG8_STAGE(PG8_SA(0, 0), a2, voffA);
            if (relax) { PG8_WAIT_VR(); relax = false; } else PG8_WAIT_V(8);
            PG8_WAIT_L(0); PG8_BAR; PG8_MMA(1, 0, At, B0); PG8_MMA(1, 1, At, B1); PG8_BAR; PG8_SCHED;
            PG8_LDB(B0, 1, 0); PG8_LDB(B1, 1, 1); PG8_SCHED; PG8_LDA(At, 1, 0); PG8_STAGE(PG8_SA(0, 1), a2 + hstep, voffA);
            PG8_WAIT_V(8); PG8_WAIT_L(0); PG8_BAR; PG8_MMA(0, 0, At, B0); PG8_MMA(0, 1, At, B1); PG8_BAR; PG8_SCHED;
            PG8_LDA(At, 1, 1); PG8_STAGE(PG8_SB(1, 0), b3, voffB); PG8_STAGE(PG8_SB(1, 1), b3 + hstep, voffB); PG8_STAGE(PG8_SA(1, 0), a3, voffA);
            PG8_WAIT_V(8); PG8_WAIT_L(0); PG8_BAR; PG8_MMA(1, 0, At, B0); PG8_MMA(1, 1, At, B1); PG8_BAR; PG8_SCHED;
        }
        if constexpr (F8) asm volatile("s_nop 15\n\ts_nop 15" ::: "memory");
        if (wr == 0) PG8_BAR;
        E(acc, cur, wr, wc, fr, fq);
        if (!has_next) break;
#pragma unroll
        for (int a = 0; a < 2; ++a)
#pragma unroll
            for (int b = 0; b < 2; ++b)
#pragma unroll
                for (int m = 0; m < 4; ++m)
#pragma unroll
                    for (int n = 0; n < 2; ++n) acc[a][b][m][n] = (f32x4){0.f, 0.f, 0.f, 0.f};
        cur = nxt; cA = nA; cB = nB; ++ui; relax = true;
        if (wr == 1) PG8_BAR;
    }
    PG8_WAIT_V(0);
    PG8_BAR;
#undef PG8_SA
#undef PG8_SB
#undef PG8_STAGE
#undef PG8_LDA
#undef PG8_LDB
#undef PG8_MMA
#undef PG8_WAIT_V
#undef PG8_WAIT_L
#undef PG8_BAR
#undef PG8_SCHED
}
}

constexpr size_t MiB = 1u << 20;
constexpr size_t WS_CTL = 0, CTL_ZERO_BYTES = 1 * MiB;
constexpr size_t WS_MOD = 1 * MiB;
constexpr size_t WS_KVMOD = 3 * MiB;
constexpr size_t WS_TOKINFO = 4 * MiB;
constexpr size_t WS_TOKSLOT = 6 * MiB;
constexpr size_t WS_SLOTW = 7 * MiB;
constexpr size_t WS_ROPE = 8 * MiB;
constexpr size_t WS_W_RIN = 24 * MiB, WS_W_ROUT = 48 * MiB, WS_W_KV = 56 * MiB, WS_W_SQ = 60 * MiB, WS_W_SO = 64 * MiB, WS_W_FIN = 68 * MiB, WS_W_FOUT = 90 * MiB, WS_W_MIN = 101 * MiB, WS_W_MOUT = 325 * MiB;
constexpr size_t WS_X = 437 * MiB, WS_H = 565 * MiB, WS_KSH = 629 * MiB, WS_VSH = 693 * MiB, WS_BIG = 757 * MiB;
constexpr size_t WS_PROJ = WS_BIG, WS_AO = WS_BIG + 384 * MiB;
constexpr size_t WS_ACTD = WS_BIG;
constexpr int MOE_CAP = MTOK;
constexpr size_t WS_HS = WS_BIG, WS_Y2 = WS_BIG, WS_ACTE = WS_BIG + 256 * MiB;
constexpr size_t WS_SQ = WS_BIG, WS_SO = WS_BIG + 64 * MiB, WS_HK = WS_BIG + 192 * MiB;
constexpr size_t WS_YB = WS_BIG + 594 * MiB;
constexpr size_t WS_END = WS_YB + 64 * MiB;
static_assert((size_t)MOE_ROWS_MAX * DM * 2 <= 256 * MiB && (size_t)NEXP * MOE_CAP * DM <= 256 * MiB && WS_ACTE + (size_t)MOE_ROWS_MAX * FFE <= WS_YB && WS_AO + (size_t)MTOK * 2048 * 2 <= WS_YB, "ws map");
constexpr int CW_BAR = 4096;
constexpr int CW_MOE = 16384;

constexpr int RING_BYTES = 131072;
constexpr int LDS_BYTES = 147456;
constexpr int MISC_OFF = LDS_BYTES - 256;

#define XB_TMO      128
#define XB_XCNT(j)  (256  + 64 * (j))
#define XB_XSUB(j)  (1280 + 64 * (j))
#define XB_XGEN(j)  (2304 + 64 * (j))
#define XB_TOP      3328
#define XB_TOPGEN   3392
#define XCD_BAR_WORDS 3456
#define XB_SPIN_CAP (1u << 20)
__device__ __forceinline__ unsigned xb_ld(unsigned* p)              { return __hip_atomic_load(p, __ATOMIC_RELAXED, __HIP_MEMORY_SCOPE_AGENT); }
__device__ __forceinline__ unsigned xb_add(unsigned* p, unsigned v) { return __hip_atomic_fetch_add(p, v, __ATOMIC_RELAXED, __HIP_MEMORY_SCOPE_AGENT); }
__device__ __forceinline__ unsigned xb_xcc_id() { return (unsigned)__builtin_amdgcn_s_getreg((3 << 11) | 20) & 0xFu; }
#define XB_SPIN(cond, bar) do { unsigned _sp = 0; while (cond) { __builtin_amdgcn_s_sleep(1); \
    if ((++_sp & 255u) == 0u) { if (xb_ld(&(bar)[XB_TMO])) break; if (_sp > XB_SPIN_CAP) { atomicAdd(&(bar)[XB_TMO], 1u); break; } } } } while (0)
struct XcdBarrier { unsigned* bar; unsigned x; volatile LAS unsigned* st; };
__device__ __forceinline__ XcdBarrier xcd_barrier_post(unsigned* bar, volatile LAS unsigned* st) {
    XcdBarrier b; b.bar = bar; b.x = xb_xcc_id(); b.st = st;
    if (threadIdx.x == 0) (void)xb_add(&bar[XB_XCNT(b.x)], 1u);
    return b;
}
__device__ __forceinline__ void xcd_barrier_complete(unsigned* bar, unsigned x, unsigned& nloc, unsigned& nx) {
    const unsigned G = gridDim.x * gridDim.y * gridDim.z;
    unsigned sum, cnt, mine, sp = 0u;
    for (;;) {
        sum = 0u; cnt = 0u; mine = 0u;
#pragma unroll
        for (unsigned j = 0; j < 16; ++j) { const unsigned c = xb_ld(&bar[XB_XCNT(j)]); sum += c; cnt += (c > 0u) ? 1u : 0u; mine = (j == x) ? c : mine; }
        if (sum == G) break;
        __builtin_amdgcn_s_sleep(1);
        if ((++sp & 255u) == 0u) { if (xb_ld(&bar[XB_TMO])) break; if (sp > XB_SPIN_CAP) { atomicAdd(&bar[XB_TMO], 1u); break; } }
    }
    nloc = mine > 0u ? mine : 1u; nx = cnt > 0u ? cnt : 1u;
}
__device__ __forceinline__ void xcd_barrier(const XcdBarrier& b) {
    asm volatile("s_waitcnt vmcnt(0)" ::: "memory");
    __syncthreads();
    if (threadIdx.x == 0) {
        unsigned* bar = b.bar;
        __builtin_amdgcn_s_waitcnt(0);
        unsigned nloc = b.st[0], nx = b.st[1];
        if (nloc == 0u) { xcd_barrier_complete(bar, b.x, nloc, nx); b.st[0] = nloc; b.st[1] = nx; }
        const unsigned old = xb_add(&bar[XB_XSUB(b.x)], 1u);
        const unsigned gen = old / nloc;
        if (old + 1u == (gen + 1u) * nloc) {
            __builtin_amdgcn_fence(__ATOMIC_RELEASE, "agent");
            asm volatile("s_waitcnt vmcnt(0)" ::: "memory");
            const unsigned og = xb_add(&bar[XB_TOP], 1u);
            const unsigned tg = og / nx;
            if (og + 1u == (tg + 1u) * nx) xb_add(&bar[XB_TOPGEN], 1u);
            else XB_SPIN(xb_ld(&bar[XB_TOPGEN]) == tg, bar);
            __builtin_amdgcn_fence(__ATOMIC_ACQUIRE, "agent");
            xb_add(&bar[XB_XGEN(b.x)], 1u);
            asm volatile("s_waitcnt vmcnt(0)" ::: "memory");
        } else {
            XB_SPIN(xb_ld(&bar[XB_XGEN(b.x)]) == gen, bar);
            __builtin_amdgcn_fence(__ATOMIC_ACQUIRE, "agent");
            asm volatile("s_waitcnt vmcnt(0)" ::: "memory");
        }
    }
    __syncthreads();
}

#define WG_BAR() do { asm volatile("s_waitcnt lgkmcnt(0)" ::: "memory"); __builtin_amdgcn_s_barrier(); asm volatile("" ::: "memory"); } while (0)
#define CFENCE() asm volatile("" ::: "memory")
__device__ __forceinline__ float wave_sum(float v) {
#pragma unroll
    for (int o = 1; o < 64; o <<= 1) v += __shfl_xor(v, o);
    return v;
}
__device__ __forceinline__ f16x4 tr_read(LAS const unsigned char* p) {
    return __builtin_bit_cast(f16x4, __builtin_amdgcn_ds_read_tr16_b64_v4i16((LAS v4i16_t*)p));
}
__device__ __forceinline__ f16x8 cat8(f16x4 a, f16x4 b) { return (f16x8){a[0], a[1], a[2], a[3], b[0], b[1], b[2], b[3]}; }
__device__ __forceinline__ f16x8 pack8(const f32x16& x, int s) {
    u32x4 w; w.x = pkh(x[8 * s + 0], x[8 * s + 1]); w.y = pkh(x[8 * s + 2], x[8 * s + 3]); w.z = pkh(x[8 * s + 4], x[8 * s + 5]); w.w = pkh(x[8 * s + 6], x[8 * s + 7]);
    return __builtin_bit_cast(f16x8, w);
}

struct Frame {
    LAS unsigned char* lds;
    unsigned* ctl;
    int wave, vcu, G;
    unsigned char* ws;
};
__device__ __forceinline__ int lane_id() { int l; asm volatile("v_mbcnt_lo_u32_b32 %0, -1, 0\n\tv_mbcnt_hi_u32_b32 %0, -1, %0" : "=v"(l)); return l; }
#define PHASE_IDS() const int lane = lane_id(); const int tid = F.wave * 64 + lane; (void)tid

template <int I> __device__ __forceinline__ const void* karg() {
    const auto kp = __builtin_amdgcn_kernarg_segment_ptr();
    unsigned long long v; asm volatile("s_load_dwordx2 %0, %1, %2\n\ts_waitcnt lgkmcnt(0)" : "=s"(v) : "s"(kp), "i"(I * 8) : "memory");
    return (const void*)(const GAS char*)v;
}
#define KIN(i) ((const float*)karg<(i)>())
template <int MAP>
__device__ __forceinline__ int srccol(int n, int N) {
    if (MAP == 1) { if (n >= 2048) return n; const int p = n & 127; return (n & ~127) + (p >> 1) + 64 * (p & 1); }
    if (MAP == 2) { const int F = N >> 1, t = n >> 8, j = n & 255; return (j < 128) ? 128 * t + j : F + 128 * t + (j - 128); }
    return n;
}
template <int MAP, bool F8>
__device__ __forceinline__ void p0_transpose_item(const float* W, int K, int N, void* WT, LAS float* scr, int item, int lane) {
    const int nblk = N / 32, kb = item / nblk, nb = item % nblk, k0 = 64 * kb, n0 = 32 * nb;
    const int sc = srccol<MAP>(n0 + (lane & 31), N);
    const float* wp = W + (size_t)(k0 + (lane >> 5)) * N + sc;
    float v[32];
#pragma unroll
    for (int i = 0; i < 32; ++i) v[i] = __builtin_nontemporal_load(wp + (size_t)(2 * i) * N);
#pragma unroll
    for (int i = 0; i < 32; ++i) scr[(2 * i + (lane >> 5)) * 33 + (lane & 31)] = F8 ? v[i] * F8_WSCALE : v[i];
    asm volatile("s_waitcnt lgkmcnt(0)" ::: "memory");
    if (F8) {
        const int c = lane & 3;
#pragma unroll
        for (int j = 0; j < 2; ++j) { const int n = (lane >> 2) + 16 * j; const LAS float* s = scr + (16 * c) * 33 + n;
            u32x4 o; o.x = pk4f8(s[0 * 33], s[1 * 33], s[2 * 33], s[3 * 33]); o.y = pk4f8(s[4 * 33], s[5 * 33], s[6 * 33], s[7 * 33]);
            o.z = pk4f8(s[8 * 33], s[9 * 33], s[10 * 33], s[11 * 33]); o.w = pk4f8(s[12 * 33], s[13 * 33], s[14 * 33], s[15 * 33]);
            *(u32x4*)((unsigned char*)WT + (size_t)(n0 + n) * K + k0 + 16 * c) = o; }
    } else {
        const int c = lane & 7;
#pragma unroll
        for (int j = 0; j < 4; ++j) { const int n = (lane >> 3) + 8 * j; const LAS float* s = scr + (8 * c) * 33 + n;
            u32x4 o; o.x = pkh(s[0 * 33], s[1 * 33]); o.y = pkh(s[2 * 33], s[3 * 33]); o.z = pkh(s[4 * 33], s[5 * 33]); o.w = pkh(s[6 * 33], s[7 * 33]);
            *(u32x4*)((f16*)WT + (size_t)(n0 + n) * K + k0 + 8 * c) = o; }
    }
    asm volatile("s_waitcnt lgkmcnt(0)" ::: "memory");
}
template <int MAP, bool F8>
__device__ __forceinline__ bool p0_group(int& r, const float* W, int nb, int K, int N, void* WT, LAS float* scr, int lane) {
    const int per = (K / 64) * (N / 32), tot = nb * per;
    if (r >= tot) { r -= tot; return false; }
    const int b = r / per, it = r % per;
    p0_transpose_item<MAP, F8>(W + (size_t)b * K * N, K, N, (unsigned char*)WT + (size_t)b * K * N * (F8 ? 1 : 2), scr, it, lane);
    return true;
}
constexpr int CONV_ITEMS_0 = 8 * (16 * 224 + 56 * 32) + 16 * 192 + 32 * 32;
constexpr int CONV_ITEMS_1 = 8 * (16 * 224 + 56 * 32) + 16 * 64 + 4 * 16 * 32 + 16 * 176 + 44 * 32;
__device__ __forceinline__ void conv_rest(int r, int which, unsigned char* ws, LAS float* scr, int lane) {
    if (which != 1) {
        if (p0_group<2, true>(r, KIN(19), NEXP, 1024, 7168, ws + WS_W_MIN, scr, lane)) return;
        if (p0_group<0, true>(r, KIN(20), NEXP, 3584, 1024, ws + WS_W_MOUT, scr, lane)) return;
        if (p0_group<1, RETIN_F8 != 0>(r, KIN(7) + (size_t)1024 * 6144, 1, 1024, 6144, (f16*)(ws + WS_W_RIN) + (size_t)1024 * 6144, scr, lane)) return;
        if (p0_group<0, false>(r, KIN(9) + (size_t)2048 * 1024, 1, 2048, 1024, (f16*)(ws + WS_W_ROUT) + (size_t)2048 * 1024, scr, lane)) return;
    }
    if (which != 0) {
        if (p0_group<2, true>(r, KIN(19) + (size_t)NEXP * 1024 * 7168, NEXP, 1024, 7168, ws + WS_W_MIN + (size_t)NEXP * 1024 * 7168, scr, lane)) return;
        if (p0_group<0, true>(r, KIN(20) + (size_t)NEXP * 3584 * 1024, NEXP, 3584, 1024, ws + WS_W_MOUT + (size_t)NEXP * 3584 * 1024, scr, lane)) return;
        if (p0_group<0, false>(r, KIN(13), 1, 1024, 2048, (f16*)(ws + WS_W_KV), scr, lane)) return;
        if (p0_group<0, false>(r, KIN(14), 2, 1024, 1024, (f16*)(ws + WS_W_SQ), scr, lane)) return;
        if (p0_group<0, false>(r, KIN(15), 2, 1024, 1024, (f16*)(ws + WS_W_SO), scr, lane)) return;
        if (p0_group<2, DENSE_F8 != 0>(r, KIN(16) + (size_t)1024 * 5632, 1, 1024, 5632, (f16*)(ws + WS_W_FIN) + (size_t)1024 * 5632, scr, lane)) return;
        p0_group<0, (DENSE_F8 != 0 && DENSE_F8_OUT != 0)>(r, KIN(17) + (size_t)2816 * 1024, 1, 2816, 1024, (f16*)(ws + WS_W_FOUT) + (size_t)2816 * 1024, scr, lane);
    }
}
__device__ __forceinline__ void p0_prologue(Frame& F) {
    PHASE_IDS();
    const int gw = F.vcu * 8 + F.wave, NGW = F.G * 8;
    LAS float* condL = (LAS float*)(F.lds);
    LAS float* scr = (LAS float*)(F.lds + 65536 + F.wave * 8448);
    for (int i = tid; i < 16 * 1024; i += 512) { const int b = i >> 10, k = i & 1023; condL[k * 16 + b] = silu_f(KIN(1)[i]); }
    WG_BAR();
    for (int it = gw; it < 1664; it += NGW) {
        const float* W; const float* bias; float* dst; int N, col0;
        if (it < 1536) { const int l = it / 384; col0 = 16 * (it % 384); N = 6144; W = KIN(3) + (size_t)l * 1024 * 6144; bias = KIN(4) + l * 6144; dst = (float*)(F.ws + WS_MOD) + (size_t)l * 16 * 6144; }
        else { col0 = 16 * (it - 1536); N = 2048; W = KIN(10); bias = KIN(11); dst = (float*)(F.ws + WS_KVMOD); }
        const int cl = lane & 3, kg = lane >> 2;
        f32x4 acc[16];
#pragma unroll
        for (int b = 0; b < 16; ++b) acc[b] = (f32x4){0.f, 0.f, 0.f, 0.f};
        const float* wp = W + (size_t)kg * N + col0 + 4 * cl;
#pragma unroll 4
        for (int k16 = 0; k16 < 64; ++k16) {
            const f32x4 w = *(const f32x4*)(wp + (size_t)k16 * 16 * N);
            const LAS f32x4* cp = (const LAS f32x4*)(condL + (16 * k16 + kg) * 16);
            const f32x4 c0 = cp[0], c1 = cp[1], c2 = cp[2], c3 = cp[3];
#pragma unroll
            for (int j = 0; j < 4; ++j) { acc[j] += c0[j] * w; acc[4 + j] += c1[j] * w; acc[8 + j] += c2[j] * w; acc[12 + j] += c3[j] * w; }
        }
        const f32x4 bv = *(const f32x4*)(bias + col0 + 4 * cl);
#pragma unroll
        for (int b = 0; b < 16; ++b) {
            f32x4 v = acc[b];
#pragma unroll
            for (int j = 0; j < 4; ++j) { v[j] += __shfl_xor(v[j], 4); v[j] += __shfl_xor(v[j], 8); v[j] += __shfl_xor(v[j], 16); v[j] += __shfl_xor(v[j], 32); }
            if (kg == 0) *(f32x4*)(dst + (size_t)b * N + col0 + 4 * cl) = v + bv;
        }
    }
    {
        const double e = -(double)lane / 64.0;
        const double invf = exp2(e * 13.287712379549449);
        float* rope = (float*)(F.ws + WS_ROPE); const int* posp = (const int*)karg<2>();
        for (int row = gw; row < MTOK; row += NGW) {
            const double rev = (double)posp[row] * invf * 0.15915494309189535;
            const float fr = (float)(rev - floor(rev));
            rope[(size_t)row * 128 + lane] = __builtin_amdgcn_cosf(fr); rope[(size_t)row * 128 + 64 + lane] = __builtin_amdgcn_sinf(fr);
        }
    }
    constexpr int per_rin = 16 * 192, per_rout = 32 * 32, per_kv = 16 * 64, per_sq = 16 * 32, per_fin = 16 * 176, per_fout = 44 * 32, per_min = 16 * 224, per_mout = 56 * 32;
    constexpr int NITEMS = CONV_IN_SCAN ? (per_rin + per_rout + per_fin + per_fout) : (2 * per_rin + 2 * per_rout + per_kv + 4 * per_sq + 2 * per_fin + 2 * per_fout + 16 * per_min + 16 * per_mout);
    for (int it = gw; it < NITEMS; it += NGW) {
        int r = it;
        if (p0_group<1, RETIN_F8 != 0>(r, KIN(7), 1, 1024, 6144, (f16*)(F.ws + WS_W_RIN), scr, lane)) continue;
        if (p0_group<0, false>(r, KIN(9), 1, 2048, 1024, (f16*)(F.ws + WS_W_ROUT), scr, lane)) continue;
        if (p0_group<2, false>(r, KIN(16), 1, 1024, 5632, (f16*)(F.ws + WS_W_FIN), scr, lane)) continue;
        if (p0_group<0, false>(r, KIN(17), 1, 2816, 1024, (f16*)(F.ws + WS_W_FOUT), scr, lane)) continue;
        if (!CONV_IN_SCAN) conv_rest(r, 2, F.ws, scr, lane);
    }
}

__device__ __forceinline__ void moe_tile_bases(const unsigned* gcnt, int (&tb)[NEXP], int& ntiles) {
    int acc = 0;
#pragma unroll
    for (int e = 0; e < NEXP; ++e) { tb[e] = acc; const unsigned c = __hip_atomic_load(gcnt + 64 * e, __ATOMIC_RELAXED, __HIP_MEMORY_SCOPE_AGENT); acc += (int)((c + 255u) >> 8); }
    ntiles = acc;
}
struct NormArgs {
    const void* x; f16* xw; const float* gain; const float* sh; const float* sc;
    f16* h; const float* gain2; const float* kvmod; f16* hk;
    const f16* y2; const float* gatef;
    float* out;
    const f16* yb;
    const float* router; unsigned* gcnt; unsigned* tokinfo; unsigned char* hs8; float* wof;
};
template <bool COMBINE, bool KV, bool FINAL, bool ROUTER, bool H8 = false, bool ADDY = false, bool XF32 = false>
__device__ __forceinline__ void norm_phase(Frame& F, const NormArgs& A) {
    PHASE_IDS();
    const int gw = F.vcu * 8 + F.wave, NGW = F.G * 8;
    LAS float* routL = (LAS float*)F.lds;
    LAS unsigned* lcnt = (LAS unsigned*)(F.lds + 32768);
    LAS unsigned* recs = (LAS unsigned*)(F.lds + 32768 + 256);
    if (ROUTER) {
        for (int i = tid; i < 8192; i += 512) routL[(i & 7) * 1024 + (i >> 3)] = A.router[i];
        if (tid < 16) lcnt[tid] = 0u;
        WG_BAR();
    }
    int ctb[NEXP]; int cnt_ = 0; (void)cnt_;
    if (COMBINE) moe_tile_bases(A.gcnt, ctb, cnt_);
    f32x4 cxf[4], nxf[4]; f16x4 cxh[4], nxh[4], cya[4], nya[4], cyb[4], nyb[4]; u32x4 ti_n = {0u, 0u, 0u, 0u};
#define NP_ISSUE(row_, ti_, xf_, xh_, ya_, yb_) do { \
        _Pragma("unroll") for (int j = 0; j < 4; ++j) { if (XF32) xf_[j] = *((const f32x4*)((const float*)A.x + (size_t)(row_) * DM) + lane + 64 * j); else xh_[j] = *((const f16x4*)((const f16*)A.x + (size_t)(row_) * DM) + lane + 64 * j); } \
        if (ADDY) { _Pragma("unroll") for (int j = 0; j < 4; ++j) ya_[j] = *((const f16x4*)(A.yb + (size_t)(row_) * DM) + lane + 64 * j); } \
        if (COMBINE) { int b1_ = 0, b2_ = 0; \
            _Pragma("unroll") for (int e = 0; e < NEXP; ++e) { b1_ = ((int)(ti_).x == e) ? ctb[e] : b1_; b2_ = ((int)(ti_).z == e) ? ctb[e] : b2_; } \
            const f16* pa_ = A.y2 + ((size_t)b1_ * 256 + (ti_).y) * DM; const f16* pb_ = A.y2 + ((size_t)b2_ * 256 + (ti_).w) * DM; \
            _Pragma("unroll") for (int j = 0; j < 4; ++j) { ya_[j] = *((const f16x4*)pa_ + lane + 64 * j); yb_[j] = *((const f16x4*)pb_ + lane + 64 * j); } } } while (0)
    if (gw < MTOK) {
        u32x4 ti0 = {0u, 0u, 0u, 0u};
        if (COMBINE) ti0 = *(const u32x4*)(A.tokinfo + 8 * (size_t)gw);
        NP_ISSUE(gw, ti0, cxf, cxh, cya, cyb);
        if (COMBINE && gw + NGW < MTOK) ti_n = *(const u32x4*)(A.tokinfo + 8 * (size_t)(gw + NGW));
    }
    int nloc = 0;
    for (int row = gw; row < MTOK; row += NGW, ++nloc) {
        const int b = row >> 11;
        if (row + NGW < MTOK) {
            NP_ISSUE(row + NGW, ti_n, nxf, nxh, nya, nyb);
            if (COMBINE && row + 2 * NGW < MTOK) ti_n = *(const u32x4*)(A.tokinfo + 8 * (size_t)(row + 2 * NGW));
        }
        f32x4 v[4];
#pragma unroll
        for (int j = 0; j < 4; ++j) { if (XF32) v[j] = cxf[j]; else v[j] = (f32x4){(float)cxh[j][0], (float)cxh[j][1], (float)cxh[j][2], (float)cxh[j][3]}; }
        if (ADDY) {
#pragma unroll
            for (int j = 0; j < 4; ++j) {
#pragma unroll
                for (int t = 0; t < 4; ++t) v[j][t] += (float)cya[j][t];
                { u32x2 w; w.x = pkh(v[j][0], v[j][1]); w.y = pkh(v[j][2], v[j][3]); *((u32x2*)(A.xw + (size_t)row * DM) + lane + 64 * j) = w; }
            }
        }
        if (COMBINE) {
#pragma unroll
            for (int j = 0; j < 4; ++j) {
                const f32x4 g = *((const f32x4*)(A.gatef + (size_t)b * 6144) + lane + 64 * j);
#pragma unroll
                for (int t = 0; t < 4; ++t) v[j][t] += g[t] * ((float)cya[j][t] + (float)cyb[j][t]);
                if (!FINAL) { u32x2 w; w.x = pkh(v[j][0], v[j][1]); w.y = pkh(v[j][2], v[j][3]); *((u32x2*)(A.xw + (size_t)row * DM) + lane + 64 * j) = w; }
            }
        }
        float ss = 0.f;
#pragma unroll
        for (int j = 0; j < 4; ++j) ss += (v[j][0] * v[j][0] + v[j][1] * v[j][1]) + (v[j][2] * v[j][2] + v[j][3] * v[j][3]);
        const float rstd = 1.0f / sqrtf(wave_sum(ss) * (1.0f / DM) + EPS);
        if (FINAL) {
#pragma unroll
            for (int j = 0; j < 4; ++j) { const f32x4 g = *((const f32x4*)A.gain + lane + 64 * j); *((f32x4*)(A.out + (size_t)row * DM) + lane + 64 * j) = v[j] * rstd * g; }
        } else {
            f32x4 hv[4];
#pragma unroll
            for (int j = 0; j < 4; ++j) {
                const f32x4 g = *((const f32x4*)A.gain + lane + 64 * j), sh = *((const f32x4*)(A.sh + (size_t)b * 6144) + lane + 64 * j), sc = *((const f32x4*)(A.sc + (size_t)b * 6144) + lane + 64 * j);
                hv[j] = (v[j] * rstd * g) * (1.0f + sc) + sh;
                if (H8) *((unsigned*)((unsigned char*)A.h + (size_t)row * DM) + lane + 64 * j) = pk4f8(hv[j][0], hv[j][1], hv[j][2], hv[j][3]);
                else { u32x2 w; w.x = pkh(hv[j][0], hv[j][1]); w.y = pkh(hv[j][2], hv[j][3]); *((u32x2*)(A.h + (size_t)row * DM) + lane + 64 * j) = w; }
            }
            if (KV) {
#pragma unroll
                for (int j = 0; j < 4; ++j) {
                    const f32x4 g = *((const f32x4*)A.gain2 + lane + 64 * j), sh = *((const f32x4*)(A.kvmod + (size_t)b * 2048) + lane + 64 * j), sc = *((const f32x4*)(A.kvmod + (size_t)b * 2048 + 1024) + lane + 64 * j);
                    const f32x4 o = (v[j] * rstd * g) * (1.0f + sc) + sh;
                    u32x2 w; w.x = pkh(o[0], o[1]); w.y = pkh(o[2], o[3]);
                    *((u32x2*)(A.hk + (size_t)row * DM) + lane + 64 * j) = w;
                }
            }
            if (ROUTER) {
                float lg[8];
#pragma unroll
                for (int e = 0; e < 8; ++e) lg[e] = 0.f;
#pragma unroll
                for (int j = 0; j < 4; ++j)
#pragma unroll
                    for (int e = 0; e < 8; ++e) {
                        const f32x4 rv = *((const LAS f32x4*)(routL + e * 1024) + lane + 64 * j);
                        lg[e] += (hv[j][0] * rv[0] + hv[j][1] * rv[1]) + (hv[j][2] * rv[2] + hv[j][3] * rv[3]);
                    }
                {
                    float r4[4], r2[2], r1;
                    const bool b0 = lane & 1, b1 = lane & 2, b2 = lane & 4;
#pragma unroll
                    for (int k = 0; k < 4; ++k) { const float keep = b0 ? lg[k + 4] : lg[k], send = b0 ? lg[k] : lg[k + 4]; r4[k] = keep + __shfl_xor(send, 1); }
#pragma unroll
                    for (int k = 0; k < 2; ++k) { const float keep = b1 ? r4[k + 2] : r4[k], send = b1 ? r4[k] : r4[k + 2]; r2[k] = keep + __shfl_xor(send, 2); }
                    { const float keep = b2 ? r2[1] : r2[0], send = b2 ? r2[0] : r2[1]; r1 = keep + __shfl_xor(send, 4); }
                    r1 += __shfl_xor(r1, 8); r1 += __shfl_xor(r1, 16); r1 += __shfl_xor(r1, 32);
#pragma unroll
                    for (int e = 0; e < 8; ++e) lg[e] = __int_as_float(__builtin_amdgcn_readlane(__float_as_int(r1), ((e >> 2) & 1) | (((e >> 1) & 1) << 1) | ((e & 1) << 2)));
                }
                int i1 = 0; float v1 = lg[0];
#pragma unroll
                for (int e = 1; e < 8; ++e) if (lg[e] > v1) { v1 = lg[e]; i1 = e; }
                int i2 = (i1 == 0) ? 1 : 0; float v2 = lg[i2];
#pragma unroll
                for (int e = 0; e < 8; ++e) if (e != i1 && lg[e] > v2) { v2 = lg[e]; i2 = e; }
                const float ed = __expf(v2 - v1), w1 = 1.0f / (1.0f + ed), w2 = ed * w1;
                if (lane == 0) {
                    const unsigned p1 = __hip_atomic_fetch_add(&lcnt[i1], 1u, __ATOMIC_RELAXED, __HIP_MEMORY_SCOPE_WORKGROUP), p2 = __hip_atomic_fetch_add(&lcnt[i2], 1u, __ATOMIC_RELAXED, __HIP_MEMORY_SCOPE_WORKGROUP);
                    LAS unsigned* rc = recs + (F.wave * 16 + nloc) * 8;
                    rc[0] = (unsigned)i1; rc[1] = p1; rc[2] = (unsigned)i2; rc[3] = p2; rc[4] = __float_as_uint(w1); rc[5] = __float_as_uint(w2);
                }
            }
        }
#pragma unroll
        for (int j = 0; j < 4; ++j) { cxf[j] = nxf[j]; cxh[j] = nxh[j]; cya[j] = nya[j]; cyb[j] = nyb[j]; }
    }
    if (ROUTER) {
        WG_BAR();
        if (tid < 8) lcnt[8 + tid] = __hip_atomic_fetch_add(A.gcnt + 64 * tid, lcnt[tid], __ATOMIC_RELAXED, __HIP_MEMORY_SCOPE_AGENT);
        WG_BAR();
        asm volatile("s_waitcnt vmcnt(0)" ::: "memory");
        for (int k0 = 0, row0 = gw; row0 < MTOK; row0 += 4 * NGW, k0 += 4) {
            u32x4 a[4];
#pragma unroll
            for (int q = 0; q < 4; ++q) { const int row = row0 + q * NGW; if (row < MTOK) a[q] = *((const u32x4*)((const unsigned char*)A.h + (size_t)row * DM) + lane); }
#pragma unroll
            for (int q = 0; q < 4; ++q) { const int row = row0 + q * NGW; if (row < MTOK) {
                const LAS unsigned* rc = recs + (F.wave * 16 + k0 + q) * 8;
                const unsigned e1 = rc[0], p1 = rc[1] + lcnt[8 + rc[0]], e2 = rc[2], p2 = rc[3] + lcnt[8 + rc[2]];
                const size_t v1 = (size_t)e1 * MOE_CAP + p1, v2 = (size_t)e2 * MOE_CAP + p2;
                *((u32x4*)(A.hs8 + v1 * DM) + lane) = a[q]; *((u32x4*)(A.hs8 + v2 * DM) + lane) = a[q];
                if (lane == 0) { *(u32x4*)(A.tokinfo + 8 * (size_t)row) = (u32x4){e1, p1, e2, p2}; A.wof[v1] = __uint_as_float(rc[4]); A.wof[v2] = __uint_as_float(rc[5]); } } }
        }
    }
}
constexpr int SC_PV = 576;
constexpr int SC_QL = 0, SC_KL = 16384, SC_VL = 32768, SC_SL = 69632, SC_ST = 135168, SC_STAGE = 0;
__device__ __forceinline__ int sc_off(int row, int ch) { return 256 * row + 16 * (ch ^ (((row & 3) << 2) | ((row >> 2) & 3))); }
__device__ __forceinline__ void scan_phase(Frame& F, const f16* proj, const float* gnw, f16* ao, int mi) {
    if (CONV_IN_SCAN) {
        if (blockIdx.x >= BATCH * RH) {
            PHASE_IDS();
            LAS float* scr = (LAS float*)(F.lds + F.wave * 8448);
            const int cw = ((int)blockIdx.x - BATCH * RH) * 8 + F.wave, NCW = ((int)gridDim.x - BATCH * RH) * 8;
            const int nit = mi ? CONV_ITEMS_1 : CONV_ITEMS_0;
            for (int it = cw; it < nit; it += NCW) conv_rest(it, mi, F.ws, scr, lane);
            return;
        }
    } else if (blockIdx.x >= 2 * BATCH * RH) return;
    const int unit = CONV_IN_SCAN ? (int)blockIdx.x : (int)(blockIdx.x >> 1), half = CONV_IN_SCAN ? 0 : (int)(blockIdx.x & 1);
    const int b = unit >> 3, hh = unit & 7;
    const int c_first_full = half ? NCHUNK / 2 : 0, c_end = CONV_IN_SCAN ? NCHUNK : (half ? NCHUNK : NCHUNK / 2);
    LAS unsigned char* L = F.lds;
    PHASE_IDS();
    const int wid = F.wave, rh = wid >> 2, cg = wid & 3, r = lane & 31, h = lane >> 5;
    const int gl = (lane >> 4) & 1, li = lane & 15, ta = li >> 2, tp = li & 3;
    const float lg = lg2gamma(hh);
    const float g63 = ex2(63.0f * lg), cd = __int_as_float(__builtin_amdgcn_readfirstlane(__float_as_int(ex2(64.0f * lg))));
    float vm[4], cj[4]; const int qloc = 32 * rh + r;
    const float wneg = __int_as_float(__builtin_amdgcn_readfirstlane(__float_as_int(ex2(-64.0f * lg))));
#pragma unroll
    for (int g4 = 0; g4 < 4; ++g4) vm[g4] = ex2((float)(16 * g4 + 8 * h - 2 * qloc - 64) * lg);
#pragma unroll
    for (int j = 0; j < 4; ++j) cj[j] = __int_as_float(__builtin_amdgcn_readfirstlane(__float_as_int(ex2((float)(2 * j) * lg))));
    const size_t rowbase = (size_t)b * SEQ;
    const f16* gq = proj + rowbase * RIN + 128 * hh;
    const f16* gk = gq + 1024;
    const f16* gv = proj + rowbase * RIN + 2048 + 256 * hh;
    const f16* gg = gv + 2048;
    const int qrow = tid >> 4, qc = tid & 15;
    const int vrow = tid >> 5, vc = tid & 31;
    int qoffL[2];
#pragma unroll
    for (int i = 0; i < 2; ++i) qoffL[i] = sc_off(qrow + 32 * i, qc);
    f32x16 SA[2][2];
#pragma unroll
    for (int dd = 0; dd < 2; ++dd)
#pragma unroll
        for (int et = 0; et < 2; ++et)
#pragma unroll
            for (int i = 0; i < 16; ++i) SA[dd][et][i] = 0.f;
    for (int i = tid; i < 65536 / 16; i += 512) *(LAS u32x4*)(L + SC_SL + i * 16) = (u32x4){0u, 0u, 0u, 0u};
    u32x4 nq[2], nk[2], nv[4];
#pragma unroll
    for (int i = 0; i < 2; ++i) { nq[i] = *(const u32x4*)(gq + (size_t)(qrow + 32 * i) * RIN + 8 * qc); nk[i] = *(const u32x4*)(gk + (size_t)(qrow + 32 * i) * RIN + 8 * qc); }
#pragma unroll
    for (int i = 0; i < 4; ++i) nv[i] = *(const u32x4*)(gv + (size_t)(vrow + 16 * i) * RIN + 8 * vc);
#pragma unroll
    for (int i = 0; i < 2; ++i) { *(LAS u32x4*)(L + SC_QL + qoffL[i]) = nq[i]; *(LAS u32x4*)(L + SC_KL + qoffL[i]) = nk[i]; }
#pragma unroll
    for (int i = 0; i < 4; ++i) *(LAS u32x4*)(L + SC_VL + (vrow + 16 * i) * SC_PV + 16 * vc) = nv[i];
    WG_BAR();
    for (int c = 0; c < c_first_full; ++c) {
        const size_t crow = (size_t)c * CHUNK;
#pragma unroll
        for (int i = 0; i < 2; ++i) { nq[i] = *(const u32x4*)(gq + (crow + 64 + qrow + 32 * i) * RIN + 8 * qc); nk[i] = *(const u32x4*)(gk + (crow + 64 + qrow + 32 * i) * RIN + 8 * qc); }
#pragma unroll
        for (int i = 0; i < 4; ++i) nv[i] = *(const u32x4*)(gv + (crow + 64 + vrow + 16 * i) * RIN + 8 * vc);
        int ro = r, ho = h, tao = ta, tpo = tp, glo = gl, vro = vrow, vco = vc;
        asm volatile("" : "+v"(ro), "+v"(ho), "+v"(tao), "+v"(tpo), "+v"(glo), "+v"(vro), "+v"(vco));
#pragma unroll
        for (int dd = 0; dd < 2; ++dd)
#pragma unroll
            for (int et = 0; et < 2; ++et)
#pragma unroll
                for (int i = 0; i < 16; ++i) SA[dd][et][i] *= cd;
#pragma unroll
        for (int kt = 0; kt < 2; ++kt)
#pragma unroll
            for (int s = 0; s < 2; ++s) {
                const int k0 = 32 * kt + 16 * s + 4 * ho + tao;
                f16x8 Vf[2], Kt[2];
#pragma unroll
                for (int et = 0; et < 2; ++et) { LAS const unsigned char* vp = L + SC_VL + k0 * SC_PV + (64 * cg + 32 * et + 16 * glo + 4 * tpo) * 2; Vf[et] = cat8(tr_read(vp), tr_read(vp + 8 * SC_PV)); }
#pragma unroll
                for (int dd = 0; dd < 2; ++dd) { const int ch = 4 * (2 * rh + dd) + 2 * glo + (tpo >> 1);
                    Kt[dd] = cat8(tr_read(L + SC_KL + sc_off(k0, ch) + 8 * (tpo & 1)), tr_read(L + SC_KL + sc_off(k0 + 8, ch) + 8 * (tpo & 1))); }
#pragma unroll
                for (int et = 0; et < 2; ++et)
#pragma unroll
                    for (int dd = 0; dd < 2; ++dd) SA[dd][et] = __builtin_amdgcn_mfma_f32_32x32x16_f16(Kt[dd], Vf[et], SA[dd][et], 0, 0, 0);
            }
        WG_BAR();
        if (c + 1 == c_first_full) {
#pragma unroll
            for (int dd = 0; dd < 2; ++dd)
#pragma unroll
                for (int et = 0; et < 2; ++et)
#pragma unroll
                    for (int g4 = 0; g4 < 4; ++g4) {
                        u32x2 w; w.x = pkh(SA[dd][et][4 * g4], SA[dd][et][4 * g4 + 1]); w.y = pkh(SA[dd][et][4 * g4 + 2], SA[dd][et][4 * g4 + 3]);
                        *(LAS u32x2*)(L + SC_SL + sc_off(64 * cg + 32 * et + ro, 4 * (2 * rh + dd) + g4) + 8 * ho) = w;
                    }
        }
#pragma unroll
        for (int i = 0; i < 2; ++i) { const int qo = sc_off((vro * 2 + (vco >> 4)) + 32 * i, vco & 15); *(LAS u32x4*)(L + SC_QL + qo) = nq[i]; *(LAS u32x4*)(L + SC_KL + qo) = nk[i]; }
#pragma unroll
        for (int i = 0; i < 4; ++i) *(LAS u32x4*)(L + SC_VL + (vrow + 16 * i) * SC_PV + 16 * vc) = nv[i];
        WG_BAR();
    }
    for (int c = c_first_full; c < c_end; ++c) {
        const size_t crow = (size_t)c * CHUNK;
        if (c + 1 < c_end) {
#pragma unroll
            for (int i = 0; i < 2; ++i) { nq[i] = *(const u32x4*)(gq + (crow + 64 + qrow + 32 * i) * RIN + 8 * qc); nk[i] = *(const u32x4*)(gk + (crow + 64 + qrow + 32 * i) * RIN + 8 * qc); }
#pragma unroll
            for (int i = 0; i < 4; ++i) nv[i] = *(const u32x4*)(gv + (crow + 64 + vrow + 16 * i) * RIN + 8 * vc);
        }
        int ro = r, ho = h, tao = ta, tpo = tp, glo = gl, vro = vrow, vco = vc;
        asm volatile("" : "+v"(ro), "+v"(ho), "+v"(tao), "+v"(tpo), "+v"(glo), "+v"(vro), "+v"(vco));
        f16x8 Pf[2][2]; f32x16 OT[2];
        {
        f16x8 Qf[8];
#pragma unroll
        for (int ks = 0; ks < 8; ++ks) Qf[ks] = *(const LAS f16x8*)(L + SC_QL + sc_off(32 * rh + ro, 2 * ks + ho));
#pragma unroll
        for (int kt = 0; kt < 2; ++kt) {
            f32x16 X;
#pragma unroll
            for (int i = 0; i < 16; ++i) X[i] = 0.f;
#pragma unroll
            for (int ks = 0; ks < 8; ++ks) { const f16x8 Kf = *(const LAS f16x8*)(L + SC_KL + sc_off(32 * kt + ro, 2 * ks + ho)); X = __builtin_amdgcn_mfma_f32_32x32x16_f16(Kf, Qf[ks], X, 0, 0, 0); }
#pragma unroll
            for (int i = 0; i < 16; ++i) { const int key = 32 * kt + (i & 3) + 8 * (i >> 2) + 4 * h; X[i] *= (key >= qloc) ? vm[i >> 2] * (kt ? cd * cj[i & 3] : cj[i & 3]) : wneg; }
            Pf[kt][0] = pack8(X, 0); Pf[kt][1] = pack8(X, 1);
        }
#pragma unroll
        for (int et = 0; et < 2; ++et)
#pragma unroll
            for (int i = 0; i < 16; ++i) OT[et][i] = 0.f;
#pragma unroll
        for (int ks = 0; ks < 8; ++ks)
#pragma unroll
            for (int et = 0; et < 2; ++et) {
                const f16x8 Sf = *(const LAS f16x8*)(L + SC_SL + sc_off(64 * cg + 32 * et + ro, 2 * ks + ho));
                OT[et] = __builtin_amdgcn_mfma_f32_32x32x16_f16(Sf, Qf[ks], OT[et], 0, 0, 0);
            }
        }
#pragma unroll
        for (int dd = 0; dd < 2; ++dd)
#pragma unroll
            for (int et = 0; et < 2; ++et)
#pragma unroll
                for (int i = 0; i < 16; ++i) SA[dd][et][i] *= cd;
#pragma unroll
        for (int kt = 0; kt < 2; ++kt)
#pragma unroll
            for (int s = 0; s < 2; ++s) {
                const int k0 = 32 * kt + 16 * s + 4 * ho + tao;
                f16x8 Vf[2], Kt[2];
#pragma unroll
                for (int et = 0; et < 2; ++et) { LAS const unsigned char* vp = L + SC_VL + k0 * SC_PV + (64 * cg + 32 * et + 16 * glo + 4 * tpo) * 2; Vf[et] = cat8(tr_read(vp), tr_read(vp + 8 * SC_PV)); }
#pragma unroll
                for (int dd = 0; dd < 2; ++dd) { const int ch = 4 * (2 * rh + dd) + 2 * glo + (tpo >> 1);
                    Kt[dd] = cat8(tr_read(L + SC_KL + sc_off(k0, ch) + 8 * (tpo & 1)), tr_read(L + SC_KL + sc_off(k0 + 8, ch) + 8 * (tpo & 1))); }
#pragma unroll
                for (int et = 0; et < 2; ++et) {
                    OT[et] = __builtin_amdgcn_mfma_f32_32x32x16_f16(Vf[et], Pf[kt][s], OT[et], 0, 0, 0);
#pragma unroll
                    for (int dd = 0; dd < 2; ++dd) SA[dd][et] = __builtin_amdgcn_mfma_f32_32x32x16_f16(Kt[dd], Vf[et], SA[dd][et], 0, 0, 0);
                }
            }
        float mean = 0.f, rstd = 0.f;
        {
        float s1 = 0.f, s2 = 0.f;
#pragma unroll
        for (int et = 0; et < 2; ++et)
#pragma unroll
            for (int i = 0; i < 16; ++i) { OT[et][i] *= g63; s1 += OT[et][i]; s2 += OT[et][i] * OT[et][i]; }
        s1 += __shfl_xor(s1, 32); s2 += __shfl_xor(s2, 32);
        if (h == 0) *(LAS f32x2*)(L + SC_ST + ((rh * 4 + cg) * 32 + r) * 8) = (f32x2){s1, s2};
        }
        WG_BAR();
        u32x4 gc[4];
        {
        float t1 = 0.f, t2 = 0.f;
#pragma unroll
        for (int c4 = 0; c4 < 4; ++c4) { const f32x2 p = *(const LAS f32x2*)(L + SC_ST + ((rh * 4 + c4) * 32 + r) * 8); t1 += p.x; t2 += p.y; }
        mean = t1 * (1.0f / 256.0f); const float var = t2 * (1.0f / 256.0f) - mean * mean; rstd = 1.0f / sqrtf(var + EPS);
#pragma unroll
        for (int i = 0; i < 4; ++i) gc[i] = *(const u32x4*)(gg + (crow + vrow + 16 * i) * RIN + 8 * vc);
        }
        {
#pragma unroll
        for (int dd = 0; dd < 2; ++dd)
#pragma unroll
            for (int et = 0; et < 2; ++et)
#pragma unroll
                for (int g4 = 0; g4 < 4; ++g4) {
                    u32x2 w; w.x = pkh(SA[dd][et][4 * g4], SA[dd][et][4 * g4 + 1]); w.y = pkh(SA[dd][et][4 * g4 + 2], SA[dd][et][4 * g4 + 3]);
                    *(LAS u32x2*)(L + SC_SL + sc_off(64 * cg + 32 * et + ro, 4 * (2 * rh + dd) + g4) + 8 * ho) = w;
                }
        }
        {
#pragma unroll
        for (int et = 0; et < 2; ++et)
#pragma unroll
            for (int g4 = 0; g4 < 4; ++g4) {
                u32x2 w; w.x = pkh((OT[et][4 * g4] - mean) * rstd, (OT[et][4 * g4 + 1] - mean) * rstd); w.y = pkh((OT[et][4 * g4 + 2] - mean) * rstd, (OT[et][4 * g4 + 3] - mean) * rstd);
                *(LAS u32x2*)(L + SC_STAGE + 16384 * (cg >> 1) + sc_off(32 * rh + ro, 8 * (cg & 1) + 4 * et + g4) + 8 * ho) = w;
            }
        }
        WG_BAR();
        {
        f32x4 gw0, gw1; { const float* gp = gnw + 256 * hh + 8 * vc; gw0 = *(const f32x4*)gp; gw1 = *(const f32x4*)(gp + 4); }
#pragma unroll
        for (int i = 0; i < 4; ++i) {
            const f16x8 n8 = *(const LAS f16x8*)(L + SC_STAGE + 16384 * (vco >> 4) + sc_off(vro + 16 * i, vco & 15));
            const f16x8 g8 = __builtin_bit_cast(f16x8, gc[i]);
            u32x4 w;
            w.x = pkh((float)n8[0] * (float)g8[0] * gw0[0], (float)n8[1] * (float)g8[1] * gw0[1]); w.y = pkh((float)n8[2] * (float)g8[2] * gw0[2], (float)n8[3] * (float)g8[3] * gw0[3]);
            w.z = pkh((float)n8[4] * (float)g8[4] * gw1[0], (float)n8[5] * (float)g8[5] * gw1[1]); w.w = pkh((float)n8[6] * (float)g8[6] * gw1[2], (float)n8[7] * (float)g8[7] * gw1[3]);
            *(u32x4*)(ao + (rowbase + crow + vrow + 16 * i) * 2048 + 256 * hh + 8 * vc) = w;
        }
        }
        WG_BAR();
        if (c + 1 < c_end) {
#pragma unroll
            for (int i = 0; i < 2; ++i) { const int qo = sc_off((vro * 2 + (vco >> 4)) + 32 * i, vco & 15); *(LAS u32x4*)(L + SC_QL + qo) = nq[i]; *(LAS u32x4*)(L + SC_KL + qo) = nk[i]; }
#pragma unroll
            for (int i = 0; i < 4; ++i) *(LAS u32x4*)(L + SC_VL + (vrow + 16 * i) * SC_PV + 16 * vc) = nv[i];
        }
        WG_BAR();
    }
}

constexpr int SBV_P = 144;
constexpr float SB_STOP = 5.421010862427522e-20f;
__device__ __forceinline__ void sb_phase(Frame& F, const f16* Q, const f16* Kc, const f16* Vc, f16* O, const float stop = SB_STOP) {
    PHASE_IDS();
    const int gw = F.vcu * 8 + F.wave, NGW = F.G * 8, r = lane & 31, h = lane >> 5;
    const int gl = (lane >> 4) & 1, li = lane & 15, ta = li >> 2, tp = li & 3;
    LAS unsigned char* Kw = F.lds + F.wave * (96 * SBV_P);
    LAS unsigned char* Vw = Kw + 32 * SBV_P; LAS unsigned char* Qw = Kw + 64 * SBV_P;
    const int vr = lane >> 3, vcc = lane & 7;
    constexpr int NU = BATCH * SBH * (SEQ / 32);
    u32x4 qn2[4], kn2[4], vn2[4];
    if (gw < NU) { const int qblk = gw & 63, bh = gw >> 6, b = bh >> 4, hd = bh & 15; const size_t rb = (size_t)b * SEQ;
        const f16* qp = Q + (rb + 32 * qblk + vr) * DM + 64 * hd + 8 * vcc; const f16* kp = Kc + (rb + 32 * qblk + vr) * DM + 64 * hd + 8 * vcc; const f16* vp = Vc + (rb + 32 * qblk + vr) * DM + 64 * hd + 8 * vcc;
#pragma unroll
        for (int i = 0; i < 4; ++i) { qn2[i] = *(const u32x4*)(qp + (size_t)(8 * i) * DM); kn2[i] = *(const u32x4*)(kp + (size_t)(8 * i) * DM); vn2[i] = *(const u32x4*)(vp + (size_t)(8 * i) * DM); } }
    for (int u = gw; u < NU; u += NGW) {
        const int qblk = u & 63, bh = u >> 6, b = bh >> 4, hd = bh & 15;
        const size_t rb = (size_t)b * SEQ;
        f16x8 Qf[4];
#pragma unroll
        for (int i = 0; i < 4; ++i) *(LAS u32x4*)(Qw + (vr + 8 * i) * SBV_P + 16 * vcc) = qn2[i];
        CFENCE();
#pragma unroll
        for (int ks = 0; ks < 4; ++ks) Qf[ks] = *(const LAS f16x8*)(Qw + r * SBV_P + (16 * ks + 8 * h) * 2);
        CFENCE();
        f32x16 OT[2];
#pragma unroll
        for (int dt = 0; dt < 2; ++dt)
#pragma unroll
            for (int i = 0; i < 16; ++i) OT[dt][i] = 0.f;
        float carry = 1.0f;
        u32x4 kn[4], vn[4];
#pragma unroll
        for (int i = 0; i < 4; ++i) { kn[i] = kn2[i]; vn[i] = vn2[i]; }
        if (u + NGW < NU) { const int un = u + NGW, qb2 = un & 63, bh2 = un >> 6, b2 = bh2 >> 4, hd2 = bh2 & 15; const size_t rb2 = (size_t)b2 * SEQ;
            const f16* qp = Q + (rb2 + 32 * qb2 + vr) * DM + 64 * hd2 + 8 * vcc; const f16* kp = Kc + (rb2 + 32 * qb2 + vr) * DM + 64 * hd2 + 8 * vcc; const f16* vp = Vc + (rb2 + 32 * qb2 + vr) * DM + 64 * hd2 + 8 * vcc;
#pragma unroll
            for (int i = 0; i < 4; ++i) { qn2[i] = *(const u32x4*)(qp + (size_t)(8 * i) * DM); kn2[i] = *(const u32x4*)(kp + (size_t)(8 * i) * DM); vn2[i] = *(const u32x4*)(vp + (size_t)(8 * i) * DM); } }
        for (int kt = qblk; kt >= 0; --kt) {
#pragma unroll
            for (int i = 0; i < 4; ++i) { *(LAS u32x4*)(Kw + (vr + 8 * i) * SBV_P + 16 * vcc) = kn[i]; *(LAS u32x4*)(Vw + (vr + 8 * i) * SBV_P + 16 * vcc) = vn[i]; }
            CFENCE();
            f16x8 Kf[4];
#pragma unroll
            for (int ks = 0; ks < 4; ++ks) Kf[ks] = *(const LAS f16x8*)(Kw + r * SBV_P + (16 * ks + 8 * h) * 2);
            CFENCE();
            if (kt > 0) { const f16* kp = Kc + (rb + 32 * (kt - 1) + vr) * DM + 64 * hd + 8 * vcc; const f16* vp = Vc + (rb + 32 * (kt - 1) + vr) * DM + 64 * hd + 8 * vcc;
#pragma unroll
                for (int i = 0; i < 4; ++i) { kn[i] = *(const u32x4*)(kp + (size_t)(8 * i) * DM); vn[i] = *(const u32x4*)(vp + (size_t)(8 * i) * DM); } }
            f32x16 S;
#pragma unroll
            for (int i = 0; i < 16; ++i) S[i] = 0.f;
#pragma unroll
            for (int ks = 0; ks < 4; ++ks) S = __builtin_amdgcn_mfma_f32_32x32x16_f16(Kf[ks], Qf[ks], S, 0, 0, 0);
            float om[16];
            const bool diag = (kt == qblk);
#pragma unroll
            for (int i = 0; i < 16; ++i) {
                const int kl = (i & 3) + 8 * (i >> 2) + 4 * h;
                float o = __builtin_amdgcn_rcpf(1.0f + ex2(S[i]));
                if (diag && kl >= r) o = 1.0f;
                om[i] = o;
            }
            float sfx[16], T[4];
#pragma unroll
            for (int g4 = 0; g4 < 4; ++g4) { sfx[4 * g4 + 3] = 1.0f; sfx[4 * g4 + 2] = om[4 * g4 + 3]; sfx[4 * g4 + 1] = sfx[4 * g4 + 2] * om[4 * g4 + 2]; sfx[4 * g4] = sfx[4 * g4 + 1] * om[4 * g4 + 1]; T[g4] = sfx[4 * g4] * om[4 * g4]; }
            float E[4]; float run = carry;
#pragma unroll
            for (int g4 = 3; g4 >= 0; --g4) {
                const auto sw = __builtin_amdgcn_permlane32_swap(__float_as_uint(T[g4]), __float_as_uint(T[g4]), false, false);
                const float tl = __uint_as_float(sw[0]), th = __uint_as_float(sw[1]);
                const float e_hi = run; run *= th; const float e_lo = run; run *= tl;
                E[g4] = h ? e_hi : e_lo;
            }
            carry = run;
            f32x16 Aw;
#pragma unroll
            for (int i = 0; i < 16; ++i) Aw[i] = (1.0f - om[i]) * (E[i >> 2] * sfx[i]);
            const f16x8 Af0 = pack8(Aw, 0), Af1 = pack8(Aw, 1);
            CFENCE();
#pragma unroll
            for (int dt = 0; dt < 2; ++dt) {
                LAS const unsigned char* vp = Vw + (4 * h + ta) * SBV_P + (32 * dt + 16 * gl + 4 * tp) * 2;
                const f16x8 V0 = cat8(tr_read(vp), tr_read(vp + 8 * SBV_P)), V1 = cat8(tr_read(vp + 16 * SBV_P), tr_read(vp + 24 * SBV_P));
                OT[dt] = __builtin_amdgcn_mfma_f32_32x32x16_f16(V0, Af0, OT[dt], 0, 0, 0);
                OT[dt] = __builtin_amdgcn_mfma_f32_32x32x16_f16(V1, Af1, OT[dt], 0, 0, 0);
            }
            CFENCE();
            if (__ballot(carry > stop) == 0ull) break;
        }
        CFENCE();
#pragma unroll
        for (int dt = 0; dt < 2; ++dt)
#pragma unroll
            for (int g4 = 0; g4 < 4; ++g4) { u32x2 w; w.x = pkh(OT[dt][4 * g4], OT[dt][4 * g4 + 1]); w.y = pkh(OT[dt][4 * g4 + 2], OT[dt][4 * g4 + 3]); *(LAS u32x2*)(Qw + r * SBV_P + (32 * dt + 8 * g4 + 4 * h) * 2) = w; }
        CFENCE();
        f16* op = O + (rb + 32 * qblk + vr) * DM + 64 * hd + 8 * vcc;
#pragma unroll
        for (int i = 0; i < 4; ++i) *(u32x4*)(op + (size_t)(8 * i) * DM) = *(const LAS u32x4*)(Qw + (vr + 8 * i) * SBV_P + 16 * vcc);
        CFENCE();
    }
}

struct Args { const void* in[22]; float* out; unsigned char* ws; int ph_lo, ph_hi; };
constexpr int N_PHASES = 34;
#define IN(k) (lo <= (k) && (k) < hi)
#define SEAM(k) do { if (IN((k) + 1)) { if (!MK_PER_PHASE) xcd_barrier(bar); } } while (0)
#define WSP(T, off) ((T*)(F.ws + (off)))
#define REPS(cond) _Pragma("unroll") for (int rep_ = 0; rep_ < ((cond) ? 2 : 1); ++rep_)
#define REPBAR() do { if (rep_) xcd_barrier(bar); } while (0)
#define REPSN(cond, n) _Pragma("unroll") for (int rep_ = 0; rep_ < ((cond) ? (n) : 1); ++rep_)
template <int L> __device__ __forceinline__ void layer_phases(Frame& F, const XcdBarrier& bar, const int lo, const int hi) {
    constexpr int pb = 1 + 8 * L;
        if (IN(pb + 0) && !DIS_K0) {
            const float* modL = WSP(const float, WS_MOD) + (size_t)L * 16 * 6144;
            NormArgs A{}; A.x = (L == 0) ? (const void*)KIN(0) : (const void*)WSP(const f16, WS_X); A.xw = WSP(f16, WS_X); A.gain = KIN(5) + L * DM; A.sh = modL; A.sc = modL + 1024; A.h = WSP(f16, WS_H);
            if constexpr (L == 2) {
                A.y2 = WSP(const f16, WS_Y2); A.gcnt = F.ctl + CW_MOE; A.tokinfo = WSP(unsigned, WS_TOKINFO); A.gatef = WSP(const float, WS_MOD) + (size_t)(L - 1) * 16 * 6144 + 5120;
                A.gain2 = KIN(12); A.kvmod = WSP(const float, WS_KVMOD); A.hk = WSP(f16, WS_HK); REPSN(PROBE_DUP == 15, 5) { REPBAR(); if (rep_) { A.xw = WSP(f16, WS_BIG + 320 * MiB); A.h = WSP(f16, WS_BIG + 448 * MiB); A.hk = WSP(f16, WS_BIG + 512 * MiB); } norm_phase<true, true, false, false>(F, A); }
            } else REPSN(PROBE_DUP == 7 && L == 1, 5) { REPBAR(); A.yb = WSP(const f16, WS_YB); if (rep_) { A.xw = WSP(f16, WS_BIG + 320 * MiB); A.h = WSP(f16, WS_BIG + 448 * MiB); } norm_phase<false, false, false, false, (RETIN_F8 != 0 && L < 2), (L == 1 || L == 3), (L == 0)>(F, A); }
            SEAM(pb + 0);
        }
        if (IN(pb + 1) && !DIS_K1) {
            if constexpr (L < 2) {
                pg8::Gemm g{WSP(const unsigned char, WS_H), WSP(const unsigned char, WS_W_RIN) + (size_t)L * RIN * DM * 2, MTOK, RIN, DM, 0, STAG_RET}; pg8::Order S; S.init(MTOK, RIN, F.G, (int)blockIdx.x);
                pg8::EpiRetIn E{WSP(f16, WS_PROJ), WSP(const float, WS_ROPE), RETIN_F8 ? 1.0f / F8_WSCALE : 1.0f};
                REPS(PROBE_DUP == 6 && L == 1) { REPBAR(); pg8::gemm_phase<pg8::EpiRetIn, RETIN_F8 != 0>(F.lds, g, S, E); }
                if constexpr (PROBE_DUP == 17 && L == 1) { xcd_barrier(bar); pg8::EpiNull<true> EN{WSP(float, WS_SLOTW)}; pg8::gemm_phase<pg8::EpiNull<true>, false>(F.lds, g, S, EN); }
            } else REPS(PROBE_DUP == 12 && L == 2) { REPBAR();
                { pg8::Gemm g{WSP(const f16, WS_H), WSP(const f16, WS_W_SQ) + (size_t)(L - 2) * DM * DM, MTOK, DM, DM, 0}; pg8::Order S; S.init(MTOK, DM, F.G, (int)blockIdx.x);
                  pg8::EpiF16 E{WSP(f16, WS_SQ), DM, 0, 0, 0.125f * 1.4426950408889634f};
                  pg8::gemm_phase<pg8::EpiF16>(F.lds, g, S, E); }
                if constexpr (L == 2) { pg8::Gemm g{WSP(const f16, WS_HK), WSP(const f16, WS_W_KV), MTOK, 2048, DM, 0}; pg8::Order S; S.init(MTOK, 2048, F.G, (int)blockIdx.x);
                  pg8::EpiF16 E{WSP(f16, WS_KSH), DM, 1024, (size_t)(WS_VSH - WS_KSH) / 2, 1.0f};
                  pg8::gemm_phase<pg8::EpiF16>(F.lds, g, S, E); }
            }
            SEAM(pb + 1);
        }
        if (IN(pb + 2) && !DIS_K2) {
#ifndef NO_SCAN
            if constexpr (L < 2) REPS(PROBE_DUP == 2 && L == 1) { REPBAR(); scan_phase(F, WSP(const f16, WS_PROJ), KIN(8) + L * 2048, WSP(f16, WS_AO), L); }
#endif
#ifndef NO_SB
            if constexpr (L >= 2) REPSN((PROBE_DUP == 3 || PROBE_DUP == 22 || PROBE_DUP == 23) && L == 3, 5) { REPBAR(); sb_phase(F, WSP(const f16, WS_SQ), WSP(const f16, WS_KSH), WSP(const f16, WS_VSH), rep_ ? WSP(f16, WS_BIG + 320 * MiB) : WSP(f16, WS_SO), (rep_ && PROBE_DUP == 22) ? 2.0f : (rep_ && PROBE_DUP == 23) ? 1e-6f : SB_STOP); }
#endif
            SEAM(pb + 2);
        }
        if (IN(pb + 3) && !DIS_K3) {
            pg8::Gemm g;
            if constexpr (L < 2) g = pg8::Gemm{WSP(const f16, WS_AO), WSP(const f16, WS_W_ROUT) + (size_t)L * DM * 2048, MTOK, DM, 2048, 0};
            else g = pg8::Gemm{WSP(const f16, WS_SO), WSP(const f16, WS_W_SO) + (size_t)(L - 2) * DM * DM, MTOK, DM, DM, 0};
            pg8::Order S; S.init(MTOK, DM, F.G, (int)blockIdx.x);
            pg8::EpiY E{WSP(f16, WS_YB), WSP(const float, WS_MOD) + (size_t)L * 16 * 6144 + 2048, 1.0f};
            REPS(PROBE_DUP == 9 && L == 1) { REPBAR(); pg8::gemm_phase<pg8::EpiY>(F.lds, g, S, E); }
            SEAM(pb + 3);
        }
        if (IN(pb + 4) && !DIS_K4) {
            const float* modL = WSP(const float, WS_MOD) + (size_t)L * 16 * 6144;
            NormArgs A{}; A.x = (L == 0) ? (const void*)KIN(0) : (const void*)WSP(const f16, WS_X); A.xw = WSP(f16, WS_X); A.gain = KIN(6) + L * DM; A.sh = modL + 3072; A.sc = modL + 4096; A.h = WSP(f16, WS_H); A.yb = WSP(const f16, WS_YB);
            if constexpr (L & 1) { A.router = KIN(18) + (size_t)(L >> 1) * DM * NEXP; A.gcnt = F.ctl + CW_MOE + (L >> 1) * 1024; A.tokinfo = WSP(unsigned, WS_TOKINFO); A.hs8 = WSP(unsigned char, WS_HS); A.wof = WSP(float, WS_SLOTW); REPSN(PROBE_DUP == 13 && L == 3, 5) { REPBAR(); if (rep_) { A.gcnt = F.ctl + CW_MOE + 4096; A.tokinfo = WSP(unsigned, WS_TOKINFO + MiB); A.xw = WSP(f16, WS_BIG + 320 * MiB); A.h = WSP(f16, WS_BIG + 448 * MiB); A.hs8 = WSP(unsigned char, WS_END); A.wof = WSP(float, WS_BIG + 512 * MiB); } norm_phase<false, false, false, true, true, true>(F, A); } }
            else norm_phase<false, false, false, false, DF8(L), true, (L == 0)>(F, A);
            SEAM(pb + 4);
        }
        if (IN(pb + 6) && !DIS_K6) {
            const int mi = L >> 1;
            pg8::Order S;
            if constexpr (L & 1) {
                int tb[NEXP], ntl; moe_tile_bases(F.ctl + CW_MOE + mi * 1024, tb, ntl);
                S.init(ntl * 256, 2 * FFE, F.G, (int)blockIdx.x); S.cap = MOE_CAP; S.avirt = 1;
#pragma unroll
                for (int e = 0; e < NEXP; ++e) S.tb[e] = tb[e];
                pg8::Gemm g{WSP(const unsigned char, WS_HS), WSP(const unsigned char, WS_W_MIN) + (size_t)mi * NEXP * 2 * FFE * DM, ntl * 256, 2 * FFE, DM, (size_t)2 * FFE * DM, STAG_MOE};
                pg8::EpiGlu<true> E{WSP(unsigned char, WS_ACTE), FFE};
                REPS(PROBE_DUP == 4 && L == 3) { REPBAR(); pg8::gemm_phase<pg8::EpiGlu<true>, true>(F.lds, g, S, E); }
                if constexpr (PROBE_DUP == 16 && L == 3) { xcd_barrier(bar); pg8::EpiNull<true> EN{WSP(float, WS_SLOTW)}; pg8::gemm_phase<pg8::EpiNull<true>, true>(F.lds, g, S, EN); }
            } else {
                S.init(MTOK, 2 * FFD, F.G, (int)blockIdx.x);
                pg8::Gemm g{WSP(const unsigned char, WS_H), WSP(const unsigned char, WS_W_FIN) + (size_t)mi * 2 * FFD * DM * 2, MTOK, 2 * FFD, DM, 0};
                pg8::EpiGlu<DF8(L), DF8O(L)> E{WSP(unsigned char, WS_ACTD), FFD};
                REPS(PROBE_DUP == 10 && L == 2) { REPBAR(); pg8::gemm_phase<pg8::EpiGlu<DF8(L), DF8O(L)>, DF8(L)>(F.lds, g, S, E); }
            }
            SEAM(pb + 6);
        }
        if (IN(pb + 7) && !DIS_K7) {
            const int mi = L >> 1;
            if constexpr (L & 1) {
                int tb[NEXP], ntl; moe_tile_bases(F.ctl + CW_MOE + mi * 1024, tb, ntl);
                pg8::Order S; S.init(ntl * 256, DM, F.G, (int)blockIdx.x); S.cap = MOE_CAP;
#pragma unroll
                for (int e = 0; e < NEXP; ++e) S.tb[e] = tb[e];
                pg8::Gemm g{WSP(const unsigned char, WS_ACTE), WSP(const unsigned char, WS_W_MOUT) + (size_t)mi * NEXP * DM * FFE, ntl * 256, DM, FFE, (size_t)DM * FFE};
                pg8::EpiMoeOut E{WSP(f16, WS_Y2), WSP(const float, WS_SLOTW)};
                REPS(PROBE_DUP == 5 && L == 3) { REPBAR(); pg8::gemm_phase<pg8::EpiMoeOut, true>(F.lds, g, S, E); }
            } else {
                pg8::Order S; S.init(MTOK, DM, F.G, (int)blockIdx.x);
                pg8::Gemm g{WSP(const unsigned char, WS_ACTD), WSP(const unsigned char, WS_W_FOUT) + (size_t)mi * DM * FFD * 2, MTOK, DM, FFD, 0};
                pg8::EpiY E{WSP(f16, WS_YB), WSP(const float, WS_MOD) + (size_t)L * 16 * 6144 + 5120, DF8O(L) ? 1.0f / (F8_WSCALE * F8_ASCALE) : 1.0f};
                REPS(PROBE_DUP == 11 && L == 2) { REPBAR(); pg8::gemm_phase<pg8::EpiY, DF8O(L)>(F.lds, g, S, E); }
            }
            SEAM(pb + 7);
        }
}
__global__ void __launch_bounds__(512, 2) mk_fwd(Args args) {
    extern __shared__ __attribute__((aligned(16))) unsigned char lds_raw[];
    Frame F;
    F.lds = (LAS unsigned char*)lds_raw;
    F.wave = __builtin_amdgcn_readfirstlane((int)threadIdx.x >> 6);
    F.G = gridDim.x; { const int bx = blockIdx.x; F.vcu = (F.G % 8 == 0) ? (bx % 8) * (F.G / 8) + bx / 8 : bx; }
    F.ws = args.ws; F.ctl = (unsigned*)(args.ws + WS_CTL);
    volatile LAS unsigned* MISC = (volatile LAS unsigned*)(F.lds + MISC_OFF);
    if (threadIdx.x < 64) ((LAS unsigned*)(F.lds + MISC_OFF))[threadIdx.x] = 0u;
    __syncthreads();
    XcdBarrier bar; bar.bar = F.ctl + CW_BAR; bar.x = 0; bar.st = nullptr;
    if (!MK_PER_PHASE) bar = xcd_barrier_post(F.ctl + CW_BAR, MISC + 8);
    const int lo = args.ph_lo, hi = args.ph_hi;

    if (IN(0)) {
#ifndef NO_P0
        REPS(PROBE_DUP == 1) { REPBAR(); p0_prologue(F); }
#endif
        SEAM(0);
    }
    layer_phases<0>(F, bar, lo, hi); layer_phases<1>(F, bar, lo, hi); layer_phases<2>(F, bar, lo, hi); layer_phases<3>(F, bar, lo, hi);
    if (IN(33)) {
        NormArgs A{}; A.x = WSP(const f16, WS_X); A.xw = WSP(f16, WS_X); A.gain = KIN(21); A.out = (float*)karg<22>();
        A.y2 = WSP(const f16, WS_Y2); A.gcnt = F.ctl + CW_MOE + 1024; A.tokinfo = WSP(unsigned, WS_TOKINFO); A.gatef = WSP(const float, WS_MOD) + (size_t)3 * 16 * 6144 + 5120;
        REPSN(PROBE_DUP == 14, 5) { REPBAR(); norm_phase<true, false, true, false>(F, A); }
        if constexpr (PROBE_DUP == 24) { _Pragma("unroll 1") for (int i = 0; i < 40; ++i) xcd_barrier(bar); }
        if constexpr (PROBE_DUP == 20 || PROBE_DUP == 21) {
            xcd_barrier(bar);
            f16x8 a = {(f16)1.f, (f16)0.5f, (f16)0.25f, (f16)1.f, (f16)1.f, (f16)0.5f, (f16)0.25f, (f16)1.f}, b = a;
            f32x16 acc[4];
#pragma unroll
            for (int i = 0; i < 4; ++i)
#pragma unroll
                for (int j = 0; j < 16; ++j) acc[i][j] = 0.f;
            f32x4 acc16[8];
#pragma unroll
            for (int i = 0; i < 8; ++i) acc16[i] = (f32x4){0.f, 0.f, 0.f, 0.f};
            for (int it = 0; it < (PROBE_DUP == 20 ? 16384 : 8192); ++it) {
                if constexpr (PROBE_DUP == 20) {
#pragma unroll
                    for (int i = 0; i < 4; ++i) acc[i] = __builtin_amdgcn_mfma_f32_32x32x16_f16(a, b, acc[i], 0, 0, 0);
                } else {
#pragma unroll
                    for (int i = 0; i < 8; ++i) acc16[i] = __builtin_amdgcn_mfma_f32_16x16x32_f16(a, b, acc16[i], 0, 0, 0);
                }
            }
            float sacc = 0.f;
#pragma unroll
            for (int i = 0; i < 4; ++i) sacc += acc[i][0] + acc16[i][0] + acc16[4 + i][1];
            if (sacc == 1.2345e37f) WSP(float, WS_SLOTW)[0] = sacc;
        }
    }
#undef IN
#undef SEAM
#undef WSP
}

extern "C" void kernel_launch(void* const* d_in, const int* in_sizes, int n_in, void* d_out, int out_size, void* d_ws, size_t ws_size, hipStream_t stream) {
    static int grid = 0;
    if (grid == 0) {
        if (n_in != 22 || out_size != MTOK * DM || ws_size < WS_END) { fprintf(stderr, "kernel_launch: unexpected shapes (n_in %d out %d ws %zu, need %zu)\n", n_in, out_size, ws_size, (size_t)WS_END); grid = -1; return; }
        int dev = 0, cus = 0;
        if (hipGetDevice(&dev) != hipSuccess || hipDeviceGetAttribute(&cus, hipDeviceAttributeMultiprocessorCount, dev) != hipSuccess) { grid = -1; return; }
        if (hipFuncSetAttribute((const void*)mk_fwd, hipFuncAttributeMaxDynamicSharedMemorySize, LDS_BYTES) != hipSuccess) { fprintf(stderr, "kernel_launch: hipFuncSetAttribute failed\n"); grid = -1; return; }
        int per_cu = 0;
        if (hipOccupancyMaxActiveBlocksPerMultiprocessor(&per_cu, (const void*)mk_fwd, 512, LDS_BYTES) != hipSuccess || per_cu < 1) fprintf(stderr, "kernel_launch: occupancy query reports %d\n", per_cu);
        (void)hipGetLastError();
        if (cus < 256) { fprintf(stderr, "kernel_launch: needs >= 256 CUs, got %d\n", cus); grid = -1; return; }
        grid = cus;
    }
    if (grid < 0) return;
    (void)hipMemsetAsync((char*)d_ws + WS_CTL, 0, CTL_ZERO_BYTES, stream);
    Args a{};
    for (int i = 0; i < 22; ++i) a.in[i] = d_in[i];
    a.out = (float*)d_out; a.ws = (unsigned char*)d_ws;
#if MK_PER_PHASE
    for (int p = 0; p < N_PHASES; ++p) {
        if (p >= 1 && p <= 32) { const int L = (p - 1) / 8, k = (p - 1) % 8; if (k == 5) continue; (void)L; }
        a.ph_lo = p; a.ph_hi = p + 1;
        hipLaunchKernelGGL(mk_fwd, dim3(grid), dim3(512), LDS_BYTES, stream, a);
    }
#else
    a.ph_lo = 0; a.ph_hi = N_PHASES;
    hipLaunchKernelGGL(mk_fwd, dim3(grid), dim3(512), LDS_BYTES, stream, a);
#endif
}
```

```cpp
#include <hip/hip_runtime.h>
#include <cstdio>
#include <cstdint>

#define LAS __attribute__((address_space(3)))
#define GAS __attribute__((address_space(1)))
typedef _Float16 f16;
typedef _Float16 f16x2 __attribute__((ext_vector_type(2)));
typedef _Float16 f16x4 __attribute__((ext_vector_type(4)));
typedef _Float16 f16x8 __attribute__((ext_vector_type(8)));
typedef float f32x2 __attribute__((ext_vector_type(2)));
typedef float f32x4 __attribute__((ext_vector_type(4)));
typedef float f32x16 __attribute__((ext_vector_type(16)));
typedef unsigned u32x2 __attribute__((ext_vector_type(2)));
typedef unsigned u32x4 __attribute__((ext_vector_type(4)));
typedef short v4i16_t __attribute__((ext_vector_type(4)));
typedef int i32x8 __attribute__((ext_vector_type(8)));
typedef int i32x4 __attribute__((ext_vector_type(4)));

#ifndef DIS_K0
#define DIS_K0 0
#endif
#ifndef DIS_K1
#define DIS_K1 0
#endif
#ifndef DIS_K2
#define DIS_K2 0
#endif
#ifndef DIS_K3
#define DIS_K3 0
#endif
#ifndef DIS_K4
#define DIS_K4 0
#endif
#ifndef DIS_K5
#define DIS_K5 0
#endif
#ifndef DIS_K6
#define DIS_K6 0
#endif
#ifndef DIS_K7
#define DIS_K7 0
#endif
#ifndef PROBE_DUP
#define PROBE_DUP 0
#endif
#ifndef DENSE_F8
#define DENSE_F8 1
#define DF8(L) (DENSE_F8 != 0 && (L) == 2)
#ifndef DENSE_F8_OUT
#define DENSE_F8_OUT 0
#endif
#define DF8O(L) (DF8(L) && DENSE_F8_OUT != 0)
#endif
#ifndef RETIN_F8
#define RETIN_F8 0
#endif
#ifndef STAG_MOE
#define STAG_MOE 0
#endif
#ifndef STAG_RET
#define STAG_RET 0
#endif
#ifndef CONV_IN_SCAN
#define CONV_IN_SCAN 1
#endif
#ifndef MK_PER_PHASE
#define MK_PER_PHASE 0
#endif

constexpr int BATCH = 16, SEQ = 2048, DM = 1024, MTOK = BATCH * SEQ;
constexpr int RH = 8, RDK = 128, RDV = 256, RIN = 6144, CHUNK = 64, NCHUNK = SEQ / CHUNK;
constexpr int SBH = 16, SDH = 64;
constexpr int FFD = 2816, NEXP = 8, FFE = 3584;
constexpr float EPS = 1e-6f;
constexpr int MOE_ROWS_MAX = 2 * MTOK + NEXP * 256;

__device__ __forceinline__ float lg2gamma(int h) {
    const float t[8] = {-4.580368961312e-02f, -2.272007650008e-02f, -1.131531322783e-02f, -5.646563141142e-03f, -2.820519062379e-03f, -1.409570254671e-03f, -7.046129765894e-04f, -3.522634716290e-04f};
    float r = t[0];
#pragma unroll
    for (int i = 1; i < 8; ++i) r = (h == i) ? t[i] : r;
    return r;
}
__device__ __forceinline__ unsigned pkh(float lo, float hi) { f32x2 v = {lo, hi}; f16x2 h = __builtin_convertvector(v, f16x2); return __builtin_bit_cast(unsigned, h); }
__device__ __forceinline__ float silu_f(float x) { return x * __builtin_amdgcn_rcpf(1.0f + __builtin_amdgcn_exp2f(-1.4426950408889634f * x)); }
__device__ __forceinline__ float ex2(float x) { return __builtin_amdgcn_exp2f(x); }
__device__ __forceinline__ unsigned pk4f8(float a, float b, float c, float d) { int w = 0; w = __builtin_amdgcn_cvt_pk_fp8_f32(a, b, w, false); w = __builtin_amdgcn_cvt_pk_fp8_f32(c, d, w, true); return (unsigned)w; }
constexpr float F8_WSCALE = 64.0f;
constexpr float F8_ASCALE = 4.0f;

namespace pg8 {
constexpr int BM = 256, BK = 64, HALF = 128, HTB = HALF * BK * 2, STAGE_BYTES = 8 * HTB, NXCD = 8, WGM = 8;
__host__ __device__ __forceinline__ int lds_byte(int r, int c) { const int st = (r >> 4) * 2 + (c >> 5), rr = r & 15, cc = c & 31, ob = rr * 64 + cc * 2; return st * 1024 + (ob ^ (((ob >> 9) & 1) << 5)); }
__host__ __device__ __forceinline__ void stage_rc(int b, int& R, int& C) { const int st = b / 1024, sb = b % 1024, swz = sb ^ (((sb >> 9) & 1) << 5); R = (st >> 1) * 16 + swz / 64; C = (st & 1) * 32 + (swz % 64) / 2; }
__host__ __device__ __forceinline__ int perm32(int rho) { const int n = rho >> 4, i = rho & 15; return 8 * (i >> 2) + 4 * n + (i & 3); }

struct Unit { int pm, pn, be, arow, vrow; };
struct Gemm { const void* A; const void* Bt; int M, N, K; size_t bstride; int stagger = 0; };

struct Order {
    int nM, nN, nwg, G, c; int tb[NEXP]; int cap, avirt;
    __device__ void init(int M, int N, int G_, int c_) { nM = M / BM; nN = N / BM; nwg = nM * nN; G = G_; c = c_; cap = 0; avirt = 0;
#pragma unroll
        for (int e = 0; e < NEXP; ++e) tb[e] = e ? 0x7fffffff : 0; }
    __device__ bool next(int i, Unit& u) const {
        const long L = (long)i * G + c; if (L >= nwg) return false;
        int wgid = (int)L; { const int q = nwg / NXCD, r = nwg % NXCD, xcd = wgid % NXCD, off = wgid / NXCD; wgid = (xcd < r ? xcd * (q + 1) : r * (q + 1) + (xcd - r) * q) + off; }
        const int nig = WGM * nN, gid = wgid / nig, fm = gid * WGM, gsz = (nM - fm) < WGM ? (nM - fm) : WGM;
        u.pm = fm + ((wgid % nig) % gsz); u.pn = (wgid % nig) / gsz;
        int be = 0;
#pragma unroll
        for (int e = 1; e < NEXP; ++e) be += (u.pm >= tb[e]) ? 1 : 0;
        u.be = be;
        int tbe = 0;
#pragma unroll
        for (int e = 1; e < NEXP; ++e) tbe = (be == e) ? tb[e] : tbe;
        u.vrow = cap ? be * cap + (u.pm - tbe) * BM : u.pm * BM; u.arow = avirt ? u.vrow : u.pm * BM;
        return true;
    }
};


struct EpiRetIn {
    static constexpr bool PERM = true; static constexpr int NST = 16;
    f16* O; const float* rope; float scl;
    __device__ __forceinline__ void operator()(const f32x4 (&acc)[2][2][4][2], const Unit& u, int wr, int wc, int fr, int fq) const {
        const int row0 = u.pm * BM + wr * 64 + fr, cl = wc * 32 + 8 * fq;
        f16* base = O + (size_t)u.pn * BM + cl;
        if (u.pn < 8) {
            const bool isk = u.pn >= 4; const int i0 = cl >> 1;
            float lg[2]; lg[0] = lg2gamma(2 * (u.pn & 3)); lg[1] = lg2gamma(2 * (u.pn & 3) + 1);
            f32x4 cs_n = *(const f32x4*)(rope + (size_t)row0 * 128 + i0), sn_n = *(const f32x4*)(rope + (size_t)row0 * 128 + 64 + i0);
#pragma unroll
            for (int ai = 0; ai < 2; ++ai)
#pragma unroll
                for (int m = 0; m < 4; ++m) {
                    const int row = row0 + ai * HALF + m * 16; const float pos = (float)(16 * m + fr);
                    const f32x4 cs = cs_n, sn = sn_n;
                    if (ai * 4 + m < 7) { const int rown = row0 + ((ai * 4 + m + 1) >> 2) * HALF + ((ai * 4 + m + 1) & 3) * 16;
                        cs_n = *(const f32x4*)(rope + (size_t)rown * 128 + i0); sn_n = *(const f32x4*)(rope + (size_t)rown * 128 + 64 + i0); }
#pragma unroll
                    for (int bj = 0; bj < 2; ++bj) {
                        const float sc = (isk ? ex2(-pos * lg[bj]) * 0.08838834764831845f : ex2((pos + 1.0f) * lg[bj])) * scl;
                        const f32x4 v0 = acc[ai][bj][m][0], v1 = acc[ai][bj][m][1];
                        u32x4 w;
                        w.x = pkh((v0[0] * cs[0] - v0[1] * sn[0]) * sc, (v0[0] * sn[0] + v0[1] * cs[0]) * sc);
                        w.y = pkh((v0[2] * cs[1] - v0[3] * sn[1]) * sc, (v0[2] * sn[1] + v0[3] * cs[1]) * sc);
                        w.z = pkh((v1[0] * cs[2] - v1[1] * sn[2]) * sc, (v1[0] * sn[2] + v1[1] * cs[2]) * sc);
                        w.w = pkh((v1[2] * cs[3] - v1[3] * sn[3]) * sc, (v1[2] * sn[3] + v1[3] * cs[3]) * sc);
                        *(u32x4*)(base + (size_t)row * RIN + bj * HALF) = w;
                    }
                }
        } else {
            const bool isg = u.pn >= 16;
#pragma unroll
            for (int ai = 0; ai < 2; ++ai)
#pragma unroll
                for (int m = 0; m < 4; ++m) {
                    const int row = row0 + ai * HALF + m * 16;
#pragma unroll
                    for (int bj = 0; bj < 2; ++bj) {
                        f32x4 v0 = acc[ai][bj][m][0] * scl, v1 = acc[ai][bj][m][1] * scl;
                        if (isg) {
#pragma unroll
                            for (int j = 0; j < 4; ++j) { v0[j] = silu_f(v0[j]); v1[j] = silu_f(v1[j]); } }
                        u32x4 w; w.x = pkh(v0[0], v0[1]); w.y = pkh(v0[2], v0[3]); w.z = pkh(v1[0], v1[1]); w.w = pkh(v1[2], v1[3]);
                        *(u32x4*)(base + (size_t)row * RIN + bj * HALF) = w;
                    }
                }
        }
    }
};
struct EpiY {
    static constexpr bool PERM = true; static constexpr int NST = 16;
    f16* Y; const float* gate; float scl;
    __device__ __forceinline__ void operator()(const f32x4 (&acc)[2][2][4][2], const Unit& u, int wr, int wc, int fr, int fq) const {
        const int row0 = u.pm * BM + wr * 64 + fr, col0 = u.pn * BM + wc * 32 + 8 * fq;
        const float* gp = gate + (size_t)(u.pm >> 3) * 6144 + col0;
        f32x4 gv[2][2];
#pragma unroll
        for (int bj = 0; bj < 2; ++bj)
#pragma unroll
            for (int n = 0; n < 2; ++n) gv[bj][n] = *(const f32x4*)(gp + bj * HALF + 4 * n) * scl;
#pragma unroll
        for (int ai = 0; ai < 2; ++ai)
#pragma unroll
            for (int m = 0; m < 4; ++m) { f16* rowp = Y + (size_t)(row0 + ai * HALF + m * 16) * DM + col0;
#pragma unroll
                for (int bj = 0; bj < 2; ++bj) { const f32x4 v0 = acc[ai][bj][m][0] * gv[bj][0], v1 = acc[ai][bj][m][1] * gv[bj][1];
                    u32x4 w; w.x = pkh(v0[0], v0[1]); w.y = pkh(v0[2], v0[3]); w.z = pkh(v1[0], v1[1]); w.w = pkh(v1[2], v1[3]);
                    *(u32x4*)(rowp + bj * HALF) = w; } }
    }
};
template <bool F8IN, bool F8 = F8IN> struct EpiGlu {
    static constexpr bool PERM = true; static constexpr int NST = 8;
    void* Ov; int ldc;
    __device__ __forceinline__ void operator()(const f32x4 (&acc)[2][2][4][2], const Unit& u, int wr, int wc, int fr, int fq) const {
        const int row0 = u.pm * BM + wr * 64 + fr, col0 = u.pn * HALF + wc * 32 + 8 * fq;
        constexpr float si = F8IN ? 1.0f / F8_WSCALE : 1.0f, so = F8 ? F8_ASCALE : 1.0f;
#pragma unroll
        for (int ai = 0; ai < 2; ++ai)
#pragma unroll
            for (int m = 0; m < 4; ++m) {
                float r[8];
#pragma unroll
                for (int n = 0; n < 2; ++n)
#pragma unroll
                    for (int p = 0; p < 2; ++p) {
                        const f32x2 a = {acc[ai][0][m][n][2 * p], acc[ai][0][m][n][2 * p + 1]}, b = {acc[ai][1][m][n][2 * p], acc[ai][1][m][n][2 * p + 1]};
                        const f32x2 t = a * (-1.4426950408889634f * si); f32x2 d = {ex2(t.x), ex2(t.y)}; d = d + 1.0f;
                        const f32x2 u = {__builtin_amdgcn_rcpf(d.x), __builtin_amdgcn_rcpf(d.y)};
                        const f32x2 q = ((a * b) * u) * (si * si * so);
                        r[4 * n + 2 * p] = q.x; r[4 * n + 2 * p + 1] = q.y;
                    }
                if (F8) { u32x2 w; w.x = pk4f8(r[0], r[1], r[2], r[3]); w.y = pk4f8(r[4], r[5], r[6], r[7]);
                    *(u32x2*)((unsigned char*)Ov + (size_t)(row0 + ai * HALF + m * 16) * ldc + col0) = w; }
                else { u32x4 w; w.x = pkh(r[0], r[1]); w.y = pkh(r[2], r[3]); w.z = pkh(r[4], r[5]); w.w = pkh(r[6], r[7]);
                    *(u32x4*)((f16*)Ov + (size_t)(row0 + ai * HALF + m * 16) * ldc + col0) = w; }
            }
    }
};
struct EpiF16 {
    static constexpr bool PERM = true; static constexpr int NST = 16;
    f16* O; int ldc; int split_cols; size_t split_stride; float scale;
    __device__ __forceinline__ void operator()(const f32x4 (&acc)[2][2][4][2], const Unit& u, int wr, int wc, int fr, int fq) const {
        const int row0 = u.pm * BM + wr * 64 + fr; int colt = u.pn * BM; f16* base = O;
        if (split_cols) { const int t = colt / split_cols; base += (size_t)t * split_stride; colt -= t * split_cols; }
        const int col0 = colt + wc * 32 + 8 * fq;
#pragma unroll
        for (int ai = 0; ai < 2; ++ai)
#pragma unroll
            for (int m = 0; m < 4; ++m) { f16* rowp = base + (size_t)(row0 + ai * HALF + m * 16) * ldc + col0;
#pragma unroll
                for (int bj = 0; bj < 2; ++bj) { const f32x4 v0 = acc[ai][bj][m][0] * scale, v1 = acc[ai][bj][m][1] * scale;
                    u32x4 w; w.x = pkh(v0[0], v0[1]); w.y = pkh(v0[2], v0[3]); w.z = pkh(v1[0], v1[1]); w.w = pkh(v1[2], v1[3]);
                    *(u32x4*)(rowp + bj * HALF) = w; } }
    }
};
struct EpiMoeOut {
    static constexpr bool PERM = true; static constexpr int NST = 16;
    f16* O; const float* roww;
    __device__ __forceinline__ void operator()(const f32x4 (&acc)[2][2][4][2], const Unit& u, int wr, int wc, int fr, int fq) const {
        const int row0 = u.pm * BM + wr * 64 + fr, col0 = u.pn * BM + wc * 32 + 8 * fq;
        float scw[2][4];
#pragma unroll
        for (int ai = 0; ai < 2; ++ai)
#pragma unroll
            for (int m = 0; m < 4; ++m) scw[ai][m] = roww[u.vrow + wr * 64 + fr + ai * HALF + m * 16];
#pragma unroll
        for (int ai = 0; ai < 2; ++ai)
#pragma unroll
            for (int m = 0; m < 4; ++m) { const int rl = wr * 64 + fr + ai * HALF + m * 16, row = u.pm * BM + rl; const float sc = scw[ai][m] * (1.0f / (F8_WSCALE * F8_ASCALE)); f16* rowp = O + (size_t)row * DM + col0;
#pragma unroll
                for (int bj = 0; bj < 2; ++bj) { const f32x4 v0 = acc[ai][bj][m][0] * sc, v1 = acc[ai][bj][m][1] * sc;
                    u32x4 w; w.x = pkh(v0[0], v0[1]); w.y = pkh(v0[2], v0[3]); w.z = pkh(v1[0], v1[1]); w.w = pkh(v1[2], v1[3]);
                    *(u32x4*)(rowp + bj * HALF) = w; } }
    }
};

template <bool P> struct EpiNull {
    static constexpr bool PERM = P; static constexpr int NST = 0;
    float* sink;
    __device__ __forceinline__ void operator()(const f32x4 (&acc)[2][2][4][2], const Unit& u, int wr, int wc, int fr, int fq) const {
        float s = 0.f;
#pragma unroll
        for (int ai = 0; ai < 2; ++ai)
#pragma unroll
            for (int bj = 0; bj < 2; ++bj)
#pragma unroll
                for (int m = 0; m < 4; ++m)
#pragma unroll
                    for (int n = 0; n < 2; ++n) s += acc[ai][bj][m][n][0] + acc[ai][bj][m][n][1] + acc[ai][bj][m][n][2] + acc[ai][bj][m][n][3];
        if (s == 1.2345e37f) sink[0] = s;
    }
};
template <class Epi, bool F8 = false>
__device__ __forceinline__ void gemm_phase(LAS unsigned char* lds, const Gemm g, const Order& S, const Epi& E) {
    const int tid = threadIdx.x, wid = __builtin_amdgcn_readfirstlane(tid >> 6), lane = tid & 63, wr = wid >> 2, wc = wid & 3, fr = lane & 15, fq = lane >> 4;
    const int KB = g.K * (F8 ? 1 : 2), nt = KB / 128;
    unsigned voffA[2], voffB[2];
#pragma unroll
    for (int i = 0; i < 2; ++i) { int R, C; stage_rc(tid * 16 + i * 8192, R, C); const int Rb = Epi::PERM ? ((R & ~31) + perm32(R & 31)) : R;
        voffA[i] = (unsigned)(R * KB + 2 * C); voffB[i] = (unsigned)(Rb * KB + 2 * C); }
    const size_t kstep = (size_t)(BK * 2);
    const size_t hstep = (size_t)HALF * KB;
    const size_t tstep = 2 * hstep;
    const unsigned ldsw = (unsigned)wid * 1024u;
    const int aoff = lds_byte(wr * 64 + fr, fq * 8), boff = lds_byte(wc * 32 + fr, fq * 8);
#define PG8_SA(b, h) (((b) * 2 + (h)) * HTB)
#define PG8_SB(b, h) ((4 + (b) * 2 + (h)) * HTB)
#define PG8_STAGE(bufoff, gbase, voff) do { _Pragma("unroll") for (int _i = 0; _i < 2; ++_i) \
        __builtin_amdgcn_global_load_lds((const unsigned*)((const char*)(gbase) + (voff)[_i]), (LAS unsigned*)(lds + (bufoff) + ldsw + _i * 8192), 16, 0, 0); } while (0)
#define PG8_LD8(dst, addr) do { const i32x4 lo_ = *(const LAS i32x4*)(addr), hi_ = *(const LAS i32x4*)((addr) + 1024); dst = __builtin_shufflevector(lo_, hi_, 0, 1, 2, 3, 4, 5, 6, 7); } while (0)
#define PG8_LDA(dst, b, h) do { _Pragma("unroll") for (int m = 0; m < 4; ++m) { if constexpr (F8) PG8_LD8(dst##8[m], lds + PG8_SA(b, h) + aoff + m * 2048); else { _Pragma("unroll") for (int k = 0; k < 2; ++k) dst[m][k] = *(const LAS f16x8*)(lds + PG8_SA(b, h) + aoff + m * 2048 + k * 1024); } } } while (0)
#define PG8_LDB(dst, b, h) do { _Pragma("unroll") for (int n = 0; n < 2; ++n) { if constexpr (F8) PG8_LD8(dst##8[n], lds + PG8_SB(b, h) + boff + n * 2048); else { _Pragma("unroll") for (int k = 0; k < 2; ++k) dst[n][k] = *(const LAS f16x8*)(lds + PG8_SB(b, h) + boff + n * 2048 + k * 1024); } } } while (0)
#define PG8_MMA(ai, bj, At, Bt) do { __builtin_amdgcn_s_setprio(1); _Pragma("unroll") for (int m = 0; m < 4; ++m) _Pragma("unroll") for (int n = 0; n < 2; ++n) { \
        if constexpr (F8) asm volatile("v_mfma_scale_f32_16x16x128_f8f6f4 %0, %1, %2, %0, %3, %3 op_sel_hi:[0,0,0]" : "+v"(acc[ai][bj][m][n]) : "v"(Bt##8[n]), "v"(At##8[m]), "v"(f8scale)); \
        else { _Pragma("unroll") for (int k = 0; k < 2; ++k) acc[ai][bj][m][n] = __builtin_amdgcn_mfma_f32_16x16x32_f16(Bt[n][k], At[m][k], acc[ai][bj][m][n], 0, 0, 0); } } \
        __builtin_amdgcn_s_setprio(0); } while (0)
#define PG8_WAIT_V(n) asm volatile("s_waitcnt vmcnt(" #n ")" ::: "memory")
#define PG8_WAIT_VR() asm volatile("s_waitcnt vmcnt(%0)" :: "n"(8 + Epi::NST) : "memory")
#define PG8_WAIT_L(n) asm volatile("s_waitcnt lgkmcnt(" #n ")" ::: "memory")
#define PG8_BAR __builtin_amdgcn_s_barrier()
#define PG8_SCHED __builtin_amdgcn_sched_barrier(0)
    Unit cur, nxt; int ui = 0; bool relax = false;
    if (!S.next(0, cur)) return;
    if (g.stagger) {
        const unsigned grp = (blockIdx.x >> 3) & 3u;
        if (grp) { const unsigned long long t0 = __builtin_amdgcn_s_memrealtime(); while (__builtin_amdgcn_s_memrealtime() - t0 < (unsigned long long)(grp * (unsigned)g.stagger)) __builtin_amdgcn_s_sleep(16); }
    }
    f32x4 acc[2][2][4][2];
#pragma unroll
    for (int a = 0; a < 2; ++a)
#pragma unroll
        for (int b = 0; b < 2; ++b)
#pragma unroll
            for (int m = 0; m < 4; ++m)
#pragma unroll
                for (int n = 0; n < 2; ++n) acc[a][b][m][n] = (f32x4){0.f, 0.f, 0.f, 0.f};
    const int f8scale = 0x7f7f7f7f;
    f16x8 At[4][2], B0[2][2], B1[2][2]; i32x8 At8[4], B08[2], B18[2];
    const char* cA = (const char*)g.A + (size_t)cur.arow * KB; const char* cB = (const char*)g.Bt + (size_t)cur.be * g.bstride + (size_t)cur.pn * tstep;
    PG8_STAGE(PG8_SB(0, 0), cB, voffB); PG8_STAGE(PG8_SB(0, 1), cB + hstep, voffB); PG8_STAGE(PG8_SA(0, 0), cA, voffA); PG8_STAGE(PG8_SA(0, 1), cA + hstep, voffA);
    if (wr == 1) PG8_BAR;
    PG8_WAIT_V(2); PG8_BAR;
    PG8_STAGE(PG8_SB(1, 0), cB + kstep, voffB); PG8_STAGE(PG8_SA(1, 0), cA + kstep, voffA); PG8_STAGE(PG8_SB(1, 1), cB + hstep + kstep, voffB);
    PG8_WAIT_V(6); PG8_BAR;
    for (;;) {
        const bool has_next = S.next(ui + 1, nxt);
        const char* nA = has_next ? (const char*)g.A + (size_t)nxt.arow * KB : cA; const char* nB = has_next ? (const char*)g.Bt + (size_t)nxt.be * g.bstride + (size_t)nxt.pn * tstep : cB;
#pragma nounroll
        for (int t = 0; t < nt; t += 2) {
            const bool last = (t == nt - 2);
            const char* a1 = cA + (size_t)(t + 1) * kstep;
            const char* a2 = last ? nA : cA + (size_t)(t + 2) * kstep; const char* b2 = last ? nB : cB + (size_t)(t + 2) * kstep;
            const char* a3 = a2 + kstep; const char* b3 = b2 + kstep;
            PG8_LDB(B0, 0, 0); PG8_LDB(B1, 0, 1); PG8_SCHED; PG8_LDA(At, 0, 0); PG8_STAGE(PG8_SA(1, 1), a1 + hstep, voffA);
            if (relax) PG8_WAIT_VR(); else PG8_WAIT_V(8);
            PG8_WAIT_L(0); PG8_BAR; PG8_MMA(0, 0, At, B0); PG8_MMA(0, 1, At, B1); PG8_BAR; PG8_SCHED;
            PG8_LDA(At, 0, 1); PG8_STAGE(PG8_SB(0, 0), b2, voffB); PG8_STAGE(PG8_SB(0, 1), b2 + hstep, voffB); PG8_STAGE(PG8_SA(0, 0), a2, voffA);
            if (relax) { PG8_WAIT_VR(); relax = false; } else PG8_WAIT_V(8);
            PG8_WAIT_L(0); PG8_BAR; PG8_MMA(1, 0, At, B0); PG8_MMA(1, 1, At, B1); PG8_BAR; PG8_SCHED;
            PG8_LDB(B0, 1, 0); PG8_LDB(B1, 1, 1); PG8_SCHED; PG8_LDA(At, 1, 0); PG8_STAGE(PG8_SA(0, 1), a2 + hstep, voffA);
            PG8_WAIT_V(8); PG8_WAIT_L(0); PG8_BAR; PG8_MMA(0, 0, At, B0); PG8_MMA(0, 1, At, B1); PG8_BAR; PG8_SCHED;
            PG8_LDA(At, 1, 1); PG8_STAGE(PG8_SB(1, 0), b3, voffB); PG8_STAGE(PG8_SB(1, 1), b3 + hstep, voffB); PG8_STAGE(PG8_SA(1, 0), a3, voffA);
            PG8_WAIT_V(8); PG8_WAIT_L(0); PG8_BAR; PG8_MMA(1, 0, At, B0); PG8_MMA(1, 1, At, B1); PG8_BAR; PG8_SCHED;
        }
        if constexpr (F8) asm volatile("s_nop 15\n\ts_nop 15" ::: "memory");
        if (wr == 0) PG8_BAR;
        E(acc, cur, wr, wc, fr, fq);
        if (!has_next) break;
#pragma unroll
        for (int a = 0; a < 2; ++a)
#pragma unroll
            for (int b = 0; b < 2; ++b)
#pragma unroll
                for (int m = 0; m < 4; ++m)
#pragma unroll
                    for (int n = 0; n < 2; ++n) acc[a][b][m][n] = (f32x4){0.f, 0.f, 0.f, 0.f};
        cur = nxt; cA = nA; cB = nB; ++ui; relax = true;
        if (wr == 1) PG8_BAR;
    }
    PG8_WAIT_V(0);
    PG8_BAR;
#undef PG8_SA
#undef PG8_SB
#undef PG8_STAGE
#undef PG8_LDA
#undef PG8_LDB
#undef PG8_MMA
#undef PG8_WAIT_V
#undef PG8_WAIT_L
#undef PG8_BAR
#undef PG8_SCHED
}
}

constexpr size_t MiB = 1u << 20;
constexpr size_t WS_CTL = 0, CTL_ZERO_BYTES = 1 * MiB;
constexpr size_t WS_MOD = 1 * MiB;
constexpr size_t WS_KVMOD = 3 * MiB;
constexpr size_t WS_TOKINFO = 4 * MiB;
constexpr size_t WS_TOKSLOT = 6 * MiB;
constexpr size_t WS_SLOTW = 7 * MiB;
constexpr size_t WS_ROPE = 8 * MiB;
constexpr size_t WS_W_RIN = 24 * MiB, WS_W_ROUT = 48 * MiB, WS_W_KV = 56 * MiB, WS_W_SQ = 60 * MiB, WS_W_SO = 64 * MiB, WS_W_FIN = 68 * MiB, WS_W_FOUT = 90 * MiB, WS_W_MIN = 101 * MiB, WS_W_MOUT = 325 * MiB;
constexpr size_t WS_X = 437 * MiB, WS_H = 565 * MiB, WS_KSH = 629 * MiB, WS_VSH = 693 * MiB, WS_BIG = 757 * MiB;
constexpr size_t WS_PROJ = WS_BIG, WS_AO = WS_BIG + 384 * MiB;
constexpr size_t WS_ACTD = WS_BIG;
constexpr int MOE_CAP = MTOK;
constexpr size_t WS_HS = WS_BIG, WS_Y2 = WS_BIG, WS_ACTE = WS_BIG + 256 * MiB;
constexpr size_t WS_SQ = WS_BIG, WS_SO = WS_BIG + 64 * MiB, WS_HK = WS_BIG + 192 * MiB;
constexpr size_t WS_YB = WS_BIG + 594 * MiB;
constexpr size_t WS_END = WS_YB + 64 * MiB;
static_assert((size_t)MOE_ROWS_MAX * DM * 2 <= 256 * MiB && (size_t)NEXP * MOE_CAP * DM <= 256 * MiB && WS_ACTE + (size_t)MOE_ROWS_MAX * FFE <= WS_YB && WS_AO + (size_t)MTOK * 2048 * 2 <= WS_YB, "ws map");
constexpr int CW_BAR = 4096;
constexpr int CW_MOE = 16384;

constexpr int RING_BYTES = 131072;
constexpr int LDS_BYTES = 147456;
constexpr int MISC_OFF = LDS_BYTES - 256;

#define XB_TMO      128
#define XB_XCNT(j)  (256  + 64 * (j))
#define XB_XSUB(j)  (1280 + 64 * (j))
#define XB_XGEN(j)  (2304 + 64 * (j))
#define XB_TOP      3328
#define XB_TOPGEN   3392
#define XCD_BAR_WORDS 3456
#define XB_SPIN_CAP (1u << 20)
__device__ __forceinline__ unsigned xb_ld(unsigned* p)              { return __hip_atomic_load(p, __ATOMIC_RELAXED, __HIP_MEMORY_SCOPE_AGENT); }
__device__ __forceinline__ unsigned xb_add(unsigned* p, unsigned v) { return __hip_atomic_fetch_add(p, v, __ATOMIC_RELAXED, __HIP_MEMORY_SCOPE_AGENT); }
__device__ __forceinline__ unsigned xb_xcc_id() { return (unsigned)__builtin_amdgcn_s_getreg((3 << 11) | 20) & 0xFu; }
#define XB_SPIN(cond, bar) do { unsigned _sp = 0; while (cond) { __builtin_amdgcn_s_sleep(1); \
    if ((++_sp & 255u) == 0u) { if (xb_ld(&(bar)[XB_TMO])) break; if (_sp > XB_SPIN_CAP) { atomicAdd(&(bar)[XB_TMO], 1u); break; } } } } while (0)
struct XcdBarrier { unsigned* bar; unsigned x; volatile LAS unsigned* st; };
__device__ __forceinline__ XcdBarrier xcd_barrier_post(unsigned* bar, volatile LAS unsigned* st) {
    XcdBarrier b; b.bar = bar; b.x = xb_xcc_id(); b.st = st;
    if (threadIdx.x == 0) (void)xb_add(&bar[XB_XCNT(b.x)], 1u);
    return b;
}
__device__ __forceinline__ void xcd_barrier_complete(unsigned* bar, unsigned x, unsigned& nloc, unsigned& nx) {
    const unsigned G = gridDim.x * gridDim.y * gridDim.z;
    unsigned sum, cnt, mine, sp = 0u;
    for (;;) {
        sum = 0u; cnt = 0u; mine = 0u;
#pragma unroll
        for (unsigned j = 0; j < 16; ++j) { const unsigned c = xb_ld(&bar[XB_XCNT(j)]); sum += c; cnt += (c > 0u) ? 1u : 0u; mine = (j == x) ? c : mine; }
        if (sum == G) break;
        __builtin_amdgcn_s_sleep(1);
        if ((++sp & 255u) == 0u) { if (xb_ld(&bar[XB_TMO])) break; if (sp > XB_SPIN_CAP) { atomicAdd(&bar[XB_TMO], 1u); break; } }
    }
    nloc = mine > 0u ? mine : 1u; nx = cnt > 0u ? cnt : 1u;
}
__device__ __forceinline__ void xcd_barrier(const XcdBarrier& b) {
    asm volatile("s_waitcnt vmcnt(0)" ::: "memory");
    __syncthreads();
    if (threadIdx.x == 0) {
        unsigned* bar = b.bar;
        __builtin_amdgcn_s_waitcnt(0);
        unsigned nloc = b.st[0], nx = b.st[1];
        if (nloc == 0u) { xcd_barrier_complete(bar, b.x, nloc, nx); b.st[0] = nloc; b.st[1] = nx; }
        const unsigned old = xb_add(&bar[XB_XSUB(b.x)], 1u);
        const unsigned gen = old / nloc;
        if (old + 1u == (gen + 1u) * nloc) {
            __builtin_amdgcn_fence(__ATOMIC_RELEASE, "agent");
            asm volatile("s_waitcnt vmcnt(0)" ::: "memory");
            const unsigned og = xb_add(&bar[XB_TOP], 1u);
            const unsigned tg = og / nx;
            if (og + 1u == (tg + 1u) * nx) xb_add(&bar[XB_TOPGEN], 1u);
            else XB_SPIN(xb_ld(&bar[XB_TOPGEN]) == tg, bar);
            __builtin_amdgcn_fence(__ATOMIC_ACQUIRE, "agent");
            xb_add(&bar[XB_XGEN(b.x)], 1u);
            asm volatile("s_waitcnt vmcnt(0)" ::: "memory");
        } else {
            XB_SPIN(xb_ld(&bar[XB_XGEN(b.x)]) == gen, bar);
            __builtin_amdgcn_fence(__ATOMIC_ACQUIRE, "agent");
            asm volatile("s_waitcnt vmcnt(0)" ::: "memory");
        }
    }
    __syncthreads();
}

#define WG_BAR() do { asm volatile("s_waitcnt lgkmcnt(0)" ::: "memory"); __builtin_amdgcn_s_barrier(); asm volatile("" ::: "memory"); } while (0)
#define CFENCE() asm volatile("" ::: "memory")
__device__ __forceinline__ float wave_sum(float v) {
#pragma unroll
    for (int o = 1; o < 64; o <<= 1) v += __shfl_xor(v, o);
    return v;
}
__device__ __forceinline__ f16x4 tr_read(LAS const unsigned char* p) {
    return __builtin_bit_cast(f16x4, __builtin_amdgcn_ds_read_tr16_b64_v4i16((LAS v4i16_t*)p));
}
__device__ __forceinline__ f16x8 cat8(f16x4 a, f16x4 b) { return (f16x8){a[0], a[1], a[2], a[3], b[0], b[1], b[2], b[3]}; }
__device__ __forceinline__ f16x8 pack8(const f32x16& x, int s) {
    u32x4 w; w.x = pkh(x[8 * s + 0], x[8 * s + 1]); w.y = pkh(x[8 * s + 2], x[8 * s + 3]); w.z = pkh(x[8 * s + 4], x[8 * s + 5]); w.w = pkh(x[8 * s + 6], x[8 * s + 7]);
    return __builtin_bit_cast(f16x8, w);
}

struct Frame {
    LAS unsigned char* lds;
    unsigned* ctl;
    int wave, vcu, G;
    unsigned char* ws;
};
__device__ __forceinline__ int lane_id() { int l; asm volatile("v_mbcnt_lo_u32_b32 %0, -1, 0\n\tv_mbcnt_hi_u32_b32 %0, -1, %0" : "=v"(l)); return l; }
#define PHASE_IDS() const int lane = lane_id(); const int tid = F.wave * 64 + lane; (void)tid

template <int I> __device__ __forceinline__ const void* karg() {
    const auto kp = __builtin_amdgcn_kernarg_segment_ptr();
    unsigned long long v; asm volatile("s_load_dwordx2 %0, %1, %2\n\ts_waitcnt lgkmcnt(0)" : "=s"(v) : "s"(kp), "i"(I * 8) : "memory");
    return (const void*)(const GAS char*)v;
}
#define KIN(i) ((const float*)karg<(i)>())
template <int MAP>
__device__ __forceinline__ int srccol(int n, int N) {
    if (MAP == 1) { if (n >= 2048) return n; const int p = n & 127; return (n & ~127) + (p >> 1) + 64 * (p & 1); }
    if (MAP == 2) { const int F = N >> 1, t = n >> 8, j = n & 255; return (j < 128) ? 128 * t + j : F + 128 * t + (j - 128); }
    return n;
}
template <int MAP, bool F8>
__device__ __forceinline__ void p0_transpose_item(const float* W, int K, int N, void* WT, LAS float* scr, int item, int lane) {
    const int nblk = N / 32, kb = item / nblk, nb = item % nblk, k0 = 64 * kb, n0 = 32 * nb;
    const int sc = srccol<MAP>(n0 + (lane & 31), N);
    const float* wp = W + (size_t)(k0 + (lane >> 5)) * N + sc;
    float v[32];
#pragma unroll
    for (int i = 0; i < 32; ++i) v[i] = __builtin_nontemporal_load(wp + (size_t)(2 * i) * N);
#pragma unroll
    for (int i = 0; i < 32; ++i) scr[(2 * i + (lane >> 5)) * 33 + (lane & 31)] = F8 ? v[i] * F8_WSCALE : v[i];
    asm volatile("s_waitcnt lgkmcnt(0)" ::: "memory");
    if (F8) {
        const int c = lane & 3;
#pragma unroll
        for (int j = 0; j < 2; ++j) { const int n = (lane >> 2) + 16 * j; const LAS float* s = scr + (16 * c) * 33 + n;
            u32x4 o; o.x = pk4f8(s[0 * 33], s[1 * 33], s[2 * 33], s[3 * 33]); o.y = pk4f8(s[4 * 33], s[5 * 33], s[6 * 33], s[7 * 33]);
            o.z = pk4f8(s[8 * 33], s[9 * 33], s[10 * 33], s[11 * 33]); o.w = pk4f8(s[12 * 33], s[13 * 33], s[14 * 33], s[15 * 33]);
            *(u32x4*)((unsigned char*)WT + (size_t)(n0 + n) * K + k0 + 16 * c) = o; }
    } else {
        const int c = lane & 7;
#pragma unroll
        for (int j = 0; j < 4; ++j) { const int n = (lane >> 3) + 8 * j; const LAS float* s = scr + (8 * c) * 33 + n;
            u32x4 o; o.x = pkh(s[0 * 33], s[1 * 33]); o.y = pkh(s[2 * 33], s[3 * 33]); o.z = pkh(s[4 * 33], s[5 * 33]); o.w = pkh(s[6 * 33], s[7 * 33]);
            *(u32x4*)((f16*)WT + (size_t)(n0 + n) * K + k0 + 8 * c) = o; }
    }
    asm volatile("s_waitcnt lgkmcnt(0)" ::: "memory");
}
template <int MAP, bool F8>
__device__ __forceinline__ bool p0_group(int& r, const float* W, int nb, int K, int N, void* WT, LAS float* scr, int lane) {
    const int per = (K / 64) * (N / 32), tot = nb * per;
    if (r >= tot) { r -= tot; return false; }
    const int b = r / per, it = r % per;
    p0_transpose_item<MAP, F8>(W + (size_t)b * K * N, K, N, (unsigned char*)WT + (size_t)b * K * N * (F8 ? 1 : 2), scr, it, lane);
    return true;
}
constexpr int CONV_ITEMS_0 = 8 * (16 * 224 + 56 * 32) + 16 * 192 + 32 * 32;
constexpr int CONV_ITEMS_1 = 8 * (16 * 224 + 56 * 32) + 16 * 64 + 4 * 16 * 32 + 16 * 176 + 44 * 32;
__device__ __forceinline__ void conv_rest(int r, int which, unsigned char* ws, LAS float* scr, int lane) {
    if (which != 1) {
        if (p0_group<2, true>(r, KIN(19), NEXP, 1024, 7168, ws + WS_W_MIN, scr, lane)) return;
        if (p0_group<0, true>(r, KIN(20), NEXP, 3584, 1024, ws + WS_W_MOUT, scr, lane)) return;
        if (p0_group<1, RETIN_F8 != 0>(r, KIN(7) + (size_t)1024 * 6144, 1, 1024, 6144, (f16*)(ws + WS_W_RIN) + (size_t)1024 * 6144, scr, lane)) return;
        if (p0_group<0, false>(r, KIN(9) + (size_t)2048 * 1024, 1, 2048, 1024, (f16*)(ws + WS_W_ROUT) + (size_t)2048 * 1024, scr, lane)) return;
    }
    if (which != 0) {
        if (p0_group<2, true>(r, KIN(19) + (size_t)NEXP * 1024 * 7168, NEXP, 1024, 7168, ws + WS_W_MIN + (size_t)NEXP * 1024 * 7168, scr, lane)) return;
        if (p0_group<0, true>(r, KIN(20) + (size_t)NEXP * 3584 * 1024, NEXP, 3584, 1024, ws + WS_W_MOUT + (size_t)NEXP * 3584 * 1024, scr, lane)) return;
        if (p0_group<0, false>(r, KIN(13), 1, 1024, 2048, (f16*)(ws + WS_W_KV), scr, lane)) return;
        if (p0_group<0, false>(r, KIN(14), 2, 1024, 1024, (f16*)(ws + WS_W_SQ), scr, lane)) return;
        if (p0_group<0, false>(r, KIN(15), 2, 1024, 1024, (f16*)(ws + WS_W_SO), scr, lane)) return;
        if (p0_group<2, DENSE_F8 != 0>(r, KIN(16) + (size_t)1024 * 5632, 1, 1024, 5632, (f16*)(ws + WS_W_FIN) + (size_t)1024 * 5632, scr, lane)) return;
        p0_group<0, (DENSE_F8 != 0 && DENSE_F8_OUT != 0)>(r, KIN(17) + (size_t)2816 * 1024, 1, 2816, 1024, (f16*)(ws + WS_W_FOUT) + (size_t)2816 * 1024, scr, lane);
    }
}
__device__ __forceinline__ void p0_prologue(Frame& F) {
    PHASE_IDS();
    const int gw = F.vcu * 8 + F.wave, NGW = F.G * 8;
    LAS float* condL = (LAS float*)(F.lds);
    LAS float* scr = (LAS float*)(F.lds + 65536 + F.wave * 8448);
    for (int i = tid; i < 16 * 1024; i += 512) { const int b = i >> 10, k = i & 1023; condL[k * 16 + b] = silu_f(KIN(1)[i]); }
    WG_BAR();
    for (int it = gw; it < 1664; it += NGW) {
        const float* W; const float* bias; float* dst; int N, col0;
        if (it < 1536) { const int l = it / 384; col0 = 16 * (it % 384); N = 6144; W = KIN(3) + (size_t)l * 1024 * 6144; bias = KIN(4) + l * 6144; dst = (float*)(F.ws + WS_MOD) + (size_t)l * 16 * 6144; }
        else { col0 = 16 * (it - 1536); N = 2048; W = KIN(10); bias = KIN(11); dst = (float*)(F.ws + WS_KVMOD); }
        const int cl = lane & 3, kg = lane >> 2;
        f32x4 acc[16];
#pragma unroll
        for (int b = 0; b < 16; ++b) acc[b] = (f32x4){0.f, 0.f, 0.f, 0.f};
        const float* wp = W + (size_t)kg * N + col0 + 4 * cl;
#pragma unroll 4
        for (int k16 = 0; k16 < 64; ++k16) {
            const f32x4 w = *(const f32x4*)(wp + (size_t)k16 * 16 * N);
            const LAS f32x4* cp = (const LAS f32x4*)(condL + (16 * k16 + kg) * 16);
            const f32x4 c0 = cp[0], c1 = cp[1], c2 = cp[2], c3 = cp[3];
#pragma unroll
            for (int j = 0; j < 4; ++j) { acc[j] += c0[j] * w; acc[4 + j] += c1[j] * w; acc[8 + j] += c2[j] * w; acc[12 + j] += c3[j] * w; }
        }
        const f32x4 bv = *(const f32x4*)(bias + col0 + 4 * cl);
#pragma unroll
        for (int b = 0; b < 16; ++b) {
            f32x4 v = acc[b];
#pragma unroll
            for (int j = 0; j < 4; ++j) { v[j] += __shfl_xor(v[j], 4); v[j] += __shfl_xor(v[j], 8); v[j] += __shfl_xor(v[j], 16); v[j] += __shfl_xor(v[j], 32); }
            if (kg == 0) *(f32x4*)(dst + (size_t)b * N + col0 + 4 * cl) = v + bv;
        }
    }
    {
        const double e = -(double)lane / 64.0;
        const double invf = exp2(e * 13.287712379549449);
        float* rope = (float*)(F.ws + WS_ROPE); const int* posp = (const int*)karg<2>();
        for (int row = gw; row < MTOK; row += NGW) {
            const double rev = (double)posp[row] * invf * 0.15915494309189535;
            const float fr = (float)(rev - floor(rev));
            rope[(size_t)row * 128 + lane] = __builtin_amdgcn_cosf(fr); rope[(size_t)row * 128 + 64 + lane] = __builtin_amdgcn_sinf(fr);
        }
    }
    constexpr int per_rin = 16 * 192, per_rout = 32 * 32, per_kv = 16 * 64, per_sq = 16 * 32, per_fin = 16 * 176, per_fout = 44 * 32, per_min = 16 * 224, per_mout = 56 * 32;
    constexpr int NITEMS = CONV_IN_SCAN ? (per_rin + per_rout + per_fin + per_fout) : (2 * per_rin + 2 * per_rout + per_kv + 4 * per_sq + 2 * per_fin + 2 * per_fout + 16 * per_min + 16 * per_mout);
    for (int it = gw; it < NITEMS; it += NGW) {
        int r = it;
        if (p0_group<1, RETIN_F8 != 0>(r, KIN(7), 1, 1024, 6144, (f16*)(F.ws + WS_W_RIN), scr, lane)) continue;
        if (p0_group<0, false>(r, KIN(9), 1, 2048, 1024, (f16*)(F.ws + WS_W_ROUT), scr, lane)) continue;
        if (p0_group<2, false>(r, KIN(16), 1, 1024, 5632, (f16*)(F.ws + WS_W_FIN), scr, lane)) continue;
        if (p0_group<0, false>(r, KIN(17), 1, 2816, 1024, (f16*)(F.ws + WS_W_FOUT), scr, lane)) continue;
        if (!CONV_IN_SCAN) conv_rest(r, 2, F.ws, scr, lane);
    }
}

__device__ __forceinline__ void moe_tile_bases(const unsigned* gcnt, int (&tb)[NEXP], int& ntiles) {
    int acc = 0;
#pragma unroll
    for (int e = 0; e < NEXP; ++e) { tb[e] = acc; const unsigned c = __hip_atomic_load(gcnt + 64 * e, __ATOMIC_RELAXED, __HIP_MEMORY_SCOPE_AGENT); acc += (int)((c + 255u) >> 8); }
    ntiles = acc;
}
struct NormArgs {
    const void* x; f16* xw; const float* gain; const float* sh; const float* sc;
    f16* h; const float* gain2; const float* kvmod; f16* hk;
    const f16* y2; const float* gatef;
    float* out;
    const f16* yb;
    const float* router; unsigned* gcnt; unsigned* tokinfo; unsigned char* hs8; float* wof;
};
template <bool COMBINE, bool KV, bool FINAL, bool ROUTER, bool H8 = false, bool ADDY = false, bool XF32 = false>
__device__ __forceinline__ void norm_phase(Frame& F, const NormArgs& A) {
    PHASE_IDS();
    const int gw = F.vcu * 8 + F.wave, NGW = F.G * 8;
    LAS float* routL = (LAS float*)F.lds;
    LAS unsigned* lcnt = (LAS unsigned*)(F.lds + 32768);
    LAS unsigned* recs = (LAS unsigned*)(F.lds + 32768 + 256);
    if (ROUTER) {
        for (int i = tid; i < 8192; i += 512) routL[(i & 7) * 1024 + (i >> 3)] = A.router[i];
        if (tid < 16) lcnt[tid] = 0u;
        WG_BAR();
    }
    int ctb[NEXP]; int cnt_ = 0; (void)cnt_;
    if (COMBINE) moe_tile_bases(A.gcnt, ctb, cnt_);
    f32x4 cxf[4], nxf[4]; f16x4 cxh[4], nxh[4], cya[4], nya[4], cyb[4], nyb[4]; u32x4 ti_n = {0u, 0u, 0u, 0u};
#define NP_ISSUE(row_, ti_, xf_, xh_, ya_, yb_) do { \
        _Pragma("unroll") for (int j = 0; j < 4; ++j) { if (XF32) xf_[j] = *((const f32x4*)((const float*)A.x + (size_t)(row_) * DM) + lane + 64 * j); else xh_[j] = *((const f16x4*)((const f16*)A.x + (size_t)(row_) * DM) + lane + 64 * j); } \
        if (ADDY) { _Pragma("unroll") for (int j = 0; j < 4; ++j) ya_[j] = *((const f16x4*)(A.yb + (size_t)(row_) * DM) + lane + 64 * j); } \
        if (COMBINE) { int b1_ = 0, b2_ = 0; \
            _Pragma("unroll") for (int e = 0; e < NEXP; ++e) { b1_ = ((int)(ti_).x == e) ? ctb[e] : b1_; b2_ = ((int)(ti_).z == e) ? ctb[e] : b2_; } \
            const f16* pa_ = A.y2 + ((size_t)b1_ * 256 + (ti_).y) * DM; const f16* pb_ = A.y2 + ((size_t)b2_ * 256 + (ti_).w) * DM; \
            _Pragma("unroll") for (int j = 0; j < 4; ++j) { ya_[j] = *((const f16x4*)pa_ + lane + 64 * j); yb_[j] = *((const f16x4*)pb_ + lane + 64 * j); } } } while (0)
    if (gw < MTOK) {
        u32x4 ti0 = {0u, 0u, 0u, 0u};
        if (COMBINE) ti0 = *(const u32x4*)(A.tokinfo + 8 * (size_t)gw);
        NP_ISSUE(gw, ti0, cxf, cxh, cya, cyb);
        if (COMBINE && gw + NGW < MTOK) ti_n = *(const u32x4*)(A.tokinfo + 8 * (size_t)(gw + NGW));
    }
    int nloc = 0;
    for (int row = gw; row < MTOK; row += NGW, ++nloc) {
        const int b = row >> 11;
        if (row + NGW < MTOK) {
            NP_ISSUE(row + NGW, ti_n, nxf, nxh, nya, nyb);
            if (COMBINE && row + 2 * NGW < MTOK) ti_n = *(const u32x4*)(A.tokinfo + 8 * (size_t)(row + 2 * NGW));
        }
        f32x4 v[4];
#pragma unroll
        for (int j = 0; j < 4; ++j) { if (XF32) v[j] = cxf[j]; else v[j] = (f32x4){(float)cxh[j][0], (float)cxh[j][1], (float)cxh[j][2], (float)cxh[j][3]}; }
        if (ADDY) {
#pragma unroll
            for (int j = 0; j < 4; ++j) {
#pragma unroll
                for (int t = 0; t < 4; ++t) v[j][t] += (float)cya[j][t];
                { u32x2 w; w.x = pkh(v[j][0], v[j][1]); w.y = pkh(v[j][2], v[j][3]); *((u32x2*)(A.xw + (size_t)row * DM) + lane + 64 * j) = w; }
            }
        }
        if (COMBINE) {
#pragma unroll
            for (int j = 0; j < 4; ++j) {
                const f32x4 g = *((const f32x4*)(A.gatef + (size_t)b * 6144) + lane + 64 * j);
#pragma unroll
                for (int t = 0; t < 4; ++t) v[j][t] += g[t] * ((float)cya[j][t] + (float)cyb[j][t]);
                if (!FINAL) { u32x2 w; w.x = pkh(v[j][0], v[j][1]); w.y = pkh(v[j][2], v[j][3]); *((u32x2*)(A.xw + (size_t)row * DM) + lane + 64 * j) = w; }
            }
        }
        float ss = 0.f;
#pragma unroll
        for (int j = 0; j < 4; ++j) ss += (v[j][0] * v[j][0] + v[j][1] * v[j][1]) + (v[j][2] * v[j][2] + v[j][3] * v[j][3]);
        const float rstd = 1.0f / sqrtf(wave_sum(ss) * (1.0f / DM) + EPS);
        if (FINAL) {
#pragma unroll
            for (int j = 0; j < 4; ++j) { const f32x4 g = *((const f32x4*)A.gain + lane + 64 * j); *((f32x4*)(A.out + (size_t)row * DM) + lane + 64 * j) = v[j] * rstd * g; }
        } else {
            f32x4 hv[4];
#pragma unroll
            for (int j = 0; j < 4; ++j) {
                const f32x4 g = *((const f32x4*)A.gain + lane + 64 * j), sh = *((const f32x4*)(A.sh + (size_t)b * 6144) + lane + 64 * j), sc = *((const f32x4*)(A.sc + (size_t)b * 6144) + lane + 64 * j);
                hv[j] = (v[j] * rstd * g) * (1.0f + sc) + sh;
                if (H8) *((unsigned*)((unsigned char*)A.h + (size_t)row * DM) + lane + 64 * j) = pk4f8(hv[j][0], hv[j][1], hv[j][2], hv[j][3]);
                else { u32x2 w; w.x = pkh(hv[j][0], hv[j][1]); w.y = pkh(hv[j][2], hv[j][3]); *((u32x2*)(A.h + (size_t)row * DM) + lane + 64 * j) = w; }
            }
            if (KV) {
#pragma unroll
                for (int j = 0; j < 4; ++j) {
                    const f32x4 g = *((const f32x4*)A.gain2 + lane + 64 * j), sh = *((const f32x4*)(A.kvmod + (size_t)b * 2048) + lane + 64 * j), sc = *((const f32x4*)(A.kvmod + (size_t)b * 2048 + 1024) + lane + 64 * j);
                    const f32x4 o = (v[j] * rstd * g) * (1.0f + sc) + sh;
                    u32x2 w; w.x = pkh(o[0], o[1]); w.y = pkh(o[2], o[3]);
                    *((u32x2*)(A.hk + (size_t)row * DM) + lane + 64 * j) = w;
                }
            }
            if (ROUTER) {
                float lg[8];
#pragma unroll
                for (int e = 0; e < 8; ++e) lg[e] = 0.f;
#pragma unroll
                for (int j = 0; j < 4; ++j)
#pragma unroll
                    for (int e = 0; e < 8; ++e) {
                        const f32x4 rv = *((const LAS f32x4*)(routL + e * 1024) + lane + 64 * j);
                        lg[e] += (hv[j][0] * rv[0] + hv[j][1] * rv[1]) + (hv[j][2] * rv[2] + hv[j][3] * rv[3]);
                    }
                {
                    float r4[4], r2[2], r1;
                    const bool b0 = lane & 1, b1 = lane & 2, b2 = lane & 4;
#pragma unroll
                    for (int k = 0; k < 4; ++k) { const float keep = b0 ? lg[k + 4] : lg[k], send = b0 ? lg[k] : lg[k + 4]; r4[k] = keep + __shfl_xor(send, 1); }
#pragma unroll
                    for (int k = 0; k < 2; ++k) { const float keep = b1 ? r4[k + 2] : r4[k], send = b1 ? r4[k] : r4[k + 2]; r2[k] = keep + __shfl_xor(send, 2); }
                    { const float keep = b2 ? r2[1] : r2[0], send = b2 ? r2[0] : r2[1]; r1 = keep + __shfl_xor(send, 4); }
                    r1 += __shfl_xor(r1, 8); r1 += __shfl_xor(r1, 16); r1 += __shfl_xor(r1, 32);
#pragma unroll
                    for (int e = 0; e < 8; ++e) lg[e] = __int_as_float(__builtin_amdgcn_readlane(__float_as_int(r1), ((e >> 2) & 1) | (((e >> 1) & 1) << 1) | ((e & 1) << 2)));
                }
                int i1 = 0; float v1 = lg[0];
#pragma unroll
                for (int e = 1; e < 8; ++e) if (lg[e] > v1) { v1 = lg[e]; i1 = e; }
                int i2 = (i1 == 0) ? 1 : 0; float v2 = lg[i2];
#pragma unroll
                for (int e = 0; e < 8; ++e) if (e != i1 && lg[e] > v2) { v2 = lg[e]; i2 = e; }
                const float ed = __expf(v2 - v1), w1 = 1.0f / (1.0f + ed), w2 = ed * w1;
                if (lane == 0) {
                    const unsigned p1 = __hip_atomic_fetch_add(&lcnt[i1], 1u, __ATOMIC_RELAXED, __HIP_MEMORY_SCOPE_WORKGROUP), p2 = __hip_atomic_fetch_add(&lcnt[i2], 1u, __ATOMIC_RELAXED, __HIP_MEMORY_SCOPE_WORKGROUP);
                    LAS unsigned* rc = recs + (F.wave * 16 + nloc) * 8;
                    rc[0] = (unsigned)i1; rc[1] = p1; rc[2] = (unsigned)i2; rc[3] = p2; rc[4] = __float_as_uint(w1); rc[5] = __float_as_uint(w2);
                }
            }
        }
#pragma unroll
        for (int j = 0; j < 4; ++j) { cxf[j] = nxf[j]; cxh[j] = nxh[j]; cya[j] = nya[j]; cyb[j] = nyb[j]; }
    }
    if (ROUTER) {
        WG_BAR();
        if (tid < 8) lcnt[8 + tid] = __hip_atomic_fetch_add(A.gcnt + 64 * tid, lcnt[tid], __ATOMIC_RELAXED, __HIP_MEMORY_SCOPE_AGENT);
        WG_BAR();
        asm volatile("s_waitcnt vmcnt(0)" ::: "memory");
        for (int k0 = 0, row0 = gw; row0 < MTOK; row0 += 4 * NGW, k0 += 4) {
            u32x4 a[4];
#pragma unroll
            for (int q = 0; q < 4; ++q) { const int row = row0 + q * NGW; if (row < MTOK) a[q] = *((const u32x4*)((const unsigned char*)A.h + (size_t)row * DM) + lane); }
#pragma unroll
            for (int q = 0; q < 4; ++q) { const int row = row0 + q * NGW; if (row < MTOK) {
                const LAS unsigned* rc = recs + (F.wave * 16 + k0 + q) * 8;
                const unsigned e1 = rc[0], p1 = rc[1] + lcnt[8 + rc[0]], e2 = rc[2], p2 = rc[3] + lcnt[8 + rc[2]];
                const size_t v1 = (size_t)e1 * MOE_CAP + p1, v2 = (size_t)e2 * MOE_CAP + p2;
                *((u32x4*)(A.hs8 + v1 * DM) + lane) = a[q]; *((u32x4*)(A.hs8 + v2 * DM) + lane) = a[q];
                if (lane == 0) { *(u32x4*)(A.tokinfo + 8 * (size_t)row) = (u32x4){e1, p1, e2, p2}; A.wof[v1] = __uint_as_float(rc[4]); A.wof[v2] = __uint_as_float(rc[5]); } } }
        }
    }
}
constexpr int SC_PV = 576;
constexpr int SC_QL = 0, SC_KL = 16384, SC_VL = 32768, SC_SL = 69632, SC_ST = 135168, SC_STAGE = 0;
__device__ __forceinline__ int sc_off(int row, int ch) { return 256 * row + 16 * (ch ^ (((row & 3) << 2) | ((row >> 2) & 3))); }
__device__ __forceinline__ void scan_phase(Frame& F, const f16* proj, const float* gnw, f16* ao, int mi) {
    if (CONV_IN_SCAN) {
        if (blockIdx.x >= BATCH * RH) {
            PHASE_IDS();
            LAS float* scr = (LAS float*)(F.lds + F.wave * 8448);
            const int cw = ((int)blockIdx.x - BATCH * RH) * 8 + F.wave, NCW = ((int)gridDim.x - BATCH * RH) * 8;
            const int nit = mi ? CONV_ITEMS_1 : CONV_ITEMS_0;
            for (int it = cw; it < nit; it += NCW) conv_rest(it, mi, F.ws, scr, lane);
            return;
        }
    } else if (blockIdx.x >= 2 * BATCH * RH) return;
    const int unit = CONV_IN_SCAN ? (int)blockIdx.x : (int)(blockIdx.x >> 1), half = CONV_IN_SCAN ? 0 : (int)(blockIdx.x & 1);
    const int b = unit >> 3, hh = unit & 7;
    const int c_first_full = half ? NCHUNK / 2 : 0, c_end = CONV_IN_SCAN ? NCHUNK : (half ? NCHUNK : NCHUNK / 2);
    LAS unsigned char* L = F.lds;
    PHASE_IDS();
    const int wid = F.wave, rh = wid >> 2, cg = wid & 3, r = lane & 31, h = lane >> 5;
    const int gl = (lane >> 4) & 1, li = lane & 15, ta = li >> 2, tp = li & 3;
    const float lg = lg2gamma(hh);
    const float g63 = ex2(63.0f * lg), cd = __int_as_float(__builtin_amdgcn_readfirstlane(__float_as_int(ex2(64.0f * lg))));
    float vm[4], cj[4]; const int qloc = 32 * rh + r;
    const float wneg = __int_as_float(__builtin_amdgcn_readfirstlane(__float_as_int(ex2(-64.0f * lg))));
#pragma unroll
    for (int g4 = 0; g4 < 4; ++g4) vm[g4] = ex2((float)(16 * g4 + 8 * h - 2 * qloc - 64) * lg);
#pragma unroll
    for (int j = 0; j < 4; ++j) cj[j] = __int_as_float(__builtin_amdgcn_readfirstlane(__float_as_int(ex2((float)(2 * j) * lg))));
    const size_t rowbase = (size_t)b * SEQ;
    const f16* gq = proj + rowbase * RIN + 128 * hh;
    const f16* gk = gq + 1024;
    const f16* gv = proj + rowbase * RIN + 2048 + 256 * hh;
    const f16* gg = gv + 2048;
    const int qrow = tid >> 4, qc = tid & 15;
    const int vrow = tid >> 5, vc = tid & 31;
    int qoffL[2];
#pragma unroll
    for (int i = 0; i < 2; ++i) qoffL[i] = sc_off(qrow + 32 * i, qc);
    f32x16 SA[2][2];
#pragma unroll
    for (int dd = 0; dd < 2; ++dd)
#pragma unroll
        for (int et = 0; et < 2; ++et)
#pragma unroll
            for (int i = 0; i < 16; ++i) SA[dd][et][i] = 0.f;
    for (int i = tid; i < 65536 / 16; i += 512) *(LAS u32x4*)(L + SC_SL + i * 16) = (u32x4){0u, 0u, 0u, 0u};
    u32x4 nq[2], nk[2], nv[4];
#pragma unroll
    for (int i = 0; i < 2; ++i) { nq[i] = *(const u32x4*)(gq + (size_t)(qrow + 32 * i) * RIN + 8 * qc); nk[i] = *(const u32x4*)(gk + (size_t)(qrow + 32 * i) * RIN + 8 * qc); }
#pragma unroll
    for (int i = 0; i < 4; ++i) nv[i] = *(const u32x4*)(gv + (size_t)(vrow + 16 * i) * RIN + 8 * vc);
#pragma unroll
    for (int i = 0; i < 2; ++i) { *(LAS u32x4*)(L + SC_QL + qoffL[i]) = nq[i]; *(LAS u32x4*)(L + SC_KL + qoffL[i]) = nk[i]; }
#pragma unroll
    for (int i = 0; i < 4; ++i) *(LAS u32x4*)(L + SC_VL + (vrow + 16 * i) * SC_PV + 16 * vc) = nv[i];
    WG_BAR();
    for (int c = 0; c < c_first_full; ++c) {
        const size_t crow = (size_t)c * CHUNK;
#pragma unroll
        for (int i = 0; i < 2; ++i) { nq[i] = *(const u32x4*)(gq + (crow + 64 + qrow + 32 * i) * RIN + 8 * qc); nk[i] = *(const u32x4*)(gk + (crow + 64 + qrow + 32 * i) * RIN + 8 * qc); }
#pragma unroll
        for (int i = 0; i < 4; ++i) nv[i] = *(const u32x4*)(gv + (crow + 64 + vrow + 16 * i) * RIN + 8 * vc);
        int ro = r, ho = h, tao = ta, tpo = tp, glo = gl, vro = vrow, vco = vc;
        asm volatile("" : "+v"(ro), "+v"(ho), "+v"(tao), "+v"(tpo), "+v"(glo), "+v"(vro), "+v"(vco));
#pragma unroll
        for (int dd = 0; dd < 2; ++dd)
#pragma unroll
            for (int et = 0; et < 2; ++et)
#pragma unroll
                for (int i = 0; i < 16; ++i) SA[dd][et][i] *= cd;
#pragma unroll
        for (int kt = 0; kt < 2; ++kt)
#pragma unroll
            for (int s = 0; s < 2; ++s) {
                const int k0 = 32 * kt + 16 * s + 4 * ho + tao;
                f16x8 Vf[2], Kt[2];
#pragma unroll
                for (int et = 0; et < 2; ++et) { LAS const unsigned char* vp = L + SC_VL + k0 * SC_PV + (64 * cg + 32 * et + 16 * glo + 4 * tpo) * 2; Vf[et] = cat8(tr_read(vp), tr_read(vp + 8 * SC_PV)); }
#pragma unroll
                for (int dd = 0; dd < 2; ++dd) { const int ch = 4 * (2 * rh + dd) + 2 * glo + (tpo >> 1);
                    Kt[dd] = cat8(tr_read(L + SC_KL + sc_off(k0, ch) + 8 * (tpo & 1)), tr_read(L + SC_KL + sc_off(k0 + 8, ch) + 8 * (tpo & 1))); }
#pragma unroll
                for (int et = 0; et < 2; ++et)
#pragma unroll
                    for (int dd = 0; dd < 2; ++dd) SA[dd][et] = __builtin_amdgcn_mfma_f32_32x32x16_f16(Kt[dd], Vf[et], SA[dd][et], 0, 0, 0);
            }
        WG_BAR();
        if (c + 1 == c_first_full) {
#pragma unroll
            for (int dd = 0; dd < 2; ++dd)
#pragma unroll
                for (int et = 0; et < 2; ++et)
#pragma unroll
                    for (int g4 = 0; g4 < 4; ++g4) {
                        u32x2 w; w.x = pkh(SA[dd][et][4 * g4], SA[dd][et][4 * g4 + 1]); w.y = pkh(SA[dd][et][4 * g4 + 2], SA[dd][et][4 * g4 + 3]);
                        *(LAS u32x2*)(L + SC_SL + sc_off(64 * cg + 32 * et + ro, 4 * (2 * rh + dd) + g4) + 8 * ho) = w;
                    }
        }
#pragma unroll
        for (int i = 0; i < 2; ++i) { const int qo = sc_off((vro * 2 + (vco >> 4)) + 32 * i, vco & 15); *(LAS u32x4*)(L + SC_QL + qo) = nq[i]; *(LAS u32x4*)(L + SC_KL + qo) = nk[i]; }
#pragma unroll
        for (int i = 0; i < 4; ++i) *(LAS u32x4*)(L + SC_VL + (vrow + 16 * i) * SC_PV + 16 * vc) = nv[i];
        WG_BAR();
    }
    for (int c = c_first_full; c < c_end; ++c) {
        const size_t crow = (size_t)c * CHUNK;
        if (c + 1 < c_end) {
#pragma unroll
            for (int i = 0; i < 2; ++i) { nq[i] = *(const u32x4*)(gq + (crow + 64 + qrow + 32 * i) * RIN + 8 * qc); nk[i] = *(const u32x4*)(gk + (crow + 64 + qrow + 32 * i) * RIN + 8 * qc); }
#pragma unroll
            for (int i = 0; i < 4; ++i) nv[i] = *(const u32x4*)(gv + (crow + 64 + vrow + 16 * i) * RIN + 8 * vc);
        }
        int ro = r, ho = h, tao = ta, tpo = tp, glo = gl, vro = vrow, vco = vc;
        asm volatile("" : "+v"(ro), "+v"(ho), "+v"(tao), "+v"(tpo), "+v"(glo), "+v"(vro), "+v"(vco));
        f16x8 Pf[2][2]; f32x16 OT[2];
        {
        f16x8 Qf[8];
#pragma unroll
        for (int ks = 0; ks < 8; ++ks) Qf[ks] = *(const LAS f16x8*)(L + SC_QL + sc_off(32 * rh + ro, 2 * ks + ho));
#pragma unroll
        for (int kt = 0; kt < 2; ++kt) {
            f32x16 X;
#pragma unroll
            for (int i = 0; i < 16; ++i) X[i] = 0.f;
#pragma unroll
            for (int ks = 0; ks < 8; ++ks) { const f16x8 Kf = *(const LAS f16x8*)(L + SC_KL + sc_off(32 * kt + ro, 2 * ks + ho)); X = __builtin_amdgcn_mfma_f32_32x32x16_f16(Kf, Qf[ks], X, 0, 0, 0); }
#pragma unroll
            for (int i = 0; i < 16; ++i) { const int key = 32 * kt + (i & 3) + 8 * (i >> 2) + 4 * h; X[i] *= (key >= qloc) ? vm[i >> 2] * (kt ? cd * cj[i & 3] : cj[i & 3]) : wneg; }
            Pf[kt][0] = pack8(X, 0); Pf[kt][1] = pack8(X, 1);
        }
#pragma unroll
        for (int et = 0; et < 2; ++et)
#pragma unroll
            for (int i = 0; i < 16; ++i) OT[et][i] = 0.f;
#pragma unroll
        for (int ks = 0; ks < 8; ++ks)
#pragma unroll
            for (int et = 0; et < 2; ++et) {
                const f16x8 Sf = *(const LAS f16x8*)(L + SC_SL + sc_off(64 * cg + 32 * et + ro, 2 * ks + ho));
                OT[et] = __builtin_amdgcn_mfma_f32_32x32x16_f16(Sf, Qf[ks], OT[et], 0, 0, 0);
            }
        }
#pragma unroll
        for (int dd = 0; dd < 2; ++dd)
#pragma unroll
            for (int et = 0; et < 2; ++et)
#pragma unroll
                for (int i = 0; i < 16; ++i) SA[dd][et][i] *= cd;
#pragma unroll
        for (int kt = 0; kt < 2; ++kt)
#pragma unroll
            for (int s = 0; s < 2; ++s) {
                const int k0 = 32 * kt + 16 * s + 4 * ho + tao;
                f16x8 Vf[2], Kt[2];
#pragma unroll
                for (int et = 0; et < 2; ++et) { LAS const unsigned char* vp = L + SC_VL + k0 * SC_PV + (64 * cg + 32 * et + 16 * glo + 4 * tpo) * 2; Vf[et] = cat8(tr_read(vp), tr_read(vp + 8 * SC_PV)); }
#pragma unroll
                for (int dd = 0; dd < 2; ++dd) { const int ch = 4 * (2 * rh + dd) + 2 * glo + (tpo >> 1);
                    Kt[dd] = cat8(tr_read(L + SC_KL + sc_off(k0, ch) + 8 * (tpo & 1)), tr_read(L + SC_KL + sc_off(k0 + 8, ch) + 8 * (tpo & 1))); }
#pragma unroll
                for (int et = 0; et < 2; ++et) {
                    OT[et] = __builtin_amdgcn_mfma_f32_32x32x16_f16(Vf[et], Pf[kt][s], OT[et], 0, 0, 0);
#pragma unroll
                    for (int dd = 0; dd < 2; ++dd) SA[dd][et] = __builtin_amdgcn_mfma_f32_32x32x16_f16(Kt[dd], Vf[et], SA[dd][et], 0, 0, 0);
                }
            }
        float mean = 0.f, rstd = 0.f;
        {
        float s1 = 0.f, s2 = 0.f;
#pragma unroll
        for (int et = 0; et < 2; ++et)
#pragma unroll
            for (int i = 0; i < 16; ++i) { OT[et][i] *= g63; s1 += OT[et][i]; s2 += OT[et][i] * OT[et][i]; }
        s1 += __shfl_xor(s1, 32); s2 += __shfl_xor(s2, 32);
        if (h == 0) *(LAS f32x2*)(L + SC_ST + ((rh * 4 + cg) * 32 + r) * 8) = (f32x2){s1, s2};
        }
        WG_BAR();
        u32x4 gc[4];
        {
        float t1 = 0.f, t2 = 0.f;
#pragma unroll
        for (int c4 = 0; c4 < 4; ++c4) { const f32x2 p = *(const LAS f32x2*)(L + SC_ST + ((rh * 4 + c4) * 32 + r) * 8); t1 += p.x; t2 += p.y; }
        mean = t1 * (1.0f / 256.0f); const float var = t2 * (1.0f / 256.0f) - mean * mean; rstd = 1.0f / sqrtf(var + EPS);
#pragma unroll
        for (int i = 0; i < 4; ++i) gc[i] = *(const u32x4*)(gg + (crow + vrow + 16 * i) * RIN + 8 * vc);
        }
        {
#pragma unroll
        for (int dd = 0; dd < 2; ++dd)
#pragma unroll
            for (int et = 0; et < 2; ++et)
#pragma unroll
                for (int g4 = 0; g4 < 4; ++g4) {
                    u32x2 w; w.x = pkh(SA[dd][et][4 * g4], SA[dd][et][4 * g4 + 1]); w.y = pkh(SA[dd][et][4 * g4 + 2], SA[dd][et][4 * g4 + 3]);
                    *(LAS u32x2*)(L + SC_SL + sc_off(64 * cg + 32 * et + ro, 4 * (2 * rh + dd) + g4) + 8 * ho) = w;
                }
        }
        {
#pragma unroll
        for (int et = 0; et < 2; ++et)
#pragma unroll
            for (int g4 = 0; g4 < 4; ++g4) {
                u32x2 w; w.x = pkh((OT[et][4 * g4] - mean) * rstd, (OT[et][4 * g4 + 1] - mean) * rstd); w.y = pkh((OT[et][4 * g4 + 2] - mean) * rstd, (OT[et][4 * g4 + 3] - mean) * rstd);
                *(LAS u32x2*)(L + SC_STAGE + 16384 * (cg >> 1) + sc_off(32 * rh + ro, 8 * (cg & 1) + 4 * et + g4) + 8 * ho) = w;
            }
        }
        WG_BAR();
        {
        f32x4 gw0, gw1; { const float* gp = gnw + 256 * hh + 8 * vc; gw0 = *(const f32x4*)gp; gw1 = *(const f32x4*)(gp + 4); }
#pragma unroll
        for (int i = 0; i < 4; ++i) {
            const f16x8 n8 = *(const LAS f16x8*)(L + SC_STAGE + 16384 * (vco >> 4) + sc_off(vro + 16 * i, vco & 15));
            const f16x8 g8 = __builtin_bit_cast(f16x8, gc[i]);
            u32x4 w;
            w.x = pkh((float)n8[0] * (float)g8[0] * gw0[0], (float)n8[1] * (float)g8[1] * gw0[1]); w.y = pkh((float)n8[2] * (float)g8[2] * gw0[2], (float)n8[3] * (float)g8[3] * gw0[3]);
            w.z = pkh((float)n8[4] * (float)g8[4] * gw1[0], (float)n8[5] * (float)g8[5] * gw1[1]); w.w = pkh((float)n8[6] * (float)g8[6] * gw1[2], (float)n8[7] * (float)g8[7] * gw1[3]);
            *(u32x4*)(ao + (rowbase + crow + vrow + 16 * i) * 2048 + 256 * hh + 8 * vc) = w;
        }
        }
        WG_BAR();
        if (c + 1 < c_end) {
#pragma unroll
            for (int i = 0; i < 2; ++i) { const int qo = sc_off((vro * 2 + (vco >> 4)) + 32 * i, vco & 15); *(LAS u32x4*)(L + SC_QL + qo) = nq[i]; *(LAS u32x4*)(L + SC_KL + qo) = nk[i]; }
#pragma unroll
            for (int i = 0; i < 4; ++i) *(LAS u32x4*)(L + SC_VL + (vrow + 16 * i) * SC_PV + 16 * vc) = nv[i];
        }
        WG_BAR();
    }
}

constexpr int SBV_P = 144;
constexpr float SB_STOP = 5.421010862427522e-20f;
__device__ __forceinline__ void sb_phase(Frame& F, const f16* Q, const f16* Kc, const f16* Vc, f16* O, const float stop = SB_STOP) {
    PHASE_IDS();
    const int gw = F.vcu * 8 + F.wave, NGW = F.G * 8, r = lane & 31, h = lane >> 5;
    const int gl = (lane >> 4) & 1, li = lane & 15, ta = li >> 2, tp = li & 3;
    LAS unsigned char* Kw = F.lds + F.wave * (96 * SBV_P);
    LAS unsigned char* Vw = Kw + 32 * SBV_P; LAS unsigned char* Qw = Kw + 64 * SBV_P;
    const int vr = lane >> 3, vcc = lane & 7;
    constexpr int NU = BATCH * SBH * (SEQ / 32);
    u32x4 qn2[4], kn2[4], vn2[4];
    if (gw < NU) { const int qblk = gw & 63, bh = gw >> 6, b = bh >> 4, hd = bh & 15; const size_t rb = (size_t)b * SEQ;
        const f16* qp = Q + (rb + 32 * qblk + vr) * DM + 64 * hd + 8 * vcc; const f16* kp = Kc + (rb + 32 * qblk + vr) * DM + 64 * hd + 8 * vcc; const f16* vp = Vc + (rb + 32 * qblk + vr) * DM + 64 * hd + 8 * vcc;
#pragma unroll
        for (int i = 0; i < 4; ++i) { qn2[i] = *(const u32x4*)(qp + (size_t)(8 * i) * DM); kn2[i] = *(const u32x4*)(kp + (size_t)(8 * i) * DM); vn2[i] = *(const u32x4*)(vp + (size_t)(8 * i) * DM); } }
    for (int u = gw; u < NU; u += NGW) {
        const int qblk = u & 63, bh = u >> 6, b = bh >> 4, hd = bh & 15;
        const size_t rb = (size_t)b * SEQ;
        f16x8 Qf[4];
#pragma unroll
        for (int i = 0; i < 4; ++i) *(LAS u32x4*)(Qw + (vr + 8 * i) * SBV_P + 16 * vcc) = qn2[i];
        CFENCE();
#pragma unroll
        for (int ks = 0; ks < 4; ++ks) Qf[ks] = *(const LAS f16x8*)(Qw + r * SBV_P + (16 * ks + 8 * h) * 2);
        CFENCE();
        f32x16 OT[2];
#pragma unroll
        for (int dt = 0; dt < 2; ++dt)
#pragma unroll
            for (int i = 0; i < 16; ++i) OT[dt][i] = 0.f;
        float carry = 1.0f;
        u32x4 kn[4], vn[4];
#pragma unroll
        for (int i = 0; i < 4; ++i) { kn[i] = kn2[i]; vn[i] = vn2[i]; }
        if (u + NGW < NU) { const int un = u + NGW, qb2 = un & 63, bh2 = un >> 6, b2 = bh2 >> 4, hd2 = bh2 & 15; const size_t rb2 = (size_t)b2 * SEQ;
            const f16* qp = Q + (rb2 + 32 * qb2 + vr) * DM + 64 * hd2 + 8 * vcc; const f16* kp = Kc + (rb2 + 32 * qb2 + vr) * DM + 64 * hd2 + 8 * vcc; const f16* vp = Vc + (rb2 + 32 * qb2 + vr) * DM + 64 * hd2 + 8 * vcc;
#pragma unroll
            for (int i = 0; i < 4; ++i) { qn2[i] = *(const u32x4*)(qp + (size_t)(8 * i) * DM); kn2[i] = *(const u32x4*)(kp + (size_t)(8 * i) * DM); vn2[i] = *(const u32x4*)(vp + (size_t)(8 * i) * DM); } }
        for (int kt = qblk; kt >= 0; --kt) {
#pragma unroll
            for (int i = 0; i < 4; ++i) { *(LAS u32x4*)(Kw + (vr + 8 * i) * SBV_P + 16 * vcc) = kn[i]; *(LAS u32x4*)(Vw + (vr + 8 * i) * SBV_P + 16 * vcc) = vn[i]; }
            CFENCE();
            f16x8 Kf[4];
#pragma unroll
            for (int ks = 0; ks < 4; ++ks) Kf[ks] = *(const LAS f16x8*)(Kw + r * SBV_P + (16 * ks + 8 * h) * 2);
            CFENCE();
            if (kt > 0) { const f16* kp = Kc + (rb + 32 * (kt - 1) + vr) * DM + 64 * hd + 8 * vcc; const f16* vp = Vc + (rb + 32 * (kt - 1) + vr) * DM + 64 * hd + 8 * vcc;
#pragma unroll
                for (int i = 0; i < 4; ++i) { kn[i] = *(const u32x4*)(kp + (size_t)(8 * i) * DM); vn[i] = *(const u32x4*)(vp + (size_t)(8 * i) * DM); } }
            f32x16 S;
#pragma unroll
            for (int i = 0; i < 16; ++i) S[i] = 0.f;
#pragma unroll
            for (int ks = 0; ks < 4; ++ks) S = __builtin_amdgcn_mfma_f32_32x32x16_f16(Kf[ks], Qf[ks], S, 0, 0, 0);
            float om[16];
            const bool diag = (kt == qblk);
#pragma unroll
            for (int i = 0; i < 16; ++i) {
                const int kl = (i & 3) + 8 * (i >> 2) + 4 * h;
                float o = __builtin_amdgcn_rcpf(1.0f + ex2(S[i]));
                if (diag && kl >= r) o = 1.0f;
                om[i] = o;
            }
            float sfx[16], T[4];
#pragma unroll
            for (int g4 = 0; g4 < 4; ++g4) { sfx[4 * g4 + 3] = 1.0f; sfx[4 * g4 + 2] = om[4 * g4 + 3]; sfx[4 * g4 + 1] = sfx[4 * g4 + 2] * om[4 * g4 + 2]; sfx[4 * g4] = sfx[4 * g4 + 1] * om[4 * g4 + 1]; T[g4] = sfx[4 * g4] * om[4 * g4]; }
            float E[4]; float run = carry;
#pragma unroll
            for (int g4 = 3; g4 >= 0; --g4) {
                const auto sw = __builtin_amdgcn_permlane32_swap(__float_as_uint(T[g4]), __float_as_uint(T[g4]), false, false);
                const float tl = __uint_as_float(sw[0]), th = __uint_as_float(sw[1]);
                const float e_hi = run; run *= th; const float e_lo = run; run *= tl;
                E[g4] = h ? e_hi : e_lo;
            }
            carry = run;
            f32x16 Aw;
#pragma unroll
            for (int i = 0; i < 16; ++i) Aw[i] = (1.0f - om[i]) * (E[i >> 2] * sfx[i]);
            const f16x8 Af0 = pack8(Aw, 0), Af1 = pack8(Aw, 1);
            CFENCE();
#pragma unroll
            for (int dt = 0; dt < 2; ++dt) {
                LAS const unsigned char* vp = Vw + (4 * h + ta) * SBV_P + (32 * dt + 16 * gl + 4 * tp) * 2;
                const f16x8 V0 = cat8(tr_read(vp), tr_read(vp + 8 * SBV_P)), V1 = cat8(tr_read(vp + 16 * SBV_P), tr_read(vp + 24 * SBV_P));
                OT[dt] = __builtin_amdgcn_mfma_f32_32x32x16_f16(V0, Af0, OT[dt], 0, 0, 0);
                OT[dt] = __builtin_amdgcn_mfma_f32_32x32x16_f16(V1, Af1, OT[dt], 0, 0, 0);
            }
            CFENCE();
            if (__ballot(carry > stop) == 0ull) break;
        }
        CFENCE();
#pragma unroll
        for (int dt = 0; dt < 2; ++dt)
#pragma unroll
            for (int g4 = 0; g4 < 4; ++g4) { u32x2 w; w.x = pkh(OT[dt][4 * g4], OT[dt][4 * g4 + 1]); w.y = pkh(OT[dt][4 * g4 + 2], OT[dt][4 * g4 + 3]); *(LAS u32x2*)(Qw + r * SBV_P + (32 * dt + 8 * g4 + 4 * h) * 2) = w; }
        CFENCE();
        f16* op = O + (rb + 32 * qblk + vr) * DM + 64 * hd + 8 * vcc;
#pragma unroll
        for (int i = 0; i < 4; ++i) *(u32x4*)(op + (size_t)(8 * i) * DM) = *(const LAS u32x4*)(Qw + (vr + 8 * i) * SBV_P + 16 * vcc);
        CFENCE();
    }
}

struct Args { const void* in[22]; float* out; unsigned char* ws; int ph_lo, ph_hi; };
constexpr int N_PHASES = 34;
#define IN(k) (lo <= (k) && (k) < hi)
#define SEAM(k) do { if (IN((k) + 1)) { if (!MK_PER_PHASE) xcd_barrier(bar); } } while (0)
#define WSP(T, off) ((T*)(F.ws + (off)))
#define REPS(cond) _Pragma("unroll") for (int rep_ = 0; rep_ < ((cond) ? 2 : 1); ++rep_)
#define REPBAR() do { if (rep_) xcd_barrier(bar); } while (0)
#define REPSN(cond, n) _Pragma("unroll") for (int rep_ = 0; rep_ < ((cond) ? (n) : 1); ++rep_)
template <int L> __device__ __forceinline__ void layer_phases(Frame& F, const XcdBarrier& bar, const int lo, const int hi) {
    constexpr int pb = 1 + 8 * L;
        if (IN(pb + 0) && !DIS_K0) {
            const float* modL = WSP(const float, WS_MOD) + (size_t)L * 16 * 6144;
            NormArgs A{}; A.x = (L == 0) ? (const void*)KIN(0) : (const void*)WSP(const f16, WS_X); A.xw = WSP(f16, WS_X); A.gain = KIN(5) + L * DM; A.sh = modL; A.sc = modL + 1024; A.h = WSP(f16, WS_H);
            if constexpr (L == 2) {
                A.y2 = WSP(const f16, WS_Y2); A.gcnt = F.ctl + CW_MOE; A.tokinfo = WSP(unsigned, WS_TOKINFO); A.gatef = WSP(const float, WS_MOD) + (size_t)(L - 1) * 16 * 6144 + 5120;
                A.gain2 = KIN(12); A.kvmod = WSP(const float, WS_KVMOD); A.hk = WSP(f16, WS_HK); REPSN(PROBE_DUP == 15, 5) { REPBAR(); if (rep_) { A.xw = WSP(f16, WS_BIG + 320 * MiB); A.h = WSP(f16, WS_BIG + 448 * MiB); A.hk = WSP(f16, WS_BIG + 512 * MiB); } norm_phase<true, true, false, false>(F, A); }
            } else REPSN(PROBE_DUP == 7 && L == 1, 5) { REPBAR(); A.yb = WSP(const f16, WS_YB); if (rep_) { A.xw = WSP(f16, WS_BIG + 320 * MiB); A.h = WSP(f16, WS_BIG + 448 * MiB); } norm_phase<false, false, false, false, (RETIN_F8 != 0 && L < 2), (L == 1 || L == 3), (L == 0)>(F, A); }
            SEAM(pb + 0);
        }
        if (IN(pb + 1) && !DIS_K1) {
            if constexpr (L < 2) {
                pg8::Gemm g{WSP(const unsigned char, WS_H), WSP(const unsigned char, WS_W_RIN) + (size_t)L * RIN * DM * 2, MTOK, RIN, DM, 0, STAG_RET}; pg8::Order S; S.init(MTOK, RIN, F.G, (int)blockIdx.x);
                pg8::EpiRetIn E{WSP(f16, WS_PROJ), WSP(const float, WS_ROPE), RETIN_F8 ? 1.0f / F8_WSCALE : 1.0f};
                REPS(PROBE_DUP == 6 && L == 1) { REPBAR(); pg8::gemm_phase<pg8::EpiRetIn, RETIN_F8 != 0>(F.lds, g, S, E); }
                if constexpr (PROBE_DUP == 17 && L == 1) { xcd_barrier(bar); pg8::EpiNull<true> EN{WSP(float, WS_SLOTW)}; pg8::gemm_phase<pg8::EpiNull<true>, false>(F.lds, g, S, EN); }
            } else REPS(PROBE_DUP == 12 && L == 2) { REPBAR();
                { pg8::Gemm g{WSP(const f16, WS_H), WSP(const f16, WS_W_SQ) + (size_t)(L - 2) * DM * DM, MTOK, DM, DM, 0}; pg8::Order S; S.init(MTOK, DM, F.G, (int)blockIdx.x);
                  pg8::EpiF16 E{WSP(f16, WS_SQ), DM, 0, 0, 0.125f * 1.4426950408889634f};
                  pg8::gemm_phase<pg8::EpiF16>(F.lds, g, S, E); }
                if constexpr (L == 2) { pg8::Gemm g{WSP(const f16, WS_HK), WSP(const f16, WS_W_KV), MTOK, 2048, DM, 0}; pg8::Order S; S.init(MTOK, 2048, F.G, (int)blockIdx.x);
                  pg8::EpiF16 E{WSP(f16, WS_KSH), DM, 1024, (size_t)(WS_VSH - WS_KSH) / 2, 1.0f};
                  pg8::gemm_phase<pg8::EpiF16>(F.lds, g, S, E); }
            }
            SEAM(pb + 1);
        }
        if (IN(pb + 2) && !DIS_K2) {
#ifndef NO_SCAN
            if constexpr (L < 2) REPS(PROBE_DUP == 2 && L == 1) { REPBAR(); scan_phase(F, WSP(const f16, WS_PROJ), KIN(8) + L * 2048, WSP(f16, WS_AO), L); }
#endif
#ifndef NO_SB
            if constexpr (L >= 2) REPSN((PROBE_DUP == 3 || PROBE_DUP == 22 || PROBE_DUP == 23) && L == 3, 5) { REPBAR(); sb_phase(F, WSP(const f16, WS_SQ), WSP(const f16, WS_KSH), WSP(const f16, WS_VSH), rep_ ? WSP(f16, WS_BIG + 320 * MiB) : WSP(f16, WS_SO), (rep_ && PROBE_DUP == 22) ? 2.0f : (rep_ && PROBE_DUP == 23) ? 1e-6f : SB_STOP); }
#endif
            SEAM(pb + 2);
        }
        if (IN(pb + 3) && !DIS_K3) {
            pg8::Gemm g;
            if constexpr (L < 2) g = pg8::Gemm{WSP(const f16, WS_AO), WSP(const f16, WS_W_ROUT) + (size_t)L * DM * 2048, MTOK, DM, 2048, 0};
            else g = pg8::Gemm{WSP(const f16, WS_SO), WSP(const f16, WS_W_SO) + (size_t)(L - 2) * DM * DM, MTOK, DM, DM, 0};
            pg8::Order S; S.init(MTOK, DM, F.G, (int)blockIdx.x);
            pg8::EpiY E{WSP(f16, WS_YB), WSP(const float, WS_MOD) + (size_t)L * 16 * 6144 + 2048, 1.0f};
            REPS(PROBE_DUP == 9 && L == 1) { REPBAR(); pg8::gemm_phase<pg8::EpiY>(F.lds, g, S, E); }
            SEAM(pb + 3);
        }
        if (IN(pb + 4) && !DIS_K4) {
            const float* modL = WSP(const float, WS_MOD) + (size_t)L * 16 * 6144;
            NormArgs A{}; A.x = (L == 0) ? (const void*)KIN(0) : (const void*)WSP(const f16, WS_X); A.xw = WSP(f16, WS_X); A.gain = KIN(6) + L * DM; A.sh = modL + 3072; A.sc = modL + 4096; A.h = WSP(f16, WS_H); A.yb = WSP(const f16, WS_YB);
            if constexpr (L & 1) { A.router = KIN(18) + (size_t)(L >> 1) * DM * NEXP; A.gcnt = F.ctl + CW_MOE + (L >> 1) * 1024; A.tokinfo = WSP(unsigned, WS_TOKINFO); A.hs8 = WSP(unsigned char, WS_HS); A.wof = WSP(float, WS_SLOTW); REPSN(PROBE_DUP == 13 && L == 3, 5) { REPBAR(); if (rep_) { A.gcnt = F.ctl + CW_MOE + 4096; A.tokinfo = WSP(unsigned, WS_TOKINFO + MiB); A.xw = WSP(f16, WS_BIG + 320 * MiB); A.h = WSP(f16, WS_BIG + 448 * MiB); A.hs8 = WSP(unsigned char, WS_END); A.wof = WSP(float, WS_BIG + 512 * MiB); } norm_phase<false, false, false, true, true, true>(F, A); } }
            else norm_phase<false, false, false, false, DF8(L), true, (L == 0)>(F, A);
            SEAM(pb + 4);
        }
        if (IN(pb + 6) && !DIS_K6) {
            const int mi = L >> 1;
            pg8::Order S;
            if constexpr (L & 1) {
                int tb[NEXP], ntl; moe_tile_bases(F.ctl + CW_MOE + mi * 1024, tb, ntl);
                S.init(ntl * 256, 2 * FFE, F.G, (int)blockIdx.x); S.cap = MOE_CAP; S.avirt = 1;
#pragma unroll
                for (int e = 0; e < NEXP; ++e) S.tb[e] = tb[e];
                pg8::Gemm g{WSP(const unsigned char, WS_HS), WSP(const unsigned char, WS_W_MIN) + (size_t)mi * NEXP * 2 * FFE * DM, ntl * 256, 2 * FFE, DM, (size_t)2 * FFE * DM, STAG_MOE};
                pg8::EpiGlu<true> E{WSP(unsigned char, WS_ACTE), FFE};
                REPS(PROBE_DUP == 4 && L == 3) { REPBAR(); pg8::gemm_phase<pg8::EpiGlu<true>, true>(F.lds, g, S, E); }
                if constexpr (PROBE_DUP == 16 && L == 3) { xcd_barrier(bar); pg8::EpiNull<true> EN{WSP(float, WS_SLOTW)}; pg8::gemm_phase<pg8::EpiNull<true>, true>(F.lds, g, S, EN); }
            } else {
                S.init(MTOK, 2 * FFD, F.G, (int)blockIdx.x);
                pg8::Gemm g{WSP(const unsigned char, WS_H), WSP(const unsigned char, WS_W_FIN) + (size_t)mi * 2 * FFD * DM * 2, MTOK, 2 * FFD, DM, 0};
                pg8::EpiGlu<DF8(L), DF8O(L)> E{WSP(unsigned char, WS_ACTD), FFD};
                REPS(PROBE_DUP == 10 && L == 2) { REPBAR(); pg8::gemm_phase<pg8::EpiGlu<DF8(L), DF8O(L)>, DF8(L)>(F.lds, g, S, E); }
            }
            SEAM(pb + 6);
        }
        if (IN(pb + 7) && !DIS_K7) {
            const int mi = L >> 1;
            if constexpr (L & 1) {
                int tb[NEXP], ntl; moe_tile_bases(F.ctl + CW_MOE + mi * 1024, tb, ntl);
                pg8::Order S; S.init(ntl * 256, DM, F.G, (int)blockIdx.x); S.cap = MOE_CAP;
#pragma unroll
                for (int e = 0; e < NEXP; ++e) S.tb[e] = tb[e];
                pg8::Gemm g{WSP(const unsigned char, WS_ACTE), WSP(const unsigned char, WS_W_MOUT) + (size_t)mi * NEXP * DM * FFE, ntl * 256, DM, FFE, (size_t)DM * FFE};
                pg8::EpiMoeOut E{WSP(f16, WS_Y2), WSP(const float, WS_SLOTW)};
                REPS(PROBE_DUP == 5 && L == 3) { REPBAR(); pg8::gemm_phase<pg8::EpiMoeOut, true>(F.lds, g, S, E); }
            } else {
                pg8::Order S; S.init(MTOK, DM, F.G, (int)blockIdx.x);
                pg8::Gemm g{WSP(const unsigned char, WS_ACTD), WSP(const unsigned char, WS_W_FOUT) + (size_t)mi * DM * FFD * 2, MTOK, DM, FFD, 0};
                pg8::EpiY E{WSP(f16, WS_YB), WSP(const float, WS_MOD) + (size_t)L * 16 * 6144 + 5120, DF8O(L) ? 1.0f / (F8_WSCALE * F8_ASCALE) : 1.0f};
                REPS(PROBE_DUP == 11 && L == 2) { REPBAR(); pg8::gemm_phase<pg8::EpiY, DF8O(L)>(F.lds, g, S, E); }
            }
            SEAM(pb + 7);
        }
}
__global__ void __launch_bounds__(512, 2) mk_fwd(Args args) {
    extern __shared__ __attribute__((aligned(16))) unsigned char lds_raw[];
    Frame F;
    F.lds = (LAS unsigned char*)lds_raw;
    F.wave = __builtin_amdgcn_readfirstlane((int)threadIdx.x >> 6);
    F.G = gridDim.x; { const int bx = blockIdx.x; F.vcu = (F.G % 8 == 0) ? (bx % 8) * (F.G / 8) + bx / 8 : bx; }
    F.ws = args.ws; F.ctl = (unsigned*)(args.ws + WS_CTL);
    volatile LAS unsigned* MISC = (volatile LAS unsigned*)(F.lds + MISC_OFF);
    if (threadIdx.x < 64) ((LAS unsigned*)(F.lds + MISC_OFF))[threadIdx.x] = 0u;
    __syncthreads();
    XcdBarrier bar; bar.bar = F.ctl + CW_BAR; bar.x = 0; bar.st = nullptr;
    if (!MK_PER_PHASE) bar = xcd_barrier_post(F.ctl + CW_BAR, MISC + 8);
    const int lo = args.ph_lo, hi = args.ph_hi;

    if (IN(0)) {
#ifndef NO_P0
        REPS(PROBE_DUP == 1) { REPBAR(); p0_prologue(F); }
#endif
        SEAM(0);
    }
    layer_phases<0>(F, bar, lo, hi); layer_phases<1>(F, bar, lo, hi); layer_phases<2>(F, bar, lo, hi); layer_phases<3>(F, bar, lo, hi);
    if (IN(33)) {
        NormArgs A{}; A.x = WSP(const f16, WS_X); A.xw = WSP(f16, WS_X); A.gain = KIN(21); A.out = (float*)karg<22>();
        A.y2 = WSP(const f16, WS_Y2); A.gcnt = F.ctl + CW_MOE + 1024; A.tokinfo = WSP(unsigned, WS_TOKINFO); A.gatef = WSP(const float, WS_MOD) + (size_t)3 * 16 * 6144 + 5120;
        REPSN(PROBE_DUP == 14, 5) { REPBAR(); norm_phase<true, false, true, false>(F, A); }
        if constexpr (PROBE_DUP == 24) { _Pragma("unroll 1") for (int i = 0; i < 40; ++i) xcd_barrier(bar); }
        if constexpr (PROBE_DUP == 20 || PROBE_DUP == 21) {
            xcd_barrier(bar);
            f16x8 a = {(f16)1.f, (f16)0.5f, (f16)0.25f, (f16)1.f, (f16)1.f, (f16)0.5f, (f16)0.25f, (f16)1.f}, b = a;
            f32x16 acc[4];
#pragma unroll
            for (int i = 0; i < 4; ++i)
#pragma unroll
                for (int j = 0; j < 16; ++j) acc[i][j] = 0.f;
            f32x4 acc16[8];
#pragma unroll
            for (int i = 0; i < 8; ++i) acc16[i] = (f32x4){0.f, 0.f, 0.f, 0.f};
            for (int it = 0; it < (PROBE_DUP == 20 ? 16384 : 8192); ++it) {
                if constexpr (PROBE_DUP == 20) {
#pragma unroll
                    for (int i = 0; i < 4; ++i) acc[i] = __builtin_amdgcn_mfma_f32_32x32x16_f16(a, b, acc[i], 0, 0, 0);
                } else {
#pragma unroll
                    for (int i = 0; i < 8; ++i) acc16[i] = __builtin_amdgcn_mfma_f32_16x16x32_f16(a, b, acc16[i], 0, 0, 0);
                }
            }
            float sacc = 0.f;
#pragma unroll
            for (int i = 0; i < 4; ++i) sacc += acc[i][0] + acc16[i][0] + acc16[4 + i][1];
            if (sacc == 1.2345e37f) WSP(float, WS_SLOTW)[0] = sacc;
        }
    }
#undef IN
#undef SEAM
#undef WSP
}

extern "C" void kernel_launch(void* const* d_in, const int* in_sizes, int n_in, void* d_out, int out_size, void* d_ws, size_t ws_size, hipStream_t stream) {
    static int grid = 0;
    if (grid == 0) {
        if (n_in != 22 || out_size != MTOK * DM || ws_size < WS_END) { fprintf(stderr, "kernel_launch: unexpected shapes (n_in %d out %d ws %zu, need %zu)\n", n_in, out_size, ws_size, (size_t)WS_END); grid = -1; return; }
        int dev = 0, cus = 0;
        if (hipGetDevice(&dev) != hipSuccess || hipDeviceGetAttribute(&cus, hipDeviceAttributeMultiprocessorCount, dev) != hipSuccess) { grid = -1; return; }
        if (hipFuncSetAttribute((const void*)mk_fwd, hipFuncAttributeMaxDynamicSharedMemorySize, LDS_BYTES) != hipSuccess) { fprintf(stderr, "kernel_launch: hipFuncSetAttribute failed\n"); grid = -1; return; }
        int per_cu = 0;
        if (hipOccupancyMaxActiveBlocksPerMultiprocessor(&per_cu, (const void*)mk_fwd, 512, LDS_BYTES) != hipSuccess || per_cu < 1) fprintf(stderr, "kernel_launch: occupancy query reports %d\n", per_cu);
        (void)hipGetLastError();
        if (cus < 256) { fprintf(stderr, "kernel_launch: needs >= 256 CUs, got %d\n", cus); grid = -1; return; }
        grid = cus;
    }
    if (grid < 0) return;
    (void)hipMemsetAsync((char*)d_ws + WS_CTL, 0, CTL_ZERO_BYTES, stream);
    Args a{};
    for (int i = 0; i < 22; ++i) a.in[i] = d_in[i];
    a.out = (float*)d_out; a.ws = (unsigned char*)d_ws;
#if MK_PER_PHASE
    for (int p = 0; p < N_PHASES; ++p) {
        if (p >= 1 && p <= 32) { const int L = (p - 1) / 8, k = (p - 1) % 8; if (k == 5) continue; (void)L; }
        a.ph_lo = p; a.ph_hi = p + 1;
        hipLaunchKernelGGL(mk_fwd, dim3(grid), dim3(512), LDS_BYTES, stream, a);
    }
#else
    a.ph_lo = 0; a.ph_hi = N_PHASES;
    hipLaunchKernelGGL(mk_fwd, dim3(grid), dim3(512), LDS_BYTES, stream, a);
#endif
}
```

```cpp
#include <hip/hip_runtime.h>
#include <cstdio>
#include <cstdint>

#define LAS __attribute__((address_space(3)))
#define GAS __attribute__((address_space(1)))
typedef _Float16 f16;
typedef _Float16 f16x2 __attribute__((ext_vector_type(2)));
typedef _Float16 f16x4 __attribute__((ext_vector_type(4)));
typedef _Float16 f16x8 __attribute__((ext_vector_type(8)));
typedef float f32x2 __attribute__((ext_vector_type(2)));
typedef float f32x4 __attribute__((ext_vector_type(4)));
typedef float f32x16 __attribute__((ext_vector_type(16)));
typedef unsigned u32x2 __attribute__((ext_vector_type(2)));
typedef unsigned u32x4 __attribute__((ext_vector_type(4)));
typedef short v4i16_t __attribute__((ext_vector_type(4)));
typedef int i32x8 __attribute__((ext_vector_type(8)));
typedef int i32x4 __attribute__((ext_vector_type(4)));

#ifndef DIS_K0
#define DIS_K0 0
#endif
#ifndef DIS_K1
#define DIS_K1 0
#endif
#ifndef DIS_K2
#define DIS_K2 0
#endif
#ifndef DIS_K3
#define DIS_K3 0
#endif
#ifndef DIS_K4
#define DIS_K4 0
#endif
#ifndef DIS_K5
#define DIS_K5 0
#endif
#ifndef DIS_K6
#define DIS_K6 0
#endif
#ifndef DIS_K7
#define DIS_K7 0
#endif
#ifndef PROBE_DUP
#define PROBE_DUP 0
#endif
#ifndef DENSE_F8
#define DENSE_F8 1
#define DF8(L) (DENSE_F8 != 0 && (L) == 2)
#ifndef DENSE_F8_OUT
#define DENSE_F8_OUT 0
#endif
#define DF8O(L) (DF8(L) && DENSE_F8_OUT != 0)
#endif
#ifndef RETIN_F8
#define RETIN_F8 0
#endif
#ifndef STAG_MOE
#define STAG_MOE 0
#endif
#ifndef STAG_RET
#define STAG_RET 0
#endif
#ifndef CONV_IN_SCAN
#define CONV_IN_SCAN 1
#endif
#ifndef MK_PER_PHASE
#define MK_PER_PHASE 0
#endif

constexpr int BATCH = 16, SEQ = 2048, DM = 1024, MTOK = BATCH * SEQ;
constexpr int RH = 8, RDK = 128, RDV = 256, RIN = 6144, CHUNK = 64, NCHUNK = SEQ / CHUNK;
constexpr int SBH = 16, SDH = 64;
constexpr int FFD = 2816, NEXP = 8, FFE = 3584;
constexpr float EPS = 1e-6f;
constexpr int MOE_ROWS_MAX = 2 * MTOK + NEXP * 256;

__device__ __forceinline__ float lg2gamma(int h) {
    const float t[8] = {-4.580368961312e-02f, -2.272007650008e-02f, -1.131531322783e-02f, -5.646563141142e-03f, -2.820519062379e-03f, -1.409570254671e-03f, -7.046129765894e-04f, -3.522634716290e-04f};
    float r = t[0];
#pragma unroll
    for (int i = 1; i < 8; ++i) r = (h == i) ? t[i] : r;
    return r;
}
__device__ __forceinline__ unsigned pkh(float lo, float hi) { f32x2 v = {lo, hi}; f16x2 h = __builtin_convertvector(v, f16x2); return __builtin_bit_cast(unsigned, h); }
__device__ __forceinline__ float silu_f(float x) { return x * __builtin_amdgcn_rcpf(1.0f + __builtin_amdgcn_exp2f(-1.4426950408889634f * x)); }
__device__ __forceinline__ float ex2(float x) { return __builtin_amdgcn_exp2f(x); }
__device__ __forceinline__ unsigned pk4f8(float a, float b, float c, float d) { int w = 0; w = __builtin_amdgcn_cvt_pk_fp8_f32(a, b, w, false); w = __builtin_amdgcn_cvt_pk_fp8_f32(c, d, w, true); return (unsigned)w; }
constexpr float F8_WSCALE = 64.0f;
constexpr float F8_ASCALE = 4.0f;

namespace pg8 {
constexpr int BM = 256, BK = 64, HALF = 128, HTB = HALF * BK * 2, STAGE_BYTES = 8 * HTB, NXCD = 8, WGM = 8;
__host__ __device__ __forceinline__ int lds_byte(int r, int c) { const int st = (r >> 4) * 2 + (c >> 5), rr = r & 15, cc = c & 31, ob = rr * 64 + cc * 2; return st * 1024 + (ob ^ (((ob >> 9) & 1) << 5)); }
__host__ __device__ __forceinline__ void stage_rc(int b, int& R, int& C) { const int st = b / 1024, sb = b % 1024, swz = sb ^ (((sb >> 9) & 1) << 5); R = (st >> 1) * 16 + swz / 64; C = (st & 1) * 32 + (swz % 64) / 2; }
__host__ __device__ __forceinline__ int perm32(int rho) { const int n = rho >> 4, i = rho & 15; return 8 * (i >> 2) + 4 * n + (i & 3); }

struct Unit { int pm, pn, be, arow, vrow; };
struct Gemm { const void* A; const void* Bt; int M, N, K; size_t bstride; int stagger = 0; };

struct Order {
    int nM, nN, nwg, G, c; int tb[NEXP]; int cap, avirt;
    __device__ void init(int M, int N, int G_, int c_) { nM = M / BM; nN = N / BM; nwg = nM * nN; G = G_; c = c_; cap = 0; avirt = 0;
#pragma unroll
        for (int e = 0; e < NEXP; ++e) tb[e] = e ? 0x7fffffff : 0; }
    __device__ bool next(int i, Unit& u) const {
        const long L = (long)i * G + c; if (L >= nwg) return false;
        int wgid = (int)L; { const int q = nwg / NXCD, r = nwg % NXCD, xcd = wgid % NXCD, off = wgid / NXCD; wgid = (xcd < r ? xcd * (q + 1) : r * (q + 1) + (xcd - r) * q) + off; }
        const int nig = WGM * nN, gid = wgid / nig, fm = gid * WGM, gsz = (nM - fm) < WGM ? (nM - fm) : WGM;
        u.pm = fm + ((wgid % nig) % gsz); u.pn = (wgid % nig) / gsz;
        int be = 0;
#pragma unroll
        for (int e = 1; e < NEXP; ++e) be += (u.pm >= tb[e]) ? 1 : 0;
        u.be = be;
        int tbe = 0;
#pragma unroll
        for (int e = 1; e < NEXP; ++e) tbe = (be == e) ? tb[e] : tbe;
        u.vrow = cap ? be * cap + (u.pm - tbe) * BM : u.pm * BM; u.arow = avirt ? u.vrow : u.pm * BM;
        return true;
    }
};


struct EpiRetIn {
    static constexpr bool PERM = true; static constexpr int NST = 16;
    f16* O; const float* rope; float scl;
    __device__ __forceinline__ void operator()(const f32x4 (&acc)[2][2][4][2], const Unit& u, int wr, int wc, int fr, int fq) const {
        const int row0 = u.pm * BM + wr * 64 + fr, cl = wc * 32 + 8 * fq;
        f16* base = O + (size_t)u.pn * BM + cl;
        if (u.pn < 8) {
            const bool isk = u.pn >= 4; const int i0 = cl >> 1;
            float lg[2]; lg[0] = lg2gamma(2 * (u.pn & 3)); lg[1] = lg2gamma(2 * (u.pn & 3) + 1);
            f32x4 cs_n = *(const f32x4*)(rope + (size_t)row0 * 128 + i0), sn_n = *(const f32x4*)(rope + (size_t)row0 * 128 + 64 + i0);
#pragma unroll
            for (int ai = 0; ai < 2; ++ai)
#pragma unroll
                for (int m = 0; m < 4; ++m) {
                    const int row = row0 + ai * HALF + m * 16; const float pos = (float)(16 * m + fr);
                    const f32x4 cs = cs_n, sn = sn_n;
                    if (ai * 4 + m < 7) { const int rown = row0 + ((ai * 4 + m + 1) >> 2) * HALF + ((ai * 4 + m + 1) & 3) * 16;
                        cs_n = *(const f32x4*)(rope + (size_t)rown * 128 + i0); sn_n = *(const f32x4*)(rope + (size_t)rown * 128 + 64 + i0); }
#pragma unroll
                    for (int bj = 0; bj < 2; ++bj) {
                        const float sc = (isk ? ex2(-pos * lg[bj]) * 0.08838834764831845f : ex2((pos + 1.0f) * lg[bj])) * scl;
                        const f32x4 v0 = acc[ai][bj][m][0], v1 = acc[ai][bj][m][1];
                        u32x4 w;
                        w.x = pkh((v0[0] * cs[0] - v0[1] * sn[0]) * sc, (v0[0] * sn[0] + v0[1] * cs[0]) * sc);
                        w.y = pkh((v0[2] * cs[1] - v0[3] * sn[1]) * sc, (v0[2] * sn[1] + v0[3] * cs[1]) * sc);
                        w.z = pkh((v1[0] * cs[2] - v1[1] * sn[2]) * sc, (v1[0] * sn[2] + v1[1] * cs[2]) * sc);
                        w.w = pkh((v1[2] * cs[3] - v1[3] * sn[3]) * sc, (v1[2] * sn[3] + v1[3] * cs[3]) * sc);
                        *(u32x4*)(base + (size_t)row * RIN + bj * HALF) = w;
                    }
                }
        } else {
            const bool isg = u.pn >= 16;
#pragma unroll
            for (int ai = 0; ai < 2; ++ai)
#pragma unroll
                for (int m = 0; m < 4; ++m) {
                    const int row = row0 + ai * HALF + m * 16;
#pragma unroll
                    for (int bj = 0; bj < 2; ++bj) {
                        f32x4 v0 = acc[ai][bj][m][0] * scl, v1 = acc[ai][bj][m][1] * scl;
                        if (isg) {
#pragma unroll
                            for (int j = 0; j < 4; ++j) { v0[j] = silu_f(v0[j]); v1[j] = silu_f(v1[j]); } }
                        u32x4 w; w.x = pkh(v0[0], v0[1]); w.y = pkh(v0[2], v0[3]); w.z = pkh(v1[0], v1[1]); w.w = pkh(v1[2], v1[3]);
                        *(u32x4*)(base + (size_t)row * RIN + bj * HALF) = w;
                    }
                }
        }
    }
};
struct EpiY {
    static constexpr bool PERM = true; static constexpr int NST = 16;
    f16* Y; const float* gate; float scl;
    __device__ __forceinline__ void operator()(const f32x4 (&acc)[2][2][4][2], const Unit& u, int wr, int wc, int fr, int fq) const {
        const int row0 = u.pm * BM + wr * 64 + fr, col0 = u.pn * BM + wc * 32 + 8 * fq;
        const float* gp = gate + (size_t)(u.pm >> 3) * 6144 + col0;
        f32x4 gv[2][2];
#pragma unroll
        for (int bj = 0; bj < 2; ++bj)
#pragma unroll
            for (int n = 0; n < 2; ++n) gv[bj][n] = *(const f32x4*)(gp + bj * HALF + 4 * n) * scl;
#pragma unroll
        for (int ai = 0; ai < 2; ++ai)
#pragma unroll
            for (int m = 0; m < 4; ++m) { f16* rowp = Y + (size_t)(row0 + ai * HALF + m * 16) * DM + col0;
#pragma unroll
                for (int bj = 0; bj < 2; ++bj) { const f32x4 v0 = acc[ai][bj][m][0] * gv[bj][0], v1 = acc[ai][bj][m][1] * gv[bj][1];
                    u32x4 w; w.x = pkh(v0[0], v0[1]); w.y = pkh(v0[2], v0[3]); w.z = pkh(v1[0], v1[1]); w.w = pkh(v1[2], v1[3]);
                    *(u32x4*)(rowp + bj * HALF) = w; } }
    }
};
template <bool F8IN, bool F8 = F8IN> struct EpiGlu {
    static constexpr bool PERM = true; static constexpr int NST = 8;
    void* Ov; int ldc;
    __device__ __forceinline__ void operator()(const f32x4 (&acc)[2][2][4][2], const Unit& u, int wr, int wc, int fr, int fq) const {
        const int row0 = u.pm * BM + wr * 64 + fr, col0 = u.pn * HALF + wc * 32 + 8 * fq;
        constexpr float si = F8IN ? 1.0f / F8_WSCALE : 1.0f, so = F8 ? F8_ASCALE : 1.0f;
#pragma unroll
        for (int ai = 0; ai < 2; ++ai)
#pragma unroll
            for (int m = 0; m < 4; ++m) {
                float r[8];
#pragma unroll
                for (int n = 0; n < 2; ++n)
#pragma unroll
                    for (int p = 0; p < 2; ++p) {
                        const f32x2 a = {acc[ai][0][m][n][2 * p], acc[ai][0][m][n][2 * p + 1]}, b = {acc[ai][1][m][n][2 * p], acc[ai][1][m][n][2 * p + 1]};
                        const f32x2 t = a * (-1.4426950408889634f * si); f32x2 d = {ex2(t.x), ex2(t.y)}; d = d + 1.0f;
                        const f32x2 u = {__builtin_amdgcn_rcpf(d.x), __builtin_amdgcn_rcpf(d.y)};
                        const f32x2 q = ((a * b) * u) * (si * si * so);
                        r[4 * n + 2 * p] = q.x; r[4 * n + 2 * p + 1] = q.y;
                    }
                if (F8) { u32x2 w; w.x = pk4f8(r[0], r[1], r[2], r[3]); w.y = pk4f8(r[4], r[5], r[6], r[7]);
                    *(u32x2*)((unsigned char*)Ov + (size_t)(row0 + ai * HALF + m * 16) * ldc + col0) = w; }
                else { u32x4 w; w.x = pkh(r[0], r[1]); w.y = pkh(r[2], r[3]); w.z = pkh(r[4], r[5]); w.w = pkh(r[6], r[7]);
                    *(u32x4*)((f16*)Ov + (size_t)(row0 + ai * HALF + m * 16) * ldc + col0) = w; }
            }
    }
};
struct EpiF16 {
    static constexpr bool PERM = true; static constexpr int NST = 16;
    f16* O; int ldc; int split_cols; size_t split_stride; float scale;
    __device__ __forceinline__ void operator()(const f32x4 (&acc)[2][2][4][2], const Unit& u, int wr, int wc, int fr, int fq) const {
        const int row0 = u.pm * BM + wr * 64 + fr; int colt = u.pn * BM; f16* base = O;
        if (split_cols) { const int t = colt / split_cols; base += (size_t)t * split_stride; colt -= t * split_cols; }
        const int col0 = colt + wc * 32 + 8 * fq;
#pragma unroll
        for (int ai = 0; ai < 2; ++ai)
#pragma unroll
            for (int m = 0; m < 4; ++m) { f16* rowp = base + (size_t)(row0 + ai * HALF + m * 16) * ldc + col0;
#pragma unroll
                for (int bj = 0; bj < 2; ++bj) { const f32x4 v0 = acc[ai][bj][m][0] * scale, v1 = acc[ai][bj][m][1] * scale;
                    u32x4 w; w.x = pkh(v0[0], v0[1]); w.y = pkh(v0[2], v0[3]); w.z = pkh(v1[0], v1[1]); w.w = pkh(v1[2], v1[3]);
                    *(u32x4*)(rowp + bj * HALF) = w; } }
    }
};
struct EpiMoeOut {
    static constexpr bool PERM = true; static constexpr int NST = 16;
    f16* O; const float* roww;
    __device__ __forceinline__ void operator()(const f32x4 (&acc)[2][2][4][2], const Unit& u, int wr, int wc, int fr, int fq) const {
        const int row0 = u.pm * BM + wr * 64 + fr, col0 = u.pn * BM + wc * 32 + 8 * fq;
        float scw[2][4];
#pragma unroll
        for (int ai = 0; ai < 2; ++ai)
#pragma unroll
            for (int m = 0; m < 4; ++m) scw[ai][m] = roww[u.vrow + wr * 64 + fr + ai * HALF + m * 16];
#pragma unroll
        for (int ai = 0; ai < 2; ++ai)
#pragma unroll
            for (int m = 0; m < 4; ++m) { const int rl = wr * 64 + fr + ai * HALF + m * 16, row = u.pm * BM + rl; const float sc = scw[ai][m] * (1.0f / (F8_WSCALE * F8_ASCALE)); f16* rowp = O + (size_t)row * DM + col0;
#pragma unroll
                for (int bj = 0; bj < 2; ++bj) { const f32x4 v0 = acc[ai][bj][m][0] * sc, v1 = acc[ai][bj][m][1] * sc;
                    u32x4 w; w.x = pkh(v0[0], v0[1]); w.y = pkh(v0[2], v0[3]); w.z = pkh(v1[0], v1[1]); w.w = pkh(v1[2], v1[3]);
                    *(u32x4*)(rowp + bj * HALF) = w; } }
    }
};

template <bool P> struct EpiNull {
    static constexpr bool PERM = P; static constexpr int NST = 0;
    float* sink;
    __device__ __forceinline__ void operator()(const f32x4 (&acc)[2][2][4][2], const Unit& u, int wr, int wc, int fr, int fq) const {
        float s = 0.f;
#pragma unroll
        for (int ai = 0; ai < 2; ++ai)
#pragma unroll
            for (int bj = 0; bj < 2; ++bj)
#pragma unroll
                for (int m = 0; m < 4; ++m)
#pragma unroll
                    for (int n = 0; n < 2; ++n) s += acc[ai][bj][m][n][0] + acc[ai][bj][m][n][1] + acc[ai][bj][m][n][2] + acc[ai][bj][m][n][3];
        if (s == 1.2345e37f) sink[0] = s;
    }
};
template <class Epi, bool F8 = false>
__device__ __forceinline__ void gemm_phase(LAS unsigned char* lds, const Gemm g, const Order& S, const Epi& E) {
    const int tid = threadIdx.x, wid = __builtin_amdgcn_readfirstlane(tid >> 6), lane = tid & 63, wr = wid >> 2, wc = wid & 3, fr = lane & 15, fq = lane >> 4;
    const int KB = g.K * (F8 ? 1 : 2), nt = KB / 128;
    unsigned voffA[2], voffB[2];
#pragma unroll
    for (int i = 0; i < 2; ++i) { int R, C; stage_rc(tid * 16 + i * 8192, R, C); const int Rb = Epi::PERM ? ((R & ~31) + perm32(R & 31)) : R;
        voffA[i] = (unsigned)(R * KB + 2 * C); voffB[i] = (unsigned)(Rb * KB + 2 * C); }
    const size_t kstep = (size_t)(BK * 2);
    const size_t hstep = (size_t)HALF * KB;
    const size_t tstep = 2 * hstep;
    const unsigned ldsw = (unsigned)wid * 1024u;
    const int aoff = lds_byte(wr * 64 + fr, fq * 8), boff = lds_byte(wc * 32 + fr, fq * 8);
#define PG8_SA(b, h) (((b) * 2 + (h)) * HTB)
#define PG8_SB(b, h) ((4 + (b) * 2 + (h)) * HTB)
#define PG8_STAGE(bufoff, gbase, voff) do { _Pragma("unroll") for (int _i = 0; _i < 2; ++_i) \
        __builtin_amdgcn_global_load_lds((const unsigned*)((const char*)(gbase) + (voff)[_i]), (LAS unsigned*)(lds + (bufoff) + ldsw + _i * 8192), 16, 0, 0); } while (0)
#define PG8_LD8(dst, addr) do { const i32x4 lo_ = *(const LAS i32x4*)(addr), hi_ = *(const LAS i32x4*)((addr) + 1024); dst = __builtin_shufflevector(lo_, hi_, 0, 1, 2, 3, 4, 5, 6, 7); } while (0)
#define PG8_LDA(dst, b, h) do { _Pragma("unroll") for (int m = 0; m < 4; ++m) { if constexpr (F8) PG8_LD8(dst##8[m], lds + PG8_SA(b, h) + aoff + m * 2048); else { _Pragma("unroll") for (int k = 0; k < 2; ++k) dst[m][k] = *(const LAS f16x8*)(lds + PG8_SA(b, h) + aoff + m * 2048 + k * 1024); } } } while (0)
#define PG8_LDB(dst, b, h) do { _Pragma("unroll") for (int n = 0; n < 2; ++n) { if constexpr (F8) PG8_LD8(dst##8[n], lds + PG8_SB(b, h) + boff + n * 2048); else { _Pragma("unroll") for (int k = 0; k < 2; ++k) dst[n][k] = *(const LAS f16x8*)(lds + PG8_SB(b, h) + boff + n * 2048 + k * 1024); } } } while (0)
#define PG8_MMA(ai, bj, At, Bt) do { __builtin_amdgcn_s_setprio(1); _Pragma("unroll") for (int m = 0; m < 4; ++m) _Pragma("unroll") for (int n = 0; n < 2; ++n) { \
        if constexpr (F8) asm volatile("v_mfma_scale_f32_16x16x128_f8f6f4 %0, %1, %2, %0, %3, %3 op_sel_hi:[0,0,0]" : "+v"(acc[ai][bj][m][n]) : "v"(Bt##8[n]), "v"(At##8[m]), "v"(f8scale)); \
        else { _Pragma("unroll") for (int k = 0; k < 2; ++k) acc[ai][bj][m][n] = __builtin_amdgcn_mfma_f32_16x16x32_f16(Bt[n][k], At[m][k], acc[ai][bj][m][n], 0, 0, 0); } } \
        __builtin_amdgcn_s_setprio(0); } while (0)
#define PG8_WAIT_V(n) asm volatile("s_waitcnt vmcnt(" #n ")" ::: "memory")
#define PG8_WAIT_VR() asm volatile("s_waitcnt vmcnt(%0)" :: "n"(8 + Epi::NST) : "memory")
#define PG8_WAIT_L(n) asm volatile("s_waitcnt lgkmcnt(" #n ")" ::: "memory")
#define PG8_BAR __builtin_amdgcn_s_barrier()
#define PG8_SCHED __builtin_amdgcn_sched_barrier(0)
    Unit cur, nxt; int ui = 0; bool relax = false;
    if (!S.next(0, cur)) return;
    if (g.stagger) {
        const unsigned grp = (blockIdx.x >> 3) & 3u;
        if (grp) { const unsigned long long t0 = __builtin_amdgcn_s_memrealtime(); while (__builtin_amdgcn_s_memrealtime() - t0 < (unsigned long long)(grp * (unsigned)g.stagger)) __builtin_amdgcn_s_sleep(16); }
    }
    f32x4 acc[2][2][4][2];
#pragma unroll
    for (int a = 0; a < 2; ++a)
#pragma unroll
        for (int b = 0; b < 2; ++b)
#pragma unroll
            for (int m = 0; m < 4; ++m)
#pragma unroll
                for (int n = 0; n < 2; ++n) acc[a][b][m][n] = (f32x4){0.f, 0.f, 0.f, 0.f};
    const int f8scale = 0x7f7f7f7f;
    f16x8 At[4][2], B0[2][2], B1[2][2]; i32x8 At8[4], B08[2], B18[2];
    const char* cA = (const char*)g.A + (size_t)cur.arow * KB; const char* cB = (const char*)g.Bt + (size_t)cur.be * g.bstride + (size_t)cur.pn * tstep;
    PG8_STAGE(PG8_SB(0, 0), cB, voffB); PG8_STAGE(PG8_SB(0, 1), cB + hstep, voffB); PG8_STAGE(PG8_SA(0, 0), cA, voffA); PG8_STAGE(PG8_SA(0, 1), cA + hstep, voffA);
    if (wr == 1) PG8_BAR;
    PG8_WAIT_V(2); PG8_BAR;
    PG8_STAGE(PG8_SB(1, 0), cB + kstep, voffB); PG8_STAGE(PG8_SA(1, 0), cA + kstep, voffA); PG8_STAGE(PG8_SB(1, 1), cB + hstep + kstep, voffB);
    PG8_WAIT_V(6); PG8_BAR;
    for (;;) {
        const bool has_next = S.next(ui + 1, nxt);
        const char* nA = has_next ? (const char*)g.A + (size_t)nxt.arow * KB : cA; const char* nB = has_next ? (const char*)g.Bt + (size_t)nxt.be * g.bstride + (size_t)nxt.pn * tstep : cB;
#pragma nounroll
        for (int t = 0; t < nt; t += 2) {
            const bool last = (t == nt - 2);
            const char* a1 = cA + (size_t)(t + 1) * kstep;
            const char* a2 = last ? nA : cA + (size_t)(t + 2) * kstep; const char* b2 = last ? nB : cB + (size_t)(t + 2) * kstep;
            const char* a3 = a2 + kstep; const char* b3 = b2 + kstep;
            PG8_LDB(B0, 0, 0); PG8_LDB(B1, 0, 1); PG8_SCHED; PG8_LDA(At, 0, 0); PG8_STAGE(PG8_SA(1, 1), a1 + hstep, voffA);
            if (relax) PG8_WAIT_VR(); else PG8_WAIT_V(8);
            PG8_WAIT_L(0); PG8_BAR; PG8_MMA(0, 0, At, B0); PG8_MMA(0, 1, At, B1); PG8_BAR; PG8_SCHED;
            PG8_LDA(At, 0, 1); PG8_STAGE(PG8_SB(0, 0), b2, voffB); PG8_STAGE(PG8_SB(0, 1), b2 + hstep, voffB); PG8_STAGE(PG8_SA(0, 0), a2, voffA);
            if (relax) { PG8_WAIT_VR(); relax = false; } else PG8_WAIT_V(8);
            PG8_WAIT_L(0); PG8_BAR; PG8_MMA(1, 0, At, B0); PG8_MMA(1, 1, At, B1); PG8_BAR; PG8_SCHED;
            PG8_LDB(B0, 1, 0); PG8_LDB(B1, 1, 1); PG8_SCHED; PG8_LDA(At, 1, 0); PG8_STAGE(PG8_SA(0, 1), a2 + hstep, voffA);
            PG8_WAIT_V(8); PG8_WAIT_L(0); PG8_BAR; PG8_MMA(0, 0, At, B0); PG8_MMA(0, 1, At, B1); PG8_BAR; PG8_SCHED;
            PG8_LDA(At, 1, 1); PG8_STAGE(PG8_SB(1, 0), b3, voffB); PG8_STAGE(PG8_SB(1, 1), b3 + hstep, voffB); PG8_STAGE(PG8_SA(1, 0), a3, voffA);
            PG8_WAIT_V(8); PG8_WAIT_L(0); PG8_BAR; PG8_MMA(1, 0, At, B0); PG8_MMA(1, 1, At, B1); PG8_BAR; PG8_SCHED;
        }
        if constexpr (F8) asm volatile("s_nop 15\n\ts_nop 15" ::: "memory");
        if (wr == 0) PG8_BAR;
        E(acc, cur, wr, wc, fr, fq);
        if (!has_next) break;
#pragma unroll
        for (int a = 0; a < 2; ++a)
#pragma unroll
            for (int b = 0; b < 2; ++b)
#pragma unroll
                for (int m = 0; m < 4; ++m)
#pragma unroll
                    for (int n = 0; n < 2; ++n) acc[a][b][m][n] = (f32x4){0.f, 0.f, 0.f, 0.f};
        cur = nxt; cA = nA; cB = nB; ++ui; relax = true;
        if (wr == 1) PG8_BAR;
    }
    PG8_WAIT_V(0);
    PG8_BAR;
#undef PG8_SA
#undef PG8_SB
#undef PG8_STAGE
#undef PG8_LDA
#undef PG8_LDB
#undef PG8_MMA
#undef PG8_WAIT_V
#undef PG8_WAIT_L
#undef PG8_BAR
#undef PG8_SCHED
}
}

constexpr size_t MiB = 1u << 20;
constexpr size_t WS_CTL = 0, CTL_ZERO_BYTES = 1 * MiB;
constexpr size_t WS_MOD = 1 * MiB;
constexpr size_t WS_KVMOD = 3 * MiB;
constexpr size_t WS_TOKINFO = 4 * MiB;
constexpr size_t WS_TOKSLOT = 6 * MiB;
constexpr size_t WS_SLOTW = 7 * MiB;
constexpr size_t WS_ROPE = 8 * MiB;
constexpr size_t WS_W_RIN = 24 * MiB, WS_W_ROUT = 48 * MiB, WS_W_KV = 56 * MiB, WS_W_SQ = 60 * MiB, WS_W_SO = 64 * MiB, WS_W_FIN = 68 * MiB, WS_W_FOUT = 90 * MiB, WS_W_MIN = 101 * MiB, WS_W_MOUT = 325 * MiB;
constexpr size_t WS_X = 437 * MiB, WS_H = 565 * MiB, WS_KSH = 629 * MiB, WS_VSH = 693 * MiB, WS_BIG = 757 * MiB;
constexpr size_t WS_PROJ = WS_BIG, WS_AO = WS_BIG + 384 * MiB;
constexpr size_t WS_ACTD = WS_BIG;
constexpr int MOE_CAP = MTOK;
constexpr size_t WS_HS = WS_BIG, WS_Y2 = WS_BIG, WS_ACTE = WS_BIG + 256 * MiB;
constexpr size_t WS_SQ = WS_BIG, WS_SO = WS_BIG + 64 * MiB, WS_HK = WS_BIG + 192 * MiB;
constexpr size_t WS_YB = WS_BIG + 594 * MiB;
constexpr size_t WS_END = WS_YB + 64 * MiB;
static_assert((size_t)MOE_ROWS_MAX * DM * 2 <= 256 * MiB && (size_t)NEXP * MOE_CAP * DM <= 256 * MiB && WS_ACTE + (size_t)MOE_ROWS_MAX * FFE <= WS_YB && WS_AO + (size_t)MTOK * 2048 * 2 <= WS_YB, "ws map");
constexpr int CW_BAR = 4096;
constexpr int CW_MOE = 16384;

constexpr int RING_BYTES = 131072;
constexpr int LDS_BYTES = 147456;
constexpr int MISC_OFF = LDS_BYTES - 256;

#define XB_TMO      128
#define XB_XCNT(j)  (256  + 64 * (j))
#define XB_XSUB(j)  (1280 + 64 * (j))
#define XB_XGEN(j)  (2304 + 64 * (j))
#define XB_TOP      3328
#define XB_TOPGEN   3392
#define XCD_BAR_WORDS 3456
#define XB_SPIN_CAP (1u << 20)
__device__ __forceinline__ unsigned xb_ld(unsigned* p)              { return __hip_atomic_load(p, __ATOMIC_RELAXED, __HIP_MEMORY_SCOPE_AGENT); }
__device__ __forceinline__ unsigned xb_add(unsigned* p, unsigned v) { return __hip_atomic_fetch_add(p, v, __ATOMIC_RELAXED, __HIP_MEMORY_SCOPE_AGENT); }
__device__ __forceinline__ unsigned xb_xcc_id() { return (unsigned)__builtin_amdgcn_s_getreg((3 << 11) | 20) & 0xFu; }
#define XB_SPIN(cond, bar) do { unsigned _sp = 0; while (cond) { __builtin_amdgcn_s_sleep(1); \
    if ((++_sp & 255u) == 0u) { if (xb_ld(&(bar)[XB_TMO])) break; if (_sp > XB_SPIN_CAP) { atomicAdd(&(bar)[XB_TMO], 1u); break; } } } } while (0)
struct XcdBarrier { unsigned* bar; unsigned x; volatile LAS unsigned* st; };
__device__ __forceinline__ XcdBarrier xcd_barrier_post(unsigned* bar, volatile LAS unsigned* st) {
    XcdBarrier b; b.bar = bar; b.x = xb_xcc_id(); b.st = st;
    if (threadIdx.x == 0) (void)xb_add(&bar[XB_XCNT(b.x)], 1u);
    return b;
}
__device__ __forceinline__ void xcd_barrier_complete(unsigned* bar, unsigned x, unsigned& nloc, unsigned& nx) {
    const unsigned G = gridDim.x * gridDim.y * gridDim.z;
    unsigned sum, cnt, mine, sp = 0u;
    for (;;) {
        sum = 0u; cnt = 0u; mine = 0u;
#pragma unroll
        for (unsigned j = 0; j < 16; ++j) { const unsigned c = xb_ld(&bar[XB_XCNT(j)]); sum += c; cnt += (c > 0u) ? 1u : 0u; mine = (j == x) ? c : mine; }
        if (sum == G) break;
        __builtin_amdgcn_s_sleep(1);
        if ((++sp & 255u) == 0u) { if (xb_ld(&bar[XB_TMO])) break; if (sp > XB_SPIN_CAP) { atomicAdd(&bar[XB_TMO], 1u); break; } }
    }
    nloc = mine > 0u ? mine : 1u; nx = cnt > 0u ? cnt : 1u;
}
__device__ __forceinline__ void xcd_barrier(const XcdBarrier& b) {
    asm volatile("s_waitcnt vmcnt(0)" ::: "memory");
    __syncthreads();
    if (threadIdx.x == 0) {
        unsigned* bar = b.bar;
        __builtin_amdgcn_s_waitcnt(0);
        unsigned nloc = b.st[0], nx = b.st[1];
        if (nloc == 0u) { xcd_barrier_complete(bar, b.x, nloc, nx); b.st[0] = nloc; b.st[1] = nx; }
        const unsigned old = xb_add(&bar[XB_XSUB(b.x)], 1u);
        const unsigned gen = old / nloc;
        if (old + 1u == (gen + 1u) * nloc) {
            __builtin_amdgcn_fence(__ATOMIC_RELEASE, "agent");
            asm volatile("s_waitcnt vmcnt(0)" ::: "memory");
            const unsigned og = xb_add(&bar[XB_TOP], 1u);
            const unsigned tg = og / nx;
            if (og + 1u == (tg + 1u) * nx) xb_add(&bar[XB_TOPGEN], 1u);
            else XB_SPIN(xb_ld(&bar[XB_TOPGEN]) == tg, bar);
            __builtin_amdgcn_fence(__ATOMIC_ACQUIRE, "agent");
            xb_add(&bar[XB_XGEN(b.x)], 1u);
            asm volatile("s_waitcnt vmcnt(0)" ::: "memory");
        } else {
            XB_SPIN(xb_ld(&bar[XB_XGEN(b.x)]) == gen, bar);
            __builtin_amdgcn_fence(__ATOMIC_ACQUIRE, "agent");
            asm volatile("s_waitcnt vmcnt(0)" ::: "memory");
        }
    }
    __syncthreads();
}

#define WG_BAR() do { asm volatile("s_waitcnt lgkmcnt(0)" ::: "memory"); __builtin_amdgcn_s_barrier(); asm volatile("" ::: "memory"); } while (0)
#define CFENCE() asm volatile("" ::: "memory")
__device__ __forceinline__ float wave_sum(float v) {
#pragma unroll
    for (int o = 1; o < 64; o <<= 1) v += __shfl_xor(v, o);
    return v;
}
__device__ __forceinline__ f16x4 tr_read(LAS const unsigned char* p) {
    return __builtin_bit_cast(f16x4, __builtin_amdgcn_ds_read_tr16_b64_v4i16((LAS v4i16_t*)p));
}
__device__ __forceinline__ f16x8 cat8(f16x4 a, f16x4 b) { return (f16x8){a[0], a[1], a[2], a[3], b[0], b[1], b[2], b[3]}; }
__device__ __forceinline__ f16x8 pack8(const f32x16& x, int s) {
    u32x4 w; w.x = pkh(x[8 * s + 0], x[8 * s + 1]); w.y = pkh(x[8 * s + 2], x[8 * s + 3]); w.z = pkh(x[8 * s + 4], x[8 * s + 5]); w.w = pkh(x[8 * s + 6], x[8 * s + 7]);
    return __builtin_bit_cast(f16x8, w);
}

struct Frame {
    LAS unsigned char* lds;
    unsigned* ctl;
    int wave, vcu, G;
    unsigned char* ws;
};
__device__ __forceinline__ int lane_id() { int l; asm volatile("v_mbcnt_lo_u32_b32 %0, -1, 0\n\tv_mbcnt_hi_u32_b32 %0, -1, %0" : "=v"(l)); return l; }
#define PHASE_IDS() const int lane = lane_id(); const int tid = F.wave * 64 + lane; (void)tid

template <int I> __device__ __forceinline__ const void* karg() {
    const auto kp = __builtin_amdgcn_kernarg_segment_ptr();
    unsigned long long v; asm volatile("s_load_dwordx2 %0, %1, %2\n\ts_waitcnt lgkmcnt(0)" : "=s"(v) : "s"(kp), "i"(I * 8) : "memory");
    return (const void*)(const GAS char*)v;
}
#define KIN(i) ((const float*)karg<(i)>())
template <int MAP>
__device__ __forceinline__ int srccol(int n, int N) {
    if (MAP == 1) { if (n >= 2048) return n; const int p = n & 127; return (n & ~127) + (p >> 1) + 64 * (p & 1); }
    if (MAP == 2) { const int F = N >> 1, t = n >> 8, j = n & 255; return (j < 128) ? 128 * t + j : F + 128 * t + (j - 128); }
    return n;
}
template <int MAP, bool F8>
__device__ __forceinline__ void p0_transpose_item(const float* W, int K, int N, void* WT, LAS float* scr, int item, int lane) {
    const int nblk = N / 32, kb = item / nblk, nb = item % nblk, k0 = 64 * kb, n0 = 32 * nb;
    const int sc = srccol<MAP>(n0 + (lane & 31), N);
    const float* wp = W + (size_t)(k0 + (lane >> 5)) * N + sc;
    float v[32];
#pragma unroll
    for (int i = 0; i < 32; ++i) v[i] = __builtin_nontemporal_load(wp + (size_t)(2 * i) * N);
#pragma unroll
    for (int i = 0; i < 32; ++i) scr[(2 * i + (lane >> 5)) * 33 + (lane & 31)] = F8 ? v[i] * F8_WSCALE : v[i];
    asm volatile("s_waitcnt lgkmcnt(0)" ::: "memory");
    if (F8) {
        const int c = lane & 3;
#pragma unroll
        for (int j = 0; j < 2; ++j) { const int n = (lane >> 2) + 16 * j; const LAS float* s = scr + (16 * c) * 33 + n;
            u32x4 o; o.x = pk4f8(s[0 * 33], s[1 * 33], s[2 * 33], s[3 * 33]); o.y = pk4f8(s[4 * 33], s[5 * 33], s[6 * 33], s[7 * 33]);
            o.z = pk4f8(s[8 * 33], s[9 * 33], s[10 * 33], s[11 * 33]); o.w = pk4f8(s[12 * 33], s[13 * 33], s[14 * 33], s[15 * 33]);
            *(u32x4*)((unsigned char*)WT + (size_t)(n0 + n) * K + k0 + 16 * c) = o; }
    } else {
        const int c = lane & 7;
#pragma unroll
        for (int j = 0; j < 4; ++j) { const int n = (lane >> 3) + 8 * j; const LAS float* s = scr + (8 * c) * 33 + n;
            u32x4 o; o.x = pkh(s[0 * 33], s[1 * 33]); o.y = pkh(s[2 * 33], s[3 * 33]); o.z = pkh(s[4 * 33], s[5 * 33]); o.w = pkh(s[6 * 33], s[7 * 33]);
            *(u32x4*)((f16*)WT + (size_t)(n0 + n) * K + k0 + 8 * c) = o; }
    }
    asm volatile("s_waitcnt lgkmcnt(0)" ::: "memory");
}
template <int MAP, bool F8>
__device__ __forceinline__ bool p0_group(int& r, const float* W, int nb, int K, int N, void* WT, LAS float* scr, int lane) {
    const int per = (K / 64) * (N / 32), tot = nb * per;
    if (r >= tot) { r -= tot; return false; }
    const int b = r / per, it = r % per;
    p0_transpose_item<MAP, F8>(W + (size_t)b * K * N, K, N, (unsigned char*)WT + (size_t)b * K * N * (F8 ? 1 : 2), scr, it, lane);
    return true;
}
constexpr int CONV_ITEMS_0 = 8 * (16 * 224 + 56 * 32) + 16 * 192 + 32 * 32;
constexpr int CONV_ITEMS_1 = 8 * (16 * 224 + 56 * 32) + 16 * 64 + 4 * 16 * 32 + 16 * 176 + 44 * 32;
__device__ __forceinline__ void conv_rest(int r, int which, unsigned char* ws, LAS float* scr, int lane) {
    if (which != 1) {
        if (p0_group<2, true>(r, KIN(19), NEXP, 1024, 7168, ws + WS_W_MIN, scr, lane)) return;
        if (p0_group<0, true>(r, KIN(20), NEXP, 3584, 1024, ws + WS_W_MOUT, scr, lane)) return;
        if (p0_group<1, RETIN_F8 != 0>(r, KIN(7) + (size_t)1024 * 6144, 1, 1024, 6144, (f16*)(ws + WS_W_RIN) + (size_t)1024 * 6144, scr, lane)) return;
        if (p0_group<0, false>(r, KIN(9) + (size_t)2048 * 1024, 1, 2048, 1024, (f16*)(ws + WS_W_ROUT) + (size_t)2048 * 1024, scr, lane)) return;
    }
    if (which != 0) {
        if (p0_group<2, true>(r, KIN(19) + (size_t)NEXP * 1024 * 7168, NEXP, 1024, 7168, ws + WS_W_MIN + (size_t)NEXP * 1024 * 7168, scr, lane)) return;
        if (p0_group<0, true>(r, KIN(20) + (size_t)NEXP * 3584 * 1024, NEXP, 3584, 1024, ws + WS_W_MOUT + (size_t)NEXP * 3584 * 1024, scr, lane)) return;
        if (p0_group<0, false>(r, KIN(13), 1, 1024, 2048, (f16*)(ws + WS_W_KV), scr, lane)) return;
        if (p0_group<0, false>(r, KIN(14), 2, 1024, 1024, (f16*)(ws + WS_W_SQ), scr, lane)) return;
        if (p0_group<0, false>(r, KIN(15), 2, 1024, 1024, (f16*)(ws + WS_W_SO), scr, lane)) return;
        if (p0_group<2, DENSE_F8 != 0>(r, KIN(16) + (size_t)1024 * 5632, 1, 1024, 5632, (f16*)(ws + WS_W_FIN) + (size_t)1024 * 5632, scr, lane)) return;
        p0_group<0, (DENSE_F8 != 0 && DENSE_F8_OUT != 0)>(r, KIN(17) + (size_t)2816 * 1024, 1, 2816, 1024, (f16*)(ws + WS_W_FOUT) + (size_t)2816 * 1024, scr, lane);
    }
}
__device__ __forceinline__ void p0_prologue(Frame& F) {
    PHASE_IDS();
    const int gw = F.vcu * 8 + F.wave, NGW = F.G * 8;
    LAS float* condL = (LAS float*)(F.lds);
    LAS float* scr = (LAS float*)(F.lds + 65536 + F.wave * 8448);
    for (int i = tid; i < 16 * 1024; i += 512) { const int b = i >> 10, k = i & 1023; condL[k * 16 + b] = silu_f(KIN(1)[i]); }
    WG_BAR();
    for (int it = gw; it < 1664; it += NGW) {
        const float* W; const float* bias; float* dst; int N, col0;
        if (it < 1536) { const int l = it / 384; col0 = 16 * (it % 384); N = 6144; W = KIN(3) + (size_t)l * 1024 * 6144; bias = KIN(4) + l * 6144; dst = (float*)(F.ws + WS_MOD) + (size_t)l * 16 * 6144; }
        else { col0 = 16 * (it - 1536); N = 2048; W = KIN(10); bias = KIN(11); dst = (float*)(F.ws + WS_KVMOD); }
        const int cl = lane & 3, kg = lane >> 2;
        f32x4 acc[16];
#pragma unroll
        for (int b = 0; b < 16; ++b) acc[b] = (f32x4){0.f, 0.f, 0.f, 0.f};
        const float* wp = W + (size_t)kg * N + col0 + 4 * cl;
#pragma unroll 4
        for (int k16 = 0; k16 < 64; ++k16) {
            const f32x4 w = *(const f32x4*)(wp + (size_t)k16 * 16 * N);
            const LAS f32x4* cp = (const LAS f32x4*)(condL + (16 * k16 + kg) * 16);
            const f32x4 c0 = cp[0], c1 = cp[1], c2 = cp[2], c3 = cp[3];
#pragma unroll
            for (int j = 0; j < 4; ++j) { acc[j] += c0[j] * w; acc[4 + j] += c1[j] * w; acc[8 + j] += c2[j] * w; acc[12 + j] += c3[j] * w; }
        }
        const f32x4 bv = *(const f32x4*)(bias + col0 + 4 * cl);
#pragma unroll
        for (int b = 0; b < 16; ++b) {
            f32x4 v = acc[b];
#pragma unroll
            for (int j = 0; j < 4; ++j) { v[j] += __shfl_xor(v[j], 4); v[j] += __shfl_xor(v[j], 8); v[j] += __shfl_xor(v[j], 16); v[j] += __shfl_xor(v[j], 32); }
            if (kg == 0) *(f32x4*)(dst + (size_t)b * N + col0 + 4 * cl) = v + bv;
        }
    }
    {
        const double e = -(double)lane / 64.0;
        const double invf = exp2(e * 13.287712379549449);
        float* rope = (float*)(F.ws + WS_ROPE); const int* posp = (const int*)karg<2>();
        for (int row = gw; row < MTOK; row += NGW) {
            const double rev = (double)posp[row] * invf * 0.15915494309189535;
            const float fr = (float)(rev - floor(rev));
            rope[(size_t)row * 128 + lane] = __builtin_amdgcn_cosf(fr); rope[(size_t)row * 128 + 64 + lane] = __builtin_amdgcn_sinf(fr);
        }
    }
    constexpr int per_rin = 16 * 192, per_rout = 32 * 32, per_kv = 16 * 64, per_sq = 16 * 32, per_fin = 16 * 176, per_fout = 44 * 32, per_min = 16 * 224, per_mout = 56 * 32;
    constexpr int NITEMS = CONV_IN_SCAN ? (per_rin + per_rout + per_fin + per_fout) : (2 * per_rin + 2 * per_rout + per_kv + 4 * per_sq + 2 * per_fin + 2 * per_fout + 16 * per_min + 16 * per_mout);
    for (int it = gw; it < NITEMS; it += NGW) {
        int r = it;
        if (p0_group<1, RETIN_F8 != 0>(r, KIN(7), 1, 1024, 6144, (f16*)(F.ws + WS_W_RIN), scr, lane)) continue;
        if (p0_group<0, false>(r, KIN(9), 1, 2048, 1024, (f16*)(F.ws + WS_W_ROUT), scr, lane)) continue;
        if (p0_group<2, false>(r, KIN(16), 1, 1024, 5632, (f16*)(F.ws + WS_W_FIN), scr, lane)) continue;
        if (p0_group<0, false>(r, KIN(17), 1, 2816, 1024, (f16*)(F.ws + WS_W_FOUT), scr, lane)) continue;
        if (!CONV_IN_SCAN) conv_rest(r, 2, F.ws, scr, lane);
    }
}

__device__ __forceinline__ void moe_tile_bases(const unsigned* gcnt, int (&tb)[NEXP], int& ntiles) {
    int acc = 0;
#pragma unroll
    for (int e = 0; e < NEXP; ++e) { tb[e] = acc; const unsigned c = __hip_atomic_load(gcnt + 64 * e, __ATOMIC_RELAXED, __HIP_MEMORY_SCOPE_AGENT); acc += (int)((c + 255u) >> 8); }
    ntiles = acc;
}
struct NormArgs {
    const void* x; f16* xw; const float* gain; const float* sh; const float* sc;
    f16* h; const float* gain2; const float* kvmod; f16* hk;
    const f16* y2; const float* gatef;
    float* out;
    const f16* yb;
    const float* router; unsigned* gcnt; unsigned* tokinfo; unsigned char* hs8; float* wof;
};
template <bool COMBINE, bool KV, bool FINAL, bool ROUTER, bool H8 = false, bool ADDY = false, bool XF32 = false>
__device__ __forceinline__ void norm_phase(Frame& F, const NormArgs& A) {
    PHASE_IDS();
    const int gw = F.vcu * 8 + F.wave, NGW = F.G * 8;
    LAS float* routL = (LAS float*)F.lds;
    LAS unsigned* lcnt = (LAS unsigned*)(F.lds + 32768);
    LAS unsigned* recs = (LAS unsigned*)(F.lds + 32768 + 256);
    if (ROUTER) {
        for (int i = tid; i < 8192; i += 512) routL[(i & 7) * 1024 + (i >> 3)] = A.router[i];
        if (tid < 16) lcnt[tid] = 0u;
        WG_BAR();
    }
    int ctb[NEXP]; int cnt_ = 0; (void)cnt_;
    if (COMBINE) moe_tile_bases(A.gcnt, ctb, cnt_);
    f32x4 cxf[4], nxf[4]; f16x4 cxh[4], nxh[4], cya[4], nya[4], cyb[4], nyb[4]; u32x4 ti_n = {0u, 0u, 0u, 0u};
#define NP_ISSUE(row_, ti_, xf_, xh_, ya_, yb_) do { \
        _Pragma("unroll") for (int j = 0; j < 4; ++j) { if (XF32) xf_[j] = *((const f32x4*)((const float*)A.x + (size_t)(row_) * DM) + lane + 64 * j); else xh_[j] = *((const f16x4*)((const f16*)A.x + (size_t)(row_) * DM) + lane + 64 * j); } \
        if (ADDY) { _Pragma("unroll") for (int j = 0; j < 4; ++j) ya_[j] = *((const f16x4*)(A.yb + (size_t)(row_) * DM) + lane + 64 * j); } \
        if (COMBINE) { int b1_ = 0, b2_ = 0; \
            _Pragma("unroll") for (int e = 0; e < NEXP; ++e) { b1_ = ((int)(ti_).x == e) ? ctb[e] : b1_; b2_ = ((int)(ti_).z == e) ? ctb[e] : b2_; } \
            const f16* pa_ = A.y2 + ((size_t)b1_ * 256 + (ti_).y) * DM; const f16* pb_ = A.y2 + ((size_t)b2_ * 256 + (ti_).w) * DM; \
            _Pragma("unroll") for (int j = 0; j < 4; ++j) { ya_[j] = *((const f16x4*)pa_ + lane + 64 * j); yb_[j] = *((const f16x4*)pb_ + lane + 64 * j); } } } while (0)
    const int WPB = NGW / BATCH, b = gw / WPB, wsub = gw - b * WPB; const size_t rbase = (size_t)b * SEQ;
    f32x4 gnv[4], shv[4], scv[4], g2v[4], sh2v[4], sc2v[4], gfv[4];
#pragma unroll
    for (int j = 0; j < 4; ++j) {
        gnv[j] = *((const f32x4*)A.gain + lane + 64 * j);
        if (!FINAL) { shv[j] = *((const f32x4*)(A.sh + (size_t)b * 6144) + lane + 64 * j); scv[j] = *((const f32x4*)(A.sc + (size_t)b * 6144) + lane + 64 * j) + 1.0f; }
        if (KV) { g2v[j] = *((const f32x4*)A.gain2 + lane + 64 * j); sh2v[j] = *((const f32x4*)(A.kvmod + (size_t)b * 2048) + lane + 64 * j); sc2v[j] = *((const f32x4*)(A.kvmod + (size_t)b * 2048 + 1024) + lane + 64 * j) + 1.0f; }
        if (COMBINE) gfv[j] = *((const f32x4*)(A.gatef + (size_t)b * 6144) + lane + 64 * j);
    }
    if (wsub < SEQ) {
        u32x4 ti0 = {0u, 0u, 0u, 0u};
        if (COMBINE) ti0 = *(const u32x4*)(A.tokinfo + 8 * (rbase + wsub));
        NP_ISSUE(rbase + wsub, ti0, cxf, cxh, cya, cyb);
        if (COMBINE && wsub + WPB < SEQ) ti_n = *(const u32x4*)(A.tokinfo + 8 * (rbase + wsub + WPB));
    }
    int nloc = 0;
    for (int sq = wsub; sq < SEQ; sq += WPB, ++nloc) {
        const size_t row = rbase + sq;
        if (sq + WPB < SEQ) {
            NP_ISSUE(row + WPB, ti_n, nxf, nxh, nya, nyb);
            if (COMBINE && sq + 2 * WPB < SEQ) ti_n = *(const u32x4*)(A.tokinfo + 8 * (row + 2 * WPB));
        }
        f32x4 v[4];
#pragma unroll
        for (int j = 0; j < 4; ++j) { if (XF32) v[j] = cxf[j]; else v[j] = (f32x4){(float)cxh[j][0], (float)cxh[j][1], (float)cxh[j][2], (float)cxh[j][3]}; }
        if (ADDY) {
#pragma unroll
            for (int j = 0; j < 4; ++j) {
#pragma unroll
                for (int t = 0; t < 4; ++t) v[j][t] += (float)cya[j][t];
                { u32x2 w; w.x = pkh(v[j][0], v[j][1]); w.y = pkh(v[j][2], v[j][3]); *((u32x2*)(A.xw + (size_t)row * DM) + lane + 64 * j) = w; }
            }
        }
        if (COMBINE) {
#pragma unroll
            for (int j = 0; j < 4; ++j) {
                const f32x4 g = gfv[j];
#pragma unroll
                for (int t = 0; t < 4; ++t) v[j][t] += g[t] * ((float)cya[j][t] + (float)cyb[j][t]);
                if (!FINAL) { u32x2 w; w.x = pkh(v[j][0], v[j][1]); w.y = pkh(v[j][2], v[j][3]); *((u32x2*)(A.xw + (size_t)row * DM) + lane + 64 * j) = w; }
            }
        }
        float ss = 0.f;
#pragma unroll
        for (int j = 0; j < 4; ++j) ss += (v[j][0] * v[j][0] + v[j][1] * v[j][1]) + (v[j][2] * v[j][2] + v[j][3] * v[j][3]);
        const float rstd = 1.0f / sqrtf(wave_sum(ss) * (1.0f / DM) + EPS);
        if (FINAL) {
#pragma unroll
            for (int j = 0; j < 4; ++j) *((f32x4*)(A.out + (size_t)row * DM) + lane + 64 * j) = v[j] * rstd * gnv[j];
        } else {
            f32x4 hv[4];
#pragma unroll
            for (int j = 0; j < 4; ++j) {
                hv[j] = (v[j] * rstd * gnv[j]) * scv[j] + shv[j];
                if (H8) *((unsigned*)((unsigned char*)A.h + (size_t)row * DM) + lane + 64 * j) = pk4f8(hv[j][0], hv[j][1], hv[j][2], hv[j][3]);
                else { u32x2 w; w.x = pkh(hv[j][0], hv[j][1]); w.y = pkh(hv[j][2], hv[j][3]); *((u32x2*)(A.h + (size_t)row * DM) + lane + 64 * j) = w; }
            }
            if (KV) {
#pragma unroll
                for (int j = 0; j < 4; ++j) {
                    const f32x4 o = (v[j] * rstd * g2v[j]) * sc2v[j] + sh2v[j];
                    u32x2 w; w.x = pkh(o[0], o[1]); w.y = pkh(o[2], o[3]);
                    *((u32x2*)(A.hk + (size_t)row * DM) + lane + 64 * j) = w;
                }
            }
            if (ROUTER) {
                float lg[8];
#pragma unroll
                for (int e = 0; e < 8; ++e) lg[e] = 0.f;
#pragma unroll
                for (int j = 0; j < 4; ++j)
#pragma unroll
                    for (int e = 0; e < 8; ++e) {
                        const f32x4 rv = *((const LAS f32x4*)(routL + e * 1024) + lane + 64 * j);
                        lg[e] += (hv[j][0] * rv[0] + hv[j][1] * rv[1]) + (hv[j][2] * rv[2] + hv[j][3] * rv[3]);
                    }
                {
                    float r4[4], r2[2], r1;
                    const bool b0 = lane & 1, b1 = lane & 2, b2 = lane & 4;
#pragma unroll
                    for (int k = 0; k < 4; ++k) { const float keep = b0 ? lg[k + 4] : lg[k], send = b0 ? lg[k] : lg[k + 4]; r4[k] = keep + __shfl_xor(send, 1); }
#pragma unroll
                    for (int k = 0; k < 2; ++k) { const float keep = b1 ? r4[k + 2] : r4[k], send = b1 ? r4[k] : r4[k + 2]; r2[k] = keep + __shfl_xor(send, 2); }
                    { const float keep = b2 ? r2[1] : r2[0], send = b2 ? r2[0] : r2[1]; r1 = keep + __shfl_xor(send, 4); }
                    r1 += __shfl_xor(r1, 8); r1 += __shfl_xor(r1, 16); r1 += __shfl_xor(r1, 32);
#pragma unroll
                    for (int e = 0; e < 8; ++e) lg[e] = __int_as_float(__builtin_amdgcn_readlane(__float_as_int(r1), ((e >> 2) & 1) | (((e >> 1) & 1) << 1) | ((e & 1) << 2)));
                }
                int i1 = 0; float v1 = lg[0];
#pragma unroll
                for (int e = 1; e < 8; ++e) if (lg[e] > v1) { v1 = lg[e]; i1 = e; }
                int i2 = (i1 == 0) ? 1 : 0; float v2 = lg[i2];
#pragma unroll
                for (int e = 0; e < 8; ++e) if (e != i1 && lg[e] > v2) { v2 = lg[e]; i2 = e; }
                const float ed = __expf(v2 - v1), w1 = 1.0f / (1.0f + ed), w2 = ed * w1;
                if (lane == 0) {
                    const unsigned p1 = __hip_atomic_fetch_add(&lcnt[i1], 1u, __ATOMIC_RELAXED, __HIP_MEMORY_SCOPE_WORKGROUP), p2 = __hip_atomic_fetch_add(&lcnt[i2], 1u, __ATOMIC_RELAXED, __HIP_MEMORY_SCOPE_WORKGROUP);
                    LAS unsigned* rc = recs + (F.wave * 16 + nloc) * 8;
                    rc[0] = (unsigned)i1; rc[1] = p1; rc[2] = (unsigned)i2; rc[3] = p2; rc[4] = __float_as_uint(w1); rc[5] = __float_as_uint(w2);
                }
            }
        }
#pragma unroll
        for (int j = 0; j < 4; ++j) { cxf[j] = nxf[j]; cxh[j] = nxh[j]; cya[j] = nya[j]; cyb[j] = nyb[j]; }
    }
    if (ROUTER) {
        WG_BAR();
        if (tid < 8) lcnt[8 + tid] = __hip_atomic_fetch_add(A.gcnt + 64 * tid, lcnt[tid], __ATOMIC_RELAXED, __HIP_MEMORY_SCOPE_AGENT);
        WG_BAR();
        asm volatile("s_waitcnt vmcnt(0)" ::: "memory");
        for (int k0 = 0, sq0 = wsub; sq0 < SEQ; sq0 += 4 * WPB, k0 += 4) {
            u32x4 a[4];
#pragma unroll
            for (int q = 0; q < 4; ++q) { const size_t row = rbase + sq0 + q * WPB; if (sq0 + q * WPB < SEQ) a[q] = *((const u32x4*)((const unsigned char*)A.h + row * DM) + lane); }
#pragma unroll
            for (int q = 0; q < 4; ++q) { const size_t row = rbase + sq0 + q * WPB; if (sq0 + q * WPB < SEQ) {
                const LAS unsigned* rc = recs + (F.wave * 16 + k0 + q) * 8;
                const unsigned e1 = rc[0], p1 = rc[1] + lcnt[8 + rc[0]], e2 = rc[2], p2 = rc[3] + lcnt[8 + rc[2]];
                const size_t v1 = (size_t)e1 * MOE_CAP + p1, v2 = (size_t)e2 * MOE_CAP + p2;
                *((u32x4*)(A.hs8 + v1 * DM) + lane) = a[q]; *((u32x4*)(A.hs8 + v2 * DM) + lane) = a[q];
                if (lane == 0) { *(u32x4*)(A.tokinfo + 8 * (size_t)row) = (u32x4){e1, p1, e2, p2}; A.wof[v1] = __uint_as_float(rc[4]); A.wof[v2] = __uint_as_float(rc[5]); } } }
        }
    }
}
constexpr int SC_PV = 576;
constexpr int SC_QL = 0, SC_KL = 16384, SC_VL = 32768, SC_SL = 69632, SC_ST = 135168, SC_STAGE = 0;
__device__ __forceinline__ int sc_off(int row, int ch) { return 256 * row + 16 * (ch ^ (((row & 3) << 2) | ((row >> 2) & 3))); }
__device__ __forceinline__ void scan_phase(Frame& F, const f16* proj, const float* gnw, f16* ao, int mi) {
    if (CONV_IN_SCAN) {
        if (blockIdx.x >= BATCH * RH) {
            PHASE_IDS();
            LAS float* scr = (LAS float*)(F.lds + F.wave * 8448);
            const int cw = ((int)blockIdx.x - BATCH * RH) * 8 + F.wave, NCW = ((int)gridDim.x - BATCH * RH) * 8;
            const int nit = mi ? CONV_ITEMS_1 : CONV_ITEMS_0;
            for (int it = cw; it < nit; it += NCW) conv_rest(it, mi, F.ws, scr, lane);
            return;
        }
    } else if (blockIdx.x >= 2 * BATCH * RH) return;
    const int unit = CONV_IN_SCAN ? (int)blockIdx.x : (int)(blockIdx.x >> 1), half = CONV_IN_SCAN ? 0 : (int)(blockIdx.x & 1);
    const int b = unit >> 3, hh = unit & 7;
    const int c_first_full = half ? NCHUNK / 2 : 0, c_end = CONV_IN_SCAN ? NCHUNK : (half ? NCHUNK : NCHUNK / 2);
    LAS unsigned char* L = F.lds;
    PHASE_IDS();
    const int wid = F.wave, rh = wid >> 2, cg = wid & 3, r = lane & 31, h = lane >> 5;
    const int gl = (lane >> 4) & 1, li = lane & 15, ta = li >> 2, tp = li & 3;
    const float lg = lg2gamma(hh);
    const float g63 = ex2(63.0f * lg), cd = __int_as_float(__builtin_amdgcn_readfirstlane(__float_as_int(ex2(64.0f * lg))));
    float vm[4], cj[4]; const int qloc = 32 * rh + r;
    const float wneg = __int_as_float(__builtin_amdgcn_readfirstlane(__float_as_int(ex2(-64.0f * lg))));
#pragma unroll
    for (int g4 = 0; g4 < 4; ++g4) vm[g4] = ex2((float)(16 * g4 + 8 * h - 2 * qloc - 64) * lg);
#pragma unroll
    for (int j = 0; j < 4; ++j) cj[j] = __int_as_float(__builtin_amdgcn_readfirstlane(__float_as_int(ex2((float)(2 * j) * lg))));
    const size_t rowbase = (size_t)b * SEQ;
    const f16* gq = proj + rowbase * RIN + 128 * hh;
    const f16* gk = gq + 1024;
    const f16* gv = proj + rowbase * RIN + 2048 + 256 * hh;
    const f16* gg = gv + 2048;
    const int qrow = tid >> 4, qc = tid & 15;
    const int vrow = tid >> 5, vc = tid & 31;
    int qoffL[2];
#pragma unroll
    for (int i = 0; i < 2; ++i) qoffL[i] = sc_off(qrow + 32 * i, qc);
    f32x16 SA[2][2];
#pragma unroll
    for (int dd = 0; dd < 2; ++dd)
#pragma unroll
        for (int et = 0; et < 2; ++et)
#pragma unroll
            for (int i = 0; i < 16; ++i) SA[dd][et][i] = 0.f;
    for (int i = tid; i < 65536 / 16; i += 512) *(LAS u32x4*)(L + SC_SL + i * 16) = (u32x4){0u, 0u, 0u, 0u};
    u32x4 nq[2], nk[2], nv[4];
#pragma unroll
    for (int i = 0; i < 2; ++i) { nq[i] = *(const u32x4*)(gq + (size_t)(qrow + 32 * i) * RIN + 8 * qc); nk[i] = *(const u32x4*)(gk + (size_t)(qrow + 32 * i) * RIN + 8 * qc); }
#pragma unroll
    for (int i = 0; i < 4; ++i) nv[i] = *(const u32x4*)(gv + (size_t)(vrow + 16 * i) * RIN + 8 * vc);
#pragma unroll
    for (int i = 0; i < 2; ++i) { *(LAS u32x4*)(L + SC_QL + qoffL[i]) = nq[i]; *(LAS u32x4*)(L + SC_KL + qoffL[i]) = nk[i]; }
#pragma unroll
    for (int i = 0; i < 4; ++i) *(LAS u32x4*)(L + SC_VL + (vrow + 16 * i) * SC_PV + 16 * vc) = nv[i];
    WG_BAR();
    for (int c = 0; c < c_first_full; ++c) {
        const size_t crow = (size_t)c * CHUNK;
#pragma unroll
        for (int i = 0; i < 2; ++i) { nq[i] = *(const u32x4*)(gq + (crow + 64 + qrow + 32 * i) * RIN + 8 * qc); nk[i] = *(const u32x4*)(gk + (crow + 64 + qrow + 32 * i) * RIN + 8 * qc); }
#pragma unroll
        for (int i = 0; i < 4; ++i) nv[i] = *(const u32x4*)(gv + (crow + 64 + vrow + 16 * i) * RIN + 8 * vc);
        int ro = r, ho = h, tao = ta, tpo = tp, glo = gl, vro = vrow, vco = vc;
        asm volatile("" : "+v"(ro), "+v"(ho), "+v"(tao), "+v"(tpo), "+v"(glo), "+v"(vro), "+v"(vco));
#pragma unroll
        for (int dd = 0; dd < 2; ++dd)
#pragma unroll
            for (int et = 0; et < 2; ++et)
#pragma unroll
                for (int i = 0; i < 16; ++i) SA[dd][et][i] *= cd;
#pragma unroll
        for (int kt = 0; kt < 2; ++kt)
#pragma unroll
            for (int s = 0; s < 2; ++s) {
                const int k0 = 32 * kt + 16 * s + 4 * ho + tao;
                f16x8 Vf[2], Kt[2];
#pragma unroll
                for (int et = 0; et < 2; ++et) { LAS const unsigned char* vp = L + SC_VL + k0 * SC_PV + (64 * cg + 32 * et + 16 * glo + 4 * tpo) * 2; Vf[et] = cat8(tr_read(vp), tr_read(vp + 8 * SC_PV)); }
#pragma unroll
                for (int dd = 0; dd < 2; ++dd) { const int ch = 4 * (2 * rh + dd) + 2 * glo + (tpo >> 1);
                    Kt[dd] = cat8(tr_read(L + SC_KL + sc_off(k0, ch) + 8 * (tpo & 1)), tr_read(L + SC_KL + sc_off(k0 + 8, ch) + 8 * (tpo & 1))); }
#pragma unroll
                for (int et = 0; et < 2; ++et)
#pragma unroll
                    for (int dd = 0; dd < 2; ++dd) SA[dd][et] = __builtin_amdgcn_mfma_f32_32x32x16_f16(Kt[dd], Vf[et], SA[dd][et], 0, 0, 0);
            }
        WG_BAR();
        if (c + 1 == c_first_full) {
#pragma unroll
            for (int dd = 0; dd < 2; ++dd)
#pragma unroll
                for (int et = 0; et < 2; ++et)
#pragma unroll
                    for (int g4 = 0; g4 < 4; ++g4) {
                        u32x2 w; w.x = pkh(SA[dd][et][4 * g4], SA[dd][et][4 * g4 + 1]); w.y = pkh(SA[dd][et][4 * g4 + 2], SA[dd][et][4 * g4 + 3]);
                        *(LAS u32x2*)(L + SC_SL + sc_off(64 * cg + 32 * et + ro, 4 * (2 * rh + dd) + g4) + 8 * ho) = w;
                    }
        }
#pragma unroll
        for (int i = 0; i < 2; ++i) { const int qo = sc_off((vro * 2 + (vco >> 4)) + 32 * i, vco & 15); *(LAS u32x4*)(L + SC_QL + qo) = nq[i]; *(LAS u32x4*)(L + SC_KL + qo) = nk[i]; }
#pragma unroll
        for (int i = 0; i < 4; ++i) *(LAS u32x4*)(L + SC_VL + (vrow + 16 * i) * SC_PV + 16 * vc) = nv[i];
        WG_BAR();
    }
    for (int c = c_first_full; c < c_end; ++c) {
        const size_t crow = (size_t)c * CHUNK;
        if (c + 1 < c_end) {
#pragma unroll
            for (int i = 0; i < 2; ++i) { nq[i] = *(const u32x4*)(gq + (crow + 64 + qrow + 32 * i) * RIN + 8 * qc); nk[i] = *(const u32x4*)(gk + (crow + 64 + qrow + 32 * i) * RIN + 8 * qc); }
#pragma unroll
            for (int i = 0; i < 4; ++i) nv[i] = *(const u32x4*)(gv + (crow + 64 + vrow + 16 * i) * RIN + 8 * vc);
        }
        int ro = r, ho = h, tao = ta, tpo = tp, glo = gl, vro = vrow, vco = vc;
        asm volatile("" : "+v"(ro), "+v"(ho), "+v"(tao), "+v"(tpo), "+v"(glo), "+v"(vro), "+v"(vco));
        f16x8 Pf[2][2]; f32x16 OT[2];
        {
        f16x8 Qf[8];
#pragma unroll
        for (int ks = 0; ks < 8; ++ks) Qf[ks] = *(const LAS f16x8*)(L + SC_QL + sc_off(32 * rh + ro, 2 * ks + ho));
#pragma unroll
        for (int kt = 0; kt < 2; ++kt) {
            f32x16 X;
#pragma unroll
            for (int i = 0; i < 16; ++i) X[i] = 0.f;
#pragma unroll
            for (int ks = 0; ks < 8; ++ks) { const f16x8 Kf = *(const LAS f16x8*)(L + SC_KL + sc_off(32 * kt + ro, 2 * ks + ho)); X = __builtin_amdgcn_mfma_f32_32x32x16_f16(Kf, Qf[ks], X, 0, 0, 0); }
#pragma unroll
            for (int i = 0; i < 16; ++i) { const int key = 32 * kt + (i & 3) + 8 * (i >> 2) + 4 * h; X[i] *= (key >= qloc) ? vm[i >> 2] * (kt ? cd * cj[i & 3] : cj[i & 3]) : wneg; }
            Pf[kt][0] = pack8(X, 0); Pf[kt][1] = pack8(X, 1);
        }
#pragma unroll
        for (int et = 0; et < 2; ++et)
#pragma unroll
            for (int i = 0; i < 16; ++i) OT[et][i] = 0.f;
#pragma unroll
        for (int ks = 0; ks < 8; ++ks)
#pragma unroll
            for (int et = 0; et < 2; ++et) {
                const f16x8 Sf = *(const LAS f16x8*)(L + SC_SL + sc_off(64 * cg + 32 * et + ro, 2 * ks + ho));
                OT[et] = __builtin_amdgcn_mfma_f32_32x32x16_f16(Sf, Qf[ks], OT[et], 0, 0, 0);
            }
        }
#pragma unroll
        for (int dd = 0; dd < 2; ++dd)
#pragma unroll
            for (int et = 0; et < 2; ++et)
#pragma unroll
                for (int i = 0; i < 16; ++i) SA[dd][et][i] *= cd;
#pragma unroll
        for (int kt = 0; kt < 2; ++kt)
#pragma unroll
            for (int s = 0; s < 2; ++s) {
                const int k0 = 32 * kt + 16 * s + 4 * ho + tao;
                f16x8 Vf[2], Kt[2];
#pragma unroll
                for (int et = 0; et < 2; ++et) { LAS const unsigned char* vp = L + SC_VL + k0 * SC_PV + (64 * cg + 32 * et + 16 * glo + 4 * tpo) * 2; Vf[et] = cat8(tr_read(vp), tr_read(vp + 8 * SC_PV)); }
#pragma unroll
                for (int dd = 0; dd < 2; ++dd) { const int ch = 4 * (2 * rh + dd) + 2 * glo + (tpo >> 1);
                    Kt[dd] = cat8(tr_read(L + SC_KL + sc_off(k0, ch) + 8 * (tpo & 1)), tr_read(L + SC_KL + sc_off(k0 + 8, ch) + 8 * (tpo & 1))); }
#pragma unroll
                for (int et = 0; et < 2; ++et) {
                    OT[et] = __builtin_amdgcn_mfma_f32_32x32x16_f16(Vf[et], Pf[kt][s], OT[et], 0, 0, 0);
#pragma unroll
                    for (int dd = 0; dd < 2; ++dd) SA[dd][et] = __builtin_amdgcn_mfma_f32_32x32x16_f16(Kt[dd], Vf[et], SA[dd][et], 0, 0, 0);
                }
            }
        float mean = 0.f, rstd = 0.f;
        {
        float s1 = 0.f, s2 = 0.f;
#pragma unroll
        for (int et = 0; et < 2; ++et)
#pragma unroll
            for (int i = 0; i < 16; ++i) { OT[et][i] *= g63; s1 += OT[et][i]; s2 += OT[et][i] * OT[et][i]; }
        s1 += __shfl_xor(s1, 32); s2 += __shfl_xor(s2, 32);
        if (h == 0) *(LAS f32x2*)(L + SC_ST + ((rh * 4 + cg) * 32 + r) * 8) = (f32x2){s1, s2};
        }
        WG_BAR();
        u32x4 gc[4];
        {
        float t1 = 0.f, t2 = 0.f;
#pragma unroll
        for (int c4 = 0; c4 < 4; ++c4) { const f32x2 p = *(const LAS f32x2*)(L + SC_ST + ((rh * 4 + c4) * 32 + r) * 8); t1 += p.x; t2 += p.y; }
        mean = t1 * (1.0f / 256.0f); const float var = t2 * (1.0f / 256.0f) - mean * mean; rstd = 1.0f / sqrtf(var + EPS);
#pragma unroll
        for (int i = 0; i < 4; ++i) gc[i] = *(const u32x4*)(gg + (crow + vrow + 16 * i) * RIN + 8 * vc);
        }
        {
#pragma unroll
        for (int dd = 0; dd < 2; ++dd)
#pragma unroll
            for (int et = 0; et < 2; ++et)
#pragma unroll
                for (int g4 = 0; g4 < 4; ++g4) {
                    u32x2 w; w.x = pkh(SA[dd][et][4 * g4], SA[dd][et][4 * g4 + 1]); w.y = pkh(SA[dd][et][4 * g4 + 2], SA[dd][et][4 * g4 + 3]);
                    *(LAS u32x2*)(L + SC_SL + sc_off(64 * cg + 32 * et + ro, 4 * (2 * rh + dd) + g4) + 8 * ho) = w;
                }
        }
        {
#pragma unroll
        for (int et = 0; et < 2; ++et)
#pragma unroll
            for (int g4 = 0; g4 < 4; ++g4) {
                u32x2 w; w.x = pkh((OT[et][4 * g4] - mean) * rstd, (OT[et][4 * g4 + 1] - mean) * rstd); w.y = pkh((OT[et][4 * g4 + 2] - mean) * rstd, (OT[et][4 * g4 + 3] - mean) * rstd);
                *(LAS u32x2*)(L + SC_STAGE + 16384 * (cg >> 1) + sc_off(32 * rh + ro, 8 * (cg & 1) + 4 * et + g4) + 8 * ho) = w;
            }
        }
        WG_BAR();
        {
        f32x4 gw0, gw1; { const float* gp = gnw + 256 * hh + 8 * vc; gw0 = *(const f32x4*)gp; gw1 = *(const f32x4*)(gp + 4); }
#pragma unroll
        for (int i = 0; i < 4; ++i) {
            const f16x8 n8 = *(const LAS f16x8*)(L + SC_STAGE + 16384 * (vco >> 4) + sc_off(vro + 16 * i, vco & 15));
            const f16x8 g8 = __builtin_bit_cast(f16x8, gc[i]);
            u32x4 w;
            w.x = pkh((float)n8[0] * (float)g8[0] * gw0[0], (float)n8[1] * (float)g8[1] * gw0[1]); w.y = pkh((float)n8[2] * (float)g8[2] * gw0[2], (float)n8[3] * (float)g8[3] * gw0[3]);
            w.z = pkh((float)n8[4] * (float)g8[4] * gw1[0], (float)n8[5] * (float)g8[5] * gw1[1]); w.w = pkh((float)n8[6] * (float)g8[6] * gw1[2], (float)n8[7] * (float)g8[7] * gw1[3]);
            *(u32x4*)(ao + (rowbase + crow + vrow + 16 * i) * 2048 + 256 * hh + 8 * vc) = w;
        }
        }
        WG_BAR();
        if (c + 1 < c_end) {
#pragma unroll
            for (int i = 0; i < 2; ++i) { const int qo = sc_off((vro * 2 + (vco >> 4)) + 32 * i, vco & 15); *(LAS u32x4*)(L + SC_QL + qo) = nq[i]; *(LAS u32x4*)(L + SC_KL + qo) = nk[i]; }
#pragma unroll
            for (int i = 0; i < 4; ++i) *(LAS u32x4*)(L + SC_VL + (vrow + 16 * i) * SC_PV + 16 * vc) = nv[i];
        }
        WG_BAR();
    }
}

constexpr int SBV_P = 144;
constexpr float SB_STOP = 5.421010862427522e-20f;
__device__ __forceinline__ void sb_phase(Frame& F, const f16* Q, const f16* Kc, const f16* Vc, f16* O, const float stop = SB_STOP) {
    PHASE_IDS();
    const int gw = F.vcu * 8 + F.wave, NGW = F.G * 8, r = lane & 31, h = lane >> 5;
    const int gl = (lane >> 4) & 1, li = lane & 15, ta = li >> 2, tp = li & 3;
    LAS unsigned char* Kw = F.lds + F.wave * (96 * SBV_P);
    LAS unsigned char* Vw = Kw + 32 * SBV_P; LAS unsigned char* Qw = Kw + 64 * SBV_P;
    const int vr = lane >> 3, vcc = lane & 7;
    constexpr int NU = BATCH * SBH * (SEQ / 32);
    u32x4 qn2[4], kn2[4], vn2[4];
    if (gw < NU) { const int qblk = gw & 63, bh = gw >> 6, b = bh >> 4, hd = bh & 15; const size_t rb = (size_t)b * SEQ;
        const f16* qp = Q + (rb + 32 * qblk + vr) * DM + 64 * hd + 8 * vcc; const f16* kp = Kc + (rb + 32 * qblk + vr) * DM + 64 * hd + 8 * vcc; const f16* vp = Vc + (rb + 32 * qblk + vr) * DM + 64 * hd + 8 * vcc;
#pragma unroll
        for (int i = 0; i < 4; ++i) { qn2[i] = *(const u32x4*)(qp + (size_t)(8 * i) * DM); kn2[i] = *(const u32x4*)(kp + (size_t)(8 * i) * DM); vn2[i] = *(const u32x4*)(vp + (size_t)(8 * i) * DM); } }
    for (int u = gw; u < NU; u += NGW) {
        const int qblk = u & 63, bh = u >> 6, b = bh >> 4, hd = bh & 15;
        const size_t rb = (size_t)b * SEQ;
        f16x8 Qf[4];
#pragma unroll
        for (int i = 0; i < 4; ++i) *(LAS u32x4*)(Qw + (vr + 8 * i) * SBV_P + 16 * vcc) = qn2[i];
        CFENCE();
#pragma unroll
        for (int ks = 0; ks < 4; ++ks) Qf[ks] = *(const LAS f16x8*)(Qw + r * SBV_P + (16 * ks + 8 * h) * 2);
        CFENCE();
        f32x16 OT[2];
#pragma unroll
        for (int dt = 0; dt < 2; ++dt)
#pragma unroll
            for (int i = 0; i < 16; ++i) OT[dt][i] = 0.f;
        float carry = 1.0f;
        u32x4 kn[4], vn[4];
#pragma unroll
        for (int i = 0; i < 4; ++i) { kn[i] = kn2[i]; vn[i] = vn2[i]; }
        if (u + NGW < NU) { const int un = u + NGW, qb2 = un & 63, bh2 = un >> 6, b2 = bh2 >> 4, hd2 = bh2 & 15; const size_t rb2 = (size_t)b2 * SEQ;
            const f16* qp = Q + (rb2 + 32 * qb2 + vr) * DM + 64 * hd2 + 8 * vcc; const f16* kp = Kc + (rb2 + 32 * qb2 + vr) * DM + 64 * hd2 + 8 * vcc; const f16* vp = Vc + (rb2 + 32 * qb2 + vr) * DM + 64 * hd2 + 8 * vcc;
#pragma unroll
            for (int i = 0; i < 4; ++i) { qn2[i] = *(const u32x4*)(qp + (size_t)(8 * i) * DM); kn2[i] = *(const u32x4*)(kp + (size_t)(8 * i) * DM); vn2[i] = *(const u32x4*)(vp + (size_t)(8 * i) * DM); } }
        for (int kt = qblk; kt >= 0; --kt) {
#pragma unroll
            for (int i = 0; i < 4; ++i) { *(LAS u32x4*)(Kw + (vr + 8 * i) * SBV_P + 16 * vcc) = kn[i]; *(LAS u32x4*)(Vw + (vr + 8 * i) * SBV_P + 16 * vcc) = vn[i]; }
            CFENCE();
            f16x8 Kf[4];
#pragma unroll
            for (int ks = 0; ks < 4; ++ks) Kf[ks] = *(const LAS f16x8*)(Kw + r * SBV_P + (16 * ks + 8 * h) * 2);
            CFENCE();
            if (kt > 0) { const f16* kp = Kc + (rb + 32 * (kt - 1) + vr) * DM + 64 * hd + 8 * vcc; const f16* vp = Vc + (rb + 32 * (kt - 1) + vr) * DM + 64 * hd + 8 * vcc;
#pragma unroll
                for (int i = 0; i < 4; ++i) { kn[i] = *(const u32x4*)(kp + (size_t)(8 * i) * DM); vn[i] = *(const u32x4*)(vp + (size_t)(8 * i) * DM); } }
            f32x16 S;
#pragma unroll
            for (int i = 0; i < 16; ++i) S[i] = 0.f;
#pragma unroll
            for (int ks = 0; ks < 4; ++ks) S = __builtin_amdgcn_mfma_f32_32x32x16_f16(Kf[ks], Qf[ks], S, 0, 0, 0);
            float om[16];
            const bool diag = (kt == qblk);
#pragma unroll
            for (int i = 0; i < 16; ++i) {
                const int kl = (i & 3) + 8 * (i >> 2) + 4 * h;
                float o = __builtin_amdgcn_rcpf(1.0f + ex2(S[i]));
                if (diag && kl >= r) o = 1.0f;
                om[i] = o;
            }
            float sfx[16], T[4];
#pragma unroll
            for (int g4 = 0; g4 < 4; ++g4) { sfx[4 * g4 + 3] = 1.0f; sfx[4 * g4 + 2] = om[4 * g4 + 3]; sfx[4 * g4 + 1] = sfx[4 * g4 + 2] * om[4 * g4 + 2]; sfx[4 * g4] = sfx[4 * g4 + 1] * om[4 * g4 + 1]; T[g4] = sfx[4 * g4] * om[4 * g4]; }
            float E[4]; float run = carry;
#pragma unroll
            for (int g4 = 3; g4 >= 0; --g4) {
                const auto sw = __builtin_amdgcn_permlane32_swap(__float_as_uint(T[g4]), __float_as_uint(T[g4]), false, false);
                const float tl = __uint_as_float(sw[0]), th = __uint_as_float(sw[1]);
                const float e_hi = run; run *= th; const float e_lo = run; run *= tl;
                E[g4] = h ? e_hi : e_lo;
            }
            carry = run;
            f32x16 Aw;
#pragma unroll
            for (int i = 0; i < 16; ++i) Aw[i] = (1.0f - om[i]) * (E[i >> 2] * sfx[i]);
            const f16x8 Af0 = pack8(Aw, 0), Af1 = pack8(Aw, 1);
            CFENCE();
#pragma unroll
            for (int dt = 0; dt < 2; ++dt) {
                LAS const unsigned char* vp = Vw + (4 * h + ta) * SBV_P + (32 * dt + 16 * gl + 4 * tp) * 2;
                const f16x8 V0 = cat8(tr_read(vp), tr_read(vp + 8 * SBV_P)), V1 = cat8(tr_read(vp + 16 * SBV_P), tr_read(vp + 24 * SBV_P));
                OT[dt] = __builtin_amdgcn_mfma_f32_32x32x16_f16(V0, Af0, OT[dt], 0, 0, 0);
                OT[dt] = __builtin_amdgcn_mfma_f32_32x32x16_f16(V1, Af1, OT[dt], 0, 0, 0);
            }
            CFENCE();
            if (__ballot(carry > stop) == 0ull) break;
        }
        CFENCE();
#pragma unroll
        for (int dt = 0; dt < 2; ++dt)
#pragma unroll
            for (int g4 = 0; g4 < 4; ++g4) { u32x2 w; w.x = pkh(OT[dt][4 * g4], OT[dt][4 * g4 + 1]); w.y = pkh(OT[dt][4 * g4 + 2], OT[dt][4 * g4 + 3]); *(LAS u32x2*)(Qw + r * SBV_P + (32 * dt + 8 * g4 + 4 * h) * 2) = w; }
        CFENCE();
        f16* op = O + (rb + 32 * qblk + vr) * DM + 64 * hd + 8 * vcc;
#pragma unroll
        for (int i = 0; i < 4; ++i) *(u32x4*)(op + (size_t)(8 * i) * DM) = *(const LAS u32x4*)(Qw + (vr + 8 * i) * SBV_P + 16 * vcc);
        CFENCE();
    }
}

struct Args { const void* in[22]; float* out; unsigned char* ws; int ph_lo, ph_hi; };
constexpr int N_PHASES = 34;
#define IN(k) (lo <= (k) && (k) < hi)
#define SEAM(k) do { if (IN((k) + 1)) { if (!MK_PER_PHASE) xcd_barrier(bar); } } while (0)
#define WSP(T, off) ((T*)(F.ws + (off)))
#define REPS(cond) _Pragma("unroll") for (int rep_ = 0; rep_ < ((cond) ? 2 : 1); ++rep_)
#define REPBAR() do { if (rep_) xcd_barrier(bar); } while (0)
#define REPSN(cond, n) _Pragma("unroll") for (int rep_ = 0; rep_ < ((cond) ? (n) : 1); ++rep_)
template <int L> __device__ __forceinline__ void layer_phases(Frame& F, const XcdBarrier& bar, const int lo, const int hi) {
    constexpr int pb = 1 + 8 * L;
        if (IN(pb + 0) && !DIS_K0) {
            const float* modL = WSP(const float, WS_MOD) + (size_t)L * 16 * 6144;
            NormArgs A{}; A.x = (L == 0) ? (const void*)KIN(0) : (const void*)WSP(const f16, WS_X); A.xw = WSP(f16, WS_X); A.gain = KIN(5) + L * DM; A.sh = modL; A.sc = modL + 1024; A.h = WSP(f16, WS_H);
            if constexpr (L == 2) {
                A.y2 = WSP(const f16, WS_Y2); A.gcnt = F.ctl + CW_MOE; A.tokinfo = WSP(unsigned, WS_TOKINFO); A.gatef = WSP(const float, WS_MOD) + (size_t)(L - 1) * 16 * 6144 + 5120;
                A.gain2 = KIN(12); A.kvmod = WSP(const float, WS_KVMOD); A.hk = WSP(f16, WS_HK); REPSN(PROBE_DUP == 15, 5) { REPBAR(); if (rep_) { A.xw = WSP(f16, WS_BIG + 320 * MiB); A.h = WSP(f16, WS_BIG + 448 * MiB); A.hk = WSP(f16, WS_BIG + 512 * MiB); } norm_phase<true, true, false, false>(F, A); }
            } else REPSN(PROBE_DUP == 7 && L == 1, 5) { REPBAR(); A.yb = WSP(const f16, WS_YB); if (rep_) { A.xw = WSP(f16, WS_BIG + 320 * MiB); A.h = WSP(f16, WS_BIG + 448 * MiB); } norm_phase<false, false, false, false, (RETIN_F8 != 0 && L < 2), (L == 1 || L == 3), (L == 0)>(F, A); }
            SEAM(pb + 0);
        }
        if (IN(pb + 1) && !DIS_K1) {
            if constexpr (L < 2) {
                pg8::Gemm g{WSP(const unsigned char, WS_H), WSP(const unsigned char, WS_W_RIN) + (size_t)L * RIN * DM * 2, MTOK, RIN, DM, 0, STAG_RET}; pg8::Order S; S.init(MTOK, RIN, F.G, (int)blockIdx.x);
                pg8::EpiRetIn E{WSP(f16, WS_PROJ), WSP(const float, WS_ROPE), RETIN_F8 ? 1.0f / F8_WSCALE : 1.0f};
                REPS(PROBE_DUP == 6 && L == 1) { REPBAR(); pg8::gemm_phase<pg8::EpiRetIn, RETIN_F8 != 0>(F.lds, g, S, E); }
                if constexpr (PROBE_DUP == 17 && L == 1) { xcd_barrier(bar); pg8::EpiNull<true> EN{WSP(float, WS_SLOTW)}; pg8::gemm_phase<pg8::EpiNull<true>, false>(F.lds, g, S, EN); }
            } else REPS(PROBE_DUP == 12 && L == 2) { REPBAR();
                { pg8::Gemm g{WSP(const f16, WS_H), WSP(const f16, WS_W_SQ) + (size_t)(L - 2) * DM * DM, MTOK, DM, DM, 0}; pg8::Order S; S.init(MTOK, DM, F.G, (int)blockIdx.x);
                  pg8::EpiF16 E{WSP(f16, WS_SQ), DM, 0, 0, 0.125f * 1.4426950408889634f};
                  pg8::gemm_phase<pg8::EpiF16>(F.lds, g, S, E); }
                if constexpr (L == 2) { pg8::Gemm g{WSP(const f16, WS_HK), WSP(const f16, WS_W_KV), MTOK, 2048, DM, 0}; pg8::Order S; S.init(MTOK, 2048, F.G, (int)blockIdx.x);
                  pg8::EpiF16 E{WSP(f16, WS_KSH), DM, 1024, (size_t)(WS_VSH - WS_KSH) / 2, 1.0f};
                  pg8::gemm_phase<pg8::EpiF16>(F.lds, g, S, E); }
            }
            SEAM(pb + 1);
        }
        if (IN(pb + 2) && !DIS_K2) {
#ifndef NO_SCAN
            if constexpr (L < 2) REPS(PROBE_DUP == 2 && L == 1) { REPBAR(); scan_phase(F, WSP(const f16, WS_PROJ), KIN(8) + L * 2048, WSP(f16, WS_AO), L); }
#endif
#ifndef NO_SB
            if constexpr (L >= 2) REPSN((PROBE_DUP == 3 || PROBE_DUP == 22 || PROBE_DUP == 23) && L == 3, 5) { REPBAR(); sb_phase(F, WSP(const f16, WS_SQ), WSP(const f16, WS_KSH), WSP(const f16, WS_VSH), rep_ ? WSP(f16, WS_BIG + 320 * MiB) : WSP(f16, WS_SO), (rep_ && PROBE_DUP == 22) ? 2.0f : (rep_ && PROBE_DUP == 23) ? 1e-6f : SB_STOP); }
#endif
            SEAM(pb + 2);
        }
        if (IN(pb + 3) && !DIS_K3) {
            pg8::Gemm g;
            if constexpr (L < 2) g = pg8::Gemm{WSP(const f16, WS_AO), WSP(const f16, WS_W_ROUT) + (size_t)L * DM * 2048, MTOK, DM, 2048, 0};
            else g = pg8::Gemm{WSP(const f16, WS_SO), WSP(const f16, WS_W_SO) + (size_t)(L - 2) * DM * DM, MTOK, DM, DM, 0};
            pg8::Order S; S.init(MTOK, DM, F.G, (int)blockIdx.x);
            pg8::EpiY E{WSP(f16, WS_YB), WSP(const float, WS_MOD) + (size_t)L * 16 * 6144 + 2048, 1.0f};
            REPS(PROBE_DUP == 9 && L == 1) { REPBAR(); pg8::gemm_phase<pg8::EpiY>(F.lds, g, S, E); }
            SEAM(pb + 3);
        }
        if (IN(pb + 4) && !DIS_K4) {
            const float* modL = WSP(const float, WS_MOD) + (size_t)L * 16 * 6144;
            NormArgs A{}; A.x = (L == 0) ? (const void*)KIN(0) : (const void*)WSP(const f16, WS_X); A.xw = WSP(f16, WS_X); A.gain = KIN(6) + L * DM; A.sh = modL + 3072; A.sc = modL + 4096; A.h = WSP(f16, WS_H); A.yb = WSP(const f16, WS_YB);
            if constexpr (L & 1) { A.router = KIN(18) + (size_t)(L >> 1) * DM * NEXP; A.gcnt = F.ctl + CW_MOE + (L >> 1) * 1024; A.tokinfo = WSP(unsigned, WS_TOKINFO); A.hs8 = WSP(unsigned char, WS_HS); A.wof = WSP(float, WS_SLOTW); REPSN(PROBE_DUP == 13 && L == 3, 5) { REPBAR(); if (rep_) { A.gcnt = F.ctl + CW_MOE + 4096; A.tokinfo = WSP(unsigned, WS_TOKINFO + MiB); A.xw = WSP(f16, WS_BIG + 320 * MiB); A.h = WSP(f16, WS_BIG + 448 * MiB); A.hs8 = WSP(unsigned char, WS_END); A.wof = WSP(float, WS_BIG + 512 * MiB); } norm_phase<false, false, false, true, true, true>(F, A); } }
            else norm_phase<false, false, false, false, DF8(L), true, (L == 0)>(F, A);
            SEAM(pb + 4);
        }
        if (IN(pb + 6) && !DIS_K6) {
            const int mi = L >> 1;
            pg8::Order S;
            if constexpr (L & 1) {
                int tb[NEXP], ntl; moe_tile_bases(F.ctl + CW_MOE + mi * 1024, tb, ntl);
                S.init(ntl * 256, 2 * FFE, F.G, (int)blockIdx.x); S.cap = MOE_CAP; S.avirt = 1;
#pragma unroll
                for (int e = 0; e < NEXP; ++e) S.tb[e] = tb[e];
                pg8::Gemm g{WSP(const unsigned char, WS_HS), WSP(const unsigned char, WS_W_MIN) + (size_t)mi * NEXP * 2 * FFE * DM, ntl * 256, 2 * FFE, DM, (size_t)2 * FFE * DM, STAG_MOE};
                pg8::EpiGlu<true> E{WSP(unsigned char, WS_ACTE), FFE};
                REPS(PROBE_DUP == 4 && L == 3) { REPBAR(); pg8::gemm_phase<pg8::EpiGlu<true>, true>(F.lds, g, S, E); }
                if constexpr (PROBE_DUP == 16 && L == 3) { xcd_barrier(bar); pg8::EpiNull<true> EN{WSP(float, WS_SLOTW)}; pg8::gemm_phase<pg8::EpiNull<true>, true>(F.lds, g, S, EN); }
            } else {
                S.init(MTOK, 2 * FFD, F.G, (int)blockIdx.x);
                pg8::Gemm g{WSP(const unsigned char, WS_H), WSP(const unsigned char, WS_W_FIN) + (size_t)mi * 2 * FFD * DM * 2, MTOK, 2 * FFD, DM, 0};
                pg8::EpiGlu<DF8(L), DF8O(L)> E{WSP(unsigned char, WS_ACTD), FFD};
                REPS(PROBE_DUP == 10 && L == 2) { REPBAR(); pg8::gemm_phase<pg8::EpiGlu<DF8(L), DF8O(L)>, DF8(L)>(F.lds, g, S, E); }
            }
            SEAM(pb + 6);
        }
        if (IN(pb + 7) && !DIS_K7) {
            const int mi = L >> 1;
            if constexpr (L & 1) {
                int tb[NEXP], ntl; moe_tile_bases(F.ctl + CW_MOE + mi * 1024, tb, ntl);
                pg8::Order S; S.init(ntl * 256, DM, F.G, (int)blockIdx.x); S.cap = MOE_CAP;
#pragma unroll
                for (int e = 0; e < NEXP; ++e) S.tb[e] = tb[e];
                pg8::Gemm g{WSP(const unsigned char, WS_ACTE), WSP(const unsigned char, WS_W_MOUT) + (size_t)mi * NEXP * DM * FFE, ntl * 256, DM, FFE, (size_t)DM * FFE};
                pg8::EpiMoeOut E{WSP(f16, WS_Y2), WSP(const float, WS_SLOTW)};
                REPS(PROBE_DUP == 5 && L == 3) { REPBAR(); pg8::gemm_phase<pg8::EpiMoeOut, true>(F.lds, g, S, E); }
            } else {
                pg8::Order S; S.init(MTOK, DM, F.G, (int)blockIdx.x);
                pg8::Gemm g{WSP(const unsigned char, WS_ACTD), WSP(const unsigned char, WS_W_FOUT) + (size_t)mi * DM * FFD * 2, MTOK, DM, FFD, 0};
                pg8::EpiY E{WSP(f16, WS_YB), WSP(const float, WS_MOD) + (size_t)L * 16 * 6144 + 5120, DF8O(L) ? 1.0f / (F8_WSCALE * F8_ASCALE) : 1.0f};
                REPS(PROBE_DUP == 11 && L == 2) { REPBAR(); pg8::gemm_phase<pg8::EpiY, DF8O(L)>(F.lds, g, S, E); }
            }
            SEAM(pb + 7);
        }
}
__global__ void __launch_bounds__(512, 2) mk_fwd(Args args) {
    extern __shared__ __attribute__((aligned(16))) unsigned char lds_raw[];
    Frame F;
    F.lds = (LAS unsigned char*)lds_raw;
    F.wave = __builtin_amdgcn_readfirstlane((int)threadIdx.x >> 6);
    F.G = gridDim.x; { const int bx = blockIdx.x; F.vcu = (F.G % 8 == 0) ? (bx % 8) * (F.G / 8) + bx / 8 : bx; }
    F.ws = args.ws; F.ctl = (unsigned*)(args.ws + WS_CTL);
    volatile LAS unsigned* MISC = (volatile LAS unsigned*)(F.lds + MISC_OFF);
    if (threadIdx.x < 64) ((LAS unsigned*)(F.lds + MISC_OFF))[threadIdx.x] = 0u;
    __syncthreads();
    XcdBarrier bar; bar.bar = F.ctl + CW_BAR; bar.x = 0; bar.st = nullptr;
    if (!MK_PER_PHASE) bar = xcd_barrier_post(F.ctl + CW_BAR, MISC + 8);
    const int lo = args.ph_lo, hi = args.ph_hi;

    if (IN(0)) {
#ifndef NO_P0
        REPS(PROBE_DUP == 1) { REPBAR(); p0_prologue(F); }
#endif
        SEAM(0);
    }
    layer_phases<0>(F, bar, lo, hi); layer_phases<1>(F, bar, lo, hi); layer_phases<2>(F, bar, lo, hi); layer_phases<3>(F, bar, lo, hi);
    if (IN(33)) {
        NormArgs A{}; A.x = WSP(const f16, WS_X); A.xw = WSP(f16, WS_X); A.gain = KIN(21); A.out = (float*)karg<22>();
        A.y2 = WSP(const f16, WS_Y2); A.gcnt = F.ctl + CW_MOE + 1024; A.tokinfo = WSP(unsigned, WS_TOKINFO); A.gatef = WSP(const float, WS_MOD) + (size_t)3 * 16 * 6144 + 5120;
        REPSN(PROBE_DUP == 14, 5) { REPBAR(); norm_phase<true, false, true, false>(F, A); }
        if constexpr (PROBE_DUP == 24) { _Pragma("unroll 1") for (int i = 0; i < 40; ++i) xcd_barrier(bar); }
        if constexpr (PROBE_DUP == 20 || PROBE_DUP == 21) {
            xcd_barrier(bar);
            f16x8 a = {(f16)1.f, (f16)0.5f, (f16)0.25f, (f16)1.f, (f16)1.f, (f16)0.5f, (f16)0.25f, (f16)1.f}, b = a;
            f32x16 acc[4];
#pragma unroll
            for (int i = 0; i < 4; ++i)
#pragma unroll
                for (int j = 0; j < 16; ++j) acc[i][j] = 0.f;
            f32x4 acc16[8];
#pragma unroll
            for (int i = 0; i < 8; ++i) acc16[i] = (f32x4){0.f, 0.f, 0.f, 0.f};
            for (int it = 0; it < (PROBE_DUP == 20 ? 16384 : 8192); ++it) {
                if constexpr (PROBE_DUP == 20) {
#pragma unroll
                    for (int i = 0; i < 4; ++i) acc[i] = __builtin_amdgcn_mfma_f32_32x32x16_f16(a, b, acc[i], 0, 0, 0);
                } else {
#pragma unroll
                    for (int i = 0; i < 8; ++i) acc16[i] = __builtin_amdgcn_mfma_f32_16x16x32_f16(a, b, acc16[i], 0, 0, 0);
                }
            }
            float sacc = 0.f;
#pragma unroll
            for (int i = 0; i < 4; ++i) sacc += acc[i][0] + acc16[i][0] + acc16[4 + i][1];
            if (sacc == 1.2345e37f) WSP(float, WS_SLOTW)[0] = sacc;
        }
    }
#undef IN
#undef SEAM
#undef WSP
}

extern "C" void kernel_launch(void* const* d_in, const int* in_sizes, int n_in, void* d_out, int out_size, void* d_ws, size_t ws_size, hipStream_t stream) {
    static int grid = 0;
    if (grid == 0) {
        if (n_in != 22 || out_size != MTOK * DM || ws_size < WS_END) { fprintf(stderr, "kernel_launch: unexpected shapes (n_in %d out %d ws %zu, need %zu)\n", n_in, out_size, ws_size, (size_t)WS_END); grid = -1; return; }
        int dev = 0, cus = 0;
        if (hipGetDevice(&dev) != hipSuccess || hipDeviceGetAttribute(&cus, hipDeviceAttributeMultiprocessorCount, dev) != hipSuccess) { grid = -1; return; }
        if (hipFuncSetAttribute((const void*)mk_fwd, hipFuncAttributeMaxDynamicSharedMemorySize, LDS_BYTES) != hipSuccess) { fprintf(stderr, "kernel_launch: hipFuncSetAttribute failed\n"); grid = -1; return; }
        int per_cu = 0;
        if (hipOccupancyMaxActiveBlocksPerMultiprocessor(&per_cu, (const void*)mk_fwd, 512, LDS_BYTES) != hipSuccess || per_cu < 1) fprintf(stderr, "kernel_launch: occupancy query reports %d\n", per_cu);
        (void)hipGetLastError();
        if (cus < 256) { fprintf(stderr, "kernel_launch: needs >= 256 CUs, got %d\n", cus); grid = -1; return; }
        grid = cus;
    }
    if (grid < 0) return;
    (void)hipMemsetAsync((char*)d_ws + WS_CTL, 0, CTL_ZERO_BYTES, stream);
    Args a{};
    for (int i = 0; i < 22; ++i) a.in[i] = d_in[i];
    a.out = (float*)d_out; a.ws = (unsigned char*)d_ws;
#if MK_PER_PHASE
    for (int p = 0; p < N_PHASES; ++p) {
        if (p >= 1 && p <= 32) { const int L = (p - 1) / 8, k = (p - 1) % 8; if (k == 5) continue; (void)L; }
        a.ph_lo = p; a.ph_hi = p + 1;
        hipLaunchKernelGGL(mk_fwd, dim3(grid), dim3(512), LDS_BYTES, stream, a);
    }
#else
    a.ph_lo = 0; a.ph_hi = N_PHASES;
    hipLaunchKernelGGL(mk_fwd, dim3(grid), dim3(512), LDS_BYTES, stream, a);
#endif
}
```

```cpp
#include <hip/hip_runtime.h>
#include <cstdio>
#include <cstdint>

#define LAS __attribute__((address_space(3)))
#define GAS __attribute__((address_space(1)))
typedef _Float16 f16;
typedef _Float16 f16x2 __attribute__((ext_vector_type(2)));
typedef _Float16 f16x4 __attribute__((ext_vector_type(4)));
typedef _Float16 f16x8 __attribute__((ext_vector_type(8)));
typedef float f32x2 __attribute__((ext_vector_type(2)));
typedef float f32x4 __attribute__((ext_vector_type(4)));
typedef float f32x16 __attribute__((ext_vector_type(16)));
typedef unsigned u32x2 __attribute__((ext_vector_type(2)));
typedef unsigned u32x4 __attribute__((ext_vector_type(4)));
typedef short v4i16_t __attribute__((ext_vector_type(4)));
typedef int i32x8 __attribute__((ext_vector_type(8)));
typedef int i32x4 __attribute__((ext_vector_type(4)));

#ifndef DIS_K0
#define DIS_K0 0
#endif
#ifndef DIS_K1
#define DIS_K1 0
#endif
#ifndef DIS_K2
#define DIS_K2 0
#endif
#ifndef DIS_K3
#define DIS_K3 0
#endif
#ifndef DIS_K4
#define DIS_K4 0
#endif
#ifndef DIS_K5
#define DIS_K5 0
#endif
#ifndef DIS_K6
#define DIS_K6 0
#endif
#ifndef DIS_K7
#define DIS_K7 0
#endif
#ifndef PROBE_DUP
#define PROBE_DUP 0
#endif
#ifndef DENSE_F8
#define DENSE_F8 1
#define DF8(L) (DENSE_F8 != 0 && (L) == 2)
#ifndef DENSE_F8_OUT
#define DENSE_F8_OUT 0
#endif
#define DF8O(L) (DF8(L) && DENSE_F8_OUT != 0)
#endif
#ifndef RETIN_F8
#define RETIN_F8 0
#endif
#ifndef STAG_MOE
#define STAG_MOE 0
#endif
#ifndef STAG_RET
#define STAG_RET 0
#endif
#ifndef CONV_IN_SCAN
#define CONV_IN_SCAN 1
#endif
#ifndef MK_PER_PHASE
#define MK_PER_PHASE 0
#endif

constexpr int BATCH = 16, SEQ = 2048, DM = 1024, MTOK = BATCH * SEQ;
constexpr int RH = 8, RDK = 128, RDV = 256, RIN = 6144, CHUNK = 64, NCHUNK = SEQ / CHUNK;
constexpr int SBH = 16, SDH = 64;
constexpr int FFD = 2816, NEXP = 8, FFE = 3584;
constexpr float EPS = 1e-6f;
constexpr int MOE_ROWS_MAX = 2 * MTOK + NEXP * 256;

__device__ __forceinline__ float lg2gamma(int h) {
    const float t[8] = {-4.580368961312e-02f, -2.272007650008e-02f, -1.131531322783e-02f, -5.646563141142e-03f, -2.820519062379e-03f, -1.409570254671e-03f, -7.046129765894e-04f, -3.522634716290e-04f};
    float r = t[0];
#pragma unroll
    for (int i = 1; i < 8; ++i) r = (h == i) ? t[i] : r;
    return r;
}
__device__ __forceinline__ unsigned pkh(float lo, float hi) { f32x2 v = {lo, hi}; f16x2 h = __builtin_convertvector(v, f16x2); return __builtin_bit_cast(unsigned, h); }
__device__ __forceinline__ float silu_f(float x) { return x * __builtin_amdgcn_rcpf(1.0f + __builtin_amdgcn_exp2f(-1.4426950408889634f * x)); }
__device__ __forceinline__ float ex2(float x) { return __builtin_amdgcn_exp2f(x); }
__device__ __forceinline__ unsigned pk4f8(float a, float b, float c, float d) { int w = 0; w = __builtin_amdgcn_cvt_pk_fp8_f32(a, b, w, false); w = __builtin_amdgcn_cvt_pk_fp8_f32(c, d, w, true); return (unsigned)w; }
constexpr float F8_WSCALE = 64.0f;
constexpr float F8_ASCALE = 4.0f;

namespace pg8 {
constexpr int BM = 256, BK = 64, HALF = 128, HTB = HALF * BK * 2, STAGE_BYTES = 8 * HTB, NXCD = 8, WGM = 8;
__host__ __device__ __forceinline__ int lds_byte(int r, int c) { const int st = (r >> 4) * 2 + (c >> 5), rr = r & 15, cc = c & 31, ob = rr * 64 + cc * 2; return st * 1024 + (ob ^ (((ob >> 9) & 1) << 5)); }
__host__ __device__ __forceinline__ void stage_rc(int b, int& R, int& C) { const int st = b / 1024, sb = b % 1024, swz = sb ^ (((sb >> 9) & 1) << 5); R = (st >> 1) * 16 + swz / 64; C = (st & 1) * 32 + (swz % 64) / 2; }
__host__ __device__ __forceinline__ int perm32(int rho) { const int n = rho >> 4, i = rho & 15; return 8 * (i >> 2) + 4 * n + (i & 3); }

struct Unit { int pm, pn, be, arow, vrow; };
struct Gemm { const void* A; const void* Bt; int M, N, K; size_t bstride; int stagger = 0; };

struct Order {
    int nM, nN, nwg, G, c; int tb[NEXP]; int cap, avirt;
    __device__ void init(int M, int N, int G_, int c_) { nM = M / BM; nN = N / BM; nwg = nM * nN; G = G_; c = c_; cap = 0; avirt = 0;
#pragma unroll
        for (int e = 0; e < NEXP; ++e) tb[e] = e ? 0x7fffffff : 0; }
    __device__ bool next(int i, Unit& u) const {
        const long L = (long)i * G + c; if (L >= nwg) return false;
        int wgid = (int)L; { const int q = nwg / NXCD, r = nwg % NXCD, xcd = wgid % NXCD, off = wgid / NXCD; wgid = (xcd < r ? xcd * (q + 1) : r * (q + 1) + (xcd - r) * q) + off; }
        const int nig = WGM * nN, gid = wgid / nig, fm = gid * WGM, gsz = (nM - fm) < WGM ? (nM - fm) : WGM;
        u.pm = fm + ((wgid % nig) % gsz); u.pn = (wgid % nig) / gsz;
        int be = 0;
#pragma unroll
        for (int e = 1; e < NEXP; ++e) be += (u.pm >= tb[e]) ? 1 : 0;
        u.be = be;
        int tbe = 0;
#pragma unroll
        for (int e = 1; e < NEXP; ++e) tbe = (be == e) ? tb[e] : tbe;
        u.vrow = cap ? be * cap + (u.pm - tbe) * BM : u.pm * BM; u.arow = avirt ? u.vrow : u.pm * BM;
        return true;
    }
};


struct EpiRetIn {
    static constexpr bool PERM = true; static constexpr int NST = 16;
    f16* O; const float* rope; float scl;
    __device__ __forceinline__ void operator()(const f32x4 (&acc)[2][2][4][2], const Unit& u, int wr, int wc, int fr, int fq) const {
        const int row0 = u.pm * BM + wr * 64 + fr, cl = wc * 32 + 8 * fq;
        f16* base = O + (size_t)u.pn * BM + cl;
        if (u.pn < 8) {
            const bool isk = u.pn >= 4; const int i0 = cl >> 1;
            float lg[2]; lg[0] = lg2gamma(2 * (u.pn & 3)); lg[1] = lg2gamma(2 * (u.pn & 3) + 1);
            f32x4 cs_n = *(const f32x4*)(rope + (size_t)row0 * 128 + i0), sn_n = *(const f32x4*)(rope + (size_t)row0 * 128 + 64 + i0);
#pragma unroll
            for (int ai = 0; ai < 2; ++ai)
#pragma unroll
                for (int m = 0; m < 4; ++m) {
                    const int row = row0 + ai * HALF + m * 16; const float pos = (float)(16 * m + fr);
                    const f32x4 cs = cs_n, sn = sn_n;
                    if (ai * 4 + m < 7) { const int rown = row0 + ((ai * 4 + m + 1) >> 2) * HALF + ((ai * 4 + m + 1) & 3) * 16;
                        cs_n = *(const f32x4*)(rope + (size_t)rown * 128 + i0); sn_n = *(const f32x4*)(rope + (size_t)rown * 128 + 64 + i0); }
#pragma unroll
                    for (int bj = 0; bj < 2; ++bj) {
                        const float sc = (isk ? ex2(-pos * lg[bj]) * 0.08838834764831845f : ex2((pos + 1.0f) * lg[bj])) * scl;
                        const f32x4 v0 = acc[ai][bj][m][0], v1 = acc[ai][bj][m][1];
                        u32x4 w;
                        w.x = pkh((v0[0] * cs[0] - v0[1] * sn[0]) * sc, (v0[0] * sn[0] + v0[1] * cs[0]) * sc);
                        w.y = pkh((v0[2] * cs[1] - v0[3] * sn[1]) * sc, (v0[2] * sn[1] + v0[3] * cs[1]) * sc);
                        w.z = pkh((v1[0] * cs[2] - v1[1] * sn[2]) * sc, (v1[0] * sn[2] + v1[1] * cs[2]) * sc);
                        w.w = pkh((v1[2] * cs[3] - v1[3] * sn[3]) * sc, (v1[2] * sn[3] + v1[3] * cs[3]) * sc);
                        *(u32x4*)(base + (size_t)row * RIN + bj * HALF) = w;
                    }
                }
        } else {
            const bool isg = u.pn >= 16;
#pragma unroll
            for (int ai = 0; ai < 2; ++ai)
#pragma unroll
                for (int m = 0; m < 4; ++m) {
                    const int row = row0 + ai * HALF + m * 16;
#pragma unroll
                    for (int bj = 0; bj < 2; ++bj) {
                        f32x4 v0 = acc[ai][bj][m][0] * scl, v1 = acc[ai][bj][m][1] * scl;
                        if (isg) {
#pragma unroll
                            for (int j = 0; j < 4; ++j) { v0[j] = silu_f(v0[j]); v1[j] = silu_f(v1[j]); } }
                        u32x4 w; w.x = pkh(v0[0], v0[1]); w.y = pkh(v0[2], v0[3]); w.z = pkh(v1[0], v1[1]); w.w = pkh(v1[2], v1[3]);
                        *(u32x4*)(base + (size_t)row * RIN + bj * HALF) = w;
                    }
                }
        }
    }
};
struct EpiY {
    static constexpr bool PERM = true; static constexpr int NST = 16;
    f16* Y; const float* gate; float scl;
    __device__ __forceinline__ void operator()(const f32x4 (&acc)[2][2][4][2], const Unit& u, int wr, int wc, int fr, int fq) const {
        const int row0 = u.pm * BM + wr * 64 + fr, col0 = u.pn * BM + wc * 32 + 8 * fq;
        const float* gp = gate + (size_t)(u.pm >> 3) * 6144 + col0;
        f32x4 gv[2][2];
#pragma unroll
        for (int bj = 0; bj < 2; ++bj)
#pragma unroll
            for (int n = 0; n < 2; ++n) gv[bj][n] = *(const f32x4*)(gp + bj * HALF + 4 * n) * scl;
#pragma unroll
        for (int ai = 0; ai < 2; ++ai)
#pragma unroll
            for (int m = 0; m < 4; ++m) { f16* rowp = Y + (size_t)(row0 + ai * HALF + m * 16) * DM + col0;
#pragma unroll
                for (int bj = 0; bj < 2; ++bj) { const f32x4 v0 = acc[ai][bj][m][0] * gv[bj][0], v1 = acc[ai][bj][m][1] * gv[bj][1];
                    u32x4 w; w.x = pkh(v0[0], v0[1]); w.y = pkh(v0[2], v0[3]); w.z = pkh(v1[0], v1[1]); w.w = pkh(v1[2], v1[3]);
                    *(u32x4*)(rowp + bj * HALF) = w; } }
    }
};
template <bool F8IN, bool F8 = F8IN> struct EpiGlu {
    static constexpr bool PERM = true; static constexpr int NST = 8;
    void* Ov; int ldc;
    __device__ __forceinline__ void operator()(const f32x4 (&acc)[2][2][4][2], const Unit& u, int wr, int wc, int fr, int fq) const {
        const int row0 = u.pm * BM + wr * 64 + fr, col0 = u.pn * HALF + wc * 32 + 8 * fq;
        constexpr float si = F8IN ? 1.0f / F8_WSCALE : 1.0f, so = F8 ? F8_ASCALE : 1.0f;
#pragma unroll
        for (int ai = 0; ai < 2; ++ai)
#pragma unroll
            for (int m = 0; m < 4; ++m) {
                float r[8];
#pragma unroll
                for (int n = 0; n < 2; ++n)
#pragma unroll
                    for (int p = 0; p < 2; ++p) {
                        const f32x2 a = {acc[ai][0][m][n][2 * p], acc[ai][0][m][n][2 * p + 1]}, b = {acc[ai][1][m][n][2 * p], acc[ai][1][m][n][2 * p + 1]};
                        const f32x2 t = a * (-1.4426950408889634f * si); f32x2 d = {ex2(t.x), ex2(t.y)}; d = d + 1.0f;
                        const f32x2 u = {__builtin_amdgcn_rcpf(d.x), __builtin_amdgcn_rcpf(d.y)};
                        const f32x2 q = ((a * b) * u) * (si * si * so);
                        r[4 * n + 2 * p] = q.x; r[4 * n + 2 * p + 1] = q.y;
                    }
                if (F8) { u32x2 w; w.x = pk4f8(r[0], r[1], r[2], r[3]); w.y = pk4f8(r[4], r[5], r[6], r[7]);
                    *(u32x2*)((unsigned char*)Ov + (size_t)(row0 + ai * HALF + m * 16) * ldc + col0) = w; }
                else { u32x4 w; w.x = pkh(r[0], r[1]); w.y = pkh(r[2], r[3]); w.z = pkh(r[4], r[5]); w.w = pkh(r[6], r[7]);
                    *(u32x4*)((f16*)Ov + (size_t)(row0 + ai * HALF + m * 16) * ldc + col0) = w; }
            }
    }
};
struct EpiF16 {
    static constexpr bool PERM = true; static constexpr int NST = 16;
    f16* O; int ldc; int split_cols; size_t split_stride; float scale;
    __device__ __forceinline__ void operator()(const f32x4 (&acc)[2][2][4][2], const Unit& u, int wr, int wc, int fr, int fq) const {
        const int row0 = u.pm * BM + wr * 64 + fr; int colt = u.pn * BM; f16* base = O;
        if (split_cols) { const int t = colt / split_cols; base += (size_t)t * split_stride; colt -= t * split_cols; }
        const int col0 = colt + wc * 32 + 8 * fq;
#pragma unroll
        for (int ai = 0; ai < 2; ++ai)
#pragma unroll
            for (int m = 0; m < 4; ++m) { f16* rowp = base + (size_t)(row0 + ai * HALF + m * 16) * ldc + col0;
#pragma unroll
                for (int bj = 0; bj < 2; ++bj) { const f32x4 v0 = acc[ai][bj][m][0] * scale, v1 = acc[ai][bj][m][1] * scale;
                    u32x4 w; w.x = pkh(v0[0], v0[1]); w.y = pkh(v0[2], v0[3]); w.z = pkh(v1[0], v1[1]); w.w = pkh(v1[2], v1[3]);
                    *(u32x4*)(rowp + bj * HALF) = w; } }
    }
};
struct EpiMoeOut {
    static constexpr bool PERM = true; static constexpr int NST = 16;
    f16* O; const float* roww; const unsigned* tof;
    __device__ __forceinline__ void operator()(const f32x4 (&acc)[2][2][4][2], const Unit& u, int wr, int wc, int fr, int fq) const {
        const int col0 = u.pn * BM + wc * 32 + 8 * fq;
        float scw[2][4]; unsigned tk[2][4];
#pragma unroll
        for (int ai = 0; ai < 2; ++ai)
#pragma unroll
            for (int m = 0; m < 4; ++m) { scw[ai][m] = roww[u.vrow + wr * 64 + fr + ai * HALF + m * 16]; tk[ai][m] = tof[u.vrow + wr * 64 + fr + ai * HALF + m * 16]; }
#pragma unroll
        for (int ai = 0; ai < 2; ++ai)
#pragma unroll
            for (int m = 0; m < 4; ++m) { const unsigned trow = (tk[ai][m] == 0xffffffffu) ? (unsigned)(2 * MTOK) : tk[ai][m];
                const float sc = scw[ai][m] * (1.0f / (F8_WSCALE * F8_ASCALE)); f16* rowp = O + (size_t)trow * DM + col0;
#pragma unroll
                for (int bj = 0; bj < 2; ++bj) { const f32x4 v0 = acc[ai][bj][m][0] * sc, v1 = acc[ai][bj][m][1] * sc;
                    u32x4 w; w.x = pkh(v0[0], v0[1]); w.y = pkh(v0[2], v0[3]); w.z = pkh(v1[0], v1[1]); w.w = pkh(v1[2], v1[3]);
                    *(u32x4*)(rowp + bj * HALF) = w; } }
    }
};

template <bool P> struct EpiNull {
    static constexpr bool PERM = P; static constexpr int NST = 0;
    float* sink;
    __device__ __forceinline__ void operator()(const f32x4 (&acc)[2][2][4][2], const Unit& u, int wr, int wc, int fr, int fq) const {
        float s = 0.f;
#pragma unroll
        for (int ai = 0; ai < 2; ++ai)
#pragma unroll
            for (int bj = 0; bj < 2; ++bj)
#pragma unroll
                for (int m = 0; m < 4; ++m)
#pragma unroll
                    for (int n = 0; n < 2; ++n) s += acc[ai][bj][m][n][0] + acc[ai][bj][m][n][1] + acc[ai][bj][m][n][2] + acc[ai][bj][m][n][3];
        if (s == 1.2345e37f) sink[0] = s;
    }
};
template <class Epi, bool F8 = false>
__device__ __forceinline__ void gemm_phase(LAS unsigned char* lds, const Gemm g, const Order& S, const Epi& E) {
    const int tid = threadIdx.x, wid = __builtin_amdgcn_readfirstlane(tid >> 6), lane = tid & 63, wr = wid >> 2, wc = wid & 3, fr = lane & 15, fq = lane >> 4;
    const int KB = g.K * (F8 ? 1 : 2), nt = KB / 128;
    unsigned voffA[2], voffB[2];
#pragma unroll
    for (int i = 0; i < 2; ++i) { int R, C; stage_rc(tid * 16 + i * 8192, R, C); const int Rb = Epi::PERM ? ((R & ~31) + perm32(R & 31)) : R;
        voffA[i] = (unsigned)(R * KB + 2 * C); voffB[i] = (unsigned)(Rb * KB + 2 * C); }
    const size_t kstep = (size_t)(BK * 2);
    const size_t hstep = (size_t)HALF * KB;
    const size_t tstep = 2 * hstep;
    const unsigned ldsw = (unsigned)wid * 1024u;
    const int aoff = lds_byte(wr * 64 + fr, fq * 8), boff = lds_byte(wc * 32 + fr, fq * 8);
#define PG8_SA(b, h) (((b) * 2 + (h)) * HTB)
#define PG8_SB(b, h) ((4 + (b) * 2 + (h)) * HTB)
#define PG8_STAGE(bufoff, gbase, voff) do { _Pragma("unroll") for (int _i = 0; _i < 2; ++_i) \
        __builtin_amdgcn_global_load_lds((const unsigned*)((const char*)(gbase) + (voff)[_i]), (LAS unsigned*)(lds + (bufoff) + ldsw + _i * 8192), 16, 0, 0); } while (0)
#define PG8_LD8(dst, addr) do { const i32x4 lo_ = *(const LAS i32x4*)(addr), hi_ = *(const LAS i32x4*)((addr) + 1024); dst = __builtin_shufflevector(lo_, hi_, 0, 1, 2, 3, 4, 5, 6, 7); } while (0)
#define PG8_LDA(dst, b, h) do { _Pragma("unroll") for (int m = 0; m < 4; ++m) { if constexpr (F8) PG8_LD8(dst##8[m], lds + PG8_SA(b, h) + aoff + m * 2048); else { _Pragma("unroll") for (int k = 0; k < 2; ++k) dst[m][k] = *(const LAS f16x8*)(lds + PG8_SA(b, h) + aoff + m * 2048 + k * 1024); } } } while (0)
#define PG8_LDB(dst, b, h) do { _Pragma("unroll") for (int n = 0; n < 2; ++n) { if constexpr (F8) PG8_LD8(dst##8[n], lds + PG8_SB(b, h) + boff + n * 2048); else { _Pragma("unroll") for (int k = 0; k < 2; ++k) dst[n][k] = *(const LAS f16x8*)(lds + PG8_SB(b, h) + boff + n * 2048 + k * 1024); } } } while (0)
#define PG8_MMA(ai, bj, At, Bt) do { __builtin_amdgcn_s_setprio(1); _Pragma("unroll") for (int m = 0; m < 4; ++m) _Pragma("unroll") for (int n = 0; n < 2; ++n) { \
        if constexpr (F8) asm volatile("v_mfma_scale_f32_16x16x128_f8f6f4 %0, %1, %2, %0, %3, %3 op_sel_hi:[0,0,0]" : "+v"(acc[ai][bj][m][n]) : "v"(Bt##8[n]), "v"(At##8[m]), "v"(f8scale)); \
        else { _Pragma("unroll") for (int k = 0; k < 2; ++k) acc[ai][bj][m][n] = __builtin_amdgcn_mfma_f32_16x16x32_f16(Bt[n][k], At[m][k], acc[ai][bj][m][n], 0, 0, 0); } } \
        __builtin_amdgcn_s_setprio(0); } while (0)
#define PG8_WAIT_V(n) asm volatile("s_waitcnt vmcnt(" #n ")" ::: "memory")
#define PG8_WAIT_VR() asm volatile("s_waitcnt vmcnt(%0)" :: "n"(8 + Epi::NST) : "memory")
#define PG8_WAIT_L(n) asm volatile("s_waitcnt lgkmcnt(" #n ")" ::: "memory")
#define PG8_BAR __builtin_amdgcn_s_barrier()
#define PG8_SCHED __builtin_amdgcn_sched_barrier(0)
    Unit cur, nxt; int ui = 0; bool relax = false;
    if (!S.next(0, cur)) return;
    if (g.stagger) {
        const unsigned grp = (blockIdx.x >> 3) & 3u;
        if (grp) { const unsigned long long t0 = __builtin_amdgcn_s_memrealtime(); while (__builtin_amdgcn_s_memrealtime() - t0 < (unsigned long long)(grp * (unsigned)g.stagger)) __builtin_amdgcn_s_sleep(16); }
    }
    f32x4 acc[2][2][4][2];
#pragma unroll
    for (int a = 0; a < 2; ++a)
#pragma unroll
        for (int b = 0; b < 2; ++b)
#pragma unroll
            for (int m = 0; m < 4; ++m)
#pragma unroll
                for (int n = 0; n < 2; ++n) acc[a][b][m][n] = (f32x4){0.f, 0.f, 0.f, 0.f};
    const int f8scale = 0x7f7f7f7f;
    f16x8 At[4][2], B0[2][2], B1[2][2]; i32x8 At8[4], B08[2], B18[2];
    const char* cA = (const char*)g.A + (size_t)cur.arow * KB; const char* cB = (const char*)g.Bt + (size_t)cur.be * g.bstride + (size_t)cur.pn * tstep;
    PG8_STAGE(PG8_SB(0, 0), cB, voffB); PG8_STAGE(PG8_SB(0, 1), cB + hstep, voffB); PG8_STAGE(PG8_SA(0, 0), cA, voffA); PG8_STAGE(PG8_SA(0, 1), cA + hstep, voffA);
    if (wr == 1) PG8_BAR;
    PG8_WAIT_V(2); PG8_BAR;
    PG8_STAGE(PG8_SB(1, 0), cB + kstep, voffB); PG8_STAGE(PG8_SA(1, 0), cA + kstep, voffA); PG8_STAGE(PG8_SB(1, 1), cB + hstep + kstep, voffB);
    PG8_WAIT_V(6); PG8_BAR;
    for (;;) {
        const bool has_next = S.next(ui + 1, nxt);
        const char* nA = has_next ? (const char*)g.A + (size_t)nxt.arow * KB : cA; const char* nB = has_next ? (const char*)g.Bt + (size_t)nxt.be * g.bstride + (size_t)nxt.pn * tstep : cB;
#pragma nounroll
        for (int t = 0; t < nt; t += 2) {
            const bool last = (t == nt - 2);
            const char* a1 = cA + (size_t)(t + 1) * kstep;
            const char* a2 = last ? nA : cA + (size_t)(t + 2) * kstep; const char* b2 = last ? nB : cB + (size_t)(t + 2) * kstep;
            const char* a3 = a2 + kstep; const char* b3 = b2 + kstep;
            PG8_LDB(B0, 0, 0); PG8_LDB(B1, 0, 1); PG8_SCHED; PG8_LDA(At, 0, 0); PG8_STAGE(PG8_SA(1, 1), a1 + hstep, voffA);
            if (relax) PG8_WAIT_VR(); else PG8_WAIT_V(8);
            PG8_WAIT_L(0); PG8_BAR; PG8_MMA(0, 0, At, B0); PG8_MMA(0, 1, At, B1); PG8_BAR; PG8_SCHED;
            PG8_LDA(At, 0, 1); PG8_STAGE(PG8_SB(0, 0), b2, voffB); PG8_STAGE(PG8_SB(0, 1), b2 + hstep, voffB); PG8_STAGE(PG8_SA(0, 0), a2, voffA);
            if (relax) { PG8_WAIT_VR(); relax = false; } else PG8_WAIT_V(8);
            PG8_WAIT_L(0); PG8_BAR; PG8_MMA(1, 0, At, B0); PG8_MMA(1, 1, At, B1); PG8_BAR; PG8_SCHED;
            PG8_LDB(B0, 1, 0); PG8_LDB(B1, 1, 1); PG8_SCHED; PG8_LDA(At, 1, 0); PG8_STAGE(PG8_SA(0, 1), a2 + hstep, voffA);
            PG8_WAIT_V(8); PG8_WAIT_L(0); PG8_BAR; PG8_MMA(0, 0, At, B0); PG8_MMA(0, 1, At, B1); PG8_BAR; PG8_SCHED;
            PG8_LDA(At, 1, 1); PG8_STAGE(PG8_SB(1, 0), b3, voffB); PG8_STAGE(PG8_SB(1, 1), b3 + hstep, voffB); PG8_STAGE(PG8_SA(1, 0), a3, voffA);
            PG8_WAIT_V(8); PG8_WAIT_L(0); PG8_BAR; PG8_MMA(1, 0, At, B0); PG8_MMA(1, 1, At, B1); PG8_BAR; PG8_SCHED;
        }
        if constexpr (F8) asm volatile("s_nop 15\n\ts_nop 15" ::: "memory");
        if (wr == 0) PG8_BAR;
        E(acc, cur, wr, wc, fr, fq);
        if (!has_next) break;
#pragma unroll
        for (int a = 0; a < 2; ++a)
#pragma unroll
            for (int b = 0; b < 2; ++b)
#pragma unroll
                for (int m = 0; m < 4; ++m)
#pragma unroll
                    for (int n = 0; n < 2; ++n) acc[a][b][m][n] = (f32x4){0.f, 0.f, 0.f, 0.f};
        cur = nxt; cA = nA; cB = nB; ++ui; relax = true;
        if (wr == 1) PG8_BAR;
    }
    PG8_WAIT_V(0);
    PG8_BAR;
#undef PG8_SA
#undef PG8_SB
#undef PG8_STAGE
#undef PG8_LDA
#undef PG8_LDB
#undef PG8_MMA
#undef PG8_WAIT_V
#undef PG8_WAIT_L
#undef PG8_BAR
#undef PG8_SCHED
}
}

constexpr size_t MiB = 1u << 20;
constexpr size_t WS_CTL = 0, CTL_ZERO_BYTES = 1 * MiB;
constexpr size_t WS_MOD = 1 * MiB;
constexpr size_t WS_KVMOD = 3 * MiB;
constexpr size_t WS_TOKINFO = 4 * MiB;
constexpr size_t WS_TOF = 5 * MiB;
constexpr size_t WS_TOKSLOT = 6 * MiB;
constexpr size_t WS_SLOTW = 7 * MiB;
constexpr size_t WS_ROPE = 8 * MiB;
constexpr size_t WS_W_RIN = 24 * MiB, WS_W_ROUT = 48 * MiB, WS_W_KV = 56 * MiB, WS_W_SQ = 60 * MiB, WS_W_SO = 64 * MiB, WS_W_FIN = 68 * MiB, WS_W_FOUT = 90 * MiB, WS_W_MIN = 101 * MiB, WS_W_MOUT = 325 * MiB;
constexpr size_t WS_X = 437 * MiB, WS_H = 565 * MiB, WS_KSH = 629 * MiB, WS_VSH = 693 * MiB, WS_BIG = 757 * MiB;
constexpr size_t WS_PROJ = WS_BIG, WS_AO = WS_BIG + 384 * MiB;
constexpr size_t WS_ACTD = WS_BIG;
constexpr int MOE_CAP = MTOK;
constexpr size_t WS_HS = WS_BIG, WS_Y2 = WS_BIG, WS_ACTE = WS_BIG + 256 * MiB;
constexpr size_t WS_SQ = WS_BIG, WS_SO = WS_BIG + 64 * MiB, WS_HK = WS_BIG + 192 * MiB;
constexpr size_t WS_YB = WS_BIG + 594 * MiB;
constexpr size_t WS_END = WS_YB + 64 * MiB;
static_assert((size_t)MOE_ROWS_MAX * DM * 2 <= 256 * MiB && (size_t)NEXP * MOE_CAP * DM <= 256 * MiB && WS_ACTE + (size_t)MOE_ROWS_MAX * FFE <= WS_YB && WS_AO + (size_t)MTOK * 2048 * 2 <= WS_YB, "ws map");
constexpr int CW_BAR = 4096;
constexpr int CW_MOE = 16384;

constexpr int RING_BYTES = 131072;
constexpr int LDS_BYTES = 147456;
constexpr int MISC_OFF = LDS_BYTES - 256;

#define XB_TMO      128
#define XB_XCNT(j)  (256  + 64 * (j))
#define XB_XSUB(j)  (1280 + 64 * (j))
#define XB_XGEN(j)  (2304 + 64 * (j))
#define XB_TOP      3328
#define XB_TOPGEN   3392
#define XCD_BAR_WORDS 3456
#define XB_SPIN_CAP (1u << 20)
__device__ __forceinline__ unsigned xb_ld(unsigned* p)              { return __hip_atomic_load(p, __ATOMIC_RELAXED, __HIP_MEMORY_SCOPE_AGENT); }
__device__ __forceinline__ unsigned xb_add(unsigned* p, unsigned v) { return __hip_atomic_fetch_add(p, v, __ATOMIC_RELAXED, __HIP_MEMORY_SCOPE_AGENT); }
__device__ __forceinline__ unsigned xb_xcc_id() { return (unsigned)__builtin_amdgcn_s_getreg((3 << 11) | 20) & 0xFu; }
#define XB_SPIN(cond, bar) do { unsigned _sp = 0; while (cond) { __builtin_amdgcn_s_sleep(1); \
    if ((++_sp & 255u) == 0u) { if (xb_ld(&(bar)[XB_TMO])) break; if (_sp > XB_SPIN_CAP) { atomicAdd(&(bar)[XB_TMO], 1u); break; } } } } while (0)
struct XcdBarrier { unsigned* bar; unsigned x; volatile LAS unsigned* st; };
__device__ __forceinline__ XcdBarrier xcd_barrier_post(unsigned* bar, volatile LAS unsigned* st) {
    XcdBarrier b; b.bar = bar; b.x = xb_xcc_id(); b.st = st;
    if (threadIdx.x == 0) (void)xb_add(&bar[XB_XCNT(b.x)], 1u);
    return b;
}
__device__ __forceinline__ void xcd_barrier_complete(unsigned* bar, unsigned x, unsigned& nloc, unsigned& nx) {
    const unsigned G = gridDim.x * gridDim.y * gridDim.z;
    unsigned sum, cnt, mine, sp = 0u;
    for (;;) {
        sum = 0u; cnt = 0u; mine = 0u;
#pragma unroll
        for (unsigned j = 0; j < 16; ++j) { const unsigned c = xb_ld(&bar[XB_XCNT(j)]); sum += c; cnt += (c > 0u) ? 1u : 0u; mine = (j == x) ? c : mine; }
        if (sum == G) break;
        __builtin_amdgcn_s_sleep(1);
        if ((++sp & 255u) == 0u) { if (xb_ld(&bar[XB_TMO])) break; if (sp > XB_SPIN_CAP) { atomicAdd(&bar[XB_TMO], 1u); break; } }
    }
    nloc = mine > 0u ? mine : 1u; nx = cnt > 0u ? cnt : 1u;
}
__device__ __forceinline__ void xcd_barrier(const XcdBarrier& b) {
    asm volatile("s_waitcnt vmcnt(0)" ::: "memory");
    __syncthreads();
    if (threadIdx.x == 0) {
        unsigned* bar = b.bar;
        __builtin_amdgcn_s_waitcnt(0);
        unsigned nloc = b.st[0], nx = b.st[1];
        if (nloc == 0u) { xcd_barrier_complete(bar, b.x, nloc, nx); b.st[0] = nloc; b.st[1] = nx; }
        const unsigned old = xb_add(&bar[XB_XSUB(b.x)], 1u);
        const unsigned gen = old / nloc;
        if (old + 1u == (gen + 1u) * nloc) {
            __builtin_amdgcn_fence(__ATOMIC_RELEASE, "agent");
            asm volatile("s_waitcnt vmcnt(0)" ::: "memory");
            const unsigned og = xb_add(&bar[XB_TOP], 1u);
            const unsigned tg = og / nx;
            if (og + 1u == (tg + 1u) * nx) xb_add(&bar[XB_TOPGEN], 1u);
            else XB_SPIN(xb_ld(&bar[XB_TOPGEN]) == tg, bar);
            __builtin_amdgcn_fence(__ATOMIC_ACQUIRE, "agent");
            xb_add(&bar[XB_XGEN(b.x)], 1u);
            asm volatile("s_waitcnt vmcnt(0)" ::: "memory");
        } else {
            XB_SPIN(xb_ld(&bar[XB_XGEN(b.x)]) == gen, bar);
            __builtin_amdgcn_fence(__ATOMIC_ACQUIRE, "agent");
            asm volatile("s_waitcnt vmcnt(0)" ::: "memory");
        }
    }
    __syncthreads();
}

#define WG_BAR() do { asm volatile("s_waitcnt lgkmcnt(0)" ::: "memory"); __builtin_amdgcn_s_barrier(); asm volatile("" ::: "memory"); } while (0)
#define CFENCE() asm volatile("" ::: "memory")
__device__ __forceinline__ float wave_sum(float v) {
#pragma unroll
    for (int o = 1; o < 64; o <<= 1) v += __shfl_xor(v, o);
    return v;
}
__device__ __forceinline__ f16x4 tr_read(LAS const unsigned char* p) {
    return __builtin_bit_cast(f16x4, __builtin_amdgcn_ds_read_tr16_b64_v4i16((LAS v4i16_t*)p));
}
__device__ __forceinline__ f16x8 cat8(f16x4 a, f16x4 b) { return (f16x8){a[0], a[1], a[2], a[3], b[0], b[1], b[2], b[3]}; }
__device__ __forceinline__ f16x8 pack8(const f32x16& x, int s) {
    u32x4 w; w.x = pkh(x[8 * s + 0], x[8 * s + 1]); w.y = pkh(x[8 * s + 2], x[8 * s + 3]); w.z = pkh(x[8 * s + 4], x[8 * s + 5]); w.w = pkh(x[8 * s + 6], x[8 * s + 7]);
    return __builtin_bit_cast(f16x8, w);
}

struct Frame {
    LAS unsigned char* lds;
    unsigned* ctl;
    int wave, vcu, G;
    unsigned char* ws;
};
__device__ __forceinline__ int lane_id() { int l; asm volatile("v_mbcnt_lo_u32_b32 %0, -1, 0\n\tv_mbcnt_hi_u32_b32 %0, -1, %0" : "=v"(l)); return l; }
#define PHASE_IDS() const int lane = lane_id(); const int tid = F.wave * 64 + lane; (void)tid

template <int I> __device__ __forceinline__ const void* karg() {
    const auto kp = __builtin_amdgcn_kernarg_segment_ptr();
    unsigned long long v; asm volatile("s_load_dwordx2 %0, %1, %2\n\ts_waitcnt lgkmcnt(0)" : "=s"(v) : "s"(kp), "i"(I * 8) : "memory");
    return (const void*)(const GAS char*)v;
}
#define KIN(i) ((const float*)karg<(i)>())
template <int MAP>
__device__ __forceinline__ int srccol(int n, int N) {
    if (MAP == 1) { if (n >= 2048) return n; const int p = n & 127; return (n & ~127) + (p >> 1) + 64 * (p & 1); }
    if (MAP == 2) { const int F = N >> 1, t = n >> 8, j = n & 255; return (j < 128) ? 128 * t + j : F + 128 * t + (j - 128); }
    return n;
}
template <int MAP, bool F8>
__device__ __forceinline__ void p0_transpose_item(const float* W, int K, int N, void* WT, LAS float* scr, int item, int lane) {
    const int nblk = N / 32, kb = item / nblk, nb = item % nblk, k0 = 64 * kb, n0 = 32 * nb;
    const int sc = srccol<MAP>(n0 + (lane & 31), N);
    const float* wp = W + (size_t)(k0 + (lane >> 5)) * N + sc;
    float v[32];
#pragma unroll
    for (int i = 0; i < 32; ++i) v[i] = __builtin_nontemporal_load(wp + (size_t)(2 * i) * N);
#pragma unroll
    for (int i = 0; i < 32; ++i) scr[(2 * i + (lane >> 5)) * 33 + (lane & 31)] = F8 ? v[i] * F8_WSCALE : v[i];
    asm volatile("s_waitcnt lgkmcnt(0)" ::: "memory");
    if (F8) {
        const int c = lane & 3;
#pragma unroll
        for (int j = 0; j < 2; ++j) { const int n = (lane >> 2) + 16 * j; const LAS float* s = scr + (16 * c) * 33 + n;
            u32x4 o; o.x = pk4f8(s[0 * 33], s[1 * 33], s[2 * 33], s[3 * 33]); o.y = pk4f8(s[4 * 33], s[5 * 33], s[6 * 33], s[7 * 33]);
            o.z = pk4f8(s[8 * 33], s[9 * 33], s[10 * 33], s[11 * 33]); o.w = pk4f8(s[12 * 33], s[13 * 33], s[14 * 33], s[15 * 33]);
            *(u32x4*)((unsigned char*)WT + (size_t)(n0 + n) * K + k0 + 16 * c) = o; }
    } else {
        const int c = lane & 7;
#pragma unroll
        for (int j = 0; j < 4; ++j) { const int n = (lane >> 3) + 8 * j; const LAS float* s = scr + (8 * c) * 33 + n;
            u32x4 o; o.x = pkh(s[0 * 33], s[1 * 33]); o.y = pkh(s[2 * 33], s[3 * 33]); o.z = pkh(s[4 * 33], s[5 * 33]); o.w = pkh(s[6 * 33], s[7 * 33]);
            *(u32x4*)((f16*)WT + (size_t)(n0 + n) * K + k0 + 8 * c) = o; }
    }
    asm volatile("s_waitcnt lgkmcnt(0)" ::: "memory");
}
template <int MAP, bool F8>
__device__ __forceinline__ bool p0_group(int& r, const float* W, int nb, int K, int N, void* WT, LAS float* scr, int lane) {
    const int per = (K / 64) * (N / 32), tot = nb * per;
    if (r >= tot) { r -= tot; return false; }
    const int b = r / per, it = r % per;
    p0_transpose_item<MAP, F8>(W + (size_t)b * K * N, K, N, (unsigned char*)WT + (size_t)b * K * N * (F8 ? 1 : 2), scr, it, lane);
    return true;
}
constexpr int CONV_ITEMS_0 = 8 * (16 * 224 + 56 * 32) + 16 * 192 + 32 * 32;
constexpr int CONV_ITEMS_1 = 8 * (16 * 224 + 56 * 32) + 16 * 64 + 4 * 16 * 32 + 16 * 176 + 44 * 32;
__device__ __forceinline__ void conv_rest(int r, int which, unsigned char* ws, LAS float* scr, int lane) {
    if (which != 1) {
        if (p0_group<2, true>(r, KIN(19), NEXP, 1024, 7168, ws + WS_W_MIN, scr, lane)) return;
        if (p0_group<0, true>(r, KIN(20), NEXP, 3584, 1024, ws + WS_W_MOUT, scr, lane)) return;
        if (p0_group<1, RETIN_F8 != 0>(r, KIN(7) + (size_t)1024 * 6144, 1, 1024, 6144, (f16*)(ws + WS_W_RIN) + (size_t)1024 * 6144, scr, lane)) return;
        if (p0_group<0, false>(r, KIN(9) + (size_t)2048 * 1024, 1, 2048, 1024, (f16*)(ws + WS_W_ROUT) + (size_t)2048 * 1024, scr, lane)) return;
    }
    if (which != 0) {
        if (p0_group<2, true>(r, KIN(19) + (size_t)NEXP * 1024 * 7168, NEXP, 1024, 7168, ws + WS_W_MIN + (size_t)NEXP * 1024 * 7168, scr, lane)) return;
        if (p0_group<0, true>(r, KIN(20) + (size_t)NEXP * 3584 * 1024, NEXP, 3584, 1024, ws + WS_W_MOUT + (size_t)NEXP * 3584 * 1024, scr, lane)) return;
        if (p0_group<0, false>(r, KIN(13), 1, 1024, 2048, (f16*)(ws + WS_W_KV), scr, lane)) return;
        if (p0_group<0, false>(r, KIN(14), 2, 1024, 1024, (f16*)(ws + WS_W_SQ), scr, lane)) return;
        if (p0_group<0, false>(r, KIN(15), 2, 1024, 1024, (f16*)(ws + WS_W_SO), scr, lane)) return;
        if (p0_group<2, DENSE_F8 != 0>(r, KIN(16) + (size_t)1024 * 5632, 1, 1024, 5632, (f16*)(ws + WS_W_FIN) + (size_t)1024 * 5632, scr, lane)) return;
        p0_group<0, (DENSE_F8 != 0 && DENSE_F8_OUT != 0)>(r, KIN(17) + (size_t)2816 * 1024, 1, 2816, 1024, (f16*)(ws + WS_W_FOUT) + (size_t)2816 * 1024, scr, lane);
    }
}
__device__ __forceinline__ void p0_prologue(Frame& F) {
    PHASE_IDS();
    const int gw = F.vcu * 8 + F.wave, NGW = F.G * 8;
    LAS float* condL = (LAS float*)(F.lds);
    LAS float* scr = (LAS float*)(F.lds + 65536 + F.wave * 8448);
    for (int i = tid; i < 16 * 1024; i += 512) { const int b = i >> 10, k = i & 1023; condL[k * 16 + b] = silu_f(KIN(1)[i]); }
    WG_BAR();
    for (int it = gw; it < 1664; it += NGW) {
        const float* W; const float* bias; float* dst; int N, col0;
        if (it < 1536) { const int l = it / 384; col0 = 16 * (it % 384); N = 6144; W = KIN(3) + (size_t)l * 1024 * 6144; bias = KIN(4) + l * 6144; dst = (float*)(F.ws + WS_MOD) + (size_t)l * 16 * 6144; }
        else { col0 = 16 * (it - 1536); N = 2048; W = KIN(10); bias = KIN(11); dst = (float*)(F.ws + WS_KVMOD); }
        const int cl = lane & 3, kg = lane >> 2;
        f32x4 acc[16];
#pragma unroll
        for (int b = 0; b < 16; ++b) acc[b] = (f32x4){0.f, 0.f, 0.f, 0.f};
        const float* wp = W + (size_t)kg * N + col0 + 4 * cl;
#pragma unroll 4
        for (int k16 = 0; k16 < 64; ++k16) {
            const f32x4 w = *(const f32x4*)(wp + (size_t)k16 * 16 * N);
            const LAS f32x4* cp = (const LAS f32x4*)(condL + (16 * k16 + kg) * 16);
            const f32x4 c0 = cp[0], c1 = cp[1], c2 = cp[2], c3 = cp[3];
#pragma unroll
            for (int j = 0; j < 4; ++j) { acc[j] += c0[j] * w; acc[4 + j] += c1[j] * w; acc[8 + j] += c2[j] * w; acc[12 + j] += c3[j] * w; }
        }
        const f32x4 bv = *(const f32x4*)(bias + col0 + 4 * cl);
#pragma unroll
        for (int b = 0; b < 16; ++b) {
            f32x4 v = acc[b];
#pragma unroll
            for (int j = 0; j < 4; ++j) { v[j] += __shfl_xor(v[j], 4); v[j] += __shfl_xor(v[j], 8); v[j] += __shfl_xor(v[j], 16); v[j] += __shfl_xor(v[j], 32); }
            if (kg == 0) *(f32x4*)(dst + (size_t)b * N + col0 + 4 * cl) = v + bv;
        }
    }
    {
        const double e = -(double)lane / 64.0;
        const double invf = exp2(e * 13.287712379549449);
        float* rope = (float*)(F.ws + WS_ROPE); const int* posp = (const int*)karg<2>();
        for (int row = gw; row < MTOK; row += NGW) {
            const double rev = (double)posp[row] * invf * 0.15915494309189535;
            const float fr = (float)(rev - floor(rev));
            rope[(size_t)row * 128 + lane] = __builtin_amdgcn_cosf(fr); rope[(size_t)row * 128 + 64 + lane] = __builtin_amdgcn_sinf(fr);
        }
    }
    constexpr int per_rin = 16 * 192, per_rout = 32 * 32, per_kv = 16 * 64, per_sq = 16 * 32, per_fin = 16 * 176, per_fout = 44 * 32, per_min = 16 * 224, per_mout = 56 * 32;
    constexpr int NITEMS = CONV_IN_SCAN ? (per_rin + per_rout + per_fin + per_fout) : (2 * per_rin + 2 * per_rout + per_kv + 4 * per_sq + 2 * per_fin + 2 * per_fout + 16 * per_min + 16 * per_mout);
    for (int it = gw; it < NITEMS; it += NGW) {
        int r = it;
        if (p0_group<1, RETIN_F8 != 0>(r, KIN(7), 1, 1024, 6144, (f16*)(F.ws + WS_W_RIN), scr, lane)) continue;
        if (p0_group<0, false>(r, KIN(9), 1, 2048, 1024, (f16*)(F.ws + WS_W_ROUT), scr, lane)) continue;
        if (p0_group<2, false>(r, KIN(16), 1, 1024, 5632, (f16*)(F.ws + WS_W_FIN), scr, lane)) continue;
        if (p0_group<0, false>(r, KIN(17), 1, 2816, 1024, (f16*)(F.ws + WS_W_FOUT), scr, lane)) continue;
        if (!CONV_IN_SCAN) conv_rest(r, 2, F.ws, scr, lane);
    }
}

__device__ __forceinline__ void moe_tile_bases(const unsigned* gcnt, int (&tb)[NEXP], int& ntiles) {
    int acc = 0;
#pragma unroll
    for (int e = 0; e < NEXP; ++e) { tb[e] = acc; const unsigned c = __hip_atomic_load(gcnt + 64 * e, __ATOMIC_RELAXED, __HIP_MEMORY_SCOPE_AGENT); acc += (int)((c + 255u) >> 8); }
    ntiles = acc;
}
struct NormArgs {
    const void* x; f16* xw; const float* gain; const float* sh; const float* sc;
    f16* h; const float* gain2; const float* kvmod; f16* hk;
    const f16* y2; const float* gatef;
    float* out;
    const f16* yb;
    const float* router; unsigned* gcnt; unsigned* tokinfo; unsigned char* hs8; float* wof; unsigned* tof;
};
template <bool COMBINE, bool KV, bool FINAL, bool ROUTER, bool H8 = false, bool ADDY = false, bool XF32 = false>
__device__ __forceinline__ void norm_phase(Frame& F, const NormArgs& A) {
    PHASE_IDS();
    const int gw = F.vcu * 8 + F.wave, NGW = F.G * 8;
    LAS float* routL = (LAS float*)F.lds;
    LAS unsigned* lcnt = (LAS unsigned*)(F.lds + 32768);
    LAS unsigned* recs = (LAS unsigned*)(F.lds + 32768 + 256);
    if (ROUTER) {
        for (int i = tid; i < 8192; i += 512) routL[(i & 7) * 1024 + (i >> 3)] = A.router[i];
        if (tid < 16) lcnt[tid] = 0u;
        WG_BAR();
    }
    int ctb[NEXP]; int cnt_ = 0; (void)cnt_;
    f32x4 cxf[4], nxf[4]; f16x4 cxh[4], nxh[4], cya[4], nya[4], cyb[4], nyb[4]; u32x4 ti_n = {0u, 0u, 0u, 0u};
#define NP_ISSUE(row_, ti_, xf_, xh_, ya_, yb_) do { \
        _Pragma("unroll") for (int j = 0; j < 4; ++j) { if (XF32) xf_[j] = *((const f32x4*)((const float*)A.x + (size_t)(row_) * DM) + lane + 64 * j); else xh_[j] = *((const f16x4*)((const f16*)A.x + (size_t)(row_) * DM) + lane + 64 * j); } \
        if (ADDY) { _Pragma("unroll") for (int j = 0; j < 4; ++j) ya_[j] = *((const f16x4*)(A.yb + (size_t)(row_) * DM) + lane + 64 * j); } \
        if (COMBINE) { const f16* pa_ = A.y2 + (size_t)(row_) * (2 * DM); const f16* pb_ = pa_ + DM;     \
            _Pragma("unroll") for (int j = 0; j < 4; ++j) { ya_[j] = *((const f16x4*)pa_ + lane + 64 * j); yb_[j] = *((const f16x4*)pb_ + lane + 64 * j); } } } while (0)
    const int WPB = NGW / BATCH, b = gw / WPB, wsub = gw - b * WPB; const size_t rbase = (size_t)b * SEQ;
    f32x4 gnv[4], shv[4], scv[4], g2v[4], sh2v[4], sc2v[4], gfv[4];
#pragma unroll
    for (int j = 0; j < 4; ++j) {
        gnv[j] = *((const f32x4*)A.gain + lane + 64 * j);
        if (!FINAL) { shv[j] = *((const f32x4*)(A.sh + (size_t)b * 6144) + lane + 64 * j); scv[j] = *((const f32x4*)(A.sc + (size_t)b * 6144) + lane + 64 * j) + 1.0f; }
        if (KV) { g2v[j] = *((const f32x4*)A.gain2 + lane + 64 * j); sh2v[j] = *((const f32x4*)(A.kvmod + (size_t)b * 2048) + lane + 64 * j); sc2v[j] = *((const f32x4*)(A.kvmod + (size_t)b * 2048 + 1024) + lane + 64 * j) + 1.0f; }
        if (COMBINE) gfv[j] = *((const f32x4*)(A.gatef + (size_t)b * 6144) + lane + 64 * j);
    }
    if (wsub < SEQ) {
        u32x4 ti0 = {0u, 0u, 0u, 0u};
        NP_ISSUE(rbase + wsub, ti0, cxf, cxh, cya, cyb);
    }
    int nloc = 0;
    for (int sq = wsub; sq < SEQ; sq += WPB, ++nloc) {
        const size_t row = rbase + sq;
        if (sq + WPB < SEQ) {
            NP_ISSUE(row + WPB, ti_n, nxf, nxh, nya, nyb);
        }
        f32x4 v[4];
#pragma unroll
        for (int j = 0; j < 4; ++j) { if (XF32) v[j] = cxf[j]; else v[j] = (f32x4){(float)cxh[j][0], (float)cxh[j][1], (float)cxh[j][2], (float)cxh[j][3]}; }
        if (ADDY) {
#pragma unroll
            for (int j = 0; j < 4; ++j) {
#pragma unroll
                for (int t = 0; t < 4; ++t) v[j][t] += (float)cya[j][t];
                { u32x2 w; w.x = pkh(v[j][0], v[j][1]); w.y = pkh(v[j][2], v[j][3]); *((u32x2*)(A.xw + (size_t)row * DM) + lane + 64 * j) = w; }
            }
        }
        if (COMBINE) {
#pragma unroll
            for (int j = 0; j < 4; ++j) {
                const f32x4 g = gfv[j];
#pragma unroll
                for (int t = 0; t < 4; ++t) v[j][t] += g[t] * ((float)cya[j][t] + (float)cyb[j][t]);
                if (!FINAL) { u32x2 w; w.x = pkh(v[j][0], v[j][1]); w.y = pkh(v[j][2], v[j][3]); *((u32x2*)(A.xw + (size_t)row * DM) + lane + 64 * j) = w; }
            }
        }
        float ss = 0.f;
#pragma unroll
        for (int j = 0; j < 4; ++j) ss += (v[j][0] * v[j][0] + v[j][1] * v[j][1]) + (v[j][2] * v[j][2] + v[j][3] * v[j][3]);
        const float rstd = 1.0f / sqrtf(wave_sum(ss) * (1.0f / DM) + EPS);
        if (FINAL) {
#pragma unroll
            for (int j = 0; j < 4; ++j) *((f32x4*)(A.out + (size_t)row * DM) + lane + 64 * j) = v[j] * rstd * gnv[j];
        } else {
            f32x4 hv[4];
#pragma unroll
            for (int j = 0; j < 4; ++j) {
                hv[j] = (v[j] * rstd * gnv[j]) * scv[j] + shv[j];
                if (H8) *((unsigned*)((unsigned char*)A.h + (size_t)row * DM) + lane + 64 * j) = pk4f8(hv[j][0], hv[j][1], hv[j][2], hv[j][3]);
                else { u32x2 w; w.x = pkh(hv[j][0], hv[j][1]); w.y = pkh(hv[j][2], hv[j][3]); *((u32x2*)(A.h + (size_t)row * DM) + lane + 64 * j) = w; }
            }
            if (KV) {
#pragma unroll
                for (int j = 0; j < 4; ++j) {
                    const f32x4 o = (v[j] * rstd * g2v[j]) * sc2v[j] + sh2v[j];
                    u32x2 w; w.x = pkh(o[0], o[1]); w.y = pkh(o[2], o[3]);
                    *((u32x2*)(A.hk + (size_t)row * DM) + lane + 64 * j) = w;
                }
            }
            if (ROUTER) {
                float lg[8];
#pragma unroll
                for (int e = 0; e < 8; ++e) lg[e] = 0.f;
#pragma unroll
                for (int j = 0; j < 4; ++j)
#pragma unroll
                    for (int e = 0; e < 8; ++e) {
                        const f32x4 rv = *((const LAS f32x4*)(routL + e * 1024) + lane + 64 * j);
                        lg[e] += (hv[j][0] * rv[0] + hv[j][1] * rv[1]) + (hv[j][2] * rv[2] + hv[j][3] * rv[3]);
                    }
                {
                    float r4[4], r2[2], r1;
                    const bool b0 = lane & 1, b1 = lane & 2, b2 = lane & 4;
#pragma unroll
                    for (int k = 0; k < 4; ++k) { const float keep = b0 ? lg[k + 4] : lg[k], send = b0 ? lg[k] : lg[k + 4]; r4[k] = keep + __shfl_xor(send, 1); }
#pragma unroll
                    for (int k = 0; k < 2; ++k) { const float keep = b1 ? r4[k + 2] : r4[k], send = b1 ? r4[k] : r4[k + 2]; r2[k] = keep + __shfl_xor(send, 2); }
                    { const float keep = b2 ? r2[1] : r2[0], send = b2 ? r2[0] : r2[1]; r1 = keep + __shfl_xor(send, 4); }
                    r1 += __shfl_xor(r1, 8); r1 += __shfl_xor(r1, 16); r1 += __shfl_xor(r1, 32);
#pragma unroll
                    for (int e = 0; e < 8; ++e) lg[e] = __int_as_float(__builtin_amdgcn_readlane(__float_as_int(r1), ((e >> 2) & 1) | (((e >> 1) & 1) << 1) | ((e & 1) << 2)));
                }
                int i1 = 0; float v1 = lg[0];
#pragma unroll
                for (int e = 1; e < 8; ++e) if (lg[e] > v1) { v1 = lg[e]; i1 = e; }
                int i2 = (i1 == 0) ? 1 : 0; float v2 = lg[i2];
#pragma unroll
                for (int e = 0; e < 8; ++e) if (e != i1 && lg[e] > v2) { v2 = lg[e]; i2 = e; }
                const float ed = __expf(v2 - v1), w1 = 1.0f / (1.0f + ed), w2 = ed * w1;
                if (lane == 0) {
                    const unsigned p1 = __hip_atomic_fetch_add(&lcnt[i1], 1u, __ATOMIC_RELAXED, __HIP_MEMORY_SCOPE_WORKGROUP), p2 = __hip_atomic_fetch_add(&lcnt[i2], 1u, __ATOMIC_RELAXED, __HIP_MEMORY_SCOPE_WORKGROUP);
                    LAS unsigned* rc = recs + (F.wave * 16 + nloc) * 8;
                    rc[0] = (unsigned)i1; rc[1] = p1; rc[2] = (unsigned)i2; rc[3] = p2; rc[4] = __float_as_uint(w1); rc[5] = __float_as_uint(w2);
                }
            }
        }
#pragma unroll
        for (int j = 0; j < 4; ++j) { cxf[j] = nxf[j]; cxh[j] = nxh[j]; cya[j] = nya[j]; cyb[j] = nyb[j]; }
    }
    if (ROUTER) {
        WG_BAR();
        if (tid < 8) lcnt[8 + tid] = __hip_atomic_fetch_add(A.gcnt + 64 * tid, lcnt[tid], __ATOMIC_RELAXED, __HIP_MEMORY_SCOPE_AGENT);
        WG_BAR();
        asm volatile("s_waitcnt vmcnt(0)" ::: "memory");
        for (int k0 = 0, sq0 = wsub; sq0 < SEQ; sq0 += 4 * WPB, k0 += 4) {
            u32x4 a[4];
#pragma unroll
            for (int q = 0; q < 4; ++q) { const size_t row = rbase + sq0 + q * WPB; if (sq0 + q * WPB < SEQ) a[q] = *((const u32x4*)((const unsigned char*)A.h + row * DM) + lane); }
#pragma unroll
            for (int q = 0; q < 4; ++q) { const size_t row = rbase + sq0 + q * WPB; if (sq0 + q * WPB < SEQ) {
                const LAS unsigned* rc = recs + (F.wave * 16 + k0 + q) * 8;
                const unsigned e1 = rc[0], p1 = rc[1] + lcnt[8 + rc[0]], e2 = rc[2], p2 = rc[3] + lcnt[8 + rc[2]];
                const size_t v1 = (size_t)e1 * MOE_CAP + p1, v2 = (size_t)e2 * MOE_CAP + p2;
                *((u32x4*)(A.hs8 + v1 * DM) + lane) = a[q]; *((u32x4*)(A.hs8 + v2 * DM) + lane) = a[q];
                if (lane == 0) { *(u32x4*)(A.tokinfo + 8 * (size_t)row) = (u32x4){e1, p1, e2, p2}; A.wof[v1] = __uint_as_float(rc[4]); A.wof[v2] = __uint_as_float(rc[5]); A.tof[v1] = 2u * (unsigned)row; A.tof[v2] = 2u * (unsigned)row + 1u; } } }
        }
    }
}
constexpr int SC_PV = 576;
constexpr int SC_QL = 0, SC_KL = 16384, SC_VL = 32768, SC_SL = 69632, SC_ST = 135168, SC_STAGE = 0;
__device__ __forceinline__ int sc_off(int row, int ch) { return 256 * row + 16 * (ch ^ (((row & 3) << 2) | ((row >> 2) & 3))); }
__device__ __forceinline__ void scan_phase(Frame& F, const f16* proj, const float* gnw, f16* ao, int mi) {
    if (CONV_IN_SCAN) {
        if (blockIdx.x >= BATCH * RH) {
            PHASE_IDS();
            LAS float* scr = (LAS float*)(F.lds + F.wave * 8448);
            const int cw = ((int)blockIdx.x - BATCH * RH) * 8 + F.wave, NCW = ((int)gridDim.x - BATCH * RH) * 8;
            const int nit = mi ? CONV_ITEMS_1 : CONV_ITEMS_0;
            for (int it = cw; it < nit; it += NCW) conv_rest(it, mi, F.ws, scr, lane);
            return;
        }
    } else if (blockIdx.x >= 2 * BATCH * RH) return;
    const int unit = CONV_IN_SCAN ? (int)blockIdx.x : (int)(blockIdx.x >> 1), half = CONV_IN_SCAN ? 0 : (int)(blockIdx.x & 1);
    const int b = unit >> 3, hh = unit & 7;
    const int c_first_full = half ? NCHUNK / 2 : 0, c_end = CONV_IN_SCAN ? NCHUNK : (half ? NCHUNK : NCHUNK / 2);
    LAS unsigned char* L = F.lds;
    PHASE_IDS();
    const int wid = F.wave, rh = wid >> 2, cg = wid & 3, r = lane & 31, h = lane >> 5;
    const int gl = (lane >> 4) & 1, li = lane & 15, ta = li >> 2, tp = li & 3;
    const float lg = lg2gamma(hh);
    const float g63 = ex2(63.0f * lg), cd = __int_as_float(__builtin_amdgcn_readfirstlane(__float_as_int(ex2(64.0f * lg))));
    float vm[4], cj[4]; const int qloc = 32 * rh + r;
    const float wneg = __int_as_float(__builtin_amdgcn_readfirstlane(__float_as_int(ex2(-64.0f * lg))));
#pragma unroll
    for (int g4 = 0; g4 < 4; ++g4) vm[g4] = ex2((float)(16 * g4 + 8 * h - 2 * qloc - 64) * lg);
#pragma unroll
    for (int j = 0; j < 4; ++j) cj[j] = __int_as_float(__builtin_amdgcn_readfirstlane(__float_as_int(ex2((float)(2 * j) * lg))));
    const size_t rowbase = (size_t)b * SEQ;
    const f16* gq = proj + rowbase * RIN + 128 * hh;
    const f16* gk = gq + 1024;
    const f16* gv = proj + rowbase * RIN + 2048 + 256 * hh;
    const f16* gg = gv + 2048;
    const int qrow = tid >> 4, qc = tid & 15;
    const int vrow = tid >> 5, vc = tid & 31;
    int qoffL[2];
#pragma unroll
    for (int i = 0; i < 2; ++i) qoffL[i] = sc_off(qrow + 32 * i, qc);
    f32x16 SA[2][2];
#pragma unroll
    for (int dd = 0; dd < 2; ++dd)
#pragma unroll
        for (int et = 0; et < 2; ++et)
#pragma unroll
            for (int i = 0; i < 16; ++i) SA[dd][et][i] = 0.f;
    for (int i = tid; i < 65536 / 16; i += 512) *(LAS u32x4*)(L + SC_SL + i * 16) = (u32x4){0u, 0u, 0u, 0u};
    u32x4 nq[2], nk[2], nv[4];
#pragma unroll
    for (int i = 0; i < 2; ++i) { nq[i] = *(const u32x4*)(gq + (size_t)(qrow + 32 * i) * RIN + 8 * qc); nk[i] = *(const u32x4*)(gk + (size_t)(qrow + 32 * i) * RIN + 8 * qc); }
#pragma unroll
    for (int i = 0; i < 4; ++i) nv[i] = *(const u32x4*)(gv + (size_t)(vrow + 16 * i) * RIN + 8 * vc);
#pragma unroll
    for (int i = 0; i < 2; ++i) { *(LAS u32x4*)(L + SC_QL + qoffL[i]) = nq[i]; *(LAS u32x4*)(L + SC_KL + qoffL[i]) = nk[i]; }
#pragma unroll
    for (int i = 0; i < 4; ++i) *(LAS u32x4*)(L + SC_VL + (vrow + 16 * i) * SC_PV + 16 * vc) = nv[i];
    WG_BAR();
    for (int c = 0; c < c_first_full; ++c) {
        const size_t crow = (size_t)c * CHUNK;
#pragma unroll
        for (int i = 0; i < 2; ++i) { nq[i] = *(const u32x4*)(gq + (crow + 64 + qrow + 32 * i) * RIN + 8 * qc); nk[i] = *(const u32x4*)(gk + (crow + 64 + qrow + 32 * i) * RIN + 8 * qc); }
#pragma unroll
        for (int i = 0; i < 4; ++i) nv[i] = *(const u32x4*)(gv + (crow + 64 + vrow + 16 * i) * RIN + 8 * vc);
        int ro = r, ho = h, tao = ta, tpo = tp, glo = gl, vro = vrow, vco = vc;
        asm volatile("" : "+v"(ro), "+v"(ho), "+v"(tao), "+v"(tpo), "+v"(glo), "+v"(vro), "+v"(vco));
#pragma unroll
        for (int dd = 0; dd < 2; ++dd)
#pragma unroll
            for (int et = 0; et < 2; ++et)
#pragma unroll
                for (int i = 0; i < 16; ++i) SA[dd][et][i] *= cd;
#pragma unroll
        for (int kt = 0; kt < 2; ++kt)
#pragma unroll
            for (int s = 0; s < 2; ++s) {
                const int k0 = 32 * kt + 16 * s + 4 * ho + tao;
                f16x8 Vf[2], Kt[2];
#pragma unroll
                for (int et = 0; et < 2; ++et) { LAS const unsigned char* vp = L + SC_VL + k0 * SC_PV + (64 * cg + 32 * et + 16 * glo + 4 * tpo) * 2; Vf[et] = cat8(tr_read(vp), tr_read(vp + 8 * SC_PV)); }
#pragma unroll
                for (int dd = 0; dd < 2; ++dd) { const int ch = 4 * (2 * rh + dd) + 2 * glo + (tpo >> 1);
                    Kt[dd] = cat8(tr_read(L + SC_KL + sc_off(k0, ch) + 8 * (tpo & 1)), tr_read(L + SC_KL + sc_off(k0 + 8, ch) + 8 * (tpo & 1))); }
#pragma unroll
                for (int et = 0; et < 2; ++et)
#pragma unroll
                    for (int dd = 0; dd < 2; ++dd) SA[dd][et] = __builtin_amdgcn_mfma_f32_32x32x16_f16(Kt[dd], Vf[et], SA[dd][et], 0, 0, 0);
            }
        WG_BAR();
        if (c + 1 == c_first_full) {
#pragma unroll
            for (int dd = 0; dd < 2; ++dd)
#pragma unroll
                for (int et = 0; et < 2; ++et)
#pragma unroll
                    for (int g4 = 0; g4 < 4; ++g4) {
                        u32x2 w; w.x = pkh(SA[dd][et][4 * g4], SA[dd][et][4 * g4 + 1]); w.y = pkh(SA[dd][et][4 * g4 + 2], SA[dd][et][4 * g4 + 3]);
                        *(LAS u32x2*)(L + SC_SL + sc_off(64 * cg + 32 * et + ro, 4 * (2 * rh + dd) + g4) + 8 * ho) = w;
                    }
        }
#pragma unroll
        for (int i = 0; i < 2; ++i) { const int qo = sc_off((vro * 2 + (vco >> 4)) + 32 * i, vco & 15); *(LAS u32x4*)(L + SC_QL + qo) = nq[i]; *(LAS u32x4*)(L + SC_KL + qo) = nk[i]; }
#pragma unroll
        for (int i = 0; i < 4; ++i) *(LAS u32x4*)(L + SC_VL + (vrow + 16 * i) * SC_PV + 16 * vc) = nv[i];
        WG_BAR();
    }
    for (int c = c_first_full; c < c_end; ++c) {
        const size_t crow = (size_t)c * CHUNK;
        if (c + 1 < c_end) {
#pragma unroll
            for (int i = 0; i < 2; ++i) { nq[i] = *(const u32x4*)(gq + (crow + 64 + qrow + 32 * i) * RIN + 8 * qc); nk[i] = *(const u32x4*)(gk + (crow + 64 + qrow + 32 * i) * RIN + 8 * qc); }
#pragma unroll
            for (int i = 0; i < 4; ++i) nv[i] = *(const u32x4*)(gv + (crow + 64 + vrow + 16 * i) * RIN + 8 * vc);
        }
        int ro = r, ho = h, tao = ta, tpo = tp, glo = gl, vro = vrow, vco = vc;
        asm volatile("" : "+v"(ro), "+v"(ho), "+v"(tao), "+v"(tpo), "+v"(glo), "+v"(vro), "+v"(vco));
        f16x8 Pf[2][2]; f32x16 OT[2];
        {
        f16x8 Qf[8];
#pragma unroll
        for (int ks = 0; ks < 8; ++ks) Qf[ks] = *(const LAS f16x8*)(L + SC_QL + sc_off(32 * rh + ro, 2 * ks + ho));
#pragma unroll
        for (int kt = 0; kt < 2; ++kt) {
            f32x16 X;
#pragma unroll
            for (int i = 0; i < 16; ++i) X[i] = 0.f;
#pragma unroll
            for (int ks = 0; ks < 8; ++ks) { const f16x8 Kf = *(const LAS f16x8*)(L + SC_KL + sc_off(32 * kt + ro, 2 * ks + ho)); X = __builtin_amdgcn_mfma_f32_32x32x16_f16(Kf, Qf[ks], X, 0, 0, 0); }
#pragma unroll
            for (int i = 0; i < 16; ++i) { const int key = 32 * kt + (i & 3) + 8 * (i >> 2) + 4 * h; X[i] *= (key >= qloc) ? vm[i >> 2] * (kt ? cd * cj[i & 3] : cj[i & 3]) : wneg; }
            Pf[kt][0] = pack8(X, 0); Pf[kt][1] = pack8(X, 1);
        }
#pragma unroll
        for (int et = 0; et < 2; ++et)
#pragma unroll
            for (int i = 0; i < 16; ++i) OT[et][i] = 0.f;
#pragma unroll
        for (int ks = 0; ks < 8; ++ks)
#pragma unroll
            for (int et = 0; et < 2; ++et) {
                const f16x8 Sf = *(const LAS f16x8*)(L + SC_SL + sc_off(64 * cg + 32 * et + ro, 2 * ks + ho));
                OT[et] = __builtin_amdgcn_mfma_f32_32x32x16_f16(Sf, Qf[ks], OT[et], 0, 0, 0);
            }
        }
#pragma unroll
        for (int dd = 0; dd < 2; ++dd)
#pragma unroll
            for (int et = 0; et < 2; ++et)
#pragma unroll
                for (int i = 0; i < 16; ++i) SA[dd][et][i] *= cd;
#pragma unroll
        for (int kt = 0; kt < 2; ++kt)
#pragma unroll
            for (int s = 0; s < 2; ++s) {
                const int k0 = 32 * kt + 16 * s + 4 * ho + tao;
                f16x8 Vf[2], Kt[2];
#pragma unroll
                for (int et = 0; et < 2; ++et) { LAS const unsigned char* vp = L + SC_VL + k0 * SC_PV + (64 * cg + 32 * et + 16 * glo + 4 * tpo) * 2; Vf[et] = cat8(tr_read(vp), tr_read(vp + 8 * SC_PV)); }
#pragma unroll
                for (int dd = 0; dd < 2; ++dd) { const int ch = 4 * (2 * rh + dd) + 2 * glo + (tpo >> 1);
                    Kt[dd] = cat8(tr_read(L + SC_KL + sc_off(k0, ch) + 8 * (tpo & 1)), tr_read(L + SC_KL + sc_off(k0 + 8, ch) + 8 * (tpo & 1))); }
#pragma unroll
                for (int et = 0; et < 2; ++et) {
                    OT[et] = __builtin_amdgcn_mfma_f32_32x32x16_f16(Vf[et], Pf[kt][s], OT[et], 0, 0, 0);
#pragma unroll
                    for (int dd = 0; dd < 2; ++dd) SA[dd][et] = __builtin_amdgcn_mfma_f32_32x32x16_f16(Kt[dd], Vf[et], SA[dd][et], 0, 0, 0);
                }
            }
        float mean = 0.f, rstd = 0.f;
        {
        float s1 = 0.f, s2 = 0.f;
#pragma unroll
        for (int et = 0; et < 2; ++et)
#pragma unroll
            for (int i = 0; i < 16; ++i) { OT[et][i] *= g63; s1 += OT[et][i]; s2 += OT[et][i] * OT[et][i]; }
        s1 += __shfl_xor(s1, 32); s2 += __shfl_xor(s2, 32);
        if (h == 0) *(LAS f32x2*)(L + SC_ST + ((rh * 4 + cg) * 32 + r) * 8) = (f32x2){s1, s2};
        }
        WG_BAR();
        u32x4 gc[4];
        {
        float t1 = 0.f, t2 = 0.f;
#pragma unroll
        for (int c4 = 0; c4 < 4; ++c4) { const f32x2 p = *(const LAS f32x2*)(L + SC_ST + ((rh * 4 + c4) * 32 + r) * 8); t1 += p.x; t2 += p.y; }
        mean = t1 * (1.0f / 256.0f); const float var = t2 * (1.0f / 256.0f) - mean * mean; rstd = 1.0f / sqrtf(var + EPS);
#pragma unroll
        for (int i = 0; i < 4; ++i) gc[i] = *(const u32x4*)(gg + (crow + vrow + 16 * i) * RIN + 8 * vc);
        }
        {
#pragma unroll
        for (int dd = 0; dd < 2; ++dd)
#pragma unroll
            for (int et = 0; et < 2; ++et)
#pragma unroll
                for (int g4 = 0; g4 < 4; ++g4) {
                    u32x2 w; w.x = pkh(SA[dd][et][4 * g4], SA[dd][et][4 * g4 + 1]); w.y = pkh(SA[dd][et][4 * g4 + 2], SA[dd][et][4 * g4 + 3]);
                    *(LAS u32x2*)(L + SC_SL + sc_off(64 * cg + 32 * et + ro, 4 * (2 * rh + dd) + g4) + 8 * ho) = w;
                }
        }
        {
#pragma unroll
        for (int et = 0; et < 2; ++et)
#pragma unroll
            for (int g4 = 0; g4 < 4; ++g4) {
                u32x2 w; w.x = pkh((OT[et][4 * g4] - mean) * rstd, (OT[et][4 * g4 + 1] - mean) * rstd); w.y = pkh((OT[et][4 * g4 + 2] - mean) * rstd, (OT[et][4 * g4 + 3] - mean) * rstd);
                *(LAS u32x2*)(L + SC_STAGE + 16384 * (cg >> 1) + sc_off(32 * rh + ro, 8 * (cg & 1) + 4 * et + g4) + 8 * ho) = w;
            }
        }
        WG_BAR();
        {
        f32x4 gw0, gw1; { const float* gp = gnw + 256 * hh + 8 * vc; gw0 = *(const f32x4*)gp; gw1 = *(const f32x4*)(gp + 4); }
#pragma unroll
        for (int i = 0; i < 4; ++i) {
            const f16x8 n8 = *(const LAS f16x8*)(L + SC_STAGE + 16384 * (vco >> 4) + sc_off(vro + 16 * i, vco & 15));
            const f16x8 g8 = __builtin_bit_cast(f16x8, gc[i]);
            u32x4 w;
            w.x = pkh((float)n8[0] * (float)g8[0] * gw0[0], (float)n8[1] * (float)g8[1] * gw0[1]); w.y = pkh((float)n8[2] * (float)g8[2] * gw0[2], (float)n8[3] * (float)g8[3] * gw0[3]);
            w.z = pkh((float)n8[4] * (float)g8[4] * gw1[0], (float)n8[5] * (float)g8[5] * gw1[1]); w.w = pkh((float)n8[6] * (float)g8[6] * gw1[2], (float)n8[7] * (float)g8[7] * gw1[3]);
            *(u32x4*)(ao + (rowbase + crow + vrow + 16 * i) * 2048 + 256 * hh + 8 * vc) = w;
        }
        }
        WG_BAR();
        if (c + 1 < c_end) {
#pragma unroll
            for (int i = 0; i < 2; ++i) { const int qo = sc_off((vro * 2 + (vco >> 4)) + 32 * i, vco & 15); *(LAS u32x4*)(L + SC_QL + qo) = nq[i]; *(LAS u32x4*)(L + SC_KL + qo) = nk[i]; }
#pragma unroll
            for (int i = 0; i < 4; ++i) *(LAS u32x4*)(L + SC_VL + (vrow + 16 * i) * SC_PV + 16 * vc) = nv[i];
        }
        WG_BAR();
    }
}

constexpr int SBV_P = 144;
constexpr float SB_STOP = 5.421010862427522e-20f;
__device__ __forceinline__ void sb_phase(Frame& F, const f16* Q, const f16* Kc, const f16* Vc, f16* O, const float stop = SB_STOP) {
    PHASE_IDS();
    const int gw = F.vcu * 8 + F.wave, NGW = F.G * 8, r = lane & 31, h = lane >> 5;
    const int gl = (lane >> 4) & 1, li = lane & 15, ta = li >> 2, tp = li & 3;
    LAS unsigned char* Kw = F.lds + F.wave * (96 * SBV_P);
    LAS unsigned char* Vw = Kw + 32 * SBV_P; LAS unsigned char* Qw = Kw + 64 * SBV_P;
    const int vr = lane >> 3, vcc = lane & 7;
    constexpr int NU = BATCH * SBH * (SEQ / 32);
    u32x4 qn2[4], kn2[4], vn2[4];
    if (gw < NU) { const int qblk = gw & 63, bh = gw >> 6, b = bh >> 4, hd = bh & 15; const size_t rb = (size_t)b * SEQ;
        const f16* qp = Q + (rb + 32 * qblk + vr) * DM + 64 * hd + 8 * vcc; const f16* kp = Kc + (rb + 32 * qblk + vr) * DM + 64 * hd + 8 * vcc; const f16* vp = Vc + (rb + 32 * qblk + vr) * DM + 64 * hd + 8 * vcc;
#pragma unroll
        for (int i = 0; i < 4; ++i) { qn2[i] = *(const u32x4*)(qp + (size_t)(8 * i) * DM); kn2[i] = *(const u32x4*)(kp + (size_t)(8 * i) * DM); vn2[i] = *(const u32x4*)(vp + (size_t)(8 * i) * DM); } }
    for (int u = gw; u < NU; u += NGW) {
        const int qblk = u & 63, bh = u >> 6, b = bh >> 4, hd = bh & 15;
        const size_t rb = (size_t)b * SEQ;
        f16x8 Qf[4];
#pragma unroll
        for (int i = 0; i < 4; ++i) *(LAS u32x4*)(Qw + (vr + 8 * i) * SBV_P + 16 * vcc) = qn2[i];
        CFENCE();
#pragma unroll
        for (int ks = 0; ks < 4; ++ks) Qf[ks] = *(const LAS f16x8*)(Qw + r * SBV_P + (16 * ks + 8 * h) * 2);
        CFENCE();
        f32x16 OT[2];
#pragma unroll
        for (int dt = 0; dt < 2; ++dt)
#pragma unroll
            for (int i = 0; i < 16; ++i) OT[dt][i] = 0.f;
        float carry = 1.0f;
        u32x4 kn[4], vn[4];
#pragma unroll
        for (int i = 0; i < 4; ++i) { kn[i] = kn2[i]; vn[i] = vn2[i]; }
        if (u + NGW < NU) { const int un = u + NGW, qb2 = un & 63, bh2 = un >> 6, b2 = bh2 >> 4, hd2 = bh2 & 15; const size_t rb2 = (size_t)b2 * SEQ;
            const f16* qp = Q + (rb2 + 32 * qb2 + vr) * DM + 64 * hd2 + 8 * vcc; const f16* kp = Kc + (rb2 + 32 * qb2 + vr) * DM + 64 * hd2 + 8 * vcc; const f16* vp = Vc + (rb2 + 32 * qb2 + vr) * DM + 64 * hd2 + 8 * vcc;
#pragma unroll
            for (int i = 0; i < 4; ++i) { qn2[i] = *(const u32x4*)(qp + (size_t)(8 * i) * DM); kn2[i] = *(const u32x4*)(kp + (size_t)(8 * i) * DM); vn2[i] = *(const u32x4*)(vp + (size_t)(8 * i) * DM); } }
        for (int kt = qblk; kt >= 0; --kt) {
#pragma unroll
            for (int i = 0; i < 4; ++i) { *(LAS u32x4*)(Kw + (vr + 8 * i) * SBV_P + 16 * vcc) = kn[i]; *(LAS u32x4*)(Vw + (vr + 8 * i) * SBV_P + 16 * vcc) = vn[i]; }
            CFENCE();
            f16x8 Kf[4];
#pragma unroll
            for (int ks = 0; ks < 4; ++ks) Kf[ks] = *(const LAS f16x8*)(Kw + r * SBV_P + (16 * ks + 8 * h) * 2);
            CFENCE();
            if (kt > 0) { const f16* kp = Kc + (rb + 32 * (kt - 1) + vr) * DM + 64 * hd + 8 * vcc; const f16* vp = Vc + (rb + 32 * (kt - 1) + vr) * DM + 64 * hd + 8 * vcc;
#pragma unroll
                for (int i = 0; i < 4; ++i) { kn[i] = *(const u32x4*)(kp + (size_t)(8 * i) * DM); vn[i] = *(const u32x4*)(vp + (size_t)(8 * i) * DM); } }
            f32x16 S;
#pragma unroll
            for (int i = 0; i < 16; ++i) S[i] = 0.f;
#pragma unroll
            for (int ks = 0; ks < 4; ++ks) S = __builtin_amdgcn_mfma_f32_32x32x16_f16(Kf[ks], Qf[ks], S, 0, 0, 0);
            float om[16];
            const bool diag = (kt == qblk);
#pragma unroll
            for (int i = 0; i < 16; ++i) {
                const int kl = (i & 3) + 8 * (i >> 2) + 4 * h;
                float o = __builtin_amdgcn_rcpf(1.0f + ex2(S[i]));
                if (diag && kl >= r) o = 1.0f;
                om[i] = o;
            }
            float sfx[16], T[4];
#pragma unroll
            for (int g4 = 0; g4 < 4; ++g4) { sfx[4 * g4 + 3] = 1.0f; sfx[4 * g4 + 2] = om[4 * g4 + 3]; sfx[4 * g4 + 1] = sfx[4 * g4 + 2] * om[4 * g4 + 2]; sfx[4 * g4] = sfx[4 * g4 + 1] * om[4 * g4 + 1]; T[g4] = sfx[4 * g4] * om[4 * g4]; }
            float E[4]; float run = carry;
#pragma unroll
            for (int g4 = 3; g4 >= 0; --g4) {
                const auto sw = __builtin_amdgcn_permlane32_swap(__float_as_uint(T[g4]), __float_as_uint(T[g4]), false, false);
                const float tl = __uint_as_float(sw[0]), th = __uint_as_float(sw[1]);
                const float e_hi = run; run *= th; const float e_lo = run; run *= tl;
                E[g4] = h ? e_hi : e_lo;
            }
            carry = run;
            f32x16 Aw;
#pragma unroll
            for (int i = 0; i < 16; ++i) Aw[i] = (1.0f - om[i]) * (E[i >> 2] * sfx[i]);
            const f16x8 Af0 = pack8(Aw, 0), Af1 = pack8(Aw, 1);
            CFENCE();
#pragma unroll
            for (int dt = 0; dt < 2; ++dt) {
                LAS const unsigned char* vp = Vw + (4 * h + ta) * SBV_P + (32 * dt + 16 * gl + 4 * tp) * 2;
                const f16x8 V0 = cat8(tr_read(vp), tr_read(vp + 8 * SBV_P)), V1 = cat8(tr_read(vp + 16 * SBV_P), tr_read(vp + 24 * SBV_P));
                OT[dt] = __builtin_amdgcn_mfma_f32_32x32x16_f16(V0, Af0, OT[dt], 0, 0, 0);
                OT[dt] = __builtin_amdgcn_mfma_f32_32x32x16_f16(V1, Af1, OT[dt], 0, 0, 0);
            }
            CFENCE();
            if (__ballot(carry > stop) == 0ull) break;
        }
        CFENCE();
#pragma unroll
        for (int dt = 0; dt < 2; ++dt)
#pragma unroll
            for (int g4 = 0; g4 < 4; ++g4) { u32x2 w; w.x = pkh(OT[dt][4 * g4], OT[dt][4 * g4 + 1]); w.y = pkh(OT[dt][4 * g4 + 2], OT[dt][4 * g4 + 3]); *(LAS u32x2*)(Qw + r * SBV_P + (32 * dt + 8 * g4 + 4 * h) * 2) = w; }
        CFENCE();
        f16* op = O + (rb + 32 * qblk + vr) * DM + 64 * hd + 8 * vcc;
#pragma unroll
        for (int i = 0; i < 4; ++i) *(u32x4*)(op + (size_t)(8 * i) * DM) = *(const LAS u32x4*)(Qw + (vr + 8 * i) * SBV_P + 16 * vcc);
        CFENCE();
    }
}

struct Args { const void* in[22]; float* out; unsigned char* ws; int ph_lo, ph_hi; };
constexpr int N_PHASES = 34;
#define IN(k) (lo <= (k) && (k) < hi)
#define SEAM(k) do { if (IN((k) + 1)) { if (!MK_PER_PHASE) xcd_barrier(bar); } } while (0)
#define WSP(T, off) ((T*)(F.ws + (off)))
#define REPS(cond) _Pragma("unroll") for (int rep_ = 0; rep_ < ((cond) ? 2 : 1); ++rep_)
#define REPBAR() do { if (rep_) xcd_barrier(bar); } while (0)
#define REPSN(cond, n) _Pragma("unroll") for (int rep_ = 0; rep_ < ((cond) ? (n) : 1); ++rep_)
template <int L> __device__ __forceinline__ void layer_phases(Frame& F, const XcdBarrier& bar, const int lo, const int hi) {
    constexpr int pb = 1 + 8 * L;
        if (IN(pb + 0) && !DIS_K0) {
            const float* modL = WSP(const float, WS_MOD) + (size_t)L * 16 * 6144;
            NormArgs A{}; A.x = (L == 0) ? (const void*)KIN(0) : (const void*)WSP(const f16, WS_X); A.xw = WSP(f16, WS_X); A.gain = KIN(5) + L * DM; A.sh = modL; A.sc = modL + 1024; A.h = WSP(f16, WS_H);
            if constexpr (L == 2) {
                A.y2 = WSP(const f16, WS_Y2); A.gcnt = F.ctl + CW_MOE; A.tokinfo = WSP(unsigned, WS_TOKINFO); A.gatef = WSP(const float, WS_MOD) + (size_t)(L - 1) * 16 * 6144 + 5120;
                A.gain2 = KIN(12); A.kvmod = WSP(const float, WS_KVMOD); A.hk = WSP(f16, WS_HK); REPSN(PROBE_DUP == 15, 5) { REPBAR(); if (rep_) { A.xw = WSP(f16, WS_BIG + 320 * MiB); A.h = WSP(f16, WS_BIG + 448 * MiB); A.hk = WSP(f16, WS_BIG + 512 * MiB); } norm_phase<true, true, false, false>(F, A); }
            } else REPSN(PROBE_DUP == 7 && L == 1, 5) { REPBAR(); A.yb = WSP(const f16, WS_YB); if (rep_) { A.xw = WSP(f16, WS_BIG + 320 * MiB); A.h = WSP(f16, WS_BIG + 448 * MiB); } norm_phase<false, false, false, false, (RETIN_F8 != 0 && L < 2), (L == 1 || L == 3), (L == 0)>(F, A); }
            SEAM(pb + 0);
        }
        if (IN(pb + 1) && !DIS_K1) {
            if constexpr (L < 2) {
                pg8::Gemm g{WSP(const unsigned char, WS_H), WSP(const unsigned char, WS_W_RIN) + (size_t)L * RIN * DM * 2, MTOK, RIN, DM, 0, STAG_RET}; pg8::Order S; S.init(MTOK, RIN, F.G, (int)blockIdx.x);
                pg8::EpiRetIn E{WSP(f16, WS_PROJ), WSP(const float, WS_ROPE), RETIN_F8 ? 1.0f / F8_WSCALE : 1.0f};
                REPS(PROBE_DUP == 6 && L == 1) { REPBAR(); pg8::gemm_phase<pg8::EpiRetIn, RETIN_F8 != 0>(F.lds, g, S, E); }
                if constexpr (PROBE_DUP == 17 && L == 1) { xcd_barrier(bar); pg8::EpiNull<true> EN{WSP(float, WS_SLOTW)}; pg8::gemm_phase<pg8::EpiNull<true>, false>(F.lds, g, S, EN); }
            } else REPS(PROBE_DUP == 12 && L == 2) { REPBAR();
                { pg8::Gemm g{WSP(const f16, WS_H), WSP(const f16, WS_W_SQ) + (size_t)(L - 2) * DM * DM, MTOK, DM, DM, 0}; pg8::Order S; S.init(MTOK, DM, F.G, (int)blockIdx.x);
                  pg8::EpiF16 E{WSP(f16, WS_SQ), DM, 0, 0, 0.125f * 1.4426950408889634f};
                  pg8::gemm_phase<pg8::EpiF16>(F.lds, g, S, E); }
                if constexpr (L == 2) { pg8::Gemm g{WSP(const f16, WS_HK), WSP(const f16, WS_W_KV), MTOK, 2048, DM, 0}; pg8::Order S; S.init(MTOK, 2048, F.G, (int)blockIdx.x);
                  pg8::EpiF16 E{WSP(f16, WS_KSH), DM, 1024, (size_t)(WS_VSH - WS_KSH) / 2, 1.0f};
                  pg8::gemm_phase<pg8::EpiF16>(F.lds, g, S, E); }
            }
            SEAM(pb + 1);
        }
        if (IN(pb + 2) && !DIS_K2) {
#ifndef NO_SCAN
            if constexpr (L < 2) REPS(PROBE_DUP == 2 && L == 1) { REPBAR(); scan_phase(F, WSP(const f16, WS_PROJ), KIN(8) + L * 2048, WSP(f16, WS_AO), L); }
#endif
#ifndef NO_SB
            if constexpr (L >= 2) REPSN((PROBE_DUP == 3 || PROBE_DUP == 22 || PROBE_DUP == 23) && L == 3, 5) { REPBAR(); sb_phase(F, WSP(const f16, WS_SQ), WSP(const f16, WS_KSH), WSP(const f16, WS_VSH), rep_ ? WSP(f16, WS_BIG + 320 * MiB) : WSP(f16, WS_SO), (rep_ && PROBE_DUP == 22) ? 2.0f : (rep_ && PROBE_DUP == 23) ? 1e-6f : SB_STOP); }
#endif
            SEAM(pb + 2);
        }
        if (IN(pb + 3) && !DIS_K3) {
            pg8::Gemm g;
            if constexpr (L < 2) g = pg8::Gemm{WSP(const f16, WS_AO), WSP(const f16, WS_W_ROUT) + (size_t)L * DM * 2048, MTOK, DM, 2048, 0};
            else g = pg8::Gemm{WSP(const f16, WS_SO), WSP(const f16, WS_W_SO) + (size_t)(L - 2) * DM * DM, MTOK, DM, DM, 0};
            pg8::Order S; S.init(MTOK, DM, F.G, (int)blockIdx.x);
            pg8::EpiY E{WSP(f16, WS_YB), WSP(const float, WS_MOD) + (size_t)L * 16 * 6144 + 2048, 1.0f};
            REPS(PROBE_DUP == 9 && L == 1) { REPBAR(); pg8::gemm_phase<pg8::EpiY>(F.lds, g, S, E); }
            SEAM(pb + 3);
        }
        if (IN(pb + 4) && !DIS_K4) {
            const float* modL = WSP(const float, WS_MOD) + (size_t)L * 16 * 6144;
            NormArgs A{}; A.x = (L == 0) ? (const void*)KIN(0) : (const void*)WSP(const f16, WS_X); A.xw = WSP(f16, WS_X); A.gain = KIN(6) + L * DM; A.sh = modL + 3072; A.sc = modL + 4096; A.h = WSP(f16, WS_H); A.yb = WSP(const f16, WS_YB);
            if constexpr (L & 1) { A.router = KIN(18) + (size_t)(L >> 1) * DM * NEXP; A.gcnt = F.ctl + CW_MOE + (L >> 1) * 1024; A.tokinfo = WSP(unsigned, WS_TOKINFO); A.hs8 = WSP(unsigned char, WS_HS); A.wof = WSP(float, WS_SLOTW); A.tof = WSP(unsigned, WS_TOF + (size_t)(L >> 1) * MiB); REPSN(PROBE_DUP == 13 && L == 3, 5) { REPBAR(); if (rep_) { A.gcnt = F.ctl + CW_MOE + 4096; A.tokinfo = WSP(unsigned, WS_BIG + 516 * MiB); A.xw = WSP(f16, WS_BIG + 320 * MiB); A.h = WSP(f16, WS_BIG + 448 * MiB); A.hs8 = WSP(unsigned char, WS_END); A.wof = WSP(float, WS_BIG + 512 * MiB); A.tof = WSP(unsigned, WS_BIG + 514 * MiB); } norm_phase<false, false, false, true, true, true>(F, A); } }
            else norm_phase<false, false, false, false, DF8(L), true, (L == 0)>(F, A);
            SEAM(pb + 4);
        }
        if (IN(pb + 6) && !DIS_K6) {
            const int mi = L >> 1;
            pg8::Order S;
            if constexpr (L & 1) {
                int tb[NEXP], ntl; moe_tile_bases(F.ctl + CW_MOE + mi * 1024, tb, ntl);
                S.init(ntl * 256, 2 * FFE, F.G, (int)blockIdx.x); S.cap = MOE_CAP; S.avirt = 1;
#pragma unroll
                for (int e = 0; e < NEXP; ++e) S.tb[e] = tb[e];
                pg8::Gemm g{WSP(const unsigned char, WS_HS), WSP(const unsigned char, WS_W_MIN) + (size_t)mi * NEXP * 2 * FFE * DM, ntl * 256, 2 * FFE, DM, (size_t)2 * FFE * DM, STAG_MOE};
                pg8::EpiGlu<true> E{WSP(unsigned char, WS_ACTE), FFE};
                REPS(PROBE_DUP == 4 && L == 3) { REPBAR(); pg8::gemm_phase<pg8::EpiGlu<true>, true>(F.lds, g, S, E); }
                if constexpr (PROBE_DUP == 16 && L == 3) { xcd_barrier(bar); pg8::EpiNull<true> EN{WSP(float, WS_SLOTW)}; pg8::gemm_phase<pg8::EpiNull<true>, true>(F.lds, g, S, EN); }
            } else {
                S.init(MTOK, 2 * FFD, F.G, (int)blockIdx.x);
                pg8::Gemm g{WSP(const unsigned char, WS_H), WSP(const unsigned char, WS_W_FIN) + (size_t)mi * 2 * FFD * DM * 2, MTOK, 2 * FFD, DM, 0};
                pg8::EpiGlu<DF8(L), DF8O(L)> E{WSP(unsigned char, WS_ACTD), FFD};
                REPS(PROBE_DUP == 10 && L == 2) { REPBAR(); pg8::gemm_phase<pg8::EpiGlu<DF8(L), DF8O(L)>, DF8(L)>(F.lds, g, S, E); }
            }
            SEAM(pb + 6);
        }
        if (IN(pb + 7) && !DIS_K7) {
            const int mi = L >> 1;
            if constexpr (L & 1) {
                int tb[NEXP], ntl; moe_tile_bases(F.ctl + CW_MOE + mi * 1024, tb, ntl);
                pg8::Order S; S.init(ntl * 256, DM, F.G, (int)blockIdx.x); S.cap = MOE_CAP;
#pragma unroll
                for (int e = 0; e < NEXP; ++e) S.tb[e] = tb[e];
                pg8::Gemm g{WSP(const unsigned char, WS_ACTE), WSP(const unsigned char, WS_W_MOUT) + (size_t)mi * NEXP * DM * FFE, ntl * 256, DM, FFE, (size_t)DM * FFE};
                pg8::EpiMoeOut E{WSP(f16, WS_Y2), WSP(const float, WS_SLOTW), WSP(const unsigned, WS_TOF + (size_t)mi * MiB)};
                REPS(PROBE_DUP == 5 && L == 3) { REPBAR(); pg8::gemm_phase<pg8::EpiMoeOut, true>(F.lds, g, S, E); }
            } else {
                pg8::Order S; S.init(MTOK, DM, F.G, (int)blockIdx.x);
                pg8::Gemm g{WSP(const unsigned char, WS_ACTD), WSP(const unsigned char, WS_W_FOUT) + (size_t)mi * DM * FFD * 2, MTOK, DM, FFD, 0};
                pg8::EpiY E{WSP(f16, WS_YB), WSP(const float, WS_MOD) + (size_t)L * 16 * 6144 + 5120, DF8O(L) ? 1.0f / (F8_WSCALE * F8_ASCALE) : 1.0f};
                REPS(PROBE_DUP == 11 && L == 2) { REPBAR(); pg8::gemm_phase<pg8::EpiY, DF8O(L)>(F.lds, g, S, E); }
            }
            SEAM(pb + 7);
        }
}
__global__ void __launch_bounds__(512, 2) mk_fwd(Args args) {
    extern __shared__ __attribute__((aligned(16))) unsigned char lds_raw[];
    Frame F;
    F.lds = (LAS unsigned char*)lds_raw;
    F.wave = __builtin_amdgcn_readfirstlane((int)threadIdx.x >> 6);
    F.G = gridDim.x; { const int bx = blockIdx.x; F.vcu = (F.G % 8 == 0) ? (bx % 8) * (F.G / 8) + bx / 8 : bx; }
    F.ws = args.ws; F.ctl = (unsigned*)(args.ws + WS_CTL);
    volatile LAS unsigned* MISC = (volatile LAS unsigned*)(F.lds + MISC_OFF);
    if (threadIdx.x < 64) ((LAS unsigned*)(F.lds + MISC_OFF))[threadIdx.x] = 0u;
    __syncthreads();
    XcdBarrier bar; bar.bar = F.ctl + CW_BAR; bar.x = 0; bar.st = nullptr;
    if (!MK_PER_PHASE) bar = xcd_barrier_post(F.ctl + CW_BAR, MISC + 8);
    const int lo = args.ph_lo, hi = args.ph_hi;

    if (IN(0)) {
#ifndef NO_P0
        REPS(PROBE_DUP == 1) { REPBAR(); p0_prologue(F); }
#endif
        SEAM(0);
    }
    layer_phases<0>(F, bar, lo, hi); layer_phases<1>(F, bar, lo, hi); layer_phases<2>(F, bar, lo, hi); layer_phases<3>(F, bar, lo, hi);
    if (IN(33)) {
        NormArgs A{}; A.x = WSP(const f16, WS_X); A.xw = WSP(f16, WS_X); A.gain = KIN(21); A.out = (float*)karg<22>();
        A.y2 = WSP(const f16, WS_Y2); A.gcnt = F.ctl + CW_MOE + 1024; A.tokinfo = WSP(unsigned, WS_TOKINFO); A.gatef = WSP(const float, WS_MOD) + (size_t)3 * 16 * 6144 + 5120;
        REPSN(PROBE_DUP == 14, 5) { REPBAR(); norm_phase<true, false, true, false>(F, A); }
        if constexpr (PROBE_DUP == 24) { _Pragma("unroll 1") for (int i = 0; i < 40; ++i) xcd_barrier(bar); }
        if constexpr (PROBE_DUP == 20 || PROBE_DUP == 21) {
            xcd_barrier(bar);
            f16x8 a = {(f16)1.f, (f16)0.5f, (f16)0.25f, (f16)1.f, (f16)1.f, (f16)0.5f, (f16)0.25f, (f16)1.f}, b = a;
            f32x16 acc[4];
#pragma unroll
            for (int i = 0; i < 4; ++i)
#pragma unroll
                for (int j = 0; j < 16; ++j) acc[i][j] = 0.f;
            f32x4 acc16[8];
#pragma unroll
            for (int i = 0; i < 8; ++i) acc16[i] = (f32x4){0.f, 0.f, 0.f, 0.f};
            for (int it = 0; it < (PROBE_DUP == 20 ? 16384 : 8192); ++it) {
                if constexpr (PROBE_DUP == 20) {
#pragma unroll
                    for (int i = 0; i < 4; ++i) acc[i] = __builtin_amdgcn_mfma_f32_32x32x16_f16(a, b, acc[i], 0, 0, 0);
                } else {
#pragma unroll
                    for (int i = 0; i < 8; ++i) acc16[i] = __builtin_amdgcn_mfma_f32_16x16x32_f16(a, b, acc16[i], 0, 0, 0);
                }
            }
            float sacc = 0.f;
#pragma unroll
            for (int i = 0; i < 4; ++i) sacc += acc[i][0] + acc16[i][0] + acc16[4 + i][1];
            if (sacc == 1.2345e37f) WSP(float, WS_SLOTW)[0] = sacc;
        }
    }
#undef IN
#undef SEAM
#undef WSP
}

extern "C" void kernel_launch(void* const* d_in, const int* in_sizes, int n_in, void* d_out, int out_size, void* d_ws, size_t ws_size, hipStream_t stream) {
    static int grid = 0;
    if (grid == 0) {
        if (n_in != 22 || out_size != MTOK * DM || ws_size < WS_END) { fprintf(stderr, "kernel_launch: unexpected shapes (n_in %d out %d ws %zu, need %zu)\n", n_in, out_size, ws_size, (size_t)WS_END); grid = -1; return; }
        int dev = 0, cus = 0;
        if (hipGetDevice(&dev) != hipSuccess || hipDeviceGetAttribute(&cus, hipDeviceAttributeMultiprocessorCount, dev) != hipSuccess) { grid = -1; return; }
        if (hipFuncSetAttribute((const void*)mk_fwd, hipFuncAttributeMaxDynamicSharedMemorySize, LDS_BYTES) != hipSuccess) { fprintf(stderr, "kernel_launch: hipFuncSetAttribute failed\n"); grid = -1; return; }
        int per_cu = 0;
        if (hipOccupancyMaxActiveBlocksPerMultiprocessor(&per_cu, (const void*)mk_fwd, 512, LDS_BYTES) != hipSuccess || per_cu < 1) fprintf(stderr, "kernel_launch: occupancy query reports %d\n", per_cu);
        (void)hipGetLastError();
        if (cus < 256) { fprintf(stderr, "kernel_launch: needs >= 256 CUs, got %d\n", cus); grid = -1; return; }
        grid = cus;
    }
    if (grid < 0) return;
    (void)hipMemsetAsync((char*)d_ws + WS_CTL, 0, CTL_ZERO_BYTES, stream);
    (void)hipMemsetAsync((char*)d_ws + WS_TOF, 0xFF, 2 * (size_t)NEXP * MOE_CAP * 4, stream);
    Args a{};
    for (int i = 0; i < 22; ++i) a.in[i] = d_in[i];
    a.out = (float*)d_out; a.ws = (unsigned char*)d_ws;
#if MK_PER_PHASE
    for (int p = 0; p < N_PHASES; ++p) {
        if (p >= 1 && p <= 32) { const int L = (p - 1) / 8, k = (p - 1) % 8; if (k == 5) continue; (void)L; }
        a.ph_lo = p; a.ph_hi = p + 1;
        hipLaunchKernelGGL(mk_fwd, dim3(grid), dim3(512), LDS_BYTES, stream, a);
    }
#else
    a.ph_lo = 0; a.ph_hi = N_PHASES;
    hipLaunchKernelGGL(mk_fwd, dim3(grid), dim3(512), LDS_BYTES, stream, a);
#endif
}
```

```cpp
#include <hip/hip_runtime.h>
#include <cstdio>
#include <cstdint>

#define LAS __attribute__((address_space(3)))
#define GAS __attribute__((address_space(1)))
typedef _Float16 f16;
typedef _Float16 f16x2 __attribute__((ext_vector_type(2)));
typedef _Float16 f16x4 __attribute__((ext_vector_type(4)));
typedef _Float16 f16x8 __attribute__((ext_vector_type(8)));
typedef float f32x2 __attribute__((ext_vector_type(2)));
typedef float f32x4 __attribute__((ext_vector_type(4)));
typedef float f32x16 __attribute__((ext_vector_type(16)));
typedef unsigned u32x2 __attribute__((ext_vector_type(2)));
typedef unsigned u32x4 __attribute__((ext_vector_type(4)));
typedef short v4i16_t __attribute__((ext_vector_type(4)));
typedef int i32x8 __attribute__((ext_vector_type(8)));
typedef int i32x4 __attribute__((ext_vector_type(4)));

#ifndef DIS_K0
#define DIS_K0 0
#endif
#ifndef DIS_K1
#define DIS_K1 0
#endif
#ifndef DIS_K2
#define DIS_K2 0
#endif
#ifndef DIS_K3
#define DIS_K3 0
#endif
#ifndef DIS_K4
#define DIS_K4 0
#endif
#ifndef DIS_K5
#define DIS_K5 0
#endif
#ifndef DIS_K6
#define DIS_K6 0
#endif
#ifndef DIS_K7
#define DIS_K7 0
#endif
#ifndef PROBE_DUP
#define PROBE_DUP 0
#endif
#ifndef DENSE_F8
#define DENSE_F8 1
#define DF8(L) (DENSE_F8 != 0 && (L) == 2)
#ifndef DENSE_F8_OUT
#define DENSE_F8_OUT 1
#endif
#ifndef DENSE_F8_OUT0
#define DENSE_F8_OUT0 1
#endif
#define DF8O(L) (DENSE_F8 != 0 && DENSE_F8_OUT != 0 && ((L) == 2 || (DENSE_F8_OUT0 != 0 && (L) == 0)))
#endif
#ifndef SQ_F8
#define SQ_F8 1
#endif
#ifndef RETIN_F8
#define RETIN_F8 0
#endif
#ifndef STAG_MOE
#define STAG_MOE 0
#endif
#ifndef STAG_RET
#define STAG_RET 0
#endif
#ifndef CONV_IN_SCAN
#define CONV_IN_SCAN 1
#endif
#ifndef MK_PER_PHASE
#define MK_PER_PHASE 0
#endif

constexpr int BATCH = 16, SEQ = 2048, DM = 1024, MTOK = BATCH * SEQ;
constexpr int RH = 8, RDK = 128, RDV = 256, RIN = 6144, CHUNK = 64, NCHUNK = SEQ / CHUNK;
constexpr int SBH = 16, SDH = 64;
constexpr int FFD = 2816, NEXP = 8, FFE = 3584;
constexpr float EPS = 1e-6f;
constexpr int MOE_ROWS_MAX = 2 * MTOK + NEXP * 256;

__device__ __forceinline__ float lg2gamma(int h) {
    const float t[8] = {-4.580368961312e-02f, -2.272007650008e-02f, -1.131531322783e-02f, -5.646563141142e-03f, -2.820519062379e-03f, -1.409570254671e-03f, -7.046129765894e-04f, -3.522634716290e-04f};
    float r = t[0];
#pragma unroll
    for (int i = 1; i < 8; ++i) r = (h == i) ? t[i] : r;
    return r;
}
__device__ __forceinline__ unsigned pkh(float lo, float hi) { f32x2 v = {lo, hi}; f16x2 h = __builtin_convertvector(v, f16x2); return __builtin_bit_cast(unsigned, h); }
__device__ __forceinline__ float silu_f(float x) { return x * __builtin_amdgcn_rcpf(1.0f + __builtin_amdgcn_exp2f(-1.4426950408889634f * x)); }
__device__ __forceinline__ float ex2(float x) { return __builtin_amdgcn_exp2f(x); }
__device__ __forceinline__ unsigned pk4f8(float a, float b, float c, float d) { int w = 0; w = __builtin_amdgcn_cvt_pk_fp8_f32(a, b, w, false); w = __builtin_amdgcn_cvt_pk_fp8_f32(c, d, w, true); return (unsigned)w; }
constexpr float F8_WSCALE = 64.0f;
constexpr float F8_ASCALE = 4.0f;

namespace pg8 {
constexpr int BM = 256, BK = 64, HALF = 128, HTB = HALF * BK * 2, STAGE_BYTES = 8 * HTB, NXCD = 8, WGM = 8;
__host__ __device__ __forceinline__ int lds_byte(int r, int c) { const int st = (r >> 4) * 2 + (c >> 5), rr = r & 15, cc = c & 31, ob = rr * 64 + cc * 2; return st * 1024 + (ob ^ (((ob >> 9) & 1) << 5)); }
__host__ __device__ __forceinline__ void stage_rc(int b, int& R, int& C) { const int st = b / 1024, sb = b % 1024, swz = sb ^ (((sb >> 9) & 1) << 5); R = (st >> 1) * 16 + swz / 64; C = (st & 1) * 32 + (swz % 64) / 2; }
__host__ __device__ __forceinline__ int perm32(int rho) { const int n = rho >> 4, i = rho & 15; return 8 * (i >> 2) + 4 * n + (i & 3); }

struct Unit { int pm, pn, be, arow, vrow; };
struct Gemm { const void* A; const void* Bt; int M, N, K; size_t bstride; int stagger = 0; };

struct Order {
    int nM, nN, nwg, G, c; int tb[NEXP]; int cap, avirt;
    __device__ void init(int M, int N, int G_, int c_) { nM = M / BM; nN = N / BM; nwg = nM * nN; G = G_; c = c_; cap = 0; avirt = 0;
#pragma unroll
        for (int e = 0; e < NEXP; ++e) tb[e] = e ? 0x7fffffff : 0; }
    __device__ bool next(int i, Unit& u) const {
        const long L = (long)i * G + c; if (L >= nwg) return false;
        int wgid = (int)L; { const int q = nwg / NXCD, r = nwg % NXCD, xcd = wgid % NXCD, off = wgid / NXCD; wgid = (xcd < r ? xcd * (q + 1) : r * (q + 1) + (xcd - r) * q) + off; }
        const int nig = WGM * nN, gid = wgid / nig, fm = gid * WGM, gsz = (nM - fm) < WGM ? (nM - fm) : WGM;
        u.pm = fm + ((wgid % nig) % gsz); u.pn = (wgid % nig) / gsz;
        int be = 0;
#pragma unroll
        for (int e = 1; e < NEXP; ++e) be += (u.pm >= tb[e]) ? 1 : 0;
        u.be = be;
        int tbe = 0;
#pragma unroll
        for (int e = 1; e < NEXP; ++e) tbe = (be == e) ? tb[e] : tbe;
        u.vrow = cap ? be * cap + (u.pm - tbe) * BM : u.pm * BM; u.arow = avirt ? u.vrow : u.pm * BM;
        return true;
    }
};


struct EpiRetIn {
    static constexpr bool PERM = true; static constexpr int NST = 16;
    f16* O; const float* rope; float scl;
    __device__ __forceinline__ void operator()(const f32x4 (&acc)[2][2][4][2], const Unit& u, int wr, int wc, int fr, int fq) const {
        const int row0 = u.pm * BM + wr * 64 + fr, cl = wc * 32 + 8 * fq;
        f16* base = O + (size_t)u.pn * BM + cl;
        if (u.pn < 8) {
            const bool isk = u.pn >= 4; const int i0 = cl >> 1;
            float lg[2]; lg[0] = lg2gamma(2 * (u.pn & 3)); lg[1] = lg2gamma(2 * (u.pn & 3) + 1);
            f32x4 cs_n = *(const f32x4*)(rope + (size_t)row0 * 128 + i0), sn_n = *(const f32x4*)(rope + (size_t)row0 * 128 + 64 + i0);
#pragma unroll
            for (int ai = 0; ai < 2; ++ai)
#pragma unroll
                for (int m = 0; m < 4; ++m) {
                    const int row = row0 + ai * HALF + m * 16; const float pos = (float)(16 * m + fr);
                    const f32x4 cs = cs_n, sn = sn_n;
                    if (ai * 4 + m < 7) { const int rown = row0 + ((ai * 4 + m + 1) >> 2) * HALF + ((ai * 4 + m + 1) & 3) * 16;
                        cs_n = *(const f32x4*)(rope + (size_t)rown * 128 + i0); sn_n = *(const f32x4*)(rope + (size_t)rown * 128 + 64 + i0); }
#pragma unroll
                    for (int bj = 0; bj < 2; ++bj) {
                        const float sc = (isk ? ex2(-pos * lg[bj]) * 0.08838834764831845f : ex2((pos + 1.0f) * lg[bj])) * scl;
                        const f32x4 v0 = acc[ai][bj][m][0], v1 = acc[ai][bj][m][1];
                        u32x4 w;
                        w.x = pkh((v0[0] * cs[0] - v0[1] * sn[0]) * sc, (v0[0] * sn[0] + v0[1] * cs[0]) * sc);
                        w.y = pkh((v0[2] * cs[1] - v0[3] * sn[1]) * sc, (v0[2] * sn[1] + v0[3] * cs[1]) * sc);
                        w.z = pkh((v1[0] * cs[2] - v1[1] * sn[2]) * sc, (v1[0] * sn[2] + v1[1] * cs[2]) * sc);
                        w.w = pkh((v1[2] * cs[3] - v1[3] * sn[3]) * sc, (v1[2] * sn[3] + v1[3] * cs[3]) * sc);
                        *(u32x4*)(base + (size_t)row * RIN + bj * HALF) = w;
                    }
                }
        } else {
            const bool isg = u.pn >= 16;
#pragma unroll
            for (int ai = 0; ai < 2; ++ai)
#pragma unroll
                for (int m = 0; m < 4; ++m) {
                    const int row = row0 + ai * HALF + m * 16;
#pragma unroll
                    for (int bj = 0; bj < 2; ++bj) {
                        f32x4 v0 = acc[ai][bj][m][0] * scl, v1 = acc[ai][bj][m][1] * scl;
                        if (isg) {
#pragma unroll
                            for (int j = 0; j < 4; ++j) { v0[j] = silu_f(v0[j]); v1[j] = silu_f(v1[j]); } }
                        u32x4 w; w.x = pkh(v0[0], v0[1]); w.y = pkh(v0[2], v0[3]); w.z = pkh(v1[0], v1[1]); w.w = pkh(v1[2], v1[3]);
                        *(u32x4*)(base + (size_t)row * RIN + bj * HALF) = w;
                    }
                }
        }
    }
};
struct EpiY {
    static constexpr bool PERM = true; static constexpr int NST = 16;
    f16* Y; const float* gate; float scl;
    __device__ __forceinline__ void operator()(const f32x4 (&acc)[2][2][4][2], const Unit& u, int wr, int wc, int fr, int fq) const {
        const int row0 = u.pm * BM + wr * 64 + fr, col0 = u.pn * BM + wc * 32 + 8 * fq;
        const float* gp = gate + (size_t)(u.pm >> 3) * 6144 + col0;
        f32x4 gv[2][2];
#pragma unroll
        for (int bj = 0; bj < 2; ++bj)
#pragma unroll
            for (int n = 0; n < 2; ++n) gv[bj][n] = *(const f32x4*)(gp + bj * HALF + 4 * n) * scl;
#pragma unroll
        for (int ai = 0; ai < 2; ++ai)
#pragma unroll
            for (int m = 0; m < 4; ++m) { f16* rowp = Y + (size_t)(row0 + ai * HALF + m * 16) * DM + col0;
#pragma unroll
                for (int bj = 0; bj < 2; ++bj) { const f32x4 v0 = acc[ai][bj][m][0] * gv[bj][0], v1 = acc[ai][bj][m][1] * gv[bj][1];
                    u32x4 w; w.x = pkh(v0[0], v0[1]); w.y = pkh(v0[2], v0[3]); w.z = pkh(v1[0], v1[1]); w.w = pkh(v1[2], v1[3]);
                    *(u32x4*)(rowp + bj * HALF) = w; } }
    }
};
struct EpiXAdd {
    static constexpr bool PERM = true; static constexpr int NST = 16;
    f16* X; const float* gate; float scl;
    __device__ __forceinline__ void operator()(const f32x4 (&acc)[2][2][4][2], const Unit& u, int wr, int wc, int fr, int fq) const {
        const int row0 = u.pm * BM + wr * 64 + fr, col0 = u.pn * BM + wc * 32 + 8 * fq;
        const float* gp = gate + (size_t)(u.pm >> 3) * 6144 + col0;
        f32x4 gv[2][2];
#pragma unroll
        for (int bj = 0; bj < 2; ++bj)
#pragma unroll
            for (int n = 0; n < 2; ++n) gv[bj][n] = *(const f32x4*)(gp + bj * HALF + 4 * n) * scl;
        u32x4 bn[2];
#pragma unroll
        for (int bj = 0; bj < 2; ++bj) bn[bj] = *(const u32x4*)(X + (size_t)row0 * DM + col0 + bj * HALF);
#pragma unroll
        for (int ai = 0; ai < 2; ++ai)
#pragma unroll
            for (int m = 0; m < 4; ++m) { f16* rowp = X + (size_t)(row0 + ai * HALF + m * 16) * DM + col0;
                const f16x8 b0 = __builtin_bit_cast(f16x8, bn[0]), b1 = __builtin_bit_cast(f16x8, bn[1]);
                if (ai * 4 + m < 7) { const f16* nrow = X + (size_t)(row0 + ((ai * 4 + m + 1) >> 2) * HALF + ((ai * 4 + m + 1) & 3) * 16) * DM + col0;
#pragma unroll
                    for (int bj = 0; bj < 2; ++bj) bn[bj] = *(const u32x4*)(nrow + bj * HALF); }
#pragma unroll
                for (int bj = 0; bj < 2; ++bj) { const f16x8 bb = bj ? b1 : b0; const f32x4 v0 = acc[ai][bj][m][0] * gv[bj][0], v1 = acc[ai][bj][m][1] * gv[bj][1];
                    u32x4 w; w.x = pkh((float)bb[0] + v0[0], (float)bb[1] + v0[1]); w.y = pkh((float)bb[2] + v0[2], (float)bb[3] + v0[3]);
                    w.z = pkh((float)bb[4] + v1[0], (float)bb[5] + v1[1]); w.w = pkh((float)bb[6] + v1[2], (float)bb[7] + v1[3]);
                    *(u32x4*)(rowp + bj * HALF) = w; } }
    }
};
template <bool F8IN, bool F8 = F8IN> struct EpiGlu {
    static constexpr bool PERM = true; static constexpr int NST = 8;
    void* Ov; int ldc;
    __device__ __forceinline__ void operator()(const f32x4 (&acc)[2][2][4][2], const Unit& u, int wr, int wc, int fr, int fq) const {
        const int row0 = u.pm * BM + wr * 64 + fr, col0 = u.pn * HALF + wc * 32 + 8 * fq;
        constexpr float si = F8IN ? 1.0f / F8_WSCALE : 1.0f, so = F8 ? F8_ASCALE : 1.0f;
#pragma unroll
        for (int ai = 0; ai < 2; ++ai)
#pragma unroll
            for (int m = 0; m < 4; ++m) {
                float r[8];
#pragma unroll
                for (int n = 0; n < 2; ++n)
#pragma unroll
                    for (int p = 0; p < 2; ++p) {
                        const f32x2 a = {acc[ai][0][m][n][2 * p], acc[ai][0][m][n][2 * p + 1]}, b = {acc[ai][1][m][n][2 * p], acc[ai][1][m][n][2 * p + 1]};
                        const f32x2 t = a * (-1.4426950408889634f * si); f32x2 d = {ex2(t.x), ex2(t.y)}; d = d + 1.0f;
                        const f32x2 u = {__builtin_amdgcn_rcpf(d.x), __builtin_amdgcn_rcpf(d.y)};
                        const f32x2 q = ((a * b) * u) * (si * si * so);
                        r[4 * n + 2 * p] = q.x; r[4 * n + 2 * p + 1] = q.y;
                    }
                if (F8) { u32x2 w; w.x = pk4f8(r[0], r[1], r[2], r[3]); w.y = pk4f8(r[4], r[5], r[6], r[7]);
                    *(u32x2*)((unsigned char*)Ov + (size_t)(row0 + ai * HALF + m * 16) * ldc + col0) = w; }
                else { u32x4 w; w.x = pkh(r[0], r[1]); w.y = pkh(r[2], r[3]); w.z = pkh(r[4], r[5]); w.w = pkh(r[6], r[7]);
                    *(u32x4*)((f16*)Ov + (size_t)(row0 + ai * HALF + m * 16) * ldc + col0) = w; }
            }
    }
};
struct EpiF16 {
    static constexpr bool PERM = true; static constexpr int NST = 16;
    f16* O; int ldc; int split_cols; size_t split_stride; float scale;
    __device__ __forceinline__ void operator()(const f32x4 (&acc)[2][2][4][2], const Unit& u, int wr, int wc, int fr, int fq) const {
        const int row0 = u.pm * BM + wr * 64 + fr; int colt = u.pn * BM; f16* base = O;
        if (split_cols) { const int t = colt / split_cols; base += (size_t)t * split_stride; colt -= t * split_cols; }
        const int col0 = colt + wc * 32 + 8 * fq;
#pragma unroll
        for (int ai = 0; ai < 2; ++ai)
#pragma unroll
            for (int m = 0; m < 4; ++m) { f16* rowp = base + (size_t)(row0 + ai * HALF + m * 16) * ldc + col0;
#pragma unroll
                for (int bj = 0; bj < 2; ++bj) { const f32x4 v0 = acc[ai][bj][m][0] * scale, v1 = acc[ai][bj][m][1] * scale;
                    u32x4 w; w.x = pkh(v0[0], v0[1]); w.y = pkh(v0[2], v0[3]); w.z = pkh(v1[0], v1[1]); w.w = pkh(v1[2], v1[3]);
                    *(u32x4*)(rowp + bj * HALF) = w; } }
    }
};
struct EpiMoeOut {
    static constexpr bool PERM = true; static constexpr int NST = 16;
    f16* O; const float* roww; const unsigned* tof;
    __device__ __forceinline__ void operator()(const f32x4 (&acc)[2][2][4][2], const Unit& u, int wr, int wc, int fr, int fq) const {
        const int col0 = u.pn * BM + wc * 32 + 8 * fq;
        float scw[2][4]; unsigned tk[2][4];
#pragma unroll
        for (int ai = 0; ai < 2; ++ai)
#pragma unroll
            for (int m = 0; m < 4; ++m) { scw[ai][m] = roww[u.vrow + wr * 64 + fr + ai * HALF + m * 16]; tk[ai][m] = tof[u.vrow + wr * 64 + fr + ai * HALF + m * 16]; }
#pragma unroll
        for (int ai = 0; ai < 2; ++ai)
#pragma unroll
            for (int m = 0; m < 4; ++m) { const unsigned trow = (tk[ai][m] == 0xffffffffu) ? (unsigned)(2 * MTOK) : tk[ai][m];
                const float sc = scw[ai][m] * (1.0f / (F8_WSCALE * F8_ASCALE)); f16* rowp = O + (size_t)trow * DM + col0;
#pragma unroll
                for (int bj = 0; bj < 2; ++bj) { const f32x4 v0 = acc[ai][bj][m][0] * sc, v1 = acc[ai][bj][m][1] * sc;
                    u32x4 w; w.x = pkh(v0[0], v0[1]); w.y = pkh(v0[2], v0[3]); w.z = pkh(v1[0], v1[1]); w.w = pkh(v1[2], v1[3]);
                    *(u32x4*)(rowp + bj * HALF) = w; } }
    }
};

template <bool P> struct EpiNull {
    static constexpr bool PERM = P; static constexpr int NST = 0;
    float* sink;
    __device__ __forceinline__ void operator()(const f32x4 (&acc)[2][2][4][2], const Unit& u, int wr, int wc, int fr, int fq) const {
        float s = 0.f;
#pragma unroll
        for (int ai = 0; ai < 2; ++ai)
#pragma unroll
            for (int bj = 0; bj < 2; ++bj)
#pragma unroll
                for (int m = 0; m < 4; ++m)
#pragma unroll
                    for (int n = 0; n < 2; ++n) s += acc[ai][bj][m][n][0] + acc[ai][bj][m][n][1] + acc[ai][bj][m][n][2] + acc[ai][bj][m][n][3];
        if (s == 1.2345e37f) sink[0] = s;
    }
};
template <class Epi, bool F8 = false>
__device__ __forceinline__ void gemm_phase(LAS unsigned char* lds, const Gemm g, const Order& S, const Epi& E) {
    const int tid = threadIdx.x, wid = __builtin_amdgcn_readfirstlane(tid >> 6), lane = tid & 63, wr = wid >> 2, wc = wid & 3, fr = lane & 15, fq = lane >> 4;
    const int KB = g.K * (F8 ? 1 : 2), nt = KB / 128;
    unsigned voffA[2], voffB[2];
#pragma unroll
    for (int i = 0; i < 2; ++i) { int R, C; stage_rc(tid * 16 + i * 8192, R, C); const int Rb = Epi::PERM ? ((R & ~31) + perm32(R & 31)) : R;
        voffA[i] = (unsigned)(R * KB + 2 * C); voffB[i] = (unsigned)(Rb * KB + 2 * C); }
    const size_t kstep = (size_t)(BK * 2);
    const size_t hstep = (size_t)HALF * KB;
    const size_t tstep = 2 * hstep;
    const unsigned ldsw = (unsigned)wid * 1024u;
    const int aoff = lds_byte(wr * 64 + fr, fq * 8), boff = lds_byte(wc * 32 + fr, fq * 8);
#define PG8_SA(b, h) (((b) * 2 + (h)) * HTB)
#define PG8_SB(b, h) ((4 + (b) * 2 + (h)) * HTB)
#define PG8_STAGE(bufoff, gbase, voff) do { _Pragma("unroll") for (int _i = 0; _i < 2; ++_i) { const char* gb_ = (const char*)(gbase); asm volatile("" : "+s"(gb_), "+v"((voff)[_i]));     \
        __builtin_amdgcn_global_load_lds((const unsigned*)(gb_ + (voff)[_i]), (LAS unsigned*)(lds + (bufoff) + ldsw + _i * 8192), 16, 0, 0); } } while (0)
#define PG8_LD8(dst, addr) do { const i32x4 lo_ = *(const LAS i32x4*)(addr), hi_ = *(const LAS i32x4*)((addr) + 1024); dst = __builtin_shufflevector(lo_, hi_, 0, 1, 2, 3, 4, 5, 6, 7); } while (0)
#define PG8_LDA(dst, b, h) do { _Pragma("unroll") for (int m = 0; m < 4; ++m) { if constexpr (F8) PG8_LD8(dst##8[m], lds + PG8_SA(b, h) + aoff + m * 2048); else { _Pragma("unroll") for (int k = 0; k < 2; ++k) dst[m][k] = *(const LAS f16x8*)(lds + PG8_SA(b, h) + aoff + m * 2048 + k * 1024); } } } while (0)
#define PG8_LDB(dst, b, h) do { _Pragma("unroll") for (int n = 0; n < 2; ++n) { if constexpr (F8) PG8_LD8(dst##8[n], lds + PG8_SB(b, h) + boff + n * 2048); else { _Pragma("unroll") for (int k = 0; k < 2; ++k) dst[n][k] = *(const LAS f16x8*)(lds + PG8_SB(b, h) + boff + n * 2048 + k * 1024); } } } while (0)
#define PG8_MMA(ai, bj, At, Bt) do { __builtin_amdgcn_s_setprio(1); _Pragma("unroll") for (int m = 0; m < 4; ++m) _Pragma("unroll") for (int n = 0; n < 2; ++n) { \
        if constexpr (F8) asm volatile("v_mfma_f32_16x16x128_f8f6f4 %0, %1, %2, %0" : "+v"(acc[ai][bj][m][n]) : "v"(Bt##8[n]), "v"(At##8[m])); \
        else { _Pragma("unroll") for (int k = 0; k < 2; ++k) acc[ai][bj][m][n] = __builtin_amdgcn_mfma_f32_16x16x32_f16(Bt[n][k], At[m][k], acc[ai][bj][m][n], 0, 0, 0); } } \
        __builtin_amdgcn_s_setprio(0); } while (0)
#define PG8_WAIT_V(n) asm volatile("s_waitcnt vmcnt(" #n ")" ::: "memory")
#define PG8_WAIT_VR() asm volatile("s_waitcnt vmcnt(%0)" :: "n"(8 + Epi::NST) : "memory")
#define PG8_WAIT_L(n) asm volatile("s_waitcnt lgkmcnt(" #n ")" ::: "memory")
#define PG8_BAR __builtin_amdgcn_s_barrier()
#define PG8_SCHED __builtin_amdgcn_sched_barrier(0)
    Unit cur, nxt; int ui = 0; bool relax = false;
    if (!S.next(0, cur)) return;
    if (g.stagger) {
        const unsigned grp = (blockIdx.x >> 3) & 3u;
        if (grp) { const unsigned long long t0 = __builtin_amdgcn_s_memrealtime(); while (__builtin_amdgcn_s_memrealtime() - t0 < (unsigned long long)(grp * (unsigned)g.stagger)) __builtin_amdgcn_s_sleep(16); }
    }
    f32x4 acc[2][2][4][2];
#pragma unroll
    for (int a = 0; a < 2; ++a)
#pragma unroll
        for (int b = 0; b < 2; ++b)
#pragma unroll
            for (int m = 0; m < 4; ++m)
#pragma unroll
                for (int n = 0; n < 2; ++n) acc[a][b][m][n] = (f32x4){0.f, 0.f, 0.f, 0.f};
    f16x8 At[4][2], B0[2][2], B1[2][2]; i32x8 At8[4], B08[2], B18[2];
    const char* cA = (const char*)g.A + (size_t)cur.arow * KB; const char* cB = (const char*)g.Bt + (size_t)cur.be * g.bstride + (size_t)cur.pn * tstep;
    PG8_STAGE(PG8_SB(0, 0), cB, voffB); PG8_STAGE(PG8_SB(0, 1), cB + hstep, voffB); PG8_STAGE(PG8_SA(0, 0), cA, voffA); PG8_STAGE(PG8_SA(0, 1), cA + hstep, voffA);
    if (wr == 1) PG8_BAR;
    PG8_WAIT_V(2); PG8_BAR;
    PG8_STAGE(PG8_SB(1, 0), cB + kstep, voffB); PG8_STAGE(PG8_SA(1, 0), cA + kstep, voffA); PG8_STAGE(PG8_SB(1, 1), cB + hstep + kstep, voffB);
    PG8_WAIT_V(6); PG8_BAR;
    for (;;) {
        const bool has_next = S.next(ui + 1, nxt);
        const char* nA = has_next ? (const char*)g.A + (size_t)nxt.arow * KB : cA; const char* nB = has_next ? (const char*)g.Bt + (size_t)nxt.be * g.bstride + (size_t)nxt.pn * tstep : cB;
#pragma nounroll
        for (int t = 0; t < nt; t += 2) {
            const bool last = (t == nt - 2);
            const char* a1 = cA + (size_t)(t + 1) * kstep;
            const char* a2 = last ? nA : cA + (size_t)(t + 2) * kstep; const char* b2 = last ? nB : cB + (size_t)(t + 2) * kstep;
            const char* a3 = a2 + kstep; const char* b3 = b2 + kstep;
            PG8_LDB(B0, 0, 0); PG8_LDB(B1, 0, 1); PG8_SCHED; PG8_LDA(At, 0, 0); PG8_STAGE(PG8_SA(1, 1), a1 + hstep, voffA);
            if (relax) PG8_WAIT_VR(); else PG8_WAIT_V(8);
            PG8_WAIT_L(0); PG8_BAR; PG8_MMA(0, 0, At, B0); PG8_MMA(0, 1, At, B1); PG8_BAR; PG8_SCHED;
            PG8_LDA(At, 0, 1); PG8_STAGE(PG8_SB(0, 0), b2, voffB); PG8_STAGE(PG8_SB(0, 1), b2 + hstep, voffB); PG8_STAGE(PG8_SA(0, 0), a2, voffA);
            if (relax) { PG8_WAIT_VR(); relax = false; } else PG8_WAIT_V(8);
            PG8_WAIT_L(0); PG8_BAR; PG8_MMA(1, 0, At, B0); PG8_MMA(1, 1, At, B1); PG8_BAR; PG8_SCHED;
            PG8_LDB(B0, 1, 0); PG8_LDB(B1, 1, 1); PG8_SCHED; PG8_LDA(At, 1, 0); PG8_STAGE(PG8_SA(0, 1), a2 + hstep, voffA);
            PG8_WAIT_V(8); PG8_WAIT_L(0); PG8_BAR; PG8_MMA(0, 0, At, B0); PG8_MMA(0, 1, At, B1); PG8_BAR; PG8_SCHED;
            PG8_LDA(At, 1, 1); PG8_STAGE(PG8_SB(1, 0), b3, voffB); PG8_STAGE(PG8_SB(1, 1), b3 + hstep, voffB); PG8_STAGE(PG8_SA(1, 0), a3, voffA);
            PG8_WAIT_V(8); PG8_WAIT_L(0); PG8_BAR; PG8_MMA(1, 0, At, B0); PG8_MMA(1, 1, At, B1); PG8_BAR; PG8_SCHED;
        }
        if constexpr (F8) asm volatile("s_nop 15\n\ts_nop 15" ::: "memory");
        if (wr == 0) PG8_BAR;
        E(acc, cur, wr, wc, fr, fq);
        if (!has_next) break;
#pragma unroll
        for (int a = 0; a < 2; ++a)
#pragma unroll
            for (int b = 0; b < 2; ++b)
#pragma unroll
                for (int m = 0; m < 4; ++m)
#pragma unroll
                    for (int n = 0; n < 2; ++n) acc[a][b][m][n] = (f32x4){0.f, 0.f, 0.f, 0.f};
        cur = nxt; cA = nA; cB = nB; ++ui; relax = true;
        if (wr == 1) PG8_BAR;
    }
    PG8_WAIT_V(0);
    PG8_BAR;
#undef PG8_SA
#undef PG8_SB
#undef PG8_STAGE
#undef PG8_LDA
#undef PG8_LDB
#undef PG8_MMA
#undef PG8_WAIT_V
#undef PG8_WAIT_L
#undef PG8_BAR
#undef PG8_SCHED
}
}

constexpr size_t MiB = 1u << 20;
constexpr size_t WS_CTL = 0, CTL_ZERO_BYTES = 128 * 1024;
constexpr size_t WS_MOD = 1 * MiB;
constexpr size_t WS_KVMOD = 3 * MiB;
constexpr size_t WS_TOKINFO = 4 * MiB;
constexpr size_t WS_TOF = 5 * MiB;
constexpr size_t WS_TOKSLOT = 6 * MiB;
constexpr size_t WS_SLOTW = 7 * MiB;
constexpr size_t WS_ROPE = 8 * MiB;
constexpr size_t WS_W_RIN = 24 * MiB, WS_W_ROUT = 48 * MiB, WS_W_KV = 56 * MiB, WS_W_SQ = 60 * MiB, WS_W_SO = 64 * MiB, WS_W_FIN = 68 * MiB, WS_W_FOUT = 90 * MiB, WS_W_MIN = 101 * MiB, WS_W_MOUT = 325 * MiB;
constexpr size_t WS_X = 437 * MiB, WS_H = 565 * MiB, WS_KSH = 629 * MiB, WS_VSH = 693 * MiB, WS_BIG = 757 * MiB;
constexpr size_t WS_PROJ = WS_BIG, WS_AO = WS_BIG + 384 * MiB;
constexpr size_t WS_ACTD = WS_BIG;
constexpr int MOE_CAP = MTOK;
constexpr size_t WS_HS = WS_BIG, WS_Y2 = WS_BIG, WS_ACTE = WS_BIG + 256 * MiB;
constexpr size_t WS_SQ = WS_BIG, WS_SO = WS_BIG + 64 * MiB, WS_HK = WS_BIG + 192 * MiB;
constexpr size_t WS_YB = WS_BIG + 594 * MiB;
constexpr size_t WS_END = WS_YB + 64 * MiB;
static_assert((size_t)MOE_ROWS_MAX * DM * 2 <= 256 * MiB && (size_t)NEXP * MOE_CAP * DM <= 256 * MiB && WS_ACTE + (size_t)MOE_ROWS_MAX * FFE <= WS_YB && WS_AO + (size_t)MTOK * 2048 * 2 <= WS_YB, "ws map");
constexpr int CW_BAR = 4096;
constexpr int CW_MOE = 16384;

constexpr int RING_BYTES = 131072;
constexpr int LDS_BYTES = 147456;
constexpr int MISC_OFF = LDS_BYTES - 256;

#define XB_TMO      128
#define XB_XCNT(j)  (256  + 64 * (j))
#define XB_XSUB(j)  (1280 + 64 * (j))
#define XB_XGEN(j)  (2304 + 64 * (j))
#define XB_TOP      3328
#define XB_TOPGEN   3392
#define XCD_BAR_WORDS 3456
#define XB_SPIN_CAP (1u << 20)
__device__ __forceinline__ unsigned xb_ld(unsigned* p)              { return __hip_atomic_load(p, __ATOMIC_RELAXED, __HIP_MEMORY_SCOPE_AGENT); }
__device__ __forceinline__ unsigned xb_add(unsigned* p, unsigned v) { return __hip_atomic_fetch_add(p, v, __ATOMIC_RELAXED, __HIP_MEMORY_SCOPE_AGENT); }
__device__ __forceinline__ unsigned xb_xcc_id() { return (unsigned)__builtin_amdgcn_s_getreg((3 << 11) | 20) & 0xFu; }
#define XB_SPIN(cond, bar) do { unsigned _sp = 0; while (cond) { __builtin_amdgcn_s_sleep(1); \
    if ((++_sp & 255u) == 0u) { if (xb_ld(&(bar)[XB_TMO])) break; if (_sp > XB_SPIN_CAP) { atomicAdd(&(bar)[XB_TMO], 1u); break; } } } } while (0)
struct XcdBarrier { unsigned* bar; unsigned x; volatile LAS unsigned* st; };
__device__ __forceinline__ XcdBarrier xcd_barrier_post(unsigned* bar, volatile LAS unsigned* st) {
    XcdBarrier b; b.bar = bar; b.x = xb_xcc_id(); b.st = st;
    if (threadIdx.x == 0) (void)xb_add(&bar[XB_XCNT(b.x)], 1u);
    return b;
}
__device__ __forceinline__ void xcd_barrier_complete(unsigned* bar, unsigned x, unsigned& nloc, unsigned& nx) {
    const unsigned G = gridDim.x * gridDim.y * gridDim.z;
    unsigned sum, cnt, mine, sp = 0u;
    for (;;) {
        sum = 0u; cnt = 0u; mine = 0u;
#pragma unroll
        for (unsigned j = 0; j < 16; ++j) { const unsigned c = xb_ld(&bar[XB_XCNT(j)]); sum += c; cnt += (c > 0u) ? 1u : 0u; mine = (j == x) ? c : mine; }
        if (sum == G) break;
        __builtin_amdgcn_s_sleep(1);
        if ((++sp & 255u) == 0u) { if (xb_ld(&bar[XB_TMO])) break; if (sp > XB_SPIN_CAP) { atomicAdd(&bar[XB_TMO], 1u); break; } }
    }
    nloc = mine > 0u ? mine : 1u; nx = cnt > 0u ? cnt : 1u;
}
__device__ __forceinline__ void xcd_barrier(const XcdBarrier& b) {
    asm volatile("s_waitcnt vmcnt(0)" ::: "memory");
    __syncthreads();
    if (threadIdx.x == 0) {
        unsigned* bar = b.bar;
        __builtin_amdgcn_s_waitcnt(0);
        unsigned nloc = b.st[0], nx = b.st[1];
        if (nloc == 0u) { xcd_barrier_complete(bar, b.x, nloc, nx); b.st[0] = nloc; b.st[1] = nx; }
        const unsigned old = xb_add(&bar[XB_XSUB(b.x)], 1u);
        const unsigned gen = old / nloc;
        if (old + 1u == (gen + 1u) * nloc) {
            __builtin_amdgcn_fence(__ATOMIC_RELEASE, "agent");
            asm volatile("s_waitcnt vmcnt(0)" ::: "memory");
            const unsigned og = xb_add(&bar[XB_TOP], 1u);
            const unsigned tg = og / nx;
            if (og + 1u == (tg + 1u) * nx) xb_add(&bar[XB_TOPGEN], 1u);
            else XB_SPIN(xb_ld(&bar[XB_TOPGEN]) == tg, bar);
            __builtin_amdgcn_fence(__ATOMIC_ACQUIRE, "agent");
            xb_add(&bar[XB_XGEN(b.x)], 1u);
            asm volatile("s_waitcnt vmcnt(0)" ::: "memory");
        } else {
            XB_SPIN(xb_ld(&bar[XB_XGEN(b.x)]) == gen, bar);
            __builtin_amdgcn_fence(__ATOMIC_ACQUIRE, "agent");
            asm volatile("s_waitcnt vmcnt(0)" ::: "memory");
        }
    }
    __syncthreads();
}

#define WG_BAR() do { asm volatile("s_waitcnt lgkmcnt(0)" ::: "memory"); __builtin_amdgcn_s_barrier(); asm volatile("" ::: "memory"); } while (0)
#define CFENCE() asm volatile("" ::: "memory")
__device__ __forceinline__ float wave_sum(float v) {
#pragma unroll
    for (int o = 1; o < 64; o <<= 1) v += __shfl_xor(v, o);
    return v;
}
__device__ __forceinline__ f16x4 tr_read(LAS const unsigned char* p) {
    return __builtin_bit_cast(f16x4, __builtin_amdgcn_ds_read_tr16_b64_v4i16((LAS v4i16_t*)p));
}
__device__ __forceinline__ f16x8 cat8(f16x4 a, f16x4 b) { return (f16x8){a[0], a[1], a[2], a[3], b[0], b[1], b[2], b[3]}; }
__device__ __forceinline__ f16x8 pack8(const f32x16& x, int s) {
    u32x4 w; w.x = pkh(x[8 * s + 0], x[8 * s + 1]); w.y = pkh(x[8 * s + 2], x[8 * s + 3]); w.z = pkh(x[8 * s + 4], x[8 * s + 5]); w.w = pkh(x[8 * s + 6], x[8 * s + 7]);
    return __builtin_bit_cast(f16x8, w);
}

struct Frame {
    LAS unsigned char* lds;
    unsigned* ctl;
    int wave, vcu, G;
    unsigned char* ws;
};
__device__ __forceinline__ int lane_id() { int l; asm volatile("v_mbcnt_lo_u32_b32 %0, -1, 0\n\tv_mbcnt_hi_u32_b32 %0, -1, %0" : "=v"(l)); return l; }
#define PHASE_IDS() const int lane = lane_id(); const int tid = F.wave * 64 + lane; (void)tid

template <int I> __device__ __forceinline__ const void* karg() {
    const auto kp = __builtin_amdgcn_kernarg_segment_ptr();
    unsigned long long v; asm volatile("s_load_dwordx2 %0, %1, %2\n\ts_waitcnt lgkmcnt(0)" : "=s"(v) : "s"(kp), "i"(I * 8) : "memory");
    return (const void*)(const GAS char*)v;
}
#define KIN(i) ((const float*)karg<(i)>())
template <int MAP>
__device__ __forceinline__ int srccol(int n, int N) {
    if (MAP == 1) { if (n >= 2048) return n; const int p = n & 127; return (n & ~127) + (p >> 1) + 64 * (p & 1); }
    if (MAP == 2) { const int F = N >> 1, t = n >> 8, j = n & 255; return (j < 128) ? 128 * t + j : F + 128 * t + (j - 128); }
    return n;
}
template <int MAP, bool F8>
__device__ __forceinline__ void p0_transpose_item(const float* W, int K, int N, void* WT, LAS float* scr, int item, int lane) {
    const int nblk = N / 32, kb = item / nblk, nb = item % nblk, k0 = 64 * kb, n0 = 32 * nb;
    const int sc = srccol<MAP>(n0 + (lane & 31), N);
    const float* wp = W + (size_t)(k0 + (lane >> 5)) * N + sc;
    float v[32];
#pragma unroll
    for (int i = 0; i < 32; ++i) v[i] = __builtin_nontemporal_load(wp + (size_t)(2 * i) * N);
#pragma unroll
    for (int i = 0; i < 32; ++i) scr[(2 * i + (lane >> 5)) * 33 + (lane & 31)] = F8 ? v[i] * F8_WSCALE : v[i];
    asm volatile("s_waitcnt lgkmcnt(0)" ::: "memory");
    if (F8) {
        const int c = lane & 3;
#pragma unroll
        for (int j = 0; j < 2; ++j) { const int n = (lane >> 2) + 16 * j; const LAS float* s = scr + (16 * c) * 33 + n;
            u32x4 o; o.x = pk4f8(s[0 * 33], s[1 * 33], s[2 * 33], s[3 * 33]); o.y = pk4f8(s[4 * 33], s[5 * 33], s[6 * 33], s[7 * 33]);
            o.z = pk4f8(s[8 * 33], s[9 * 33], s[10 * 33], s[11 * 33]); o.w = pk4f8(s[12 * 33], s[13 * 33], s[14 * 33], s[15 * 33]);
            *(u32x4*)((unsigned char*)WT + (size_t)(n0 + n) * K + k0 + 16 * c) = o; }
    } else {
        const int c = lane & 7;
#pragma unroll
        for (int j = 0; j < 4; ++j) { const int n = (lane >> 3) + 8 * j; const LAS float* s = scr + (8 * c) * 33 + n;
            u32x4 o; o.x = pkh(s[0 * 33], s[1 * 33]); o.y = pkh(s[2 * 33], s[3 * 33]); o.z = pkh(s[4 * 33], s[5 * 33]); o.w = pkh(s[6 * 33], s[7 * 33]);
            *(u32x4*)((f16*)WT + (size_t)(n0 + n) * K + k0 + 8 * c) = o; }
    }
    asm volatile("s_waitcnt lgkmcnt(0)" ::: "memory");
}
template <int MAP, bool F8>
__device__ __forceinline__ bool p0_group(int& r, const float* W, int nb, int K, int N, void* WT, LAS float* scr, int lane) {
    const int per = (K / 64) * (N / 32), tot = nb * per;
    if (r >= tot) { r -= tot; return false; }
    const int b = r / per, it = r % per;
    p0_transpose_item<MAP, F8>(W + (size_t)b * K * N, K, N, (unsigned char*)WT + (size_t)b * K * N * (F8 ? 1 : 2), scr, it, lane);
    return true;
}
constexpr int CONV_ITEMS_0 = 8 * (16 * 224 + 56 * 32) + 16 * 192 + 32 * 32;
constexpr int CONV_ITEMS_1 = 8 * (16 * 224 + 56 * 32) + 16 * 64 + 4 * 16 * 32 + 16 * 176 + 44 * 32;
__device__ __forceinline__ void conv_rest(int r, int which, unsigned char* ws, LAS float* scr, int lane) {
    if (which != 1) {
        if (p0_group<2, true>(r, KIN(19), NEXP, 1024, 7168, ws + WS_W_MIN, scr, lane)) return;
        if (p0_group<0, true>(r, KIN(20), NEXP, 3584, 1024, ws + WS_W_MOUT, scr, lane)) return;
        if (p0_group<1, RETIN_F8 != 0>(r, KIN(7) + (size_t)1024 * 6144, 1, 1024, 6144, (f16*)(ws + WS_W_RIN) + (size_t)1024 * 6144, scr, lane)) return;
        if (p0_group<0, false>(r, KIN(9) + (size_t)2048 * 1024, 1, 2048, 1024, (f16*)(ws + WS_W_ROUT) + (size_t)2048 * 1024, scr, lane)) return;
    }
    if (which != 0) {
        if (p0_group<2, true>(r, KIN(19) + (size_t)NEXP * 1024 * 7168, NEXP, 1024, 7168, ws + WS_W_MIN + (size_t)NEXP * 1024 * 7168, scr, lane)) return;
        if (p0_group<0, true>(r, KIN(20) + (size_t)NEXP * 3584 * 1024, NEXP, 3584, 1024, ws + WS_W_MOUT + (size_t)NEXP * 3584 * 1024, scr, lane)) return;
        if (p0_group<0, false>(r, KIN(13), 1, 1024, 2048, (f16*)(ws + WS_W_KV), scr, lane)) return;
        if (p0_group<0, SQ_F8 != 0>(r, KIN(14), 2, 1024, 1024, (f16*)(ws + WS_W_SQ), scr, lane)) return;
        if (p0_group<0, false>(r, KIN(15), 2, 1024, 1024, (f16*)(ws + WS_W_SO), scr, lane)) return;
        if (p0_group<2, DENSE_F8 != 0>(r, KIN(16) + (size_t)1024 * 5632, 1, 1024, 5632, (f16*)(ws + WS_W_FIN) + (size_t)1024 * 5632, scr, lane)) return;
        p0_group<0, (DENSE_F8 != 0 && DENSE_F8_OUT != 0)>(r, KIN(17) + (size_t)2816 * 1024, 1, 2816, 1024, (f16*)(ws + WS_W_FOUT) + (size_t)2816 * 1024, scr, lane);
    }
}
__device__ __forceinline__ void p0_prologue(Frame& F) {
    PHASE_IDS();
    const int gw = F.vcu * 8 + F.wave, NGW = F.G * 8;
    LAS float* condL = (LAS float*)(F.lds);
    LAS float* scr = (LAS float*)(F.lds + 65536 + F.wave * 8448);
    for (int i = tid; i < 16 * 1024; i += 512) { const int b = i >> 10, k = i & 1023; condL[k * 16 + b] = silu_f(KIN(1)[i]); }
    WG_BAR();
    for (int it = gw; it < 1664; it += NGW) {
        const float* W; const float* bias; float* dst; int N, col0;
        if (it < 1536) { const int l = it / 384; col0 = 16 * (it % 384); N = 6144; W = KIN(3) + (size_t)l * 1024 * 6144; bias = KIN(4) + l * 6144; dst = (float*)(F.ws + WS_MOD) + (size_t)l * 16 * 6144; }
        else { col0 = 16 * (it - 1536); N = 2048; W = KIN(10); bias = KIN(11); dst = (float*)(F.ws + WS_KVMOD); }
        const int cl = lane & 3, kg = lane >> 2;
        f32x4 acc[16];
#pragma unroll
        for (int b = 0; b < 16; ++b) acc[b] = (f32x4){0.f, 0.f, 0.f, 0.f};
        const float* wp = W + (size_t)kg * N + col0 + 4 * cl;
#pragma unroll 4
        for (int k16 = 0; k16 < 64; ++k16) {
            const f32x4 w = *(const f32x4*)(wp + (size_t)k16 * 16 * N);
            const LAS f32x4* cp = (const LAS f32x4*)(condL + (16 * k16 + kg) * 16);
            const f32x4 c0 = cp[0], c1 = cp[1], c2 = cp[2], c3 = cp[3];
#pragma unroll
            for (int j = 0; j < 4; ++j) { acc[j] += c0[j] * w; acc[4 + j] += c1[j] * w; acc[8 + j] += c2[j] * w; acc[12 + j] += c3[j] * w; }
        }
        const f32x4 bv = *(const f32x4*)(bias + col0 + 4 * cl);
#pragma unroll
        for (int b = 0; b < 16; ++b) {
            f32x4 v = acc[b];
#pragma unroll
            for (int j = 0; j < 4; ++j) { v[j] += __shfl_xor(v[j], 4); v[j] += __shfl_xor(v[j], 8); v[j] += __shfl_xor(v[j], 16); v[j] += __shfl_xor(v[j], 32); }
            if (kg == 0) *(f32x4*)(dst + (size_t)b * N + col0 + 4 * cl) = v + bv;
        }
    }
    for (int i = gw * 64 + lane; i < 2 * NEXP * MOE_CAP / 4; i += NGW * 64) *((u32x4*)(F.ws + WS_TOF) + i) = (u32x4){0xffffffffu, 0xffffffffu, 0xffffffffu, 0xffffffffu};
    {
        const double e = -(double)lane / 64.0;
        const double invf = exp2(e * 13.287712379549449);
        float* rope = (float*)(F.ws + WS_ROPE); const int* posp = (const int*)karg<2>();
        for (int row = gw; row < MTOK; row += NGW) {
            const double rev = (double)posp[row] * invf * 0.15915494309189535;
            const float fr = (float)(rev - floor(rev));
            rope[(size_t)row * 128 + lane] = __builtin_amdgcn_cosf(fr); rope[(size_t)row * 128 + 64 + lane] = __builtin_amdgcn_sinf(fr);
        }
    }
    constexpr int per_rin = 16 * 192, per_rout = 32 * 32, per_kv = 16 * 64, per_sq = 16 * 32, per_fin = 16 * 176, per_fout = 44 * 32, per_min = 16 * 224, per_mout = 56 * 32;
    constexpr int NITEMS = CONV_IN_SCAN ? (per_rin + per_rout + per_fin + per_fout) : (2 * per_rin + 2 * per_rout + per_kv + 4 * per_sq + 2 * per_fin + 2 * per_fout + 16 * per_min + 16 * per_mout);
    for (int it = gw; it < NITEMS; it += NGW) {
        int r = it;
        if (p0_group<1, RETIN_F8 != 0>(r, KIN(7), 1, 1024, 6144, (f16*)(F.ws + WS_W_RIN), scr, lane)) continue;
        if (p0_group<0, false>(r, KIN(9), 1, 2048, 1024, (f16*)(F.ws + WS_W_ROUT), scr, lane)) continue;
        if (p0_group<2, false>(r, KIN(16), 1, 1024, 5632, (f16*)(F.ws + WS_W_FIN), scr, lane)) continue;
        if (p0_group<0, (DENSE_F8 != 0 && DENSE_F8_OUT != 0 && DENSE_F8_OUT0 != 0)>(r, KIN(17), 1, 2816, 1024, (f16*)(F.ws + WS_W_FOUT), scr, lane)) continue;
        if (!CONV_IN_SCAN) conv_rest(r, 2, F.ws, scr, lane);
    }
}

__device__ __forceinline__ void moe_tile_bases(const unsigned* gcnt, int (&tb)[NEXP], int& ntiles) {
    int acc = 0;
#pragma unroll
    for (int e = 0; e < NEXP; ++e) { tb[e] = acc; const unsigned c = __hip_atomic_load(gcnt + 64 * e, __ATOMIC_RELAXED, __HIP_MEMORY_SCOPE_AGENT); acc += (int)((c + 255u) >> 8); }
    ntiles = acc;
}
struct NormArgs {
    const void* x; f16* xw; const float* gain; const float* sh; const float* sc;
    f16* h; const float* gain2; const float* kvmod; f16* hk;
    const f16* y2; const float* gatef;
    float* out;
    const f16* yb;
    const float* router; unsigned* gcnt; unsigned* tokinfo; unsigned char* hs8; float* wof; unsigned* tof;
};
template <bool COMBINE, bool KV, bool FINAL, bool ROUTER, bool H8 = false, bool ADDY = false, bool XF32 = false>
__device__ __forceinline__ void norm_phase(Frame& F, const NormArgs& A) {
    PHASE_IDS();
    const int gw = F.vcu * 8 + F.wave, NGW = F.G * 8;
    LAS float* routL = (LAS float*)F.lds;
    LAS unsigned* lcnt = (LAS unsigned*)(F.lds + 32768);
    LAS unsigned* recs = (LAS unsigned*)(F.lds + 32768 + 256);
    if (ROUTER) {
        for (int i = tid; i < 8192; i += 512) routL[(i & 7) * 1024 + (i >> 3)] = A.router[i];
        if (tid < 16) lcnt[tid] = 0u;
        WG_BAR();
    }
    int ctb[NEXP]; int cnt_ = 0; (void)cnt_;
    f32x4 cxf[4], nxf[4]; f16x4 cxh[4], nxh[4], cya[4], nya[4], cyb[4], nyb[4]; u32x4 ti_n = {0u, 0u, 0u, 0u};
#define NP_ISSUE(row_, ti_, xf_, xh_, ya_, yb_) do { \
        _Pragma("unroll") for (int j = 0; j < 4; ++j) { if (XF32) xf_[j] = *((const f32x4*)((const float*)A.x + (size_t)(row_) * DM) + lane + 64 * j); else xh_[j] = *((const f16x4*)((const f16*)A.x + (size_t)(row_) * DM) + lane + 64 * j); } \
        if (ADDY) { _Pragma("unroll") for (int j = 0; j < 4; ++j) ya_[j] = *((const f16x4*)(A.yb + (size_t)(row_) * DM) + lane + 64 * j); } \
        if (COMBINE) { const f16* pa_ = A.y2 + (size_t)(row_) * (2 * DM); const f16* pb_ = pa_ + DM;     \
            _Pragma("unroll") for (int j = 0; j < 4; ++j) { ya_[j] = *((const f16x4*)pa_ + lane + 64 * j); yb_[j] = *((const f16x4*)pb_ + lane + 64 * j); } } } while (0)
    const int WPB = NGW / BATCH, b = gw / WPB, wsub = gw - b * WPB; const size_t rbase = (size_t)b * SEQ;
    f32x4 gnv[4], shv[4], scv[4], g2v[4], sh2v[4], sc2v[4], gfv[4];
#pragma unroll
    for (int j = 0; j < 4; ++j) {
        gnv[j] = *((const f32x4*)A.gain + lane + 64 * j);
        if (!FINAL) { shv[j] = *((const f32x4*)(A.sh + (size_t)b * 6144) + lane + 64 * j); scv[j] = *((const f32x4*)(A.sc + (size_t)b * 6144) + lane + 64 * j) + 1.0f; }
        if (KV) { g2v[j] = *((const f32x4*)A.gain2 + lane + 64 * j); sh2v[j] = *((const f32x4*)(A.kvmod + (size_t)b * 2048) + lane + 64 * j); sc2v[j] = *((const f32x4*)(A.kvmod + (size_t)b * 2048 + 1024) + lane + 64 * j) + 1.0f; }
        if (COMBINE) gfv[j] = *((const f32x4*)(A.gatef + (size_t)b * 6144) + lane + 64 * j);
    }
    if (wsub < SEQ) {
        u32x4 ti0 = {0u, 0u, 0u, 0u};
        NP_ISSUE(rbase + wsub, ti0, cxf, cxh, cya, cyb);
    }
    int nloc = 0;
    for (int sq = wsub; sq < SEQ; sq += WPB, ++nloc) {
        const size_t row = rbase + sq;
        if (sq + WPB < SEQ) {
            NP_ISSUE(row + WPB, ti_n, nxf, nxh, nya, nyb);
        }
        f32x4 v[4];
#pragma unroll
        for (int j = 0; j < 4; ++j) { if (XF32) v[j] = cxf[j]; else v[j] = (f32x4){(float)cxh[j][0], (float)cxh[j][1], (float)cxh[j][2], (float)cxh[j][3]}; }
        if (ADDY) {
#pragma unroll
            for (int j = 0; j < 4; ++j) {
#pragma unroll
                for (int t = 0; t < 4; ++t) v[j][t] += (float)cya[j][t];
                { u32x2 w; w.x = pkh(v[j][0], v[j][1]); w.y = pkh(v[j][2], v[j][3]); *((u32x2*)(A.xw + (size_t)row * DM) + lane + 64 * j) = w; }
            }
        }
        if (COMBINE) {
#pragma unroll
            for (int j = 0; j < 4; ++j) {
                const f32x4 g = gfv[j];
#pragma unroll
                for (int t = 0; t < 4; ++t) v[j][t] += g[t] * ((float)cya[j][t] + (float)cyb[j][t]);
                if (!FINAL) { u32x2 w; w.x = pkh(v[j][0], v[j][1]); w.y = pkh(v[j][2], v[j][3]); *((u32x2*)(A.xw + (size_t)row * DM) + lane + 64 * j) = w; }
            }
        }
        float ss = 0.f;
#pragma unroll
        for (int j = 0; j < 4; ++j) ss += (v[j][0] * v[j][0] + v[j][1] * v[j][1]) + (v[j][2] * v[j][2] + v[j][3] * v[j][3]);
        const float rstd = 1.0f / sqrtf(wave_sum(ss) * (1.0f / DM) + EPS);
        if (FINAL) {
#pragma unroll
            for (int j = 0; j < 4; ++j) *((f32x4*)(A.out + (size_t)row * DM) + lane + 64 * j) = v[j] * rstd * gnv[j];
        } else {
            f32x4 hv[4];
#pragma unroll
            for (int j = 0; j < 4; ++j) {
                hv[j] = (v[j] * rstd * gnv[j]) * scv[j] + shv[j];
                if (H8) *((unsigned*)((unsigned char*)A.h + (size_t)row * DM) + lane + 64 * j) = pk4f8(hv[j][0], hv[j][1], hv[j][2], hv[j][3]);
                else { u32x2 w; w.x = pkh(hv[j][0], hv[j][1]); w.y = pkh(hv[j][2], hv[j][3]); *((u32x2*)(A.h + (size_t)row * DM) + lane + 64 * j) = w; }
            }
            if (KV) {
#pragma unroll
                for (int j = 0; j < 4; ++j) {
                    const f32x4 o = (v[j] * rstd * g2v[j]) * sc2v[j] + sh2v[j];
                    u32x2 w; w.x = pkh(o[0], o[1]); w.y = pkh(o[2], o[3]);
                    *((u32x2*)(A.hk + (size_t)row * DM) + lane + 64 * j) = w;
                }
            }
            if (ROUTER) {
                float lg[8];
#pragma unroll
                for (int e = 0; e < 8; ++e) lg[e] = 0.f;
#pragma unroll
                for (int j = 0; j < 4; ++j)
#pragma unroll
                    for (int e = 0; e < 8; ++e) {
                        const f32x4 rv = *((const LAS f32x4*)(routL + e * 1024) + lane + 64 * j);
                        lg[e] += (hv[j][0] * rv[0] + hv[j][1] * rv[1]) + (hv[j][2] * rv[2] + hv[j][3] * rv[3]);
                    }
                {
                    float r4[4], r2[2], r1;
                    const bool b0 = lane & 1, b1 = lane & 2, b2 = lane & 4;
#pragma unroll
                    for (int k = 0; k < 4; ++k) { const float keep = b0 ? lg[k + 4] : lg[k], send = b0 ? lg[k] : lg[k + 4]; r4[k] = keep + __shfl_xor(send, 1); }
#pragma unroll
                    for (int k = 0; k < 2; ++k) { const float keep = b1 ? r4[k + 2] : r4[k], send = b1 ? r4[k] : r4[k + 2]; r2[k] = keep + __shfl_xor(send, 2); }
                    { const float keep = b2 ? r2[1] : r2[0], send = b2 ? r2[0] : r2[1]; r1 = keep + __shfl_xor(send, 4); }
                    r1 += __shfl_xor(r1, 8); r1 += __shfl_xor(r1, 16); r1 += __shfl_xor(r1, 32);
#pragma unroll
                    for (int e = 0; e < 8; ++e) lg[e] = __int_as_float(__builtin_amdgcn_readlane(__float_as_int(r1), ((e >> 2) & 1) | (((e >> 1) & 1) << 1) | ((e & 1) << 2)));
                }
                int i1 = 0; float v1 = lg[0];
#pragma unroll
                for (int e = 1; e < 8; ++e) if (lg[e] > v1) { v1 = lg[e]; i1 = e; }
                int i2 = (i1 == 0) ? 1 : 0; float v2 = lg[i2];
#pragma unroll
                for (int e = 0; e < 8; ++e) if (e != i1 && lg[e] > v2) { v2 = lg[e]; i2 = e; }
                const float ed = __expf(v2 - v1), w1 = 1.0f / (1.0f + ed), w2 = ed * w1;
                if (lane == 0) {
                    const unsigned p1 = __hip_atomic_fetch_add(&lcnt[i1], 1u, __ATOMIC_RELAXED, __HIP_MEMORY_SCOPE_WORKGROUP), p2 = __hip_atomic_fetch_add(&lcnt[i2], 1u, __ATOMIC_RELAXED, __HIP_MEMORY_SCOPE_WORKGROUP);
                    LAS unsigned* rc = recs + (F.wave * 16 + nloc) * 8;
                    rc[0] = (unsigned)i1; rc[1] = p1; rc[2] = (unsigned)i2; rc[3] = p2; rc[4] = __float_as_uint(w1); rc[5] = __float_as_uint(w2);
                }
            }
        }
#pragma unroll
        for (int j = 0; j < 4; ++j) { cxf[j] = nxf[j]; cxh[j] = nxh[j]; cya[j] = nya[j]; cyb[j] = nyb[j]; }
    }
    if (ROUTER) {
        WG_BAR();
        if (tid < 8) lcnt[8 + tid] = __hip_atomic_fetch_add(A.gcnt + 64 * tid, lcnt[tid], __ATOMIC_RELAXED, __HIP_MEMORY_SCOPE_AGENT);
        WG_BAR();
        asm volatile("s_waitcnt vmcnt(0)" ::: "memory");
        for (int k0 = 0, sq0 = wsub; sq0 < SEQ; sq0 += 4 * WPB, k0 += 4) {
            u32x4 a[4];
#pragma unroll
            for (int q = 0; q < 4; ++q) { const size_t row = rbase + sq0 + q * WPB; if (sq0 + q * WPB < SEQ) a[q] = *((const u32x4*)((const unsigned char*)A.h + row * DM) + lane); }
#pragma unroll
            for (int q = 0; q < 4; ++q) { const size_t row = rbase + sq0 + q * WPB; if (sq0 + q * WPB < SEQ) {
                const LAS unsigned* rc = recs + (F.wave * 16 + k0 + q) * 8;
                const unsigned e1 = rc[0], p1 = rc[1] + lcnt[8 + rc[0]], e2 = rc[2], p2 = rc[3] + lcnt[8 + rc[2]];
                const size_t v1 = (size_t)e1 * MOE_CAP + p1, v2 = (size_t)e2 * MOE_CAP + p2;
                *((u32x4*)(A.hs8 + v1 * DM) + lane) = a[q]; *((u32x4*)(A.hs8 + v2 * DM) + lane) = a[q];
                if (lane == 0) { *(u32x4*)(A.tokinfo + 8 * (size_t)row) = (u32x4){e1, p1, e2, p2}; A.wof[v1] = __uint_as_float(rc[4]); A.wof[v2] = __uint_as_float(rc[5]); A.tof[v1] = 2u * (unsigned)row; A.tof[v2] = 2u * (unsigned)row + 1u; } } }
        }
    }
}
constexpr int SC_PV = 576;
constexpr int SC_QL = 0, SC_KL = 16384, SC_VL = 32768, SC_SL = 69632, SC_ST = 135168, SC_STAGE = 0;
__device__ __forceinline__ int sc_off(int row, int ch) { return 256 * row + 16 * (ch ^ (((row & 3) << 2) | ((row >> 2) & 3))); }
__device__ __forceinline__ void scan_phase(Frame& F, const f16* proj, const float* gnw, f16* ao, int mi) {
    if (CONV_IN_SCAN) {
        if (blockIdx.x >= BATCH * RH) {
            PHASE_IDS();
            LAS float* scr = (LAS float*)(F.lds + F.wave * 8448);
            const int cw = ((int)blockIdx.x - BATCH * RH) * 8 + F.wave, NCW = ((int)gridDim.x - BATCH * RH) * 8;
            const int nit = mi ? CONV_ITEMS_1 : CONV_ITEMS_0;
            for (int it = cw; it < nit; it += NCW) conv_rest(it, mi, F.ws, scr, lane);
            return;
        }
    } else if (blockIdx.x >= 2 * BATCH * RH) return;
    const int unit = CONV_IN_SCAN ? (int)blockIdx.x : (int)(blockIdx.x >> 1), half = CONV_IN_SCAN ? 0 : (int)(blockIdx.x & 1);
    const int b = unit >> 3, hh = unit & 7;
    const int c_first_full = half ? NCHUNK / 2 : 0, c_end = CONV_IN_SCAN ? NCHUNK : (half ? NCHUNK : NCHUNK / 2);
    LAS unsigned char* L = F.lds;
    PHASE_IDS();
    const int wid = F.wave, rh = wid >> 2, cg = wid & 3, r = lane & 31, h = lane >> 5;
    const int gl = (lane >> 4) & 1, li = lane & 15, ta = li >> 2, tp = li & 3;
    const float lg = lg2gamma(hh);
    const float g63 = ex2(63.0f * lg), cd = __int_as_float(__builtin_amdgcn_readfirstlane(__float_as_int(ex2(64.0f * lg))));
    float vm[4], cj[4]; const int qloc = 32 * rh + r;
    const float wneg = __int_as_float(__builtin_amdgcn_readfirstlane(__float_as_int(ex2(-64.0f * lg))));
#pragma unroll
    for (int g4 = 0; g4 < 4; ++g4) vm[g4] = ex2((float)(16 * g4 + 8 * h - 2 * qloc - 64) * lg);
#pragma unroll
    for (int j = 0; j < 4; ++j) cj[j] = __int_as_float(__builtin_amdgcn_readfirstlane(__float_as_int(ex2((float)(2 * j) * lg))));
    const size_t rowbase = (size_t)b * SEQ;
    const f16* gq = proj + rowbase * RIN + 128 * hh;
    const f16* gk = gq + 1024;
    const f16* gv = proj + rowbase * RIN + 2048 + 256 * hh;
    const f16* gg = gv + 2048;
    const int qrow = tid >> 4, qc = tid & 15;
    const int vrow = tid >> 5, vc = tid & 31;
    int qoffL[2];
#pragma unroll
    for (int i = 0; i < 2; ++i) qoffL[i] = sc_off(qrow + 32 * i, qc);
    f32x16 SA[2][2];
#pragma unroll
    for (int dd = 0; dd < 2; ++dd)
#pragma unroll
        for (int et = 0; et < 2; ++et)
#pragma unroll
            for (int i = 0; i < 16; ++i) SA[dd][et][i] = 0.f;
    for (int i = tid; i < 65536 / 16; i += 512) *(LAS u32x4*)(L + SC_SL + i * 16) = (u32x4){0u, 0u, 0u, 0u};
    u32x4 nq[2], nk[2], nv[4];
#pragma unroll
    for (int i = 0; i < 2; ++i) { nq[i] = *(const u32x4*)(gq + (size_t)(qrow + 32 * i) * RIN + 8 * qc); nk[i] = *(const u32x4*)(gk + (size_t)(qrow + 32 * i) * RIN + 8 * qc); }
#pragma unroll
    for (int i = 0; i < 4; ++i) nv[i] = *(const u32x4*)(gv + (size_t)(vrow + 16 * i) * RIN + 8 * vc);
#pragma unroll
    for (int i = 0; i < 2; ++i) { *(LAS u32x4*)(L + SC_QL + qoffL[i]) = nq[i]; *(LAS u32x4*)(L + SC_KL + qoffL[i]) = nk[i]; }
#pragma unroll
    for (int i = 0; i < 4; ++i) *(LAS u32x4*)(L + SC_VL + (vrow + 16 * i) * SC_PV + 16 * vc) = nv[i];
    WG_BAR();
    for (int c = 0; c < c_first_full; ++c) {
        const size_t crow = (size_t)c * CHUNK;
#pragma unroll
        for (int i = 0; i < 2; ++i) { nq[i] = *(const u32x4*)(gq + (crow + 64 + qrow + 32 * i) * RIN + 8 * qc); nk[i] = *(const u32x4*)(gk + (crow + 64 + qrow + 32 * i) * RIN + 8 * qc); }
#pragma unroll
        for (int i = 0; i < 4; ++i) nv[i] = *(const u32x4*)(gv + (crow + 64 + vrow + 16 * i) * RIN + 8 * vc);
        int ro = r, ho = h, tao = ta, tpo = tp, glo = gl, vro = vrow, vco = vc;
        asm volatile("" : "+v"(ro), "+v"(ho), "+v"(tao), "+v"(tpo), "+v"(glo), "+v"(vro), "+v"(vco));
#pragma unroll
        for (int dd = 0; dd < 2; ++dd)
#pragma unroll
            for (int et = 0; et < 2; ++et)
#pragma unroll
                for (int i = 0; i < 16; ++i) SA[dd][et][i] *= cd;
#pragma unroll
        for (int kt = 0; kt < 2; ++kt)
#pragma unroll
            for (int s = 0; s < 2; ++s) {
                const int k0 = 32 * kt + 16 * s + 4 * ho + tao;
                f16x8 Vf[2], Kt[2];
#pragma unroll
                for (int et = 0; et < 2; ++et) { LAS const unsigned char* vp = L + SC_VL + k0 * SC_PV + (64 * cg + 32 * et + 16 * glo + 4 * tpo) * 2; Vf[et] = cat8(tr_read(vp), tr_read(vp + 8 * SC_PV)); }
#pragma unroll
                for (int dd = 0; dd < 2; ++dd) { const int ch = 4 * (2 * rh + dd) + 2 * glo + (tpo >> 1);
                    Kt[dd] = cat8(tr_read(L + SC_KL + sc_off(k0, ch) + 8 * (tpo & 1)), tr_read(L + SC_KL + sc_off(k0 + 8, ch) + 8 * (tpo & 1))); }
#pragma unroll
                for (int et = 0; et < 2; ++et)
#pragma unroll
                    for (int dd = 0; dd < 2; ++dd) SA[dd][et] = __builtin_amdgcn_mfma_f32_32x32x16_f16(Kt[dd], Vf[et], SA[dd][et], 0, 0, 0);
            }
        WG_BAR();
        if (c + 1 == c_first_full) {
#pragma unroll
            for (int dd = 0; dd < 2; ++dd)
#pragma unroll
                for (int et = 0; et < 2; ++et)
#pragma unroll
                    for (int g4 = 0; g4 < 4; ++g4) {
                        u32x2 w; w.x = pkh(SA[dd][et][4 * g4], SA[dd][et][4 * g4 + 1]); w.y = pkh(SA[dd][et][4 * g4 + 2], SA[dd][et][4 * g4 + 3]);
                        *(LAS u32x2*)(L + SC_SL + sc_off(64 * cg + 32 * et + ro, 4 * (2 * rh + dd) + g4) + 8 * ho) = w;
                    }
        }
#pragma unroll
        for (int i = 0; i < 2; ++i) { const int qo = sc_off((vro * 2 + (vco >> 4)) + 32 * i, vco & 15); *(LAS u32x4*)(L + SC_QL + qo) = nq[i]; *(LAS u32x4*)(L + SC_KL + qo) = nk[i]; }
#pragma unroll
        for (int i = 0; i < 4; ++i) *(LAS u32x4*)(L + SC_VL + (vrow + 16 * i) * SC_PV + 16 * vc) = nv[i];
        WG_BAR();
    }
    for (int c = c_first_full; c < c_end; ++c) {
        const size_t crow = (size_t)c * CHUNK;
        if (c + 1 < c_end) {
#pragma unroll
            for (int i = 0; i < 2; ++i) { nq[i] = *(const u32x4*)(gq + (crow + 64 + qrow + 32 * i) * RIN + 8 * qc); nk[i] = *(const u32x4*)(gk + (crow + 64 + qrow + 32 * i) * RIN + 8 * qc); }
#pragma unroll
            for (int i = 0; i < 4; ++i) nv[i] = *(const u32x4*)(gv + (crow + 64 + vrow + 16 * i) * RIN + 8 * vc);
        }
        int ro = r, ho = h, tao = ta, tpo = tp, glo = gl, vro = vrow, vco = vc;
        asm volatile("" : "+v"(ro), "+v"(ho), "+v"(tao), "+v"(tpo), "+v"(glo), "+v"(vro), "+v"(vco));
        f16x8 Pf[2][2]; f32x16 OT[2];
        {
        f16x8 Qf[8];
#pragma unroll
        for (int ks = 0; ks < 8; ++ks) Qf[ks] = *(const LAS f16x8*)(L + SC_QL + sc_off(32 * rh + ro, 2 * ks + ho));
#pragma unroll
        for (int kt = 0; kt < 2; ++kt) {
            f32x16 X;
#pragma unroll
            for (int i = 0; i < 16; ++i) X[i] = 0.f;
#pragma unroll
            for (int ks = 0; ks < 8; ++ks) { const f16x8 Kf = *(const LAS f16x8*)(L + SC_KL + sc_off(32 * kt + ro, 2 * ks + ho)); X = __builtin_amdgcn_mfma_f32_32x32x16_f16(Kf, Qf[ks], X, 0, 0, 0); }
#pragma unroll
            for (int i = 0; i < 16; ++i) { const int key = 32 * kt + (i & 3) + 8 * (i >> 2) + 4 * h; X[i] *= (key >= qloc) ? vm[i >> 2] * (kt ? cd * cj[i & 3] : cj[i & 3]) : wneg; }
            Pf[kt][0] = pack8(X, 0); Pf[kt][1] = pack8(X, 1);
        }
#pragma unroll
        for (int et = 0; et < 2; ++et)
#pragma unroll
            for (int i = 0; i < 16; ++i) OT[et][i] = 0.f;
#pragma unroll
        for (int ks = 0; ks < 8; ++ks)
#pragma unroll
            for (int et = 0; et < 2; ++et) {
                const f16x8 Sf = *(const LAS f16x8*)(L + SC_SL + sc_off(64 * cg + 32 * et + ro, 2 * ks + ho));
                OT[et] = __builtin_amdgcn_mfma_f32_32x32x16_f16(Sf, Qf[ks], OT[et], 0, 0, 0);
            }
        }
#pragma unroll
        for (int dd = 0; dd < 2; ++dd)
#pragma unroll
            for (int et = 0; et < 2; ++et)
#pragma unroll
                for (int i = 0; i < 16; ++i) SA[dd][et][i] *= cd;
#pragma unroll
        for (int kt = 0; kt < 2; ++kt)
#pragma unroll
            for (int s = 0; s < 2; ++s) {
                const int k0 = 32 * kt + 16 * s + 4 * ho + tao;
                f16x8 Vf[2], Kt[2];
#pragma unroll
                for (int et = 0; et < 2; ++et) { LAS const unsigned char* vp = L + SC_VL + k0 * SC_PV + (64 * cg + 32 * et + 16 * glo + 4 * tpo) * 2; Vf[et] = cat8(tr_read(vp), tr_read(vp + 8 * SC_PV)); }
#pragma unroll
                for (int dd = 0; dd < 2; ++dd) { const int ch = 4 * (2 * rh + dd) + 2 * glo + (tpo >> 1);
                    Kt[dd] = cat8(tr_read(L + SC_KL + sc_off(k0, ch) + 8 * (tpo & 1)), tr_read(L + SC_KL + sc_off(k0 + 8, ch) + 8 * (tpo & 1))); }
#pragma unroll
                for (int et = 0; et < 2; ++et) {
                    OT[et] = __builtin_amdgcn_mfma_f32_32x32x16_f16(Vf[et], Pf[kt][s], OT[et], 0, 0, 0);
#pragma unroll
                    for (int dd = 0; dd < 2; ++dd) SA[dd][et] = __builtin_amdgcn_mfma_f32_32x32x16_f16(Kt[dd], Vf[et], SA[dd][et], 0, 0, 0);
                }
            }
        float mean = 0.f, rstd = 0.f;
        {
        float s1 = 0.f, s2 = 0.f;
#pragma unroll
        for (int et = 0; et < 2; ++et)
#pragma unroll
            for (int i = 0; i < 16; ++i) { OT[et][i] *= g63; s1 += OT[et][i]; s2 += OT[et][i] * OT[et][i]; }
        s1 += __shfl_xor(s1, 32); s2 += __shfl_xor(s2, 32);
        if (h == 0) *(LAS f32x2*)(L + SC_ST + ((rh * 4 + cg) * 32 + r) * 8) = (f32x2){s1, s2};
        }
        WG_BAR();
        u32x4 gc[4];
        {
        float t1 = 0.f, t2 = 0.f;
#pragma unroll
        for (int c4 = 0; c4 < 4; ++c4) { const f32x2 p = *(const LAS f32x2*)(L + SC_ST + ((rh * 4 + c4) * 32 + r) * 8); t1 += p.x; t2 += p.y; }
        mean = t1 * (1.0f / 256.0f); const float var = t2 * (1.0f / 256.0f) - mean * mean; rstd = 1.0f / sqrtf(var + EPS);
#pragma unroll
        for (int i = 0; i < 4; ++i) gc[i] = *(const u32x4*)(gg + (crow + vrow + 16 * i) * RIN + 8 * vc);
        }
        {
#pragma unroll
        for (int dd = 0; dd < 2; ++dd)
#pragma unroll
            for (int et = 0; et < 2; ++et)
#pragma unroll
                for (int g4 = 0; g4 < 4; ++g4) {
                    u32x2 w; w.x = pkh(SA[dd][et][4 * g4], SA[dd][et][4 * g4 + 1]); w.y = pkh(SA[dd][et][4 * g4 + 2], SA[dd][et][4 * g4 + 3]);
                    *(LAS u32x2*)(L + SC_SL + sc_off(64 * cg + 32 * et + ro, 4 * (2 * rh + dd) + g4) + 8 * ho) = w;
                }
        }
        {
#pragma unroll
        for (int et = 0; et < 2; ++et)
#pragma unroll
            for (int g4 = 0; g4 < 4; ++g4) {
                u32x2 w; w.x = pkh((OT[et][4 * g4] - mean) * rstd, (OT[et][4 * g4 + 1] - mean) * rstd); w.y = pkh((OT[et][4 * g4 + 2] - mean) * rstd, (OT[et][4 * g4 + 3] - mean) * rstd);
                *(LAS u32x2*)(L + SC_STAGE + 16384 * (cg >> 1) + sc_off(32 * rh + ro, 8 * (cg & 1) + 4 * et + g4) + 8 * ho) = w;
            }
        }
        WG_BAR();
        {
        f32x4 gw0, gw1; { const float* gp = gnw + 256 * hh + 8 * vc; gw0 = *(const f32x4*)gp; gw1 = *(const f32x4*)(gp + 4); }
#pragma unroll
        for (int i = 0; i < 4; ++i) {
            const f16x8 n8 = *(const LAS f16x8*)(L + SC_STAGE + 16384 * (vco >> 4) + sc_off(vro + 16 * i, vco & 15));
            const f16x8 g8 = __builtin_bit_cast(f16x8, gc[i]);
            u32x4 w;
            w.x = pkh((float)n8[0] * (float)g8[0] * gw0[0], (float)n8[1] * (float)g8[1] * gw0[1]); w.y = pkh((float)n8[2] * (float)g8[2] * gw0[2], (float)n8[3] * (float)g8[3] * gw0[3]);
            w.z = pkh((float)n8[4] * (float)g8[4] * gw1[0], (float)n8[5] * (float)g8[5] * gw1[1]); w.w = pkh((float)n8[6] * (float)g8[6] * gw1[2], (float)n8[7] * (float)g8[7] * gw1[3]);
            *(u32x4*)(ao + (rowbase + crow + vrow + 16 * i) * 2048 + 256 * hh + 8 * vc) = w;
        }
        }
        WG_BAR();
        if (c + 1 < c_end) {
#pragma unroll
            for (int i = 0; i < 2; ++i) { const int qo = sc_off((vro * 2 + (vco >> 4)) + 32 * i, vco & 15); *(LAS u32x4*)(L + SC_QL + qo) = nq[i]; *(LAS u32x4*)(L + SC_KL + qo) = nk[i]; }
#pragma unroll
            for (int i = 0; i < 4; ++i) *(LAS u32x4*)(L + SC_VL + (vrow + 16 * i) * SC_PV + 16 * vc) = nv[i];
        }
        WG_BAR();
    }
}

constexpr int SBV_P = 144;
constexpr float SB_STOP = 5.421010862427522e-20f;
__device__ __forceinline__ void sb_phase(Frame& F, const f16* Q, const f16* Kc, const f16* Vc, f16* O, const float stop = SB_STOP) {
    PHASE_IDS();
    const int gw = F.vcu * 8 + F.wave, NGW = F.G * 8, r = lane & 31, h = lane >> 5;
    const int gl = (lane >> 4) & 1, li = lane & 15, ta = li >> 2, tp = li & 3;
    LAS unsigned char* Kw = F.lds + F.wave * (96 * SBV_P);
    LAS unsigned char* Vw = Kw + 32 * SBV_P; LAS unsigned char* Qw = Kw + 64 * SBV_P;
    const int vr = lane >> 3, vcc = lane & 7;
    constexpr int NU = BATCH * SBH * (SEQ / 32);
    u32x4 qn2[4], kn2[4], vn2[4];
    if (gw < NU) { const int qblk = gw & 63, bh = gw >> 6, b = bh >> 4, hd = bh & 15; const size_t rb = (size_t)b * SEQ;
        const f16* qp = Q + (rb + 32 * qblk + vr) * DM + 64 * hd + 8 * vcc; const f16* kp = Kc + (rb + 32 * qblk + vr) * DM + 64 * hd + 8 * vcc; const f16* vp = Vc + (rb + 32 * qblk + vr) * DM + 64 * hd + 8 * vcc;
#pragma unroll
        for (int i = 0; i < 4; ++i) { qn2[i] = *(const u32x4*)(qp + (size_t)(8 * i) * DM); kn2[i] = *(const u32x4*)(kp + (size_t)(8 * i) * DM); vn2[i] = *(const u32x4*)(vp + (size_t)(8 * i) * DM); } }
    for (int u = gw; u < NU; u += NGW) {
        const int qblk = u & 63, bh = u >> 6, b = bh >> 4, hd = bh & 15;
        const size_t rb = (size_t)b * SEQ;
        f16x8 Qf[4];
#pragma unroll
        for (int i = 0; i < 4; ++i) *(LAS u32x4*)(Qw + (vr + 8 * i) * SBV_P + 16 * vcc) = qn2[i];
        CFENCE();
#pragma unroll
        for (int ks = 0; ks < 4; ++ks) Qf[ks] = *(const LAS f16x8*)(Qw + r * SBV_P + (16 * ks + 8 * h) * 2);
        CFENCE();
        f32x16 OT[2];
#pragma unroll
        for (int dt = 0; dt < 2; ++dt)
#pragma unroll
            for (int i = 0; i < 16; ++i) OT[dt][i] = 0.f;
        float carry = 1.0f;
        u32x4 kn[4], vn[4];
#pragma unroll
        for (int i = 0; i < 4; ++i) { kn[i] = kn2[i]; vn[i] = vn2[i]; }
        if (u + NGW < NU) { const int un = u + NGW, qb2 = un & 63, bh2 = un >> 6, b2 = bh2 >> 4, hd2 = bh2 & 15; const size_t rb2 = (size_t)b2 * SEQ;
            const f16* qp = Q + (rb2 + 32 * qb2 + vr) * DM + 64 * hd2 + 8 * vcc; const f16* kp = Kc + (rb2 + 32 * qb2 + vr) * DM + 64 * hd2 + 8 * vcc; const f16* vp = Vc + (rb2 + 32 * qb2 + vr) * DM + 64 * hd2 + 8 * vcc;
#pragma unroll
            for (int i = 0; i < 4; ++i) { qn2[i] = *(const u32x4*)(qp + (size_t)(8 * i) * DM); kn2[i] = *(const u32x4*)(kp + (size_t)(8 * i) * DM); vn2[i] = *(const u32x4*)(vp + (size_t)(8 * i) * DM); } }
        for (int kt = qblk; kt >= 0; --kt) {
#pragma unroll
            for (int i = 0; i < 4; ++i) { *(LAS u32x4*)(Kw + (vr + 8 * i) * SBV_P + 16 * vcc) = kn[i]; *(LAS u32x4*)(Vw + (vr + 8 * i) * SBV_P + 16 * vcc) = vn[i]; }
            CFENCE();
            f16x8 Kf[4];
#pragma unroll
            for (int ks = 0; ks < 4; ++ks) Kf[ks] = *(const LAS f16x8*)(Kw + r * SBV_P + (16 * ks + 8 * h) * 2);
            CFENCE();
            if (kt > 0) { const f16* kp = Kc + (rb + 32 * (kt - 1) + vr) * DM + 64 * hd + 8 * vcc; const f16* vp = Vc + (rb + 32 * (kt - 1) + vr) * DM + 64 * hd + 8 * vcc;
#pragma unroll
                for (int i = 0; i < 4; ++i) { kn[i] = *(const u32x4*)(kp + (size_t)(8 * i) * DM); vn[i] = *(const u32x4*)(vp + (size_t)(8 * i) * DM); } }
            f32x16 S;
#pragma unroll
            for (int i = 0; i < 16; ++i) S[i] = 0.f;
#pragma unroll
            for (int ks = 0; ks < 4; ++ks) S = __builtin_amdgcn_mfma_f32_32x32x16_f16(Kf[ks], Qf[ks], S, 0, 0, 0);
            float om[16];
            const bool diag = (kt == qblk);
#pragma unroll
            for (int i = 0; i < 16; ++i) {
                const int kl = (i & 3) + 8 * (i >> 2) + 4 * h;
                float o = __builtin_amdgcn_rcpf(1.0f + ex2(S[i]));
                if (diag && kl >= r) o = 1.0f;
                om[i] = o;
            }
            float sfx[16], T[4];
#pragma unroll
            for (int g4 = 0; g4 < 4; ++g4) { sfx[4 * g4 + 3] = 1.0f; sfx[4 * g4 + 2] = om[4 * g4 + 3]; sfx[4 * g4 + 1] = sfx[4 * g4 + 2] * om[4 * g4 + 2]; sfx[4 * g4] = sfx[4 * g4 + 1] * om[4 * g4 + 1]; T[g4] = sfx[4 * g4] * om[4 * g4]; }
            float E[4]; float run = carry;
#pragma unroll
            for (int g4 = 3; g4 >= 0; --g4) {
                const auto sw = __builtin_amdgcn_permlane32_swap(__float_as_uint(T[g4]), __float_as_uint(T[g4]), false, false);
                const float tl = __uint_as_float(sw[0]), th = __uint_as_float(sw[1]);
                const float e_hi = run; run *= th; const float e_lo = run; run *= tl;
                E[g4] = h ? e_hi : e_lo;
            }
            carry = run;
            f32x16 Aw;
#pragma unroll
            for (int i = 0; i < 16; ++i) Aw[i] = (1.0f - om[i]) * (E[i >> 2] * sfx[i]);
            const f16x8 Af0 = pack8(Aw, 0), Af1 = pack8(Aw, 1);
            CFENCE();
#pragma unroll
            for (int dt = 0; dt < 2; ++dt) {
                LAS const unsigned char* vp = Vw + (4 * h + ta) * SBV_P + (32 * dt + 16 * gl + 4 * tp) * 2;
                const f16x8 V0 = cat8(tr_read(vp), tr_read(vp + 8 * SBV_P)), V1 = cat8(tr_read(vp + 16 * SBV_P), tr_read(vp + 24 * SBV_P));
                OT[dt] = __builtin_amdgcn_mfma_f32_32x32x16_f16(V0, Af0, OT[dt], 0, 0, 0);
                OT[dt] = __builtin_amdgcn_mfma_f32_32x32x16_f16(V1, Af1, OT[dt], 0, 0, 0);
            }
            CFENCE();
            if (__ballot(carry > stop) == 0ull) break;
        }
        CFENCE();
#pragma unroll
        for (int dt = 0; dt < 2; ++dt)
#pragma unroll
            for (int g4 = 0; g4 < 4; ++g4) { u32x2 w; w.x = pkh(OT[dt][4 * g4], OT[dt][4 * g4 + 1]); w.y = pkh(OT[dt][4 * g4 + 2], OT[dt][4 * g4 + 3]); *(LAS u32x2*)(Qw + r * SBV_P + (32 * dt + 8 * g4 + 4 * h) * 2) = w; }
        CFENCE();
        f16* op = O + (rb + 32 * qblk + vr) * DM + 64 * hd + 8 * vcc;
#pragma unroll
        for (int i = 0; i < 4; ++i) *(u32x4*)(op + (size_t)(8 * i) * DM) = *(const LAS u32x4*)(Qw + (vr + 8 * i) * SBV_P + 16 * vcc);
        CFENCE();
    }
}

struct Args { const void* in[22]; float* out; unsigned char* ws; int ph_lo, ph_hi; };
constexpr int N_PHASES = 34;
#define IN(k) (lo <= (k) && (k) < hi)
#define SEAM(k) do { if (IN((k) + 1)) { if (!MK_PER_PHASE) xcd_barrier(bar); } } while (0)
#define WSP(T, off) ((T*)(F.ws + (off)))
#define REPS(cond) _Pragma("unroll") for (int rep_ = 0; rep_ < ((cond) ? 2 : 1); ++rep_)
#define REPBAR() do { if (rep_) xcd_barrier(bar); } while (0)
#define REPSN(cond, n) _Pragma("unroll") for (int rep_ = 0; rep_ < ((cond) ? (n) : 1); ++rep_)
template <int L> __device__ __forceinline__ void layer_phases(Frame& F, const XcdBarrier& bar, const int lo, const int hi) {
    constexpr int pb = 1 + 8 * L;
        if (IN(pb + 0) && !DIS_K0) {
            const float* modL = WSP(const float, WS_MOD) + (size_t)L * 16 * 6144;
            NormArgs A{}; A.x = (L == 0) ? (const void*)KIN(0) : (const void*)WSP(const f16, WS_X); A.xw = WSP(f16, WS_X); A.gain = KIN(5) + L * DM; A.sh = modL; A.sc = modL + 1024; A.h = WSP(f16, WS_H);
            if constexpr (L == 2) {
                A.y2 = WSP(const f16, WS_Y2); A.gcnt = F.ctl + CW_MOE; A.tokinfo = WSP(unsigned, WS_TOKINFO); A.gatef = WSP(const float, WS_MOD) + (size_t)(L - 1) * 16 * 6144 + 5120;
                A.gain2 = KIN(12); A.kvmod = WSP(const float, WS_KVMOD); A.hk = WSP(f16, WS_HK); REPSN(PROBE_DUP == 15, 5) { REPBAR(); if (rep_) { A.xw = WSP(f16, WS_BIG + 320 * MiB); A.h = WSP(f16, WS_BIG + 448 * MiB); A.hk = WSP(f16, WS_BIG + 512 * MiB); } norm_phase<true, true, false, false, SQ_F8 != 0>(F, A); }
            } else REPSN(PROBE_DUP == 7 && L == 1, 5) { REPBAR(); A.yb = WSP(const f16, WS_YB); if (rep_) { A.xw = WSP(f16, WS_BIG + 320 * MiB); A.h = WSP(f16, WS_BIG + 448 * MiB); } norm_phase<false, false, false, false, (RETIN_F8 != 0 && L < 2) || (SQ_F8 != 0 && L >= 2), false, (L == 0)>(F, A); }
            SEAM(pb + 0);
        }
        if (IN(pb + 1) && !DIS_K1) {
            if constexpr (L < 2) {
                pg8::Gemm g{WSP(const unsigned char, WS_H), WSP(const unsigned char, WS_W_RIN) + (size_t)L * RIN * DM * 2, MTOK, RIN, DM, 0, STAG_RET}; pg8::Order S; S.init(MTOK, RIN, F.G, (int)blockIdx.x);
                pg8::EpiRetIn E{WSP(f16, WS_PROJ), WSP(const float, WS_ROPE), RETIN_F8 ? 1.0f / F8_WSCALE : 1.0f};
                REPS(PROBE_DUP == 6 && L == 1) { REPBAR(); pg8::gemm_phase<pg8::EpiRetIn, RETIN_F8 != 0>(F.lds, g, S, E); }
                if constexpr (PROBE_DUP == 17 && L == 1) { xcd_barrier(bar); pg8::EpiNull<true> EN{WSP(float, WS_SLOTW)}; pg8::gemm_phase<pg8::EpiNull<true>, false>(F.lds, g, S, EN); }
            } else REPS(PROBE_DUP == 12 && L == 2) { REPBAR();
                { pg8::Gemm g{WSP(const unsigned char, WS_H), WSP(const unsigned char, WS_W_SQ) + (size_t)(L - 2) * DM * DM * (SQ_F8 ? 1 : 2), MTOK, DM, DM, 0}; pg8::Order S; S.init(MTOK, DM, F.G, (int)blockIdx.x);
                  pg8::EpiF16 E{WSP(f16, WS_SQ), DM, 0, 0, 0.125f * 1.4426950408889634f * (SQ_F8 ? 1.0f / F8_WSCALE : 1.0f)};
                  pg8::gemm_phase<pg8::EpiF16, SQ_F8 != 0>(F.lds, g, S, E); }
                if constexpr (L == 2) { pg8::Gemm g{WSP(const f16, WS_HK), WSP(const f16, WS_W_KV), MTOK, 2048, DM, 0}; pg8::Order S; S.init(MTOK, 2048, F.G, (int)blockIdx.x);
                  pg8::EpiF16 E{WSP(f16, WS_KSH), DM, 1024, (size_t)(WS_VSH - WS_KSH) / 2, 1.0f};
                  pg8::gemm_phase<pg8::EpiF16>(F.lds, g, S, E); }
            }
            SEAM(pb + 1);
        }
        if (IN(pb + 2) && !DIS_K2) {
#ifndef NO_SCAN
            if constexpr (L < 2) REPS(PROBE_DUP == 2 && L == 1) { REPBAR(); scan_phase(F, WSP(const f16, WS_PROJ), KIN(8) + L * 2048, WSP(f16, WS_AO), L); }
#endif
#ifndef NO_SB
            if constexpr (L >= 2) REPSN((PROBE_DUP == 3 || PROBE_DUP == 22 || PROBE_DUP == 23) && L == 3, 5) { REPBAR(); sb_phase(F, WSP(const f16, WS_SQ), WSP(const f16, WS_KSH), WSP(const f16, WS_VSH), rep_ ? WSP(f16, WS_BIG + 320 * MiB) : WSP(f16, WS_SO), (rep_ && PROBE_DUP == 22) ? 2.0f : (rep_ && PROBE_DUP == 23) ? 1e-6f : SB_STOP); }
#endif
            SEAM(pb + 2);
        }
        if (IN(pb + 3) && !DIS_K3) {
            pg8::Gemm g;
            if constexpr (L < 2) g = pg8::Gemm{WSP(const f16, WS_AO), WSP(const f16, WS_W_ROUT) + (size_t)L * DM * 2048, MTOK, DM, 2048, 0};
            else g = pg8::Gemm{WSP(const f16, WS_SO), WSP(const f16, WS_W_SO) + (size_t)(L - 2) * DM * DM, MTOK, DM, DM, 0};
            pg8::Order S; S.init(MTOK, DM, F.G, (int)blockIdx.x);
            if constexpr (L == 0) {
                pg8::EpiY E{WSP(f16, WS_YB), WSP(const float, WS_MOD) + (size_t)L * 16 * 6144 + 2048, 1.0f};
                pg8::gemm_phase<pg8::EpiY>(F.lds, g, S, E);
            } else {
                pg8::EpiXAdd E{WSP(f16, WS_X), WSP(const float, WS_MOD) + (size_t)L * 16 * 6144 + 2048, 1.0f};
                pg8::gemm_phase<pg8::EpiXAdd>(F.lds, g, S, E);
            }
            SEAM(pb + 3);
        }
        if (IN(pb + 4) && !DIS_K4) {
            const float* modL = WSP(const float, WS_MOD) + (size_t)L * 16 * 6144;
            NormArgs A{}; A.x = (L == 0) ? (const void*)KIN(0) : (const void*)WSP(const f16, WS_X); A.xw = WSP(f16, WS_X); A.gain = KIN(6) + L * DM; A.sh = modL + 3072; A.sc = modL + 4096; A.h = WSP(f16, WS_H); A.yb = WSP(const f16, WS_YB);
            if constexpr (L & 1) { A.router = KIN(18) + (size_t)(L >> 1) * DM * NEXP; A.gcnt = F.ctl + CW_MOE + (L >> 1) * 1024; A.tokinfo = WSP(unsigned, WS_TOKINFO); A.hs8 = WSP(unsigned char, WS_HS); A.wof = WSP(float, WS_SLOTW); A.tof = WSP(unsigned, WS_TOF + (size_t)(L >> 1) * MiB); REPSN(PROBE_DUP == 13 && L == 3, 5) { REPBAR(); if (rep_) { A.gcnt = F.ctl + CW_MOE + 4096; A.tokinfo = WSP(unsigned, WS_BIG + 516 * MiB); A.xw = WSP(f16, WS_BIG + 320 * MiB); A.h = WSP(f16, WS_BIG + 448 * MiB); A.hs8 = WSP(unsigned char, WS_END); A.wof = WSP(float, WS_BIG + 512 * MiB); A.tof = WSP(unsigned, WS_BIG + 514 * MiB); } norm_phase<false, false, false, true, true, false>(F, A); } }
            else norm_phase<false, false, false, false, DF8(L), (L == 0), (L == 0)>(F, A);
            SEAM(pb + 4);
        }
        if (IN(pb + 6) && !DIS_K6) {
            const int mi = L >> 1;
            pg8::Order S;
            if constexpr (L & 1) {
                int tb[NEXP], ntl; moe_tile_bases(F.ctl + CW_MOE + mi * 1024, tb, ntl);
                S.init(ntl * 256, 2 * FFE, F.G, (int)blockIdx.x); S.cap = MOE_CAP; S.avirt = 1;
#pragma unroll
                for (int e = 0; e < NEXP; ++e) S.tb[e] = tb[e];
                pg8::Gemm g{WSP(const unsigned char, WS_HS), WSP(const unsigned char, WS_W_MIN) + (size_t)mi * NEXP * 2 * FFE * DM, ntl * 256, 2 * FFE, DM, (size_t)2 * FFE * DM, STAG_MOE};
                pg8::EpiGlu<true> E{WSP(unsigned char, WS_ACTE), FFE};
                REPS(PROBE_DUP == 4 && L == 3) { REPBAR(); pg8::gemm_phase<pg8::EpiGlu<true>, true>(F.lds, g, S, E); }
                if constexpr (PROBE_DUP == 16 && L == 3) { xcd_barrier(bar); pg8::EpiNull<true> EN{WSP(float, WS_SLOTW)}; pg8::gemm_phase<pg8::EpiNull<true>, true>(F.lds, g, S, EN); }
            } else {
                S.init(MTOK, 2 * FFD, F.G, (int)blockIdx.x);
                pg8::Gemm g{WSP(const unsigned char, WS_H), WSP(const unsigned char, WS_W_FIN) + (size_t)mi * 2 * FFD * DM * 2, MTOK, 2 * FFD, DM, 0};
                pg8::EpiGlu<DF8(L), DF8O(L)> E{WSP(unsigned char, WS_ACTD), FFD};
                REPS(PROBE_DUP == 10 && L == 2) { REPBAR(); pg8::gemm_phase<pg8::EpiGlu<DF8(L), DF8O(L)>, DF8(L)>(F.lds, g, S, E); }
            }
            SEAM(pb + 6);
        }
        if (IN(pb + 7) && !DIS_K7) {
            const int mi = L >> 1;
            if constexpr (L & 1) {
                int tb[NEXP], ntl; moe_tile_bases(F.ctl + CW_MOE + mi * 1024, tb, ntl);
                pg8::Order S; S.init(ntl * 256, DM, F.G, (int)blockIdx.x); S.cap = MOE_CAP;
#pragma unroll
                for (int e = 0; e < NEXP; ++e) S.tb[e] = tb[e];
                pg8::Gemm g{WSP(const unsigned char, WS_ACTE), WSP(const unsigned char, WS_W_MOUT) + (size_t)mi * NEXP * DM * FFE, ntl * 256, DM, FFE, (size_t)DM * FFE};
                pg8::EpiMoeOut E{WSP(f16, WS_Y2), WSP(const float, WS_SLOTW), WSP(const unsigned, WS_TOF + (size_t)mi * MiB)};
                REPS(PROBE_DUP == 5 && L == 3) { REPBAR(); pg8::gemm_phase<pg8::EpiMoeOut, true>(F.lds, g, S, E); }
            } else {
                pg8::Order S; S.init(MTOK, DM, F.G, (int)blockIdx.x);
                pg8::Gemm g{WSP(const unsigned char, WS_ACTD), WSP(const unsigned char, WS_W_FOUT) + (size_t)mi * DM * FFD * 2, MTOK, DM, FFD, 0};
                pg8::EpiXAdd E{WSP(f16, WS_X), WSP(const float, WS_MOD) + (size_t)L * 16 * 6144 + 5120, DF8O(L) ? 1.0f / (F8_WSCALE * F8_ASCALE) : 1.0f};
                pg8::gemm_phase<pg8::EpiXAdd, DF8O(L)>(F.lds, g, S, E);
            }
            SEAM(pb + 7);
        }
}
__global__ void __launch_bounds__(512, 2) mk_fwd(Args args) {
    extern __shared__ __attribute__((aligned(16))) unsigned char lds_raw[];
    Frame F;
    F.lds = (LAS unsigned char*)lds_raw;
    F.wave = __builtin_amdgcn_readfirstlane((int)threadIdx.x >> 6);
    F.G = gridDim.x; { const int bx = blockIdx.x; F.vcu = (F.G % 8 == 0) ? (bx % 8) * (F.G / 8) + bx / 8 : bx; }
    F.ws = args.ws; F.ctl = (unsigned*)(args.ws + WS_CTL);
    volatile LAS unsigned* MISC = (volatile LAS unsigned*)(F.lds + MISC_OFF);
    if (threadIdx.x < 64) ((LAS unsigned*)(F.lds + MISC_OFF))[threadIdx.x] = 0u;
    __syncthreads();
    XcdBarrier bar; bar.bar = F.ctl + CW_BAR; bar.x = 0; bar.st = nullptr;
    if (!MK_PER_PHASE) bar = xcd_barrier_post(F.ctl + CW_BAR, MISC + 8);
    const int lo = args.ph_lo, hi = args.ph_hi;

    if (IN(0)) {
#ifndef NO_P0
        REPS(PROBE_DUP == 1) { REPBAR(); p0_prologue(F); }
#endif
        SEAM(0);
    }
    layer_phases<0>(F, bar, lo, hi); layer_phases<1>(F, bar, lo, hi); layer_phases<2>(F, bar, lo, hi); layer_phases<3>(F, bar, lo, hi);
    if (IN(33)) {
        NormArgs A{}; A.x = WSP(const f16, WS_X); A.xw = WSP(f16, WS_X); A.gain = KIN(21); A.out = (float*)karg<22>();
        A.y2 = WSP(const f16, WS_Y2); A.gcnt = F.ctl + CW_MOE + 1024; A.tokinfo = WSP(unsigned, WS_TOKINFO); A.gatef = WSP(const float, WS_MOD) + (size_t)3 * 16 * 6144 + 5120;
        REPSN(PROBE_DUP == 14, 5) { REPBAR(); norm_phase<true, false, true, false>(F, A); }
        if constexpr (PROBE_DUP == 24) { _Pragma("unroll 1") for (int i = 0; i < 40; ++i) xcd_barrier(bar); }
        if constexpr (PROBE_DUP == 20 || PROBE_DUP == 21) {
            xcd_barrier(bar);
            f16x8 a = {(f16)1.f, (f16)0.5f, (f16)0.25f, (f16)1.f, (f16)1.f, (f16)0.5f, (f16)0.25f, (f16)1.f}, b = a;
            f32x16 acc[4];
#pragma unroll
            for (int i = 0; i < 4; ++i)
#pragma unroll
                for (int j = 0; j < 16; ++j) acc[i][j] = 0.f;
            f32x4 acc16[8];
#pragma unroll
            for (int i = 0; i < 8; ++i) acc16[i] = (f32x4){0.f, 0.f, 0.f, 0.f};
            for (int it = 0; it < (PROBE_DUP == 20 ? 16384 : 8192); ++it) {
                if constexpr (PROBE_DUP == 20) {
#pragma unroll
                    for (int i = 0; i < 4; ++i) acc[i] = __builtin_amdgcn_mfma_f32_32x32x16_f16(a, b, acc[i], 0, 0, 0);
                } else {
#pragma unroll
                    for (int i = 0; i < 8; ++i) acc16[i] = __builtin_amdgcn_mfma_f32_16x16x32_f16(a, b, acc16[i], 0, 0, 0);
                }
            }
            float sacc = 0.f;
#pragma unroll
            for (int i = 0; i < 4; ++i) sacc += acc[i][0] + acc16[i][0] + acc16[4 + i][1];
            if (sacc == 1.2345e37f) WSP(float, WS_SLOTW)[0] = sacc;
        }
    }
#undef IN
#undef SEAM
#undef WSP
}

extern "C" void kernel_launch(void* const* d_in, const int* in_sizes, int n_in, void* d_out, int out_size, void* d_ws, size_t ws_size, hipStream_t stream) {
    static int grid = 0;
    if (grid == 0) {
        if (n_in != 22 || out_size != MTOK * DM || ws_size < WS_END) { fprintf(stderr, "kernel_launch: unexpected shapes (n_in %d out %d ws %zu, need %zu)\n", n_in, out_size, ws_size, (size_t)WS_END); grid = -1; return; }
        int dev = 0, cus = 0;
        if (hipGetDevice(&dev) != hipSuccess || hipDeviceGetAttribute(&cus, hipDeviceAttributeMultiprocessorCount, dev) != hipSuccess) { grid = -1; return; }
        if (hipFuncSetAttribute((const void*)mk_fwd, hipFuncAttributeMaxDynamicSharedMemorySize, LDS_BYTES) != hipSuccess) { fprintf(stderr, "kernel_launch: hipFuncSetAttribute failed\n"); grid = -1; return; }
        int per_cu = 0;
        if (hipOccupancyMaxActiveBlocksPerMultiprocessor(&per_cu, (const void*)mk_fwd, 512, LDS_BYTES) != hipSuccess || per_cu < 1) fprintf(stderr, "kernel_launch: occupancy query reports %d\n", per_cu);
        (void)hipGetLastError();
        if (cus < 256) { fprintf(stderr, "kernel_launch: needs >= 256 CUs, got %d\n", cus); grid = -1; return; }
        grid = cus;
    }
    if (grid < 0) return;
    (void)hipMemsetAsync((char*)d_ws + WS_CTL, 0, CTL_ZERO_BYTES, stream);
    Args a{};
    for (int i = 0; i < 22; ++i) a.in[i] = d_in[i];
    a.out = (float*)d_out; a.ws = (unsigned char*)d_ws;
#if MK_PER_PHASE
    for (int p = 0; p < N_PHASES; ++p) {
        if (p >= 1 && p <= 32) { const int L = (p - 1) / 8, k = (p - 1) % 8; if (k == 5) continue; (void)L; }
        a.ph_lo = p; a.ph_hi = p + 1;
        hipLaunchKernelGGL(mk_fwd, dim3(grid), dim3(512), LDS_BYTES, stream, a);
    }
#else
    a.ph_lo = 0; a.ph_hi = N_PHASES;
    hipLaunchKernelGGL(mk_fwd, dim3(grid), dim3(512), LDS_BYTES, stream, a);
#endif
}
```
